# Optimizing an MI355X kernel written in HIP

```python
import math
import jax
import jax.numpy as jnp
from jax import lax
import numpy as np

D_MODEL = 1024
BATCH = 8
SEQ = 2048
DEPTH = 2

N_EVEN = (DEPTH + 1) // 2
N_ODD = DEPTH // 2
CHUNK = 64
NORM_EPS = 1e-6
RW_HEADS = 8
RW_HEAD_DIM = 64
RW_DIM = RW_HEADS * RW_HEAD_DIM
R_DECAY = 64
R_AAA = 64
R_GATE = 128
RW_IN = 3 * RW_DIM + R_DECAY + R_AAA + R_GATE
RW_LN_EPS = 64e-5
HG_HEADS = 8
HG_KEY_DIM = 64
HG_VAL_DIM = 64
HG_KDIM = HG_HEADS * HG_KEY_DIM
HG_VDIM = HG_HEADS * HG_VAL_DIM
HG_IN = 2 * HG_KDIM + 2 * HG_VDIM
EVEN_IN = RW_IN + HG_IN
EVEN_MIX = RW_DIM + HG_VDIM
GD_HEADS = 4
GD_HEAD_DIM = 128
GD_DIM = GD_HEADS * GD_HEAD_DIM
CONV_K = 4
GD_IN = 4 * GD_DIM + 2 * GD_HEADS
ML_HEADS = 4
ML_HEAD_DIM = 128
ML_DIM = ML_HEADS * ML_HEAD_DIM
ML_IN = 4 * ML_DIM + 2 * ML_HEADS
ODD_IN = GD_IN + ML_IN
ODD_MIX = GD_DIM + ML_DIM
N_GROUPS = 4
EXPERTS_PER_GROUP = 8
N_EXPERTS = N_GROUPS * EXPERTS_PER_GROUP
TOP_K_FINE = 2
D_EXPERT = 256

kernel_name = 'hybrid_rwkv7_hgrn2_gdn_mlstm_hmoe'


def _rms(x, g, eps=NORM_EPS):
    xf = x.astype(jnp.float32)
    y = xf * lax.rsqrt(jnp.mean(xf * xf, axis=-1, keepdims=True) + eps)
    return (y * g.astype(jnp.float32)).astype(x.dtype)


def _l2n(t):
    return t * lax.rsqrt(jnp.sum(t * t, axis=-1, keepdims=True) + 1e-6)


def _heads(t, h):
    return t.reshape(t.shape[:-1] + (h, t.shape[-1] // h))


def _shift(t):
    return jnp.pad(t[:, :-1], ((0, 0), (1, 0), (0, 0)))


def _to_chunks(t):
    b, s, h = t.shape[:3]
    t = t.reshape((b, s // CHUNK, CHUNK, h) + t.shape[3:])
    return jnp.moveaxis(t, (1, 3), (0, 2))


def _from_chunks(t):
    t = jnp.moveaxis(t, (0, 2), (1, 3))
    return t.reshape((t.shape[0], t.shape[1] * t.shape[2]) + t.shape[3:])


def _causal_conv(t, w):
    k = w.shape[0]
    n = t.shape[1]
    tp = jnp.pad(t, ((0, 0), (k - 1, 0), (0, 0)))
    y = tp[:, 0:n] * w[0]
    for j in range(1, k):
        y = y + tp[:, j:j + n] * w[j]
    return y


def _rwkv7_mix(p, mu, w0, w2, a0, a2, g2, k_k, k_a, r_k, ln_w, ln_b):
    bsz, n, _ = p.shape
    p = p + mu * (_shift(p) - p)
    r = p[..., :RW_DIM]
    k = p[..., RW_DIM:2 * RW_DIM]
    v = p[..., 2 * RW_DIM:3 * RW_DIM]
    o1 = 3 * RW_DIM
    wl = p[..., o1:o1 + R_DECAY]
    al = p[..., o1 + R_DECAY:o1 + R_DECAY + R_AAA]
    gl = p[..., o1 + R_DECAY + R_AAA:]
    w = -jax.nn.softplus(-(w0 + jnp.tanh(wl) @ w2)) - 0.5
    decay = jnp.exp(-jnp.exp(w))
    a = jax.nn.sigmoid(a0 + al @ a2)
    g = jax.nn.sigmoid(gl) @ g2
    kk = _l2n(_heads(k * k_k, RW_HEADS))
    k = k * (1.0 + (a - 1.0) * k_a)
    rh, kh, vh, ah, wh = (_heads(t, RW_HEADS) for t in (r, k, v, a, decay))

    def step(s, inp):
        r_t, w_t, k_t, v_t, kk_t, a_t = inp
        sa = jnp.einsum('bhvk,bhk->bhv', s, -kk_t)
        s = s * w_t[:, :, None, :] + sa[..., None] * (kk_t * a_t)[:, :, None, :] + v_t[..., None] * k_t[:, :, None, :]
        return s, jnp.einsum('bhvk,bhk->bhv', s, r_t)

    tm = lambda t: jnp.moveaxis(t, 1, 0)
    s0 = jnp.zeros((bsz, RW_HEADS, RW_HEAD_DIM, RW_HEAD_DIM), jnp.float32)
    _, y = lax.scan(step, s0, (tm(rh), tm(wh), tm(kh), tm(vh), tm(kk), tm(ah)))
    y = jnp.moveaxis(y, 0, 1)
    mean = jnp.mean(y, axis=-1, keepdims=True)
    var = jnp.mean(jnp.square(y - mean), axis=-1, keepdims=True)
    y = ((y - mean) * lax.rsqrt(var + RW_LN_EPS)).reshape(bsz, n, RW_DIM) * ln_w + ln_b
    bonus = jnp.sum(rh * kh * r_k, axis=-1, keepdims=True) * vh
    return (y + bonus.reshape(bsz, n, RW_DIM)) * g


def _chunk_gla(q, k, v, logf):
    q, k, v, logf = (_to_chunks(t) for t in (q, k, v, logf))
    bcum = jnp.cumsum(logf, axis=-2)
    incl = jnp.tril(jnp.ones((CHUNK, CHUNK), dtype=bool))[:, :, None]

    def step(s, inp):
        qc, kc, vc, bc = inp
        b_last = bc[..., -1, :]
        o_inter = jnp.einsum('bhtd,bhdv->bhtv', qc * jnp.exp(bc), s)
        dec = jnp.exp(jnp.where(incl, bc[..., :, None, :] - bc[..., None, :, :], -jnp.inf))
        attn = jnp.einsum('bhtd,bhsd,bhtsd->bhts', qc, kc, dec)
        o = o_inter + attn @ vc
        s = jnp.exp(b_last)[..., None] * s + jnp.einsum('bhsd,bhsv->bhdv', kc * jnp.exp(b_last[..., None, :] - bc), vc)
        return s, o

    bsz, h = q.shape[1], q.shape[2]
    s0 = jnp.zeros((bsz, h, q.shape[-1], v.shape[-1]), jnp.float32)
    _, o = lax.scan(step, s0, (q, k, v, bcum))
    return _from_chunks(o)


def _hgrn2_mix(p, lb, norm_g):
    bsz, n, _ = p.shape
    q = jax.nn.silu(p[..., :HG_KDIM])
    f = p[..., HG_KDIM:2 * HG_KDIM]
    i = p[..., 2 * HG_KDIM:2 * HG_KDIM + HG_VDIM]
    g = p[..., 2 * HG_KDIM + HG_VDIM:]
    fg = lb + (1.0 - lb) * jax.nn.sigmoid(f)
    o = _chunk_gla(_heads(q, HG_HEADS), _heads(1.0 - fg, HG_HEADS), _heads(i, HG_HEADS), _heads(jnp.log(fg), HG_HEADS))
    o = _rms(o, norm_g).reshape(bsz, n, HG_VDIM)
    return o * jax.nn.silu(g)


def _chunk_gated_delta(q, k, v, g, beta):
    q, k, v, g, beta = (_to_chunks(t) for t in (q, k, v, g, beta))
    gam = jnp.cumsum(g, axis=-1)
    incl = jnp.tril(jnp.ones((CHUNK, CHUNK), dtype=bool))
    strict = jnp.tril(jnp.ones((CHUNK, CHUNK), dtype=bool), -1)
    decay = jnp.exp(jnp.where(incl, gam[..., :, None] - gam[..., None, :], -jnp.inf))
    k_beta = k * beta[..., None]
    m = jnp.where(strict, jnp.einsum('...td,...sd->...ts', k_beta, k) * decay, 0.0)
    eye = jnp.eye(CHUNK, dtype=m.dtype)
    tinv = lax.linalg.triangular_solve(eye + m, jnp.broadcast_to(eye, m.shape), left_side=True, lower=True, unit_diagonal=True)
    u = tinv @ (v * beta[..., None])
    w = tinv @ (k_beta * jnp.exp(gam)[..., None])
    attn = jnp.einsum('...td,...sd->...ts', q, k) * decay
    q_dec = q * jnp.exp(gam)[..., None]
    k_dec = k * jnp.exp(gam[..., -1:] - gam)[..., None]
    g_last = jnp.exp(gam[..., -1])

    def step(s, inp):
        u_c, w_c, a_c, qd, kd, gl = inp
        v_new = u_c - w_c @ s
        o = qd @ s + a_c @ v_new
        s = s * gl[..., None, None] + jnp.einsum('bhsd,bhsv->bhdv', kd, v_new)
        return s, o

    s0 = jnp.zeros((q.shape[1], q.shape[2], q.shape[-1], v.shape[-1]), jnp.float32)
    _, o = lax.scan(step, s0, (u, w, attn, q_dec, k_dec, g_last))
    return _from_chunks(o)


def _gdn_mix(p, conv_w, a_log, dt_bias, norm_g):
    bsz, n, _ = p.shape
    qkv = jax.nn.silu(_causal_conv(p[..., :3 * GD_DIM], conv_w))
    q = _l2n(_heads(qkv[..., :GD_DIM], GD_HEADS)) * GD_HEAD_DIM ** -0.5
    k = _l2n(_heads(qkv[..., GD_DIM:2 * GD_DIM], GD_HEADS))
    v = _heads(qkv[..., 2 * GD_DIM:], GD_HEADS)
    z = p[..., 3 * GD_DIM:4 * GD_DIM]
    beta = jax.nn.sigmoid(p[..., 4 * GD_DIM:4 * GD_DIM + GD_HEADS])
    g = -jnp.exp(a_log) * jax.nn.softplus(p[..., 4 * GD_DIM + GD_HEADS:] + dt_bias)
    o = _chunk_gated_delta(q, k, v, g, beta)
    o = _rms(o, norm_g).reshape(bsz, n, GD_DIM)
    return o * jax.nn.silu(z)


def _chunk_mlstm(q, k, v, ig, logf):
    q, k, v, ig, logf = (_to_chunks(t) for t in (q, k, v, ig, logf))
    bcum = jnp.cumsum(logf, axis=-1)
    incl = jnp.tril(jnp.ones((CHUNK, CHUNK), dtype=bool))

    def step(carry, inp):
        c, nvec, m = carry
        qc, kc, vc, igc, bc = inp
        b_last = bc[..., -1]
        d_log = jnp.where(incl, bc[..., :, None] - bc[..., None, :] + igc[..., None, :], -jnp.inf)
        inter_log = bc + m[..., None]
        m_t = jnp.maximum(inter_log, jnp.max(d_log, axis=-1))
        d_w = jnp.exp(d_log - m_t[..., None])
        inter_w = jnp.exp(inter_log - m_t)
        sc = jnp.einsum('bhtd,bhsd->bhts', qc, kc) * d_w
        num = inter_w[..., None] * jnp.einsum('bhtd,bhdv->bhtv', qc, c) + sc @ vc
        den = inter_w * jnp.einsum('bhtd,bhd->bht', qc, nvec) + jnp.sum(sc, axis=-1)
        h = num / jnp.maximum(jnp.abs(den), jnp.exp(-m_t))[..., None]
        upd_log = b_last[..., None] - bc + igc
        m_new = jnp.maximum(b_last + m, jnp.max(upd_log, axis=-1))
        w_s = jnp.exp(upd_log - m_new[..., None])
        dec = jnp.exp(b_last + m - m_new)
        c = dec[..., None, None] * c + jnp.einsum('bhs,bhsd,bhsv->bhdv', w_s, kc, vc)
        nvec = dec[..., None] * nvec + jnp.einsum('bhs,bhsd->bhd', w_s, kc)
        return (c, nvec, m_new), h

    bsz, h = q.shape[1], q.shape[2]
    c0 = jnp.zeros((bsz, h, q.shape[-1], v.shape[-1]), jnp.float32)
    n0 = jnp.zeros((bsz, h, q.shape[-1]), jnp.float32)
    m0 = jnp.zeros((bsz, h), jnp.float32)
    _, o = lax.scan(step, (c0, n0, m0), (q, k, v, ig, bcum))
    return _from_chunks(o)


def _mlstm_mix(p, i_bias, f_bias, norm_g):
    bsz, n, _ = p.shape
    q = _heads(p[..., :ML_DIM], ML_HEADS)
    k = _heads(p[..., ML_DIM:2 * ML_DIM], ML_HEADS) * ML_HEAD_DIM ** -0.5
    v = _heads(p[..., 2 * ML_DIM:3 * ML_DIM], ML_HEADS)
    o_gate = jax.nn.sigmoid(p[..., 3 * ML_DIM:4 * ML_DIM])
    ig = p[..., 4 * ML_DIM:4 * ML_DIM + ML_HEADS] + i_bias
    logf = jax.nn.log_sigmoid(p[..., 4 * ML_DIM + ML_HEADS:] + f_bias)
    h = _chunk_mlstm(q, k, v, ig, logf)
    h = _rms(h, norm_g.reshape(ML_HEADS, ML_HEAD_DIM)).reshape(bsz, n, ML_DIM)
    return o_gate * h


def _hmoe(x, w_group, b_group, w_router, b_router, w_gate, w_up, w_down):
    bsz, n, d = x.shape
    xt = x.reshape(-1, d)
    ntok = xt.shape[0]
    grp_logits = (xt @ w_group).astype(jnp.float32) + b_group.astype(jnp.float32)
    p_grp = jax.nn.softmax(grp_logits, axis=-1)
    p_top, g_idx = lax.top_k(p_grp, 1)
    fine = ((xt @ w_router).astype(jnp.float32) + b_router.astype(jnp.float32)).reshape(ntok, N_GROUPS, EXPERTS_PER_GROUP)
    fine_sel = fine[jnp.arange(ntok), g_idx[:, 0]]
    f_val, f_idx = lax.top_k(fine_sel, TOP_K_FINE)
    gate = p_top * jax.nn.softmax(f_val, axis=-1)
    eid = g_idx * EXPERTS_PER_GROUP + f_idx
    combine = jnp.sum(jax.nn.one_hot(eid, N_EXPERTS, dtype=jnp.float32) * gate[..., None], axis=1)
    y = jnp.zeros((ntok, d), jnp.float32)
    for grp in range(N_GROUPS):
        sl = slice(grp * EXPERTS_PER_GROUP, (grp + 1) * EXPERTS_PER_GROUP)
        hid = jax.nn.silu(jnp.einsum('nd,edf->nef', xt, w_gate[sl])) * jnp.einsum('nd,edf->nef', xt, w_up[sl])
        hid = hid * combine[:, sl, None].astype(hid.dtype)
        y = y + jnp.einsum('nef,efd->nd', hid, w_down[sl]).astype(jnp.float32)
    return y.reshape(bsz, n, d)


def setup_inputs(seed: int = 0) -> dict:
    key = jax.random.key(seed)
    keys = iter(jax.random.split(key, 48))
    f32 = jnp.float32

    def nrm(shape, scale):
        return jax.random.normal(next(keys), shape, f32) * scale

    def unif(shape, lo, hi):
        return jax.random.uniform(next(keys), shape, f32, lo, hi)

    ne, no = N_EVEN, N_ODD
    x = nrm((BATCH, SEQ, D_MODEL), 1.0)
    norm_mix = 1.0 + nrm((DEPTH, D_MODEL), 0.05)
    norm_ffn = 1.0 + nrm((DEPTH, D_MODEL), 0.05)
    norm_final = 1.0 + nrm((D_MODEL,), 0.05)
    ev_w_in = nrm((ne, D_MODEL, EVEN_IN), D_MODEL ** -0.5)
    ev_mu = unif((ne, RW_IN), 0.0, 1.0)
    rw_w0 = -1.0 + nrm((ne, RW_DIM), 0.5)
    rw_w2 = nrm((ne, R_DECAY, RW_DIM), 0.5 * R_DECAY ** -0.5)
    rw_a0 = nrm((ne, RW_DIM), 0.1)
    rw_a2 = nrm((ne, R_AAA, RW_DIM), 0.5 * R_AAA ** -0.5)
    rw_g2 = nrm((ne, R_GATE, RW_DIM), R_GATE ** -0.5)
    rw_k_k = 0.85 + nrm((ne, RW_DIM), 0.05)
    rw_k_a = 1.0 + nrm((ne, RW_DIM), 0.05)
    rw_r_k = nrm((ne, RW_HEADS, RW_HEAD_DIM), 0.1)
    rw_ln_w = 1.0 + nrm((ne, RW_DIM), 0.05)
    rw_ln_b = nrm((ne, RW_DIM), 0.02)
    hg_lb_logits = nrm((ne + 1, HG_KDIM), 0.5)
    hg_norm = 1.0 + nrm((ne, HG_VAL_DIM), 0.05)
    ev_w_out = nrm((ne, EVEN_MIX, D_MODEL), EVEN_MIX ** -0.5)
    od_w_in = nrm((no, D_MODEL, ODD_IN), D_MODEL ** -0.5)
    gd_conv = nrm((no, CONV_K, 3 * GD_DIM), CONV_K ** -0.5)
    gd_a_log = jnp.log(unif((no, GD_HEADS), 1.0, 16.0))
    dt = jnp.exp(unif((no, GD_HEADS), math.log(1e-3), math.log(1e-1)))
    gd_dt_bias = dt + jnp.log(-jnp.expm1(-dt))
    gd_norm = 1.0 + nrm((no, GD_HEAD_DIM), 0.05)
    ml_i_bias = nrm((no, ML_HEADS), 0.1)
    ml_f_bias = jnp.linspace(3.0, 6.0, ML_HEADS, dtype=f32) + nrm((no, ML_HEADS), 0.1)
    ml_norm = 1.0 + nrm((no, ML_DIM), 0.05)
    od_w_out = nrm((no, ODD_MIX, D_MODEL), ODD_MIX ** -0.5)
    moe_w_group = nrm((DEPTH, D_MODEL, N_GROUPS), D_MODEL ** -0.5)
    moe_b_group = nrm((DEPTH, N_GROUPS), 0.01)
    moe_w_router = nrm((DEPTH, D_MODEL, N_EXPERTS), D_MODEL ** -0.5)
    moe_b_router = nrm((DEPTH, N_EXPERTS), 0.01)
    moe_w_gate = nrm((DEPTH, N_EXPERTS, D_MODEL, D_EXPERT), D_MODEL ** -0.5)
    moe_w_up = nrm((DEPTH, N_EXPERTS, D_MODEL, D_EXPERT), D_MODEL ** -0.5)
    moe_w_down = nrm((DEPTH, N_EXPERTS, D_EXPERT, D_MODEL), D_EXPERT ** -0.5)
    return {'x': x, 'norm_mix': norm_mix, 'norm_ffn': norm_ffn, 'norm_final': norm_final,
            'ev_w_in': ev_w_in, 'ev_mu': ev_mu, 'rw_w0': rw_w0, 'rw_w2': rw_w2, 'rw_a0': rw_a0,
            'rw_a2': rw_a2, 'rw_g2': rw_g2, 'rw_k_k': rw_k_k, 'rw_k_a': rw_k_a, 'rw_r_k': rw_r_k,
            'rw_ln_w': rw_ln_w, 'rw_ln_b': rw_ln_b, 'hg_lb_logits': hg_lb_logits, 'hg_norm': hg_norm,
            'ev_w_out': ev_w_out, 'od_w_in': od_w_in, 'gd_conv': gd_conv, 'gd_a_log': gd_a_log,
            'gd_dt_bias': gd_dt_bias, 'gd_norm': gd_norm, 'ml_i_bias': ml_i_bias, 'ml_f_bias': ml_f_bias,
            'ml_norm': ml_norm, 'od_w_out': od_w_out, 'moe_w_group': moe_w_group, 'moe_b_group': moe_b_group,
            'moe_w_router': moe_w_router, 'moe_b_router': moe_b_router, 'moe_w_gate': moe_w_gate,
            'moe_w_up': moe_w_up, 'moe_w_down': moe_w_down}


def reference(x, norm_mix, norm_ffn, norm_final, ev_w_in, ev_mu, rw_w0, rw_w2, rw_a0, rw_a2, rw_g2,
              rw_k_k, rw_k_a, rw_r_k, rw_ln_w, rw_ln_b, hg_lb_logits, hg_norm, ev_w_out, od_w_in,
              gd_conv, gd_a_log, gd_dt_bias, gd_norm, ml_i_bias, ml_f_bias, ml_norm, od_w_out,
              moe_w_group, moe_b_group, moe_w_router, moe_b_router, moe_w_gate, moe_w_up, moe_w_down):
    lb_table = jnp.cumsum(jax.nn.softmax(hg_lb_logits.astype(jnp.float32), axis=0), axis=0)
    h = x
    for layer in range(DEPTH):
        hn = _rms(h, norm_mix[layer])
        j = layer // 2
        if layer % 2 == 0:
            p = jnp.matmul(hn, ev_w_in[j]).astype(jnp.float32)
            ya = _rwkv7_mix(p[..., :RW_IN], ev_mu[j], rw_w0[j], rw_w2[j], rw_a0[j], rw_a2[j], rw_g2[j],
                            rw_k_k[j], rw_k_a[j], rw_r_k[j], rw_ln_w[j], rw_ln_b[j])
            yb = _hgrn2_mix(p[..., RW_IN:], lb_table[j], hg_norm[j])
            mix = jnp.matmul(jnp.concatenate([ya, yb], axis=-1), ev_w_out[j])
        else:
            p = jnp.matmul(hn, od_w_in[j]).astype(jnp.float32)
            yc = _gdn_mix(p[..., :GD_IN], gd_conv[j], gd_a_log[j], gd_dt_bias[j], gd_norm[j])
            yd = _mlstm_mix(p[..., GD_IN:], ml_i_bias[j], ml_f_bias[j], ml_norm[j])
            mix = jnp.matmul(jnp.concatenate([yc, yd], axis=-1), od_w_out[j])
        h = h + mix.astype(h.dtype)
        ffn = _hmoe(_rms(h, norm_ffn[layer]), moe_w_group[layer], moe_b_group[layer], moe_w_router[layer],
                    moe_b_router[layer], moe_w_gate[layer], moe_w_up[layer], moe_w_down[layer])
        h = h + ffn.astype(h.dtype)
    return _rms(h, norm_final)
```

```cpp
#include <hip/hip_runtime.h>
#include <stdint.h>
#include <stdio.h>

#ifndef SINGLE_LAUNCH
#define SINGLE_LAUNCH 0
#endif

typedef unsigned short bf16_t;
typedef short bf16x8 __attribute__((ext_vector_type(8)));
typedef float f32x16 __attribute__((ext_vector_type(16)));
typedef float f32x4 __attribute__((ext_vector_type(4)));
typedef unsigned u32x4 __attribute__((ext_vector_type(4)));
typedef unsigned u32x2 __attribute__((ext_vector_type(2)));

#define NT 512
constexpr int D = 1024, NBATCH = 8, SEQ = 2048, M = NBATCH * SEQ;
constexpr int EVEN_IN = 3840, ODD_SRC = 4112, ODD_IN = 4096;
constexpr int NPHASE = 17;
constexpr int LDS_BYTES = 144 * 1024;

constexpr size_t WS_CTL = 0;
constexpr size_t WS_WIN0 = 65536;
constexpr size_t WS_WOUT0 = WS_WIN0 + (size_t)EVEN_IN * D * 2;
constexpr size_t WS_WIN1 = WS_WOUT0 + (size_t)D * D * 2;
constexpr size_t WS_WOUT1 = WS_WIN1 + (size_t)ODD_IN * D * 2;
constexpr size_t WS_WGU = WS_WOUT1 + (size_t)D * D * 2;
constexpr size_t WS_WD = WS_WGU + (size_t)2 * 32 * 512 * 1024 * 2;
constexpr size_t WS_XN = WS_WD + (size_t)2 * 32 * 1024 * 256 * 2;
constexpr size_t WS_P = WS_XN + (size_t)M * D * 2;
constexpr size_t WS_LTOK = WS_P + (size_t)M * 4096 * 2;
constexpr size_t WS_LGATE = WS_LTOK + (size_t)32 * M * 4;
constexpr size_t WS_GATES = WS_LGATE + (size_t)32 * M * 4;
constexpr size_t WS_END = WS_GATES + (size_t)M * 16 * 4;
constexpr size_t P_HID = 0;
constexpr size_t P_Y = (size_t)32 * 1024 * 1024;
constexpr int CTL_CNT = 0;
constexpr int CTL_BAR = 1024;

struct Params {
    const float* x; const float* norm_mix; const float* norm_ffn; const float* norm_final;
    const float* ev_w_in; const float* ev_mu; const float* rw_w0; const float* rw_w2; const float* rw_a0; const float* rw_a2; const float* rw_g2;
    const float* rw_k_k; const float* rw_k_a; const float* rw_r_k; const float* rw_ln_w; const float* rw_ln_b; const float* hg_lb; const float* hg_norm;
    const float* ev_w_out; const float* od_w_in; const float* gd_conv; const float* gd_a_log; const float* gd_dt_bias; const float* gd_norm;
    const float* ml_i_bias; const float* ml_f_bias; const float* ml_norm; const float* od_w_out;
    const float* moe_w_group; const float* moe_b_group; const float* moe_w_router; const float* moe_b_router;
    const float* moe_w_gate; const float* moe_w_up; const float* moe_w_down;
    float* out; unsigned char* ws;
    int ph_lo, ph_hi;
};

__device__ __forceinline__ float bf2f(unsigned short u) { return __uint_as_float(((unsigned)u) << 16); }
__device__ __forceinline__ unsigned short f2bf(float f) { unsigned u = __float_as_uint(f); u += 0x7fffu + ((u >> 16) & 1u); return (unsigned short)(u >> 16); }
__device__ __forceinline__ unsigned pack2(float a, float b) { return (unsigned)f2bf(a) | ((unsigned)f2bf(b) << 16); }
__device__ __forceinline__ float lo16(unsigned u) { return __uint_as_float(u << 16); }
__device__ __forceinline__ float hi16(unsigned u) { return __uint_as_float(u & 0xffff0000u); }
__device__ __forceinline__ float sigmoidf_(float x) { return 1.0f / (1.0f + __expf(-x)); }
__device__ __forceinline__ float siluf_(float x) { return x / (1.0f + __expf(-x)); }
__device__ __forceinline__ float softplusf_(float x) { return x > 20.f ? x : log1pf(__expf(x)); }

template <int CTRL> __device__ __forceinline__ float dppf(float x) {
    return __int_as_float(__builtin_amdgcn_update_dpp(0, __float_as_int(x), CTRL, 0xF, 0xF, false));
}
__device__ __forceinline__ float red16(float x) {
    x += dppf<0xB1>(x);
    x += dppf<0x4E>(x);
    x += dppf<0x141>(x);
    x += dppf<0x140>(x);
    return x;
}
__device__ __forceinline__ float red64(float x) {
    x = red16(x);
    x += __shfl_xor(x, 16);
    x += __shfl_xor(x, 32);
    return x;
}

__device__ __forceinline__ void conv_tile(float* tile, const float* s0, const float* s1, size_t ld, bf16_t* d, size_t ldd) {
    const int tid = threadIdx.x;
#pragma unroll
    for (int i = 0; i < 2; ++i) {
        const int k = (tid >> 4) + 32 * i, nn = (tid & 15) * 4;
        const float* s = nn < 32 ? s0 + (size_t)k * ld + nn : s1 + (size_t)k * ld + (nn - 32);
        const float4 v = *(const float4*)s;
        float* t = tile + k * 65 + nn;
        t[0] = v.x; t[1] = v.y; t[2] = v.z; t[3] = v.w;
    }
    __syncthreads();
    const int n = tid >> 3, kc = (tid & 7) * 8;
    float f0 = tile[(kc + 0) * 65 + n], f1 = tile[(kc + 1) * 65 + n], f2 = tile[(kc + 2) * 65 + n], f3 = tile[(kc + 3) * 65 + n];
    float f4 = tile[(kc + 4) * 65 + n], f5 = tile[(kc + 5) * 65 + n], f6 = tile[(kc + 6) * 65 + n], f7 = tile[(kc + 7) * 65 + n];
    u32x4 o; o.x = pack2(f0, f1); o.y = pack2(f2, f3); o.z = pack2(f4, f5); o.w = pack2(f6, f7);
    *(u32x4*)(d + (size_t)n * ldd + kc) = o;
    __syncthreads();
}

__device__ __forceinline__ void phase_convert(const Params& p, char* lds) {
    float* tile = (float*)lds;
    unsigned char* ws = p.ws;
    const int total = 960 + 256 + 1024 + 256 + 8192 + 4096;
    for (int g0 = blockIdx.x; g0 < total; g0 += gridDim.x) {
        int g = g0;
        if (g < 960) { const int kt = g & 15, nt = g >> 4;
            const float* s0 = p.ev_w_in + (size_t)(kt * 64) * EVEN_IN + nt * 64;
            conv_tile(tile, s0, s0 + 32, EVEN_IN, (bf16_t*)(ws + WS_WIN0) + (size_t)(nt * 64) * D + kt * 64, D); continue; }
        g -= 960;
        if (g < 256) { const int kt = g & 15, nt = g >> 4;
            const float* s0 = p.ev_w_out + (size_t)(kt * 64) * D + nt * 64;
            conv_tile(tile, s0, s0 + 32, D, (bf16_t*)(ws + WS_WOUT0) + (size_t)(nt * 64) * D + kt * 64, D); continue; }
        g -= 256;
        if (g < 1024) { const int kt = g & 15, nt = g >> 4;
            const float* s0 = p.od_w_in + (size_t)(kt * 64) * ODD_SRC + nt * 64 + (nt >= 32 ? 8 : 0);
            conv_tile(tile, s0, s0 + 32, ODD_SRC, (bf16_t*)(ws + WS_WIN1) + (size_t)(nt * 64) * D + kt * 64, D); continue; }
        g -= 1024;
        if (g < 256) { const int kt = g & 15, nt = g >> 4;
            const float* s0 = p.od_w_out + (size_t)(kt * 64) * D + nt * 64;
            conv_tile(tile, s0, s0 + 32, D, (bf16_t*)(ws + WS_WOUT1) + (size_t)(nt * 64) * D + kt * 64, D); continue; }
        g -= 256;
        if (g < 8192) { const int le = g >> 7, r = g & 127, kt = r & 15, s = r >> 4;
            const size_t so = (size_t)le * 1024 * 256 + (size_t)(kt * 64) * 256 + s * 32;
            conv_tile(tile, p.moe_w_gate + so, p.moe_w_up + so, 256, (bf16_t*)(ws + WS_WGU) + (size_t)le * 512 * 1024 + (size_t)(s * 64) * 1024 + kt * 64, 1024); continue; }
        g -= 8192;
        { const int le = g >> 6, r = g & 63, kt = r & 3, nt = r >> 2;
            const float* s0 = p.moe_w_down + (size_t)le * 256 * 1024 + (size_t)(kt * 64) * 1024 + nt * 64;
            conv_tile(tile, s0, s0 + 32, 1024, (bf16_t*)(ws + WS_WD) + (size_t)le * 1024 * 256 + (size_t)(nt * 64) * 256 + kt * 64, 256); }
    }
}

template <int MODE>
__device__ __forceinline__ void phase_rows(const Params& p, char* lds, int layer) {
    const int tid = threadIdx.x, lane = tid & 63, wave = tid >> 6;
    unsigned char* ws = p.ws;
    const float* src = (MODE == 0) ? p.x : p.out;
    const float* gain = (MODE == 0) ? p.norm_mix : (MODE == 1) ? p.norm_ffn + layer * D : (MODE == 2) ? p.norm_mix + D : p.norm_final;
    bf16_t* XN = (bf16_t*)(ws + WS_XN);
    const bf16_t* Y0 = (const bf16_t*)(ws + WS_P + P_Y);
    const bf16_t* Y1 = Y0 + (size_t)M * D;
    float* rstd_s = (float*)lds;
    float* Ht = (float*)(lds + 1024);
    float* Wt = Ht + 64 * 132;
    float* lg = Wt + 40 * 132;
    constexpr int NO = (MODE == 1) ? 5 : 2;
    constexpr int NOUT = (MODE == 1) ? 36 : 16;
    for (int grp = blockIdx.x; grp < M / 64; grp += gridDim.x) {
        const int t0 = grp * 64;
        for (int q = 0; q < 8; ++q) {
            const int tl = wave * 8 + q, tok = t0 + tl;
            float4 v[4];
#pragma unroll
            for (int i = 0; i < 4; ++i) v[i] = *(const float4*)(src + (size_t)tok * D + i * 256 + lane * 4);
            if (MODE == 2 || MODE == 3) {
#pragma unroll
                for (int i = 0; i < 4; ++i) {
                    const u32x2 a = *(const u32x2*)(Y0 + (size_t)tok * D + i * 256 + lane * 4);
                    const u32x2 b = *(const u32x2*)(Y1 + (size_t)tok * D + i * 256 + lane * 4);
                    v[i].x += lo16(a.x) + lo16(b.x); v[i].y += hi16(a.x) + hi16(b.x); v[i].z += lo16(a.y) + lo16(b.y); v[i].w += hi16(a.y) + hi16(b.y);
                }
            }
            float ss = 0.f;
#pragma unroll
            for (int i = 0; i < 4; ++i) ss += v[i].x * v[i].x + v[i].y * v[i].y + v[i].z * v[i].z + v[i].w * v[i].w;
            ss = red64(ss);
            const float rstd = rsqrtf(ss * (1.0f / D) + 1e-6f);
            if (lane == 0) rstd_s[tl] = rstd;
#pragma unroll
            for (int i = 0; i < 4; ++i) {
                const float4 g4 = *(const float4*)(gain + i * 256 + lane * 4);
                if (MODE == 2) *(float4*)(p.out + (size_t)tok * D + i * 256 + lane * 4) = v[i];
                const float o0 = v[i].x * rstd * g4.x, o1 = v[i].y * rstd * g4.y, o2 = v[i].z * rstd * g4.z, o3 = v[i].w * rstd * g4.w;
                if (MODE == 3) { float4 o; o.x = o0; o.y = o1; o.z = o2; o.w = o3; *(float4*)(p.out + (size_t)tok * D + i * 256 + lane * 4) = o; }
                else { u32x2 o; o.x = pack2(o0, o1); o.y = pack2(o2, o3); *(u32x2*)(XN + (size_t)tok * D + i * 256 + lane * 4) = o; }
            }
        }
        if (MODE == 1 || MODE == 2) {
            float acc[NO];
#pragma unroll
            for (int o = 0; o < NO; ++o) acc[o] = 0.f;
            const int btok = tid & 63, og = tid >> 6;
            for (int dc = 0; dc < 8; ++dc) {
                __syncthreads();
                {
                    const int tk = tid >> 3, part = tid & 7;
#pragma unroll
                    for (int q = 0; q < 4; ++q) {
                        const float4 h = *(const float4*)(p.out + (size_t)(t0 + tk) * D + dc * 128 + part * 16 + q * 4);
                        *(float4*)(Ht + tk * 132 + part * 16 + q * 4) = h;
                    }
                }
                for (int idx = tid; idx < 128 * 40; idx += NT) {
                    const int d = idx & 127, o = idx >> 7, dd = dc * 128 + d;
                    float w = 0.f;
                    if (MODE == 1) {
                        if (o < 4) w = p.moe_w_group[(size_t)layer * D * 4 + dd * 4 + o];
                        else if (o < 36) w = p.moe_w_router[(size_t)layer * D * 32 + dd * 32 + (o - 4)];
                    } else {
                        if (o < 16) w = p.od_w_in[(size_t)dd * ODD_SRC + (o < 8 ? 2048 + o : 4104 + (o - 8))];
                    }
                    Wt[o * 132 + d] = w * gain[dd];
                }
                __syncthreads();
#pragma unroll 4
                for (int d4 = 0; d4 < 32; ++d4) {
                    const float4 h = *(const float4*)(Ht + btok * 132 + d4 * 4);
#pragma unroll
                    for (int o = 0; o < NO; ++o) {
                        const float4 w = *(const float4*)(Wt + (og * NO + o) * 132 + d4 * 4);
                        acc[o] += h.x * w.x + h.y * w.y + h.z * w.z + h.w * w.w;
                    }
                }
            }
            const float rs = rstd_s[btok];
            if (MODE == 2) {
                float* G = (float*)(ws + WS_GATES);
#pragma unroll
                for (int o = 0; o < NO; ++o) G[(size_t)(t0 + btok) * 16 + og * NO + o] = acc[o] * rs;
            } else {
#pragma unroll
                for (int o = 0; o < NO; ++o) { const int oo = og * NO + o;
                    if (oo < NOUT) lg[btok * 40 + oo] = acc[o] * rs + (oo < 4 ? p.moe_b_group[layer * 4 + oo] : p.moe_b_router[layer * 32 + oo - 4]); }
                __syncthreads();
                if (tid < 64) {
                    const float* l = lg + tid * 40;
                    int gi = 0; float gm = l[0];
#pragma unroll
                    for (int j = 1; j < 4; ++j) if (l[j] > gm) { gm = l[j]; gi = j; }
                    float se = 0.f;
#pragma unroll
                    for (int j = 0; j < 4; ++j) se += __expf(l[j] - gm);
                    const float ptop = 1.0f / se;
                    const float* f = l + 4 + gi * 8;
                    int i1 = 0; float v1 = f[0];
#pragma unroll
                    for (int j = 1; j < 8; ++j) if (f[j] > v1) { v1 = f[j]; i1 = j; }
                    int i2 = -1; float v2 = -3.0e38f;
#pragma unroll
                    for (int j = 0; j < 8; ++j) if (j != i1 && f[j] > v2) { v2 = f[j]; i2 = j; }
                    const float w1 = 1.0f / (1.0f + __expf(v2 - v1)), w2 = 1.0f - w1;
                    int* cnt = (int*)(ws + WS_CTL) + CTL_CNT + layer * 32;
                    int* ltok = (int*)(ws + WS_LTOK); float* lgate = (float*)(ws + WS_LGATE);
                    const int tok = t0 + tid;
                    const int e1 = gi * 8 + i1, e2 = gi * 8 + i2;
                    const int p1 = atomicAdd(cnt + e1, 1); ltok[(size_t)e1 * M + p1] = tok * 2; lgate[(size_t)e1 * M + p1] = ptop * w1;
                    const int p2 = atomicAdd(cnt + e2, 1); ltok[(size_t)e2 * M + p2] = tok * 2 + 1; lgate[(size_t)e2 * M + p2] = ptop * w2;
                }
            }
        }
        __syncthreads();
    }
}

template <class Epi>
__device__ __forceinline__ void gemm_tile(char* lds, const bf16_t* a0, const bf16_t* a1, const bf16_t* a2, const bf16_t* a3,
                                          const bf16_t* b0, const bf16_t* b1, int nk, Epi& epi) {
    const int tid = threadIdx.x, lane = tid & 63, wave = tid >> 6, wm = wave >> 1, wn = wave & 1;
    const int lr = tid >> 3, lc = tid & 7, lsw = (lr >> 1) & 7;
    const int wofs = lr * 128 + ((lc ^ lsw) * 16);
    f32x16 acc[2][2];
#pragma unroll
    for (int i = 0; i < 2; ++i)
#pragma unroll
        for (int j = 0; j < 2; ++j)
#pragma unroll
            for (int r = 0; r < 16; ++r) acc[i][j][r] = 0.f;
    u32x4 ra0, ra1, ra2, ra3, rb0, rb1;
    ra0 = *(const u32x4*)a0; ra1 = *(const u32x4*)a1; ra2 = *(const u32x4*)a2; ra3 = *(const u32x4*)a3;
    rb0 = *(const u32x4*)b0; rb1 = *(const u32x4*)b1;
    {
        char* st = lds;
        *(u32x4*)(st + wofs) = ra0; *(u32x4*)(st + wofs + 8192) = ra1; *(u32x4*)(st + wofs + 16384) = ra2; *(u32x4*)(st + wofs + 24576) = ra3;
        *(u32x4*)(st + 32768 + wofs) = rb0; *(u32x4*)(st + 32768 + wofs + 8192) = rb1;
    }
    __syncthreads();
    const int fr = lane & 31, fh = lane >> 5, fsw = (fr >> 1) & 7;
    const int aofs = (wm * 64 + fr) * 128, bofs = 32768 + (wn * 64 + fr) * 128;
    for (int kt = 0; kt < nk; ++kt) {
        const char* st = lds + (kt & 1) * 49152;
        if (kt + 1 < nk) {
            const int ko = (kt + 1) * 64;
            ra0 = *(const u32x4*)(a0 + ko); ra1 = *(const u32x4*)(a1 + ko); ra2 = *(const u32x4*)(a2 + ko); ra3 = *(const u32x4*)(a3 + ko);
            rb0 = *(const u32x4*)(b0 + ko); rb1 = *(const u32x4*)(b1 + ko);
        }
#pragma unroll
        for (int kk = 0; kk < 4; ++kk) {
            const int co = (((kk * 2 + fh) ^ fsw) * 16);
            const bf16x8 af0 = *(const bf16x8*)(st + aofs + co), af1 = *(const bf16x8*)(st + aofs + 4096 + co);
            const bf16x8 wf0 = *(const bf16x8*)(st + bofs + co), wf1 = *(const bf16x8*)(st + bofs + 4096 + co);
            acc[0][0] = __builtin_amdgcn_mfma_f32_32x32x16_bf16(wf0, af0, acc[0][0], 0, 0, 0);
            acc[0][1] = __builtin_amdgcn_mfma_f32_32x32x16_bf16(wf1, af0, acc[0][1], 0, 0, 0);
            acc[1][0] = __builtin_amdgcn_mfma_f32_32x32x16_bf16(wf0, af1, acc[1][0], 0, 0, 0);
            acc[1][1] = __builtin_amdgcn_mfma_f32_32x32x16_bf16(wf1, af1, acc[1][1], 0, 0, 0);
        }
        if (kt + 1 < nk) {
            char* sn = lds + ((kt + 1) & 1) * 49152;
            *(u32x4*)(sn + wofs) = ra0; *(u32x4*)(sn + wofs + 8192) = ra1; *(u32x4*)(sn + wofs + 16384) = ra2; *(u32x4*)(sn + wofs + 24576) = ra3;
            *(u32x4*)(sn + 32768 + wofs) = rb0; *(u32x4*)(sn + 32768 + wofs + 8192) = rb1;
        }
        __syncthreads();
    }
    epi(acc, wm, wn, fr, fh);
}

struct EpiStoreBf16 { bf16_t* C; int ldc, m0, n0;
    __device__ __forceinline__ void operator()(const f32x16 (&acc)[2][2], int wm, int wn, int fr, int fh) const {
#pragma unroll
        for (int i = 0; i < 2; ++i) { bf16_t* rowp = C + (size_t)(m0 + wm * 64 + i * 32 + fr) * ldc + n0 + wn * 64 + 4 * fh;
#pragma unroll
            for (int j = 0; j < 2; ++j)
#pragma unroll
                for (int g = 0; g < 4; ++g) { u32x2 o; o.x = pack2(acc[i][j][4 * g], acc[i][j][4 * g + 1]); o.y = pack2(acc[i][j][4 * g + 2], acc[i][j][4 * g + 3]);
                    *(u32x2*)(rowp + j * 32 + 8 * g) = o; } }
    } };
struct EpiResidF32 { const float* R; float* C; int m0, n0;
    __device__ __forceinline__ void operator()(const f32x16 (&acc)[2][2], int wm, int wn, int fr, int fh) const {
#pragma unroll
        for (int i = 0; i < 2; ++i) { const size_t ro = (size_t)(m0 + wm * 64 + i * 32 + fr) * D + n0 + wn * 64 + 4 * fh;
#pragma unroll
            for (int j = 0; j < 2; ++j)
#pragma unroll
                for (int g = 0; g < 4; ++g) { const float4 r = *(const float4*)(R + ro + j * 32 + 8 * g);
                    float4 o; o.x = r.x + acc[i][j][4 * g]; o.y = r.y + acc[i][j][4 * g + 1]; o.z = r.z + acc[i][j][4 * g + 2]; o.w = r.w + acc[i][j][4 * g + 3];
                    *(float4*)(C + ro + j * 32 + 8 * g) = o; } }
    } };

template <int WHICH>
__device__ __forceinline__ void phase_dense_gemm(const Params& p, char* lds) {
    unsigned char* ws = p.ws;
    const bf16_t* A = (const bf16_t*)(ws + WS_XN);
    const bf16_t* Bt = (const bf16_t*)(ws + (WHICH == 0 ? WS_WIN0 : WHICH == 1 ? WS_WOUT0 : WHICH == 2 ? WS_WIN1 : WS_WOUT1));
    constexpr int N = (WHICH == 0) ? EVEN_IN : (WHICH == 2) ? ODD_IN : D;
    constexpr int nN = N / 128, nM = M / 256;
    const int G = gridDim.x, b = blockIdx.x;
    const int tid = threadIdx.x, lr = tid >> 3, lc = tid & 7;
    const bool xs = (G % 8 == 0);
    const int per = xs ? G / 8 : G, xcd = xs ? b % 8 : 0, lb = xs ? b / 8 : b;
    const int tiles_local = xs ? (nM / 8) * nN : nM * nN;
    for (int lt = lb; lt < tiles_local; lt += per) {
        int mt, nt;
        if (xs) { mt = xcd * 8 + (lt & 7); nt = lt >> 3; } else { mt = lt % nM; nt = lt / nM; }
        const int m0 = mt * 256, n0 = nt * 128;
        const bf16_t* a0 = A + (size_t)(m0 + lr) * D + lc * 8;
        const bf16_t* b0 = Bt + (size_t)(n0 + lr) * D + lc * 8;
        if (WHICH == 0 || WHICH == 2) { EpiStoreBf16 e{(bf16_t*)(ws + WS_P), N, m0, n0};
            gemm_tile(lds, a0, a0 + 64 * D, a0 + 128 * D, a0 + 192 * D, b0, b0 + 64 * D, D / 64, e); }
        else { EpiResidF32 e{WHICH == 1 ? p.x : p.out, p.out, m0, n0};
            gemm_tile(lds, a0, a0 + 64 * D, a0 + 128 * D, a0 + 192 * D, b0, b0 + 64 * D, D / 64, e); }
    }
}

struct EpiGateUp { bf16_t* HID; const float* lgate; int cnt, mloc0, slot0, f0;
    __device__ __forceinline__ void operator()(const f32x16 (&acc)[2][2], int wm, int wn, int fr, int fh) const {
#pragma unroll
        for (int i = 0; i < 2; ++i) { const int ml = mloc0 + wm * 64 + i * 32 + fr;
            if (ml < cnt) { const float gt = lgate[ml]; bf16_t* rowp = HID + (size_t)(slot0 + ml) * 256 + f0 + wn * 32 + 4 * fh;
#pragma unroll
                for (int g = 0; g < 4; ++g) { float h[4];
#pragma unroll
                    for (int e = 0; e < 4; ++e) { const float a = acc[i][0][4 * g + e], u = acc[i][1][4 * g + e]; h[e] = siluf_(a) * u * gt; }
                    u32x2 o; o.x = pack2(h[0], h[1]); o.y = pack2(h[2], h[3]); *(u32x2*)(rowp + 8 * g) = o; } } }
    } };
struct EpiDown { bf16_t* Y; const int* ltok; int cnt, mloc0, n0;
    __device__ __forceinline__ void operator()(const f32x16 (&acc)[2][2], int wm, int wn, int fr, int fh) const {
#pragma unroll
        for (int i = 0; i < 2; ++i) { const int ml = mloc0 + wm * 64 + i * 32 + fr;
            if (ml < cnt) { const int tk = ltok[ml]; bf16_t* rowp = Y + ((size_t)(tk & 1) * M + (tk >> 1)) * D + n0 + wn * 64 + 4 * fh;
#pragma unroll
                for (int j = 0; j < 2; ++j)
#pragma unroll
                    for (int g = 0; g < 4; ++g) { u32x2 o; o.x = pack2(acc[i][j][4 * g], acc[i][j][4 * g + 1]); o.y = pack2(acc[i][j][4 * g + 2], acc[i][j][4 * g + 3]);
                        *(u32x2*)(rowp + j * 32 + 8 * g) = o; } } }
    } };

template <int DOWN>
__device__ __forceinline__ void phase_moe_gemm(const Params& p, char* lds, int layer) {
    unsigned char* ws = p.ws;
    const int tid = threadIdx.x, lr = tid >> 3, lc = tid & 7;
    int* sh = (int*)(lds + 98304);
    const int* cntg = (const int*)(ws + WS_CTL) + CTL_CNT + layer * 32;
    constexpr int NTN = DOWN ? 8 : 4;
    if (tid == 0) { int tp = 0, sp = 0;
        for (int e = 0; e < 32; ++e) { const int c = cntg[e]; sh[e] = tp; sh[64 + e] = sp; sh[128 + e] = c; tp += ((c + 255) >> 8) * NTN; sp += c; }
        sh[32] = tp; }
    __syncthreads();
    const int total = sh[32];
    const int* ltok_all = (const int*)(ws + WS_LTOK); const float* lgate_all = (const float*)(ws + WS_LGATE);
    bf16_t* HID = (bf16_t*)(ws + WS_P + P_HID); bf16_t* Y = (bf16_t*)(ws + WS_P + P_Y);
    const bf16_t* XN = (const bf16_t*)(ws + WS_XN);
    for (int t = blockIdx.x; t < total; t += gridDim.x) {
        int e = 0;
#pragma unroll 1
        for (int q = 1; q < 32; ++q) if (t >= sh[q]) e = q;
        const int r = t - sh[e], mt = r / NTN, nt = r % NTN;
        const int cnt = sh[128 + e], slot0 = sh[64 + e], mloc0 = mt * 256;
        const int* ltok = ltok_all + (size_t)e * M; const float* lgate = lgate_all + (size_t)e * M;
        int rows[4];
#pragma unroll
        for (int i = 0; i < 4; ++i) { int ml = mloc0 + lr + 64 * i; rows[i] = ml < cnt ? ml : cnt - 1; }
        if (!DOWN) {
            const bf16_t* Bt = (const bf16_t*)(ws + WS_WGU) + ((size_t)(layer * 32 + e) * 512 + nt * 128 + lr) * 1024 + lc * 8;
            const bf16_t* a0 = XN + (size_t)(ltok[rows[0]] >> 1) * D + lc * 8;
            const bf16_t* a1 = XN + (size_t)(ltok[rows[1]] >> 1) * D + lc * 8;
            const bf16_t* a2 = XN + (size_t)(ltok[rows[2]] >> 1) * D + lc * 8;
            const bf16_t* a3 = XN + (size_t)(ltok[rows[3]] >> 1) * D + lc * 8;
            EpiGateUp ep{HID, lgate, cnt, mloc0, slot0, nt * 64};
            gemm_tile(lds, a0, a1, a2, a3, Bt, Bt + (size_t)64 * 1024, 16, ep);
        } else {
            const bf16_t* Bt = (const bf16_t*)(ws + WS_WD) + ((size_t)(layer * 32 + e) * 1024 + nt * 128 + lr) * 256 + lc * 8;
            const bf16_t* a0 = HID + (size_t)(slot0 + rows[0]) * 256 + lc * 8;
            const bf16_t* a1 = HID + (size_t)(slot0 + rows[1]) * 256 + lc * 8;
            const bf16_t* a2 = HID + (size_t)(slot0 + rows[2]) * 256 + lc * 8;
            const bf16_t* a3 = HID + (size_t)(slot0 + rows[3]) * 256 + lc * 8;
            EpiDown ep{Y, ltok, cnt, mloc0, nt * 128};
            gemm_tile(lds, a0, a1, a2, a3, Bt, Bt + (size_t)64 * 256, 4, ep);
        }
    }
    __syncthreads();
}

constexpr int CH = 32;

__device__ __forceinline__ void rwkv_unit(const Params& p, char* lds, int bb, int hh, int cg) {
    const int tid = threadIdx.x;
    unsigned char* ws = p.ws;
    const bf16_t* P = (const bf16_t*)(ws + WS_P);
    bf16_t* O16 = (bf16_t*)(ws + WS_XN);
    float* AUX = p.out;
    float* w2s = (float*)lds;
    float* a2s = w2s + 4096;
    float* g2s = a2s + 4096;
    float* TW = g2s + 4096;
    float* AL = TW + CH * 64;
    float* SG = AL + CH * 64;
    float* R = SG + CH * 128;
    float* KS = R + CH * 64;
    float* WD = KS + CH * 64;
    float* KK = WD + CH * 64;
    float* BB = KK + CH * 64;
    float* VS = BB + CH * 64;
    float* YS = VS + CH * 32;
    for (int i = tid; i < 4096; i += NT) { const int j = i >> 6, c = i & 63; w2s[i] = p.rw_w2[j * 512 + hh * 64 + c]; a2s[i] = p.rw_a2[j * 512 + hh * 64 + c]; }
    for (int i = tid; i < 4096; i += NT) { const int j = i >> 5, c = i & 31; g2s[i] = p.rw_g2[j * 512 + hh * 64 + cg * 32 + c]; }
    int pcol = 0, role = -1, lcol = 0;
    if (tid < 64) { role = 0; lcol = tid; pcol = hh * 64 + lcol; }
    else if (tid < 128) { role = 1; lcol = tid - 64; pcol = 512 + hh * 64 + lcol; }
    else if (tid < 160) { role = 2; lcol = tid - 128; pcol = 1024 + hh * 64 + cg * 32 + lcol; }
    else if (tid < 224) { role = 3; lcol = tid - 160; pcol = 1536 + lcol; }
    else if (tid < 288) { role = 4; lcol = tid - 224; pcol = 1600 + lcol; }
    else if (tid < 416) { role = 5; lcol = tid - 288; pcol = 1664 + lcol; }
    const float mu = role >= 0 ? p.ev_mu[pcol] : 0.f;
    const bf16_t* pbase = P + (size_t)(bb * SEQ) * EVEN_IN + pcol;
    float prev = 0.f;
    float praw[CH];
    if (role >= 0) {
#pragma unroll
        for (int i = 0; i < CH; ++i) praw[i] = bf2f(pbase[(size_t)i * EVEN_IN]);
    }
    const int vrow = tid >> 4, kq = tid & 15;
    float S0 = 0.f, S1 = 0.f, S2 = 0.f, S3 = 0.f;
    const int pt = tid >> 4, pc4 = (tid & 15) * 4;
    const int hc = hh * 64 + pc4;
    const float4 w0v = *(const float4*)(p.rw_w0 + hc), a0v = *(const float4*)(p.rw_a0 + hc), kkv = *(const float4*)(p.rw_k_k + hc), kav = *(const float4*)(p.rw_k_a + hc), rkv = *(const float4*)(p.rw_r_k + hc);
    __syncthreads();
    for (int c0 = 0; c0 < SEQ; c0 += CH) {
        if (role >= 0) {
#pragma unroll
            for (int i = 0; i < CH; ++i) {
                const float cur = praw[i];
                const float s = cur + mu * (prev - cur);
                prev = cur;
                if (role == 0) R[i * 64 + lcol] = s;
                else if (role == 1) KS[i * 64 + lcol] = s;
                else if (role == 2) VS[i * 32 + lcol] = s;
                else if (role == 3) TW[i * 64 + lcol] = tanhf(s);
                else if (role == 4) AL[i * 64 + lcol] = s;
                else SG[i * 128 + lcol] = sigmoidf_(s);
            }
        }
        __syncthreads();
        if (role >= 0 && c0 + CH < SEQ) {
#pragma unroll
            for (int i = 0; i < CH; ++i) praw[i] = bf2f(pbase[(size_t)(c0 + CH + i) * EVEN_IN]);
        }
        {
            float wp0 = w0v.x, wp1 = w0v.y, wp2 = w0v.z, wp3 = w0v.w, ap0 = a0v.x, ap1 = a0v.y, ap2 = a0v.z, ap3 = a0v.w;
#pragma unroll 8
            for (int j = 0; j < 64; ++j) {
                const float tw = TW[pt * 64 + j], al = AL[pt * 64 + j];
                const float4 w2 = *(const float4*)(w2s + j * 64 + pc4), a2 = *(const float4*)(a2s + j * 64 + pc4);
                wp0 += tw * w2.x; wp1 += tw * w2.y; wp2 += tw * w2.z; wp3 += tw * w2.w;
                ap0 += al * a2.x; ap1 += al * a2.y; ap2 += al * a2.z; ap3 += al * a2.w;
            }
            const int gc = (tid & 15) * 2;
            float g0 = 0.f, g1 = 0.f;
#pragma unroll 8
            for (int j = 0; j < 128; ++j) { const float sg = SG[pt * 128 + j]; const float2 g2 = *(const float2*)(g2s + j * 32 + gc); g0 += sg * g2.x; g1 += sg * g2.y; }
            const float4 ks = *(const float4*)(KS + pt * 64 + pc4);
            const float4 rs = *(const float4*)(R + pt * 64 + pc4);
            float d0 = __expf(-__expf(-softplusf_(-wp0) - 0.5f)), d1 = __expf(-__expf(-softplusf_(-wp1) - 0.5f));
            float d2 = __expf(-__expf(-softplusf_(-wp2) - 0.5f)), d3 = __expf(-__expf(-softplusf_(-wp3) - 0.5f));
            const float A0 = sigmoidf_(ap0), A1 = sigmoidf_(ap1), A2 = sigmoidf_(ap2), A3 = sigmoidf_(ap3);
            float q0 = ks.x * kkv.x, q1 = ks.y * kkv.y, q2 = ks.z * kkv.z, q3 = ks.w * kkv.w;
            const float nrm = rsqrtf(red16(q0 * q0 + q1 * q1 + q2 * q2 + q3 * q3) + 1e-6f);
            q0 *= nrm; q1 *= nrm; q2 *= nrm; q3 *= nrm;
            const float k20 = ks.x * (1.f + (A0 - 1.f) * kav.x), k21 = ks.y * (1.f + (A1 - 1.f) * kav.y), k22 = ks.z * (1.f + (A2 - 1.f) * kav.z), k23 = ks.w * (1.f + (A3 - 1.f) * kav.w);
            const float bonus = red16(rs.x * k20 * rkv.x + rs.y * k21 * rkv.y + rs.z * k22 * rkv.z + rs.w * k23 * rkv.w);
            float4 o;
            o.x = d0; o.y = d1; o.z = d2; o.w = d3; *(float4*)(WD + pt * 64 + pc4) = o;
            o.x = q0; o.y = q1; o.z = q2; o.w = q3; *(float4*)(KK + pt * 64 + pc4) = o;
            o.x = q0 * A0; o.y = q1 * A1; o.z = q2 * A2; o.w = q3 * A3; *(float4*)(BB + pt * 64 + pc4) = o;
            __syncthreads();
            o.x = k20; o.y = k21; o.z = k22; o.w = k23; *(float4*)(KS + pt * 64 + pc4) = o;
            const float2 vv = *(const float2*)(VS + pt * 32 + gc);
            const size_t tok = (size_t)bb * SEQ + c0 + pt;
            const int oc = hh * 64 + cg * 32 + gc;
            float2 bo; bo.x = bonus * vv.x; bo.y = bonus * vv.y; *(float2*)(AUX + tok * D + oc) = bo;
            float2 go; go.x = g0; go.y = g1; *(float2*)(AUX + tok * D + 512 + oc) = go;
        }
        __syncthreads();
#pragma unroll 2
        for (int i = 0; i < CH; ++i) {
            const float4 kk = *(const float4*)(KK + i * 64 + kq * 4), wd = *(const float4*)(WD + i * 64 + kq * 4), b4 = *(const float4*)(BB + i * 64 + kq * 4);
            const float4 k2 = *(const float4*)(KS + i * 64 + kq * 4), r4 = *(const float4*)(R + i * 64 + kq * 4);
            const float v = VS[i * 32 + vrow];
            const float sa = -red16(S0 * kk.x + S1 * kk.y + S2 * kk.z + S3 * kk.w);
            S0 = S0 * wd.x + v * k2.x + sa * b4.x; S1 = S1 * wd.y + v * k2.y + sa * b4.y; S2 = S2 * wd.z + v * k2.z + sa * b4.z; S3 = S3 * wd.w + v * k2.w + sa * b4.w;
            const float y = red16(S0 * r4.x + S1 * r4.y + S2 * r4.z + S3 * r4.w);
            if (kq == 0) YS[i * 32 + vrow] = y;
        }
        __syncthreads();
        {
            const int ft = tid >> 4, fc = (tid & 15) * 2;
            const unsigned o = pack2(YS[ft * 32 + fc], YS[ft * 32 + fc + 1]);
            *(unsigned*)(O16 + ((size_t)bb * SEQ + c0 + ft) * D + hh * 64 + cg * 32 + fc) = o;
        }
    }
    __syncthreads();
}

__device__ __forceinline__ void hgrn_unit(const Params& p, char* lds, int bb, int hh, int cg) {
    const int tid = threadIdx.x;
    unsigned char* ws = p.ws;
    const bf16_t* P = (const bf16_t*)(ws + WS_P);
    bf16_t* O16 = (bf16_t*)(ws + WS_XN);
    float* Q = (float*)lds;
    float* FG = Q + CH * 64;
    float* KM = FG + CH * 64;
    float* VS = KM + CH * 64;
    float* YS = VS + CH * 32;
    int pcol = 0, role = -1, lcol = 0;
    if (tid < 64) { role = 0; lcol = tid; pcol = 1792 + hh * 64 + lcol; }
    else if (tid < 128) { role = 1; lcol = tid - 64; pcol = 1792 + 512 + hh * 64 + lcol; }
    else if (tid < 160) { role = 2; lcol = tid - 128; pcol = 1792 + 1024 + hh * 64 + cg * 32 + lcol; }
    float lb = 0.f;
    if (role == 1) { const float l0 = p.hg_lb[hh * 64 + lcol], l1 = p.hg_lb[512 + hh * 64 + lcol]; const float mx = fmaxf(l0, l1); const float e0 = __expf(l0 - mx), e1 = __expf(l1 - mx); lb = e0 / (e0 + e1); }
    const bf16_t* pbase = P + (size_t)(bb * SEQ) * EVEN_IN + pcol;
    float praw[CH];
    if (role >= 0) {
#pragma unroll
        for (int i = 0; i < CH; ++i) praw[i] = bf2f(pbase[(size_t)i * EVEN_IN]);
    }
    const int vcol = tid >> 4, dq = tid & 15;
    float S0 = 0.f, S1 = 0.f, S2 = 0.f, S3 = 0.f;
    for (int c0 = 0; c0 < SEQ; c0 += CH) {
        if (role >= 0) {
#pragma unroll
            for (int i = 0; i < CH; ++i) {
                const float s = praw[i];
                if (role == 0) Q[i * 64 + lcol] = siluf_(s);
                else if (role == 1) { const float fg = lb + (1.f - lb) * sigmoidf_(s); FG[i * 64 + lcol] = fg; KM[i * 64 + lcol] = 1.f - fg; }
                else VS[i * 32 + lcol] = s;
            }
        }
        __syncthreads();
        if (role >= 0 && c0 + CH < SEQ) {
#pragma unroll
            for (int i = 0; i < CH; ++i) praw[i] = bf2f(pbase[(size_t)(c0 + CH + i) * EVEN_IN]);
        }
#pragma unroll 2
        for (int i = 0; i < CH; ++i) {
            const float4 fg = *(const float4*)(FG + i * 64 + dq * 4), km = *(const float4*)(KM + i * 64 + dq * 4), q4 = *(const float4*)(Q + i * 64 + dq * 4);
            const float v = VS[i * 32 + vcol];
            S0 = fg.x * S0 + km.x * v; S1 = fg.y * S1 + km.y * v; S2 = fg.z * S2 + km.z * v; S3 = fg.w * S3 + km.w * v;
            const float y = red16(S0 * q4.x + S1 * q4.y + S2 * q4.z + S3 * q4.w);
            if (dq == 0) YS[i * 32 + vcol] = y;
        }
        __syncthreads();
        {
            const int ft = tid >> 4, fc = (tid & 15) * 2;
            const unsigned o = pack2(YS[ft * 32 + fc], YS[ft * 32 + fc + 1]);
            *(unsigned*)(O16 + ((size_t)bb * SEQ + c0 + ft) * D + 512 + hh * 64 + cg * 32 + fc) = o;
        }
        __syncthreads();
    }
}

__device__ __forceinline__ void phase_mix0(const Params& p, char* lds) {
    for (int u = blockIdx.x; u < 256; u += gridDim.x) {
        const int v = u & 127, bb = v >> 4, hh = (v >> 1) & 7, cg = v & 1;
        if (u < 128) rwkv_unit(p, lds, bb, hh, cg); else hgrn_unit(p, lds, bb, hh, cg);
        __syncthreads();
    }
}

__device__ __forceinline__ void phase_post0(const Params& p) {
    const int tid = threadIdx.x, lane = tid & 63, wave = tid >> 6;
    unsigned char* ws = p.ws;
    bf16_t* O16 = (bf16_t*)(ws + WS_XN);
    const bf16_t* P = (const bf16_t*)(ws + WS_P);
    const float* AUX = p.out;
    const int c0 = lane * 16;
    for (int tok = blockIdx.x * 8 + wave; tok < M; tok += gridDim.x * 8) {
        const u32x4 r0 = *(const u32x4*)(O16 + (size_t)tok * D + c0), r1 = *(const u32x4*)(O16 + (size_t)tok * D + c0 + 8);
        float y[16];
        y[0] = lo16(r0.x); y[1] = hi16(r0.x); y[2] = lo16(r0.y); y[3] = hi16(r0.y); y[4] = lo16(r0.z); y[5] = hi16(r0.z); y[6] = lo16(r0.w); y[7] = hi16(r0.w);
        y[8] = lo16(r1.x); y[9] = hi16(r1.x); y[10] = lo16(r1.y); y[11] = hi16(r1.y); y[12] = lo16(r1.z); y[13] = hi16(r1.z); y[14] = lo16(r1.w); y[15] = hi16(r1.w);
        float o[16];
        if (lane < 32) {
            float s = 0.f;
#pragma unroll
            for (int j = 0; j < 16; ++j) s += y[j];
            s += dppf<0xB1>(s); s += dppf<0x4E>(s);
            const float mean = s * (1.0f / 64.0f);
            float q = 0.f;
#pragma unroll
            for (int j = 0; j < 16; ++j) { const float d = y[j] - mean; q += d * d; }
            q += dppf<0xB1>(q); q += dppf<0x4E>(q);
            const float rstd = rsqrtf(q * (1.0f / 64.0f) + 64e-5f);
#pragma unroll
            for (int j4 = 0; j4 < 4; ++j4) {
                const float4 lw = *(const float4*)(p.rw_ln_w + c0 + j4 * 4), lb = *(const float4*)(p.rw_ln_b + c0 + j4 * 4);
                const float4 bv = *(const float4*)(AUX + (size_t)tok * D + c0 + j4 * 4), gv = *(const float4*)(AUX + (size_t)tok * D + 512 + c0 + j4 * 4);
                o[j4 * 4 + 0] = ((y[j4 * 4 + 0] - mean) * rstd * lw.x + lb.x + bv.x) * gv.x;
                o[j4 * 4 + 1] = ((y[j4 * 4 + 1] - mean) * rstd * lw.y + lb.y + bv.y) * gv.y;
                o[j4 * 4 + 2] = ((y[j4 * 4 + 2] - mean) * rstd * lw.z + lb.z + bv.z) * gv.z;
                o[j4 * 4 + 3] = ((y[j4 * 4 + 3] - mean) * rstd * lw.w + lb.w + bv.w) * gv.w;
            }
        } else {
            float q = 0.f;
#pragma unroll
            for (int j = 0; j < 16; ++j) q += y[j] * y[j];
            q += dppf<0xB1>(q); q += dppf<0x4E>(q);
            const float rstd = rsqrtf(q * (1.0f / 64.0f) + 1e-6f);
            const int cc = c0 - 512;
            const u32x4 g0 = *(const u32x4*)(P + (size_t)tok * EVEN_IN + 1792 + 1536 + cc), g1 = *(const u32x4*)(P + (size_t)tok * EVEN_IN + 1792 + 1536 + cc + 8);
            float gt[16];
            gt[0] = lo16(g0.x); gt[1] = hi16(g0.x); gt[2] = lo16(g0.y); gt[3] = hi16(g0.y); gt[4] = lo16(g0.z); gt[5] = hi16(g0.z); gt[6] = lo16(g0.w); gt[7] = hi16(g0.w);
            gt[8] = lo16(g1.x); gt[9] = hi16(g1.x); gt[10] = lo16(g1.y); gt[11] = hi16(g1.y); gt[12] = lo16(g1.z); gt[13] = hi16(g1.z); gt[14] = lo16(g1.w); gt[15] = hi16(g1.w);
#pragma unroll
            for (int j = 0; j < 16; ++j) o[j] = y[j] * rstd * p.hg_norm[(cc + j) & 63] * siluf_(gt[j]);
        }
        u32x4 w0, w1;
        w0.x = pack2(o[0], o[1]); w0.y = pack2(o[2], o[3]); w0.z = pack2(o[4], o[5]); w0.w = pack2(o[6], o[7]);
        w1.x = pack2(o[8], o[9]); w1.y = pack2(o[10], o[11]); w1.z = pack2(o[12], o[13]); w1.w = pack2(o[14], o[15]);
        *(u32x4*)(O16 + (size_t)tok * D + c0) = w0; *(u32x4*)(O16 + (size_t)tok * D + c0 + 8) = w1;
    }
}

__device__ __forceinline__ void gdn_unit(const Params& p, char* lds, int bb, int hh, int cg) {
    const int tid = threadIdx.x;
    unsigned char* ws = p.ws;
    const bf16_t* P = (const bf16_t*)(ws + WS_P);
    const float* GT = (const float*)(ws + WS_GATES);
    bf16_t* O16 = (bf16_t*)(ws + WS_XN);
    float* Q = (float*)lds;
    float* K = Q + CH * 128;
    float* VS = K + CH * 128;
    float* YS = VS + CH * 32;
    float* BE = YS + CH * 32;
    float* AD = BE + CH;
    int role = -1, lcol = 0, ccol = 0;
    if (tid < 128) { role = 0; lcol = tid; ccol = hh * 128 + lcol; }
    else if (tid < 256) { role = 1; lcol = tid - 128; ccol = 512 + hh * 128 + lcol; }
    else if (tid < 288) { role = 2; lcol = tid - 256; ccol = 1024 + hh * 128 + cg * 32 + lcol; }
    float cw0 = 0.f, cw1 = 0.f, cw2 = 0.f, cw3 = 0.f;
    if (role >= 0) { cw0 = p.gd_conv[ccol]; cw1 = p.gd_conv[1536 + ccol]; cw2 = p.gd_conv[2 * 1536 + ccol]; cw3 = p.gd_conv[3 * 1536 + ccol]; }
    const bf16_t* pbase = P + (size_t)(bb * SEQ) * ODD_IN + ccol;
    float x1 = 0.f, x2 = 0.f, x3 = 0.f;
    float praw[CH];
    if (role >= 0) {
#pragma unroll
        for (int i = 0; i < CH; ++i) praw[i] = bf2f(pbase[(size_t)i * ODD_IN]);
    }
    const float negA = -__expf(p.gd_a_log[hh]), dtb = p.gd_dt_bias[hh];
    const int vcol = tid >> 4, dq = tid & 15;
    float S[8];
#pragma unroll
    for (int j = 0; j < 8; ++j) S[j] = 0.f;
    for (int c0 = 0; c0 < SEQ; c0 += CH) {
        if (role >= 0) {
#pragma unroll
            for (int i = 0; i < CH; ++i) {
                const float cur = praw[i];
                const float yv = siluf_(cw0 * x3 + cw1 * x2 + cw2 * x1 + cw3 * cur);
                x3 = x2; x2 = x1; x1 = cur;
                if (role == 0) Q[i * 128 + lcol] = yv; else if (role == 1) K[i * 128 + lcol] = yv; else VS[i * 32 + lcol] = yv;
            }
        }
        if (tid >= 320 && tid < 320 + CH) { const int i = tid - 320; const size_t tok = (size_t)bb * SEQ + c0 + i;
            BE[i] = sigmoidf_(GT[tok * 16 + hh]); AD[i] = __expf(negA * softplusf_(GT[tok * 16 + 4 + hh] + dtb)); }
        __syncthreads();
        if (role >= 0 && c0 + CH < SEQ) {
#pragma unroll
            for (int i = 0; i < CH; ++i) praw[i] = bf2f(pbase[(size_t)(c0 + CH + i) * ODD_IN]);
        }
        {
            const int t = tid >> 4, c8 = (tid & 15) * 8;
            float4 qa = *(const float4*)(Q + t * 128 + c8), qb = *(const float4*)(Q + t * 128 + c8 + 4);
            float4 ka = *(const float4*)(K + t * 128 + c8), kb = *(const float4*)(K + t * 128 + c8 + 4);
            const float sq = red16(qa.x * qa.x + qa.y * qa.y + qa.z * qa.z + qa.w * qa.w + qb.x * qb.x + qb.y * qb.y + qb.z * qb.z + qb.w * qb.w);
            const float sk = red16(ka.x * ka.x + ka.y * ka.y + ka.z * ka.z + ka.w * ka.w + kb.x * kb.x + kb.y * kb.y + kb.z * kb.z + kb.w * kb.w);
            const float nq = rsqrtf(sq + 1e-6f) * 0.08838834764831845f, nk = rsqrtf(sk + 1e-6f);
            qa.x *= nq; qa.y *= nq; qa.z *= nq; qa.w *= nq; qb.x *= nq; qb.y *= nq; qb.z *= nq; qb.w *= nq;
            ka.x *= nk; ka.y *= nk; ka.z *= nk; ka.w *= nk; kb.x *= nk; kb.y *= nk; kb.z *= nk; kb.w *= nk;
            *(float4*)(Q + t * 128 + c8) = qa; *(float4*)(Q + t * 128 + c8 + 4) = qb; *(float4*)(K + t * 128 + c8) = ka; *(float4*)(K + t * 128 + c8 + 4) = kb;
        }
        __syncthreads();
#pragma unroll 2
        for (int i = 0; i < CH; ++i) {
            const float4 ka = *(const float4*)(K + i * 128 + dq * 8), kb = *(const float4*)(K + i * 128 + dq * 8 + 4);
            const float4 qa = *(const float4*)(Q + i * 128 + dq * 8), qb = *(const float4*)(Q + i * 128 + dq * 8 + 4);
            const float v = VS[i * 32 + vcol], be = BE[i], a = AD[i];
            const float ks = red16(ka.x * S[0] + ka.y * S[1] + ka.z * S[2] + ka.w * S[3] + kb.x * S[4] + kb.y * S[5] + kb.z * S[6] + kb.w * S[7]);
            const float vn = be * (v - a * ks);
            S[0] = a * S[0] + ka.x * vn; S[1] = a * S[1] + ka.y * vn; S[2] = a * S[2] + ka.z * vn; S[3] = a * S[3] + ka.w * vn;
            S[4] = a * S[4] + kb.x * vn; S[5] = a * S[5] + kb.y * vn; S[6] = a * S[6] + kb.z * vn; S[7] = a * S[7] + kb.w * vn;
            const float y = red16(qa.x * S[0] + qa.y * S[1] + qa.z * S[2] + qa.w * S[3] + qb.x * S[4] + qb.y * S[5] + qb.z * S[6] + qb.w * S[7]);
            if (dq == 0) YS[i * 32 + vcol] = y;
        }
        __syncthreads();
        {
            const int ft = tid >> 4, fc = (tid & 15) * 2;
            const unsigned o = pack2(YS[ft * 32 + fc], YS[ft * 32 + fc + 1]);
            *(unsigned*)(O16 + ((size_t)bb * SEQ + c0 + ft) * D + hh * 128 + cg * 32 + fc) = o;
        }
        __syncthreads();
    }
}

__device__ __forceinline__ void mlstm_unit(const Params& p, char* lds, int bb, int hh, int cg) {
    const int tid = threadIdx.x, lane = tid & 63;
    unsigned char* ws = p.ws;
    const bf16_t* P = (const bf16_t*)(ws + WS_P);
    const float* GT = (const float*)(ws + WS_GATES);
    bf16_t* O16 = (bf16_t*)(ws + WS_XN);
    float* Q = (float*)lds;
    float* K = Q + CH * 128;
    float* VS = K + CH * 128;
    float* YS = VS + CH * 32;
    float* IG = YS + CH * 32;
    float* LF = IG + CH;
    int role = -1, lcol = 0, pcol = 0;
    if (tid < 128) { role = 0; lcol = tid; pcol = 2048 + hh * 128 + lcol; }
    else if (tid < 256) { role = 1; lcol = tid - 128; pcol = 2560 + hh * 128 + lcol; }
    else if (tid < 288) { role = 2; lcol = tid - 256; pcol = 3072 + hh * 128 + cg * 32 + lcol; }
    const bf16_t* pbase = P + (size_t)(bb * SEQ) * ODD_IN + pcol;
    float praw[CH];
    if (role >= 0) {
#pragma unroll
        for (int i = 0; i < CH; ++i) praw[i] = bf2f(pbase[(size_t)i * ODD_IN]);
    }
    const float ib = p.ml_i_bias[hh], fb = p.ml_f_bias[hh];
    const int vcol = tid >> 4, dq = tid & 15;
    float C[8];
#pragma unroll
    for (int j = 0; j < 8; ++j) C[j] = 0.f;
    float n0 = 0.f, n1 = 0.f;
    float m = 0.f;
    for (int c0 = 0; c0 < SEQ; c0 += CH) {
        if (role >= 0) {
#pragma unroll
            for (int i = 0; i < CH; ++i) {
                const float s = praw[i];
                if (role == 0) Q[i * 128 + lcol] = s; else if (role == 1) K[i * 128 + lcol] = s * 0.08838834764831845f; else VS[i * 32 + lcol] = s;
            }
        }
        if (tid >= 320 && tid < 320 + CH) { const int i = tid - 320; const size_t tok = (size_t)bb * SEQ + c0 + i;
            IG[i] = GT[tok * 16 + 8 + hh] + ib; const float z = GT[tok * 16 + 12 + hh] + fb; LF[i] = -softplusf_(-z); }
        __syncthreads();
        if (role >= 0 && c0 + CH < SEQ) {
#pragma unroll
            for (int i = 0; i < CH; ++i) praw[i] = bf2f(pbase[(size_t)(c0 + CH + i) * ODD_IN]);
        }
#pragma unroll 2
        for (int i = 0; i < CH; ++i) {
            const float4 ka = *(const float4*)(K + i * 128 + dq * 8), kb = *(const float4*)(K + i * 128 + dq * 8 + 4);
            const float4 qa = *(const float4*)(Q + i * 128 + dq * 8), qb = *(const float4*)(Q + i * 128 + dq * 8 + 4);
            const float2 kn = *(const float2*)(K + i * 128 + lane * 2), qn = *(const float2*)(Q + i * 128 + lane * 2);
            const float v = VS[i * 32 + vcol];
            const float xm = LF[i] + m, ig = IG[i];
            const float mn = fmaxf(xm, ig);
            const float fd = __expf(xm - mn), iw = __expf(ig - mn);
            m = mn;
            const float iv = iw * v;
            C[0] = fd * C[0] + ka.x * iv; C[1] = fd * C[1] + ka.y * iv; C[2] = fd * C[2] + ka.z * iv; C[3] = fd * C[3] + ka.w * iv;
            C[4] = fd * C[4] + kb.x * iv; C[5] = fd * C[5] + kb.y * iv; C[6] = fd * C[6] + kb.z * iv; C[7] = fd * C[7] + kb.w * iv;
            n0 = fd * n0 + iw * kn.x; n1 = fd * n1 + iw * kn.y;
            const float num = red16(qa.x * C[0] + qa.y * C[1] + qa.z * C[2] + qa.w * C[3] + qb.x * C[4] + qb.y * C[5] + qb.z * C[6] + qb.w * C[7]);
            const float den = red64(qn.x * n0 + qn.y * n1);
            const float y = num / fmaxf(fabsf(den), __expf(-mn));
            if (dq == 0) YS[i * 32 + vcol] = y;
        }
        __syncthreads();
        {
            const int ft = tid >> 4, fc = (tid & 15) * 2;
            const unsigned o = pack2(YS[ft * 32 + fc], YS[ft * 32 + fc + 1]);
            *(unsigned*)(O16 + ((size_t)bb * SEQ + c0 + ft) * D + 512 + hh * 128 + cg * 32 + fc) = o;
        }
        __syncthreads();
    }
}

__device__ __forceinline__ void phase_mix1(const Params& p, char* lds) {
    for (int u = blockIdx.x; u < 256; u += gridDim.x) {
        const int v = u & 127, bb = v >> 4, hh = (v >> 2) & 3, cg = v & 3;
        if (u < 128) gdn_unit(p, lds, bb, hh, cg); else mlstm_unit(p, lds, bb, hh, cg);
        __syncthreads();
    }
}

__device__ __forceinline__ void phase_post1(const Params& p) {
    const int tid = threadIdx.x, lane = tid & 63, wave = tid >> 6;
    unsigned char* ws = p.ws;
    bf16_t* O16 = (bf16_t*)(ws + WS_XN);
    const bf16_t* P = (const bf16_t*)(ws + WS_P);
    const int c0 = lane * 16;
    for (int tok = blockIdx.x * 8 + wave; tok < M; tok += gridDim.x * 8) {
        const u32x4 r0 = *(const u32x4*)(O16 + (size_t)tok * D + c0), r1 = *(const u32x4*)(O16 + (size_t)tok * D + c0 + 8);
        float y[16];
        y[0] = lo16(r0.x); y[1] = hi16(r0.x); y[2] = lo16(r0.y); y[3] = hi16(r0.y); y[4] = lo16(r0.z); y[5] = hi16(r0.z); y[6] = lo16(r0.w); y[7] = hi16(r0.w);
        y[8] = lo16(r1.x); y[9] = hi16(r1.x); y[10] = lo16(r1.y); y[11] = hi16(r1.y); y[12] = lo16(r1.z); y[13] = hi16(r1.z); y[14] = lo16(r1.w); y[15] = hi16(r1.w);
        float q = 0.f;
#pragma unroll
        for (int j = 0; j < 16; ++j) q += y[j] * y[j];
        q += dppf<0xB1>(q); q += dppf<0x4E>(q); q += dppf<0x141>(q);
        const float rstd = rsqrtf(q * (1.0f / 128.0f) + 1e-6f);
        const int gcol = lane < 32 ? 1536 + c0 : 3584 + (c0 - 512);
        const u32x4 g0 = *(const u32x4*)(P + (size_t)tok * ODD_IN + gcol), g1 = *(const u32x4*)(P + (size_t)tok * ODD_IN + gcol + 8);
        float gt[16];
        gt[0] = lo16(g0.x); gt[1] = hi16(g0.x); gt[2] = lo16(g0.y); gt[3] = hi16(g0.y); gt[4] = lo16(g0.z); gt[5] = hi16(g0.z); gt[6] = lo16(g0.w); gt[7] = hi16(g0.w);
        gt[8] = lo16(g1.x); gt[9] = hi16(g1.x); gt[10] = lo16(g1.y); gt[11] = hi16(g1.y); gt[12] = lo16(g1.z); gt[13] = hi16(g1.z); gt[14] = lo16(g1.w); gt[15] = hi16(g1.w);
        float o[16];
        if (lane < 32) {
#pragma unroll
            for (int j = 0; j < 16; ++j) o[j] = y[j] * rstd * p.gd_norm[(c0 + j) & 127] * siluf_(gt[j]);
        } else {
#pragma unroll
            for (int j = 0; j < 16; ++j) o[j] = y[j] * rstd * p.ml_norm[c0 - 512 + j] * sigmoidf_(gt[j]);
        }
        u32x4 w0, w1;
        w0.x = pack2(o[0], o[1]); w0.y = pack2(o[2], o[3]); w0.z = pack2(o[4], o[5]); w0.w = pack2(o[6], o[7]);
        w1.x = pack2(o[8], o[9]); w1.y = pack2(o[10], o[11]); w1.z = pack2(o[12], o[13]); w1.w = pack2(o[14], o[15]);
        *(u32x4*)(O16 + (size_t)tok * D + c0) = w0; *(u32x4*)(O16 + (size_t)tok * D + c0 + 8) = w1;
    }
}

__device__ __forceinline__ void grid_barrier() { }
__global__ void __launch_bounds__(NT) fwd_kernel(Params p) {
    extern __shared__ __attribute__((aligned(16))) char lds[];
    const int lo = p.ph_lo, hi = p.ph_hi;
#define IN(k) (lo <= (k) && (k) < hi)
#define SEAM(k) do { if (IN(k) && IN((k) + 1)) grid_barrier(); } while (0)
    if (IN(0)) { phase_convert(p, lds); phase_rows<0>(p, lds, 0); }   SEAM(0);
    if (IN(1)) phase_dense_gemm<0>(p, lds);                           SEAM(1);
    if (IN(2)) phase_mix0(p, lds);                                    SEAM(2);
    if (IN(3)) phase_post0(p);                                        SEAM(3);
    if (IN(4)) phase_dense_gemm<1>(p, lds);                           SEAM(4);
    if (IN(5)) phase_rows<1>(p, lds, 0);                              SEAM(5);
    if (IN(6)) phase_moe_gemm<0>(p, lds, 0);                          SEAM(6);
    if (IN(7)) phase_moe_gemm<1>(p, lds, 0);                          SEAM(7);
    if (IN(8)) phase_rows<2>(p, lds, 1);                              SEAM(8);
    if (IN(9)) phase_dense_gemm<2>(p, lds);                           SEAM(9);
    if (IN(10)) phase_mix1(p, lds);                                   SEAM(10);
    if (IN(11)) phase_post1(p);                                       SEAM(11);
    if (IN(12)) phase_dense_gemm<3>(p, lds);                          SEAM(12);
    if (IN(13)) phase_rows<1>(p, lds, 1);                             SEAM(13);
    if (IN(14)) phase_moe_gemm<0>(p, lds, 1);                         SEAM(14);
    if (IN(15)) phase_moe_gemm<1>(p, lds, 1);                         SEAM(15);
    if (IN(16)) phase_rows<3>(p, lds, 0);
#undef IN
#undef SEAM
}

extern "C" void kernel_launch(void* const* d_in, const int* in_sizes, int n_in, void* d_out, int out_size, void* d_ws, size_t ws_size, hipStream_t stream) {
    static int ok = 0;
    if (ok == 0) {
        ok = 1;
        if (n_in != 35 || out_size != M * D || ws_size < WS_END) { fprintf(stderr, "kernel_launch: unexpected sizes n_in=%d out=%d ws=%zu need=%zu\n", n_in, out_size, ws_size, (size_t)WS_END); ok = -1; }
        if (hipFuncSetAttribute((const void*)fwd_kernel, hipFuncAttributeMaxDynamicSharedMemorySize, LDS_BYTES) != hipSuccess) { fprintf(stderr, "kernel_launch: hipFuncSetAttribute failed\n"); ok = -1; }
    }
    if (ok < 0) return;
    Params p{};
    const float** f = (const float**)&p;
    for (int i = 0; i < 35; ++i) f[i] = (const float*)d_in[i];
    p.out = (float*)d_out; p.ws = (unsigned char*)d_ws;
    hipMemsetAsync((char*)d_ws + WS_CTL, 0, 65536, stream);
    for (int ph = 0; ph < NPHASE; ++ph) {
        p.ph_lo = ph; p.ph_hi = ph + 1;
        hipLaunchKernelGGL(fwd_kernel, dim3(256), dim3(NT), LDS_BYTES, stream, p);
    }
}
```

```cpp
#include <hip/hip_runtime.h>
#include <hip/hip_cooperative_groups.h>
#include <stdint.h>
#include <stdio.h>

#ifndef SINGLE_LAUNCH
#define SINGLE_LAUNCH 1
#endif

typedef unsigned short bf16_t;
typedef short bf16x8 __attribute__((ext_vector_type(8)));
typedef float f32x16 __attribute__((ext_vector_type(16)));
typedef float f32x4 __attribute__((ext_vector_type(4)));
typedef unsigned u32x4 __attribute__((ext_vector_type(4)));
typedef unsigned u32x2 __attribute__((ext_vector_type(2)));

#define NT 512
constexpr int D = 1024, NBATCH = 8, SEQ = 2048, M = NBATCH * SEQ;
constexpr int EVEN_IN = 3840, ODD_SRC = 4112, ODD_IN = 4096;
constexpr int NPHASE = 17;
constexpr int LDS_BYTES = 144 * 1024;

constexpr size_t WS_CTL = 0;
constexpr size_t WS_WIN0 = 65536;
constexpr size_t WS_WOUT0 = WS_WIN0 + (size_t)EVEN_IN * D * 2;
constexpr size_t WS_WIN1 = WS_WOUT0 + (size_t)D * D * 2;
constexpr size_t WS_WOUT1 = WS_WIN1 + (size_t)ODD_IN * D * 2;
constexpr size_t WS_WGU = WS_WOUT1 + (size_t)D * D * 2;
constexpr size_t WS_WD = WS_WGU + (size_t)2 * 32 * 512 * 1024 * 2;
constexpr size_t WS_XN = WS_WD + (size_t)2 * 32 * 1024 * 256 * 2;
constexpr size_t WS_P = WS_XN + (size_t)M * D * 2;
constexpr size_t WS_LTOK = WS_P + (size_t)M * 4096 * 2;
constexpr size_t WS_LGATE = WS_LTOK + (size_t)32 * M * 4;
constexpr size_t WS_GATES = WS_LGATE + (size_t)32 * M * 4;
constexpr size_t WS_END = WS_GATES + (size_t)M * 16 * 4;
constexpr size_t P_HID = 0;
constexpr size_t P_Y = (size_t)32 * 1024 * 1024;
constexpr int CTL_CNT = 0;
constexpr int CTL_BAR = 1024;

struct Params {
    const float* x; const float* norm_mix; const float* norm_ffn; const float* norm_final;
    const float* ev_w_in; const float* ev_mu; const float* rw_w0; const float* rw_w2; const float* rw_a0; const float* rw_a2; const float* rw_g2;
    const float* rw_k_k; const float* rw_k_a; const float* rw_r_k; const float* rw_ln_w; const float* rw_ln_b; const float* hg_lb; const float* hg_norm;
    const float* ev_w_out; const float* od_w_in; const float* gd_conv; const float* gd_a_log; const float* gd_dt_bias; const float* gd_norm;
    const float* ml_i_bias; const float* ml_f_bias; const float* ml_norm; const float* od_w_out;
    const float* moe_w_group; const float* moe_b_group; const float* moe_w_router; const float* moe_b_router;
    const float* moe_w_gate; const float* moe_w_up; const float* moe_w_down;
    float* out; unsigned char* ws;
    int ph_lo, ph_hi;
};

__device__ __forceinline__ float bf2f(unsigned short u) { return __uint_as_float(((unsigned)u) << 16); }
__device__ __forceinline__ unsigned short f2bf(float f) { unsigned u = __float_as_uint(f); u += 0x7fffu + ((u >> 16) & 1u); return (unsigned short)(u >> 16); }
__device__ __forceinline__ unsigned pack2(float a, float b) { return (unsigned)f2bf(a) | ((unsigned)f2bf(b) << 16); }
__device__ __forceinline__ float lo16(unsigned u) { return __uint_as_float(u << 16); }
__device__ __forceinline__ float hi16(unsigned u) { return __uint_as_float(u & 0xffff0000u); }
__device__ __forceinline__ float sigmoidf_(float x) { return 1.0f / (1.0f + __expf(-x)); }
__device__ __forceinline__ float siluf_(float x) { return x / (1.0f + __expf(-x)); }
__device__ __forceinline__ float softplusf_(float x) { return x > 20.f ? x : log1pf(__expf(x)); }

template <int CTRL> __device__ __forceinline__ float dppf(float x) {
    return __int_as_float(__builtin_amdgcn_update_dpp(0, __float_as_int(x), CTRL, 0xF, 0xF, false));
}
__device__ __forceinline__ float red16(float x) {
    x += dppf<0xB1>(x);
    x += dppf<0x4E>(x);
    x += dppf<0x141>(x);
    x += dppf<0x140>(x);
    return x;
}
__device__ __forceinline__ float red64(float x) {
    x = red16(x);
    x += __shfl_xor(x, 16);
    x += __shfl_xor(x, 32);
    return x;
}

__device__ __forceinline__ void conv_tile(float* tile, const float* s0, const float* s1, size_t ld, bf16_t* d, size_t ldd) {
    const int tid = threadIdx.x;
#pragma unroll
    for (int i = 0; i < 2; ++i) {
        const int k = (tid >> 4) + 32 * i, nn = (tid & 15) * 4;
        const float* s = nn < 32 ? s0 + (size_t)k * ld + nn : s1 + (size_t)k * ld + (nn - 32);
        const float4 v = *(const float4*)s;
        float* t = tile + k * 65 + nn;
        t[0] = v.x; t[1] = v.y; t[2] = v.z; t[3] = v.w;
    }
    __syncthreads();
    const int n = tid >> 3, kc = (tid & 7) * 8;
    float f0 = tile[(kc + 0) * 65 + n], f1 = tile[(kc + 1) * 65 + n], f2 = tile[(kc + 2) * 65 + n], f3 = tile[(kc + 3) * 65 + n];
    float f4 = tile[(kc + 4) * 65 + n], f5 = tile[(kc + 5) * 65 + n], f6 = tile[(kc + 6) * 65 + n], f7 = tile[(kc + 7) * 65 + n];
    u32x4 o; o.x = pack2(f0, f1); o.y = pack2(f2, f3); o.z = pack2(f4, f5); o.w = pack2(f6, f7);
    *(u32x4*)(d + (size_t)n * ldd + kc) = o;
    __syncthreads();
}

__device__ __forceinline__ void phase_convert(const Params& p, char* lds) {
    float* tile = (float*)lds;
    unsigned char* ws = p.ws;
    const int total = 960 + 256 + 1024 + 256 + 8192 + 4096;
    for (int g0 = blockIdx.x; g0 < total; g0 += gridDim.x) {
        int g = g0;
        if (g < 960) { const int kt = g & 15, nt = g >> 4;
            const float* s0 = p.ev_w_in + (size_t)(kt * 64) * EVEN_IN + nt * 64;
            conv_tile(tile, s0, s0 + 32, EVEN_IN, (bf16_t*)(ws + WS_WIN0) + (size_t)(nt * 64) * D + kt * 64, D); continue; }
        g -= 960;
        if (g < 256) { const int kt = g & 15, nt = g >> 4;
            const float* s0 = p.ev_w_out + (size_t)(kt * 64) * D + nt * 64;
            conv_tile(tile, s0, s0 + 32, D, (bf16_t*)(ws + WS_WOUT0) + (size_t)(nt * 64) * D + kt * 64, D); continue; }
        g -= 256;
        if (g < 1024) { const int kt = g & 15, nt = g >> 4;
            const float* s0 = p.od_w_in + (size_t)(kt * 64) * ODD_SRC + nt * 64 + (nt >= 32 ? 8 : 0);
            conv_tile(tile, s0, s0 + 32, ODD_SRC, (bf16_t*)(ws + WS_WIN1) + (size_t)(nt * 64) * D + kt * 64, D); continue; }
        g -= 1024;
        if (g < 256) { const int kt = g & 15, nt = g >> 4;
            const float* s0 = p.od_w_out + (size_t)(kt * 64) * D + nt * 64;
            conv_tile(tile, s0, s0 + 32, D, (bf16_t*)(ws + WS_WOUT1) + (size_t)(nt * 64) * D + kt * 64, D); continue; }
        g -= 256;
        if (g < 8192) { const int le = g >> 7, r = g & 127, kt = r & 15, s = r >> 4;
            const size_t so = (size_t)le * 1024 * 256 + (size_t)(kt * 64) * 256 + s * 32;
            conv_tile(tile, p.moe_w_gate + so, p.moe_w_up + so, 256, (bf16_t*)(ws + WS_WGU) + (size_t)le * 512 * 1024 + (size_t)(s * 64) * 1024 + kt * 64, 1024); continue; }
        g -= 8192;
        { const int le = g >> 6, r = g & 63, kt = r & 3, nt = r >> 2;
            const float* s0 = p.moe_w_down + (size_t)le * 256 * 1024 + (size_t)(kt * 64) * 1024 + nt * 64;
            conv_tile(tile, s0, s0 + 32, 1024, (bf16_t*)(ws + WS_WD) + (size_t)le * 1024 * 256 + (size_t)(nt * 64) * 256 + kt * 64, 256); }
    }
}

template <int MODE>
__device__ __forceinline__ void phase_rows(const Params& p, char* lds, int layer) {
    const int tid = threadIdx.x, lane = tid & 63, wave = tid >> 6;
    unsigned char* ws = p.ws;
    const float* src = (MODE == 0) ? p.x : p.out;
    const float* gain = (MODE == 0) ? p.norm_mix : (MODE == 1) ? p.norm_ffn + layer * D : (MODE == 2) ? p.norm_mix + D : p.norm_final;
    bf16_t* XN = (bf16_t*)(ws + WS_XN);
    const bf16_t* Y0 = (const bf16_t*)(ws + WS_P + P_Y);
    const bf16_t* Y1 = Y0 + (size_t)M * D;
    float* rstd_s = (float*)lds;
    float* Ht = (float*)(lds + 1024);
    float* Wt = Ht + 64 * 132;
    float* lg = Wt + 40 * 132;
    constexpr int NO = (MODE == 1) ? 5 : 2;
    constexpr int NOUT = (MODE == 1) ? 36 : 16;
    for (int grp = blockIdx.x; grp < M / 64; grp += gridDim.x) {
        const int t0 = grp * 64;
        for (int q = 0; q < 8; ++q) {
            const int tl = wave * 8 + q, tok = t0 + tl;
            float4 v[4];
#pragma unroll
            for (int i = 0; i < 4; ++i) v[i] = *(const float4*)(src + (size_t)tok * D + i * 256 + lane * 4);
            if (MODE == 2 || MODE == 3) {
#pragma unroll
                for (int i = 0; i < 4; ++i) {
                    const u32x2 a = *(const u32x2*)(Y0 + (size_t)tok * D + i * 256 + lane * 4);
                    const u32x2 b = *(const u32x2*)(Y1 + (size_t)tok * D + i * 256 + lane * 4);
                    v[i].x += lo16(a.x) + lo16(b.x); v[i].y += hi16(a.x) + hi16(b.x); v[i].z += lo16(a.y) + lo16(b.y); v[i].w += hi16(a.y) + hi16(b.y);
                }
            }
            float ss = 0.f;
#pragma unroll
            for (int i = 0; i < 4; ++i) ss += v[i].x * v[i].x + v[i].y * v[i].y + v[i].z * v[i].z + v[i].w * v[i].w;
            ss = red64(ss);
            const float rstd = rsqrtf(ss * (1.0f / D) + 1e-6f);
            if (lane == 0) rstd_s[tl] = rstd;
#pragma unroll
            for (int i = 0; i < 4; ++i) {
                const float4 g4 = *(const float4*)(gain + i * 256 + lane * 4);
                if (MODE == 2) *(float4*)(p.out + (size_t)tok * D + i * 256 + lane * 4) = v[i];
                const float o0 = v[i].x * rstd * g4.x, o1 = v[i].y * rstd * g4.y, o2 = v[i].z * rstd * g4.z, o3 = v[i].w * rstd * g4.w;
                if (MODE == 3) { float4 o; o.x = o0; o.y = o1; o.z = o2; o.w = o3; *(float4*)(p.out + (size_t)tok * D + i * 256 + lane * 4) = o; }
                else { u32x2 o; o.x = pack2(o0, o1); o.y = pack2(o2, o3); *(u32x2*)(XN + (size_t)tok * D + i * 256 + lane * 4) = o; }
            }
        }
        if (MODE == 1 || MODE == 2) {
            float acc[NO];
#pragma unroll
            for (int o = 0; o < NO; ++o) acc[o] = 0.f;
            const int btok = tid & 63, og = tid >> 6;
            for (int dc = 0; dc < 8; ++dc) {
                __syncthreads();
                {
                    const int tk = tid >> 3, part = tid & 7;
#pragma unroll
                    for (int q = 0; q < 4; ++q) {
                        const float4 h = *(const float4*)(p.out + (size_t)(t0 + tk) * D + dc * 128 + part * 16 + q * 4);
                        *(float4*)(Ht + tk * 132 + part * 16 + q * 4) = h;
                    }
                }
                for (int idx = tid; idx < 128 * 40; idx += NT) {
                    const int d = idx & 127, o = idx >> 7, dd = dc * 128 + d;
                    float w = 0.f;
                    if (MODE == 1) {
                        if (o < 4) w = p.moe_w_group[(size_t)layer * D * 4 + dd * 4 + o];
                        else if (o < 36) w = p.moe_w_router[(size_t)layer * D * 32 + dd * 32 + (o - 4)];
                    } else {
                        if (o < 16) w = p.od_w_in[(size_t)dd * ODD_SRC + (o < 8 ? 2048 + o : 4104 + (o - 8))];
                    }
                    Wt[o * 132 + d] = w * gain[dd];
                }
                __syncthreads();
#pragma unroll 4
                for (int d4 = 0; d4 < 32; ++d4) {
                    const float4 h = *(const float4*)(Ht + btok * 132 + d4 * 4);
#pragma unroll
                    for (int o = 0; o < NO; ++o) {
                        const float4 w = *(const float4*)(Wt + (og * NO + o) * 132 + d4 * 4);
                        acc[o] += h.x * w.x + h.y * w.y + h.z * w.z + h.w * w.w;
                    }
                }
            }
            const float rs = rstd_s[btok];
            if (MODE == 2) {
                float* G = (float*)(ws + WS_GATES);
#pragma unroll
                for (int o = 0; o < NO; ++o) G[(size_t)(t0 + btok) * 16 + og * NO + o] = acc[o] * rs;
            } else {
#pragma unroll
                for (int o = 0; o < NO; ++o) { const int oo = og * NO + o;
                    if (oo < NOUT) lg[btok * 40 + oo] = acc[o] * rs + (oo < 4 ? p.moe_b_group[layer * 4 + oo] : p.moe_b_router[layer * 32 + oo - 4]); }
                __syncthreads();
                if (tid < 64) {
                    const float* l = lg + tid * 40;
                    int gi = 0; float gm = l[0];
#pragma unroll
                    for (int j = 1; j < 4; ++j) if (l[j] > gm) { gm = l[j]; gi = j; }
                    float se = 0.f;
#pragma unroll
                    for (int j = 0; j < 4; ++j) se += __expf(l[j] - gm);
                    const float ptop = 1.0f / se;
                    const float* f = l + 4 + gi * 8;
                    int i1 = 0; float v1 = f[0];
#pragma unroll
                    for (int j = 1; j < 8; ++j) if (f[j] > v1) { v1 = f[j]; i1 = j; }
                    int i2 = -1; float v2 = -3.0e38f;
#pragma unroll
                    for (int j = 0; j < 8; ++j) if (j != i1 && f[j] > v2) { v2 = f[j]; i2 = j; }
                    const float w1 = 1.0f / (1.0f + __expf(v2 - v1)), w2 = 1.0f - w1;
                    int* cnt = (int*)(ws + WS_CTL) + CTL_CNT + layer * 32;
                    int* ltok = (int*)(ws + WS_LTOK); float* lgate = (float*)(ws + WS_LGATE);
                    const int tok = t0 + tid;
                    const int e1 = gi * 8 + i1, e2 = gi * 8 + i2;
                    const int p1 = atomicAdd(cnt + e1, 1); ltok[(size_t)e1 * M + p1] = tok * 2; lgate[(size_t)e1 * M + p1] = ptop * w1;
                    const int p2 = atomicAdd(cnt + e2, 1); ltok[(size_t)e2 * M + p2] = tok * 2 + 1; lgate[(size_t)e2 * M + p2] = ptop * w2;
                }
            }
        }
        __syncthreads();
    }
}

template <class Epi>
__device__ __forceinline__ void gemm_tile(char* lds, const bf16_t* a0, const bf16_t* a1, const bf16_t* a2, const bf16_t* a3,
                                          const bf16_t* b0, const bf16_t* b1, int nk, Epi& epi) {
    const int tid = threadIdx.x, lane = tid & 63, wave = tid >> 6, wm = wave >> 1, wn = wave & 1;
    const int lr = tid >> 3, lc = tid & 7, lsw = (lr >> 1) & 7;
    const int wofs = lr * 128 + ((lc ^ lsw) * 16);
    f32x16 acc[2][2];
#pragma unroll
    for (int i = 0; i < 2; ++i)
#pragma unroll
        for (int j = 0; j < 2; ++j)
#pragma unroll
            for (int r = 0; r < 16; ++r) acc[i][j][r] = 0.f;
    u32x4 ra0, ra1, ra2, ra3, rb0, rb1;
    ra0 = *(const u32x4*)a0; ra1 = *(const u32x4*)a1; ra2 = *(const u32x4*)a2; ra3 = *(const u32x4*)a3;
    rb0 = *(const u32x4*)b0; rb1 = *(const u32x4*)b1;
    {
        char* st = lds;
        *(u32x4*)(st + wofs) = ra0; *(u32x4*)(st + wofs + 8192) = ra1; *(u32x4*)(st + wofs + 16384) = ra2; *(u32x4*)(st + wofs + 24576) = ra3;
        *(u32x4*)(st + 32768 + wofs) = rb0; *(u32x4*)(st + 32768 + wofs + 8192) = rb1;
    }
    __syncthreads();
    const int fr = lane & 31, fh = lane >> 5, fsw = (fr >> 1) & 7;
    const int aofs = (wm * 64 + fr) * 128, bofs = 32768 + (wn * 64 + fr) * 128;
    for (int kt = 0; kt < nk; ++kt) {
        const char* st = lds + (kt & 1) * 49152;
        if (kt + 1 < nk) {
            const int ko = (kt + 1) * 64;
            ra0 = *(const u32x4*)(a0 + ko); ra1 = *(const u32x4*)(a1 + ko); ra2 = *(const u32x4*)(a2 + ko); ra3 = *(const u32x4*)(a3 + ko);
            rb0 = *(const u32x4*)(b0 + ko); rb1 = *(const u32x4*)(b1 + ko);
        }
#pragma unroll
        for (int kk = 0; kk < 4; ++kk) {
            const int co = (((kk * 2 + fh) ^ fsw) * 16);
            const bf16x8 af0 = *(const bf16x8*)(st + aofs + co), af1 = *(const bf16x8*)(st + aofs + 4096 + co);
            const bf16x8 wf0 = *(const bf16x8*)(st + bofs + co), wf1 = *(const bf16x8*)(st + bofs + 4096 + co);
            acc[0][0] = __builtin_amdgcn_mfma_f32_32x32x16_bf16(wf0, af0, acc[0][0], 0, 0, 0);
            acc[0][1] = __builtin_amdgcn_mfma_f32_32x32x16_bf16(wf1, af0, acc[0][1], 0, 0, 0);
            acc[1][0] = __builtin_amdgcn_mfma_f32_32x32x16_bf16(wf0, af1, acc[1][0], 0, 0, 0);
            acc[1][1] = __builtin_amdgcn_mfma_f32_32x32x16_bf16(wf1, af1, acc[1][1], 0, 0, 0);
        }
        if (kt + 1 < nk) {
            char* sn = lds + ((kt + 1) & 1) * 49152;
            *(u32x4*)(sn + wofs) = ra0; *(u32x4*)(sn + wofs + 8192) = ra1; *(u32x4*)(sn + wofs + 16384) = ra2; *(u32x4*)(sn + wofs + 24576) = ra3;
            *(u32x4*)(sn + 32768 + wofs) = rb0; *(u32x4*)(sn + 32768 + wofs + 8192) = rb1;
        }
        __syncthreads();
    }
    epi(acc, wm, wn, fr, fh);
}

struct EpiStoreBf16 { bf16_t* C; int ldc, m0, n0;
    __device__ __forceinline__ void operator()(const f32x16 (&acc)[2][2], int wm, int wn, int fr, int fh) const {
#pragma unroll
        for (int i = 0; i < 2; ++i) { bf16_t* rowp = C + (size_t)(m0 + wm * 64 + i * 32 + fr) * ldc + n0 + wn * 64 + 4 * fh;
#pragma unroll
            for (int j = 0; j < 2; ++j)
#pragma unroll
                for (int g = 0; g < 4; ++g) { u32x2 o; o.x = pack2(acc[i][j][4 * g], acc[i][j][4 * g + 1]); o.y = pack2(acc[i][j][4 * g + 2], acc[i][j][4 * g + 3]);
                    *(u32x2*)(rowp + j * 32 + 8 * g) = o; } }
    } };
struct EpiResidF32 { const float* R; float* C; int m0, n0;
    __device__ __forceinline__ void operator()(const f32x16 (&acc)[2][2], int wm, int wn, int fr, int fh) const {
#pragma unroll
        for (int i = 0; i < 2; ++i) { const size_t ro = (size_t)(m0 + wm * 64 + i * 32 + fr) * D + n0 + wn * 64 + 4 * fh;
#pragma unroll
            for (int j = 0; j < 2; ++j)
#pragma unroll
                for (int g = 0; g < 4; ++g) { const float4 r = *(const float4*)(R + ro + j * 32 + 8 * g);
                    float4 o; o.x = r.x + acc[i][j][4 * g]; o.y = r.y + acc[i][j][4 * g + 1]; o.z = r.z + acc[i][j][4 * g + 2]; o.w = r.w + acc[i][j][4 * g + 3];
                    *(float4*)(C + ro + j * 32 + 8 * g) = o; } }
    } };

template <int WHICH>
__device__ __forceinline__ void phase_dense_gemm(const Params& p, char* lds) {
    unsigned char* ws = p.ws;
    const bf16_t* A = (const bf16_t*)(ws + WS_XN);
    const bf16_t* Bt = (const bf16_t*)(ws + (WHICH == 0 ? WS_WIN0 : WHICH == 1 ? WS_WOUT0 : WHICH == 2 ? WS_WIN1 : WS_WOUT1));
    constexpr int N = (WHICH == 0) ? EVEN_IN : (WHICH == 2) ? ODD_IN : D;
    constexpr int nN = N / 128, nM = M / 256;
    const int G = gridDim.x, b = blockIdx.x;
    const int tid = threadIdx.x, lr = tid >> 3, lc = tid & 7;
    const bool xs = (G % 8 == 0);
    const int per = xs ? G / 8 : G, xcd = xs ? b % 8 : 0, lb = xs ? b / 8 : b;
    const int tiles_local = xs ? (nM / 8) * nN : nM * nN;
    for (int lt = lb; lt < tiles_local; lt += per) {
        int mt, nt;
        if (xs) { mt = xcd * 8 + (lt & 7); nt = lt >> 3; } else { mt = lt % nM; nt = lt / nM; }
        const int m0 = mt * 256, n0 = nt * 128;
        const bf16_t* a0 = A + (size_t)(m0 + lr) * D + lc * 8;
        const bf16_t* b0 = Bt + (size_t)(n0 + lr) * D + lc * 8;
        if (WHICH == 0 || WHICH == 2) { EpiStoreBf16 e{(bf16_t*)(ws + WS_P), N, m0, n0};
            gemm_tile(lds, a0, a0 + 64 * D, a0 + 128 * D, a0 + 192 * D, b0, b0 + 64 * D, D / 64, e); }
        else { EpiResidF32 e{WHICH == 1 ? p.x : p.out, p.out, m0, n0};
            gemm_tile(lds, a0, a0 + 64 * D, a0 + 128 * D, a0 + 192 * D, b0, b0 + 64 * D, D / 64, e); }
    }
}

struct EpiGateUp { bf16_t* HID; const float* lgate; int cnt, mloc0, slot0, f0;
    __device__ __forceinline__ void operator()(const f32x16 (&acc)[2][2], int wm, int wn, int fr, int fh) const {
#pragma unroll
        for (int i = 0; i < 2; ++i) { const int ml = mloc0 + wm * 64 + i * 32 + fr;
            if (ml < cnt) { const float gt = lgate[ml]; bf16_t* rowp = HID + (size_t)(slot0 + ml) * 256 + f0 + wn * 32 + 4 * fh;
#pragma unroll
                for (int g = 0; g < 4; ++g) { float h[4];
#pragma unroll
                    for (int e = 0; e < 4; ++e) { const float a = acc[i][0][4 * g + e], u = acc[i][1][4 * g + e]; h[e] = siluf_(a) * u * gt; }
                    u32x2 o; o.x = pack2(h[0], h[1]); o.y = pack2(h[2], h[3]); *(u32x2*)(rowp + 8 * g) = o; } } }
    } };
struct EpiDown { bf16_t* Y; const int* ltok; int cnt, mloc0, n0;
    __device__ __forceinline__ void operator()(const f32x16 (&acc)[2][2], int wm, int wn, int fr, int fh) const {
#pragma unroll
        for (int i = 0; i < 2; ++i) { const int ml = mloc0 + wm * 64 + i * 32 + fr;
            if (ml < cnt) { const int tk = ltok[ml]; bf16_t* rowp = Y + ((size_t)(tk & 1) * M + (tk >> 1)) * D + n0 + wn * 64 + 4 * fh;
#pragma unroll
                for (int j = 0; j < 2; ++j)
#pragma unroll
                    for (int g = 0; g < 4; ++g) { u32x2 o; o.x = pack2(acc[i][j][4 * g], acc[i][j][4 * g + 1]); o.y = pack2(acc[i][j][4 * g + 2], acc[i][j][4 * g + 3]);
                        *(u32x2*)(rowp + j * 32 + 8 * g) = o; } } }
    } };

template <int DOWN>
__device__ __forceinline__ void phase_moe_gemm(const Params& p, char* lds, int layer) {
    unsigned char* ws = p.ws;
    const int tid = threadIdx.x, lr = tid >> 3, lc = tid & 7;
    int* sh = (int*)(lds + 98304);
    const int* cntg = (const int*)(ws + WS_CTL) + CTL_CNT + layer * 32;
    constexpr int NTN = DOWN ? 8 : 4;
    if (tid == 0) { int tp = 0, sp = 0;
        for (int e = 0; e < 32; ++e) { const int c = cntg[e]; sh[e] = tp; sh[64 + e] = sp; sh[128 + e] = c; tp += ((c + 255) >> 8) * NTN; sp += c; }
        sh[32] = tp; }
    __syncthreads();
    const int total = sh[32];
    const int* ltok_all = (const int*)(ws + WS_LTOK); const float* lgate_all = (const float*)(ws + WS_LGATE);
    bf16_t* HID = (bf16_t*)(ws + WS_P + P_HID); bf16_t* Y = (bf16_t*)(ws + WS_P + P_Y);
    const bf16_t* XN = (const bf16_t*)(ws + WS_XN);
    for (int t = blockIdx.x; t < total; t += gridDim.x) {
        int e = 0;
#pragma unroll 1
        for (int q = 1; q < 32; ++q) if (t >= sh[q]) e = q;
        const int r = t - sh[e], mt = r / NTN, nt = r % NTN;
        const int cnt = sh[128 + e], slot0 = sh[64 + e], mloc0 = mt * 256;
        const int* ltok = ltok_all + (size_t)e * M; const float* lgate = lgate_all + (size_t)e * M;
        int rows[4];
#pragma unroll
        for (int i = 0; i < 4; ++i) { int ml = mloc0 + lr + 64 * i; rows[i] = ml < cnt ? ml : cnt - 1; }
        if (!DOWN) {
            const bf16_t* Bt = (const bf16_t*)(ws + WS_WGU) + ((size_t)(layer * 32 + e) * 512 + nt * 128 + lr) * 1024 + lc * 8;
            const bf16_t* a0 = XN + (size_t)(ltok[rows[0]] >> 1) * D + lc * 8;
            const bf16_t* a1 = XN + (size_t)(ltok[rows[1]] >> 1) * D + lc * 8;
            const bf16_t* a2 = XN + (size_t)(ltok[rows[2]] >> 1) * D + lc * 8;
            const bf16_t* a3 = XN + (size_t)(ltok[rows[3]] >> 1) * D + lc * 8;
            EpiGateUp ep{HID, lgate, cnt, mloc0, slot0, nt * 64};
            gemm_tile(lds, a0, a1, a2, a3, Bt, Bt + (size_t)64 * 1024, 16, ep);
        } else {
            const bf16_t* Bt = (const bf16_t*)(ws + WS_WD) + ((size_t)(layer * 32 + e) * 1024 + nt * 128 + lr) * 256 + lc * 8;
            const bf16_t* a0 = HID + (size_t)(slot0 + rows[0]) * 256 + lc * 8;
            const bf16_t* a1 = HID + (size_t)(slot0 + rows[1]) * 256 + lc * 8;
            const bf16_t* a2 = HID + (size_t)(slot0 + rows[2]) * 256 + lc * 8;
            const bf16_t* a3 = HID + (size_t)(slot0 + rows[3]) * 256 + lc * 8;
            EpiDown ep{Y, ltok, cnt, mloc0, nt * 128};
            gemm_tile(lds, a0, a1, a2, a3, Bt, Bt + (size_t)64 * 256, 4, ep);
        }
    }
    __syncthreads();
}

constexpr int CH = 32;

__device__ __forceinline__ void rwkv_unit(const Params& p, char* lds, int bb, int hh, int cg) {
    const int tid = threadIdx.x;
    unsigned char* ws = p.ws;
    const bf16_t* P = (const bf16_t*)(ws + WS_P);
    bf16_t* O16 = (bf16_t*)(ws + WS_XN);
    float* AUX = p.out;
    float* w2s = (float*)lds;
    float* a2s = w2s + 4096;
    float* g2s = a2s + 4096;
    float* TW = g2s + 4096;
    float* AL = TW + CH * 64;
    float* SG = AL + CH * 64;
    float* R = SG + CH * 128;
    float* KS = R + CH * 64;
    float* WD = KS + CH * 64;
    float* KK = WD + CH * 64;
    float* BB = KK + CH * 64;
    float* VS = BB + CH * 64;
    float* YS = VS + CH * 32;
    for (int i = tid; i < 4096; i += NT) { const int j = i >> 6, c = i & 63; w2s[i] = p.rw_w2[j * 512 + hh * 64 + c]; a2s[i] = p.rw_a2[j * 512 + hh * 64 + c]; }
    for (int i = tid; i < 4096; i += NT) { const int j = i >> 5, c = i & 31; g2s[i] = p.rw_g2[j * 512 + hh * 64 + cg * 32 + c]; }
    int pcol = 0, role = -1, lcol = 0;
    if (tid < 64) { role = 0; lcol = tid; pcol = hh * 64 + lcol; }
    else if (tid < 128) { role = 1; lcol = tid - 64; pcol = 512 + hh * 64 + lcol; }
    else if (tid < 160) { role = 2; lcol = tid - 128; pcol = 1024 + hh * 64 + cg * 32 + lcol; }
    else if (tid < 224) { role = 3; lcol = tid - 160; pcol = 1536 + lcol; }
    else if (tid < 288) { role = 4; lcol = tid - 224; pcol = 1600 + lcol; }
    else if (tid < 416) { role = 5; lcol = tid - 288; pcol = 1664 + lcol; }
    const float mu = role >= 0 ? p.ev_mu[pcol] : 0.f;
    const bf16_t* pbase = P + (size_t)(bb * SEQ) * EVEN_IN + pcol;
    float prev = 0.f;
    float praw[CH];
    if (role >= 0) {
#pragma unroll
        for (int i = 0; i < CH; ++i) praw[i] = bf2f(pbase[(size_t)i * EVEN_IN]);
    }
    const int vrow = tid >> 4, kq = tid & 15;
    float S0 = 0.f, S1 = 0.f, S2 = 0.f, S3 = 0.f;
    const int pt = tid >> 4, pc4 = (tid & 15) * 4;
    const int hc = hh * 64 + pc4;
    const float4 w0v = *(const float4*)(p.rw_w0 + hc), a0v = *(const float4*)(p.rw_a0 + hc), kkv = *(const float4*)(p.rw_k_k + hc), kav = *(const float4*)(p.rw_k_a + hc), rkv = *(const float4*)(p.rw_r_k + hc);
    __syncthreads();
    for (int c0 = 0; c0 < SEQ; c0 += CH) {
        if (role >= 0) {
#pragma unroll
            for (int i = 0; i < CH; ++i) {
                const float cur = praw[i];
                const float s = cur + mu * (prev - cur);
                prev = cur;
                if (role == 0) R[i * 64 + lcol] = s;
                else if (role == 1) KS[i * 64 + lcol] = s;
                else if (role == 2) VS[i * 32 + lcol] = s;
                else if (role == 3) TW[i * 64 + lcol] = tanhf(s);
                else if (role == 4) AL[i * 64 + lcol] = s;
                else SG[i * 128 + lcol] = sigmoidf_(s);
            }
        }
        __syncthreads();
        if (role >= 0 && c0 + CH < SEQ) {
#pragma unroll
            for (int i = 0; i < CH; ++i) praw[i] = bf2f(pbase[(size_t)(c0 + CH + i) * EVEN_IN]);
        }
        {
            float wp0 = w0v.x, wp1 = w0v.y, wp2 = w0v.z, wp3 = w0v.w, ap0 = a0v.x, ap1 = a0v.y, ap2 = a0v.z, ap3 = a0v.w;
#pragma unroll 8
            for (int j = 0; j < 64; ++j) {
                const float tw = TW[pt * 64 + j], al = AL[pt * 64 + j];
                const float4 w2 = *(const float4*)(w2s + j * 64 + pc4), a2 = *(const float4*)(a2s + j * 64 + pc4);
                wp0 += tw * w2.x; wp1 += tw * w2.y; wp2 += tw * w2.z; wp3 += tw * w2.w;
                ap0 += al * a2.x; ap1 += al * a2.y; ap2 += al * a2.z; ap3 += al * a2.w;
            }
            const int gc = (tid & 15) * 2;
            float g0 = 0.f, g1 = 0.f;
#pragma unroll 8
            for (int j = 0; j < 128; ++j) { const float sg = SG[pt * 128 + j]; const float2 g2 = *(const float2*)(g2s + j * 32 + gc); g0 += sg * g2.x; g1 += sg * g2.y; }
            const float4 ks = *(const float4*)(KS + pt * 64 + pc4);
            const float4 rs = *(const float4*)(R + pt * 64 + pc4);
            float d0 = __expf(-__expf(-softplusf_(-wp0) - 0.5f)), d1 = __expf(-__expf(-softplusf_(-wp1) - 0.5f));
            float d2 = __expf(-__expf(-softplusf_(-wp2) - 0.5f)), d3 = __expf(-__expf(-softplusf_(-wp3) - 0.5f));
            const float A0 = sigmoidf_(ap0), A1 = sigmoidf_(ap1), A2 = sigmoidf_(ap2), A3 = sigmoidf_(ap3);
            float q0 = ks.x * kkv.x, q1 = ks.y * kkv.y, q2 = ks.z * kkv.z, q3 = ks.w * kkv.w;
            const float nrm = rsqrtf(red16(q0 * q0 + q1 * q1 + q2 * q2 + q3 * q3) + 1e-6f);
            q0 *= nrm; q1 *= nrm; q2 *= nrm; q3 *= nrm;
            const float k20 = ks.x * (1.f + (A0 - 1.f) * kav.x), k21 = ks.y * (1.f + (A1 - 1.f) * kav.y), k22 = ks.z * (1.f + (A2 - 1.f) * kav.z), k23 = ks.w * (1.f + (A3 - 1.f) * kav.w);
            const float bonus = red16(rs.x * k20 * rkv.x + rs.y * k21 * rkv.y + rs.z * k22 * rkv.z + rs.w * k23 * rkv.w);
            float4 o;
            o.x = d0; o.y = d1; o.z = d2; o.w = d3; *(float4*)(WD + pt * 64 + pc4) = o;
            o.x = q0; o.y = q1; o.z = q2; o.w = q3; *(float4*)(KK + pt * 64 + pc4) = o;
            o.x = q0 * A0; o.y = q1 * A1; o.z = q2 * A2; o.w = q3 * A3; *(float4*)(BB + pt * 64 + pc4) = o;
            __syncthreads();
            o.x = k20; o.y = k21; o.z = k22; o.w = k23; *(float4*)(KS + pt * 64 + pc4) = o;
            const float2 vv = *(const float2*)(VS + pt * 32 + gc);
            const size_t tok = (size_t)bb * SEQ + c0 + pt;
            const int oc = hh * 64 + cg * 32 + gc;
            float2 bo; bo.x = bonus * vv.x; bo.y = bonus * vv.y; *(float2*)(AUX + tok * D + oc) = bo;
            float2 go; go.x = g0; go.y = g1; *(float2*)(AUX + tok * D + 512 + oc) = go;
        }
        __syncthreads();
#pragma unroll 2
        for (int i = 0; i < CH; ++i) {
            const float4 kk = *(const float4*)(KK + i * 64 + kq * 4), wd = *(const float4*)(WD + i * 64 + kq * 4), b4 = *(const float4*)(BB + i * 64 + kq * 4);
            const float4 k2 = *(const float4*)(KS + i * 64 + kq * 4), r4 = *(const float4*)(R + i * 64 + kq * 4);
            const float v = VS[i * 32 + vrow];
            const float sa = -red16(S0 * kk.x + S1 * kk.y + S2 * kk.z + S3 * kk.w);
            S0 = S0 * wd.x + v * k2.x + sa * b4.x; S1 = S1 * wd.y + v * k2.y + sa * b4.y; S2 = S2 * wd.z + v * k2.z + sa * b4.z; S3 = S3 * wd.w + v * k2.w + sa * b4.w;
            const float y = red16(S0 * r4.x + S1 * r4.y + S2 * r4.z + S3 * r4.w);
            if (kq == 0) YS[i * 32 + vrow] = y;
        }
        __syncthreads();
        {
            const int ft = tid >> 4, fc = (tid & 15) * 2;
            const unsigned o = pack2(YS[ft * 32 + fc], YS[ft * 32 + fc + 1]);
            *(unsigned*)(O16 + ((size_t)bb * SEQ + c0 + ft) * D + hh * 64 + cg * 32 + fc) = o;
        }
    }
    __syncthreads();
}

__device__ __forceinline__ void hgrn_unit(const Params& p, char* lds, int bb, int hh, int cg) {
    const int tid = threadIdx.x;
    unsigned char* ws = p.ws;
    const bf16_t* P = (const bf16_t*)(ws + WS_P);
    bf16_t* O16 = (bf16_t*)(ws + WS_XN);
    float* Q = (float*)lds;
    float* FG = Q + CH * 64;
    float* KM = FG + CH * 64;
    float* VS = KM + CH * 64;
    float* YS = VS + CH * 32;
    int pcol = 0, role = -1, lcol = 0;
    if (tid < 64) { role = 0; lcol = tid; pcol = 1792 + hh * 64 + lcol; }
    else if (tid < 128) { role = 1; lcol = tid - 64; pcol = 1792 + 512 + hh * 64 + lcol; }
    else if (tid < 160) { role = 2; lcol = tid - 128; pcol = 1792 + 1024 + hh * 64 + cg * 32 + lcol; }
    float lb = 0.f;
    if (role == 1) { const float l0 = p.hg_lb[hh * 64 + lcol], l1 = p.hg_lb[512 + hh * 64 + lcol]; const float mx = fmaxf(l0, l1); const float e0 = __expf(l0 - mx), e1 = __expf(l1 - mx); lb = e0 / (e0 + e1); }
    const bf16_t* pbase = P + (size_t)(bb * SEQ) * EVEN_IN + pcol;
    float praw[CH];
    if (role >= 0) {
#pragma unroll
        for (int i = 0; i < CH; ++i) praw[i] = bf2f(pbase[(size_t)i * EVEN_IN]);
    }
    const int vcol = tid >> 4, dq = tid & 15;
    float S0 = 0.f, S1 = 0.f, S2 = 0.f, S3 = 0.f;
    for (int c0 = 0; c0 < SEQ; c0 += CH) {
        if (role >= 0) {
#pragma unroll
            for (int i = 0; i < CH; ++i) {
                const float s = praw[i];
                if (role == 0) Q[i * 64 + lcol] = siluf_(s);
                else if (role == 1) { const float fg = lb + (1.f - lb) * sigmoidf_(s); FG[i * 64 + lcol] = fg; KM[i * 64 + lcol] = 1.f - fg; }
                else VS[i * 32 + lcol] = s;
            }
        }
        __syncthreads();
        if (role >= 0 && c0 + CH < SEQ) {
#pragma unroll
            for (int i = 0; i < CH; ++i) praw[i] = bf2f(pbase[(size_t)(c0 + CH + i) * EVEN_IN]);
        }
#pragma unroll 2
        for (int i = 0; i < CH; ++i) {
            const float4 fg = *(const float4*)(FG + i * 64 + dq * 4), km = *(const float4*)(KM + i * 64 + dq * 4), q4 = *(const float4*)(Q + i * 64 + dq * 4);
            const float v = VS[i * 32 + vcol];
            S0 = fg.x * S0 + km.x * v; S1 = fg.y * S1 + km.y * v; S2 = fg.z * S2 + km.z * v; S3 = fg.w * S3 + km.w * v;
            const float y = red16(S0 * q4.x + S1 * q4.y + S2 * q4.z + S3 * q4.w);
            if (dq == 0) YS[i * 32 + vcol] = y;
        }
        __syncthreads();
        {
            const int ft = tid >> 4, fc = (tid & 15) * 2;
            const unsigned o = pack2(YS[ft * 32 + fc], YS[ft * 32 + fc + 1]);
            *(unsigned*)(O16 + ((size_t)bb * SEQ + c0 + ft) * D + 512 + hh * 64 + cg * 32 + fc) = o;
        }
        __syncthreads();
    }
}

__device__ __forceinline__ void phase_mix0(const Params& p, char* lds) {
    for (int u = blockIdx.x; u < 256; u += gridDim.x) {
        const int v = u & 127, bb = v >> 4, hh = (v >> 1) & 7, cg = v & 1;
        if (u < 128) rwkv_unit(p, lds, bb, hh, cg); else hgrn_unit(p, lds, bb, hh, cg);
        __syncthreads();
    }
}

__device__ __forceinline__ void phase_post0(const Params& p) {
    const int tid = threadIdx.x, lane = tid & 63, wave = tid >> 6;
    unsigned char* ws = p.ws;
    bf16_t* O16 = (bf16_t*)(ws + WS_XN);
    const bf16_t* P = (const bf16_t*)(ws + WS_P);
    const float* AUX = p.out;
    const int c0 = lane * 16;
    for (int tok = blockIdx.x * 8 + wave; tok < M; tok += gridDim.x * 8) {
        const u32x4 r0 = *(const u32x4*)(O16 + (size_t)tok * D + c0), r1 = *(const u32x4*)(O16 + (size_t)tok * D + c0 + 8);
        float y[16];
        y[0] = lo16(r0.x); y[1] = hi16(r0.x); y[2] = lo16(r0.y); y[3] = hi16(r0.y); y[4] = lo16(r0.z); y[5] = hi16(r0.z); y[6] = lo16(r0.w); y[7] = hi16(r0.w);
        y[8] = lo16(r1.x); y[9] = hi16(r1.x); y[10] = lo16(r1.y); y[11] = hi16(r1.y); y[12] = lo16(r1.z); y[13] = hi16(r1.z); y[14] = lo16(r1.w); y[15] = hi16(r1.w);
        float o[16];
        if (lane < 32) {
            float s = 0.f;
#pragma unroll
            for (int j = 0; j < 16; ++j) s += y[j];
            s += dppf<0xB1>(s); s += dppf<0x4E>(s);
            const float mean = s * (1.0f / 64.0f);
            float q = 0.f;
#pragma unroll
            for (int j = 0; j < 16; ++j) { const float d = y[j] - mean; q += d * d; }
            q += dppf<0xB1>(q); q += dppf<0x4E>(q);
            const float rstd = rsqrtf(q * (1.0f / 64.0f) + 64e-5f);
#pragma unroll
            for (int j4 = 0; j4 < 4; ++j4) {
                const float4 lw = *(const float4*)(p.rw_ln_w + c0 + j4 * 4), lb = *(const float4*)(p.rw_ln_b + c0 + j4 * 4);
                const float4 bv = *(const float4*)(AUX + (size_t)tok * D + c0 + j4 * 4), gv = *(const float4*)(AUX + (size_t)tok * D + 512 + c0 + j4 * 4);
                o[j4 * 4 + 0] = ((y[j4 * 4 + 0] - mean) * rstd * lw.x + lb.x + bv.x) * gv.x;
                o[j4 * 4 + 1] = ((y[j4 * 4 + 1] - mean) * rstd * lw.y + lb.y + bv.y) * gv.y;
                o[j4 * 4 + 2] = ((y[j4 * 4 + 2] - mean) * rstd * lw.z + lb.z + bv.z) * gv.z;
                o[j4 * 4 + 3] = ((y[j4 * 4 + 3] - mean) * rstd * lw.w + lb.w + bv.w) * gv.w;
            }
        } else {
            float q = 0.f;
#pragma unroll
            for (int j = 0; j < 16; ++j) q += y[j] * y[j];
            q += dppf<0xB1>(q); q += dppf<0x4E>(q);
            const float rstd = rsqrtf(q * (1.0f / 64.0f) + 1e-6f);
            const int cc = c0 - 512;
            const u32x4 g0 = *(const u32x4*)(P + (size_t)tok * EVEN_IN + 1792 + 1536 + cc), g1 = *(const u32x4*)(P + (size_t)tok * EVEN_IN + 1792 + 1536 + cc + 8);
            float gt[16];
            gt[0] = lo16(g0.x); gt[1] = hi16(g0.x); gt[2] = lo16(g0.y); gt[3] = hi16(g0.y); gt[4] = lo16(g0.z); gt[5] = hi16(g0.z); gt[6] = lo16(g0.w); gt[7] = hi16(g0.w);
            gt[8] = lo16(g1.x); gt[9] = hi16(g1.x); gt[10] = lo16(g1.y); gt[11] = hi16(g1.y); gt[12] = lo16(g1.z); gt[13] = hi16(g1.z); gt[14] = lo16(g1.w); gt[15] = hi16(g1.w);
#pragma unroll
            for (int j = 0; j < 16; ++j) o[j] = y[j] * rstd * p.hg_norm[(cc + j) & 63] * siluf_(gt[j]);
        }
        u32x4 w0, w1;
        w0.x = pack2(o[0], o[1]); w0.y = pack2(o[2], o[3]); w0.z = pack2(o[4], o[5]); w0.w = pack2(o[6], o[7]);
        w1.x = pack2(o[8], o[9]); w1.y = pack2(o[10], o[11]); w1.z = pack2(o[12], o[13]); w1.w = pack2(o[14], o[15]);
        *(u32x4*)(O16 + (size_t)tok * D + c0) = w0; *(u32x4*)(O16 + (size_t)tok * D + c0 + 8) = w1;
    }
}

__device__ __forceinline__ void gdn_unit(const Params& p, char* lds, int bb, int hh, int cg) {
    const int tid = threadIdx.x;
    unsigned char* ws = p.ws;
    const bf16_t* P = (const bf16_t*)(ws + WS_P);
    const float* GT = (const float*)(ws + WS_GATES);
    bf16_t* O16 = (bf16_t*)(ws + WS_XN);
    float* Q = (float*)lds;
    float* K = Q + CH * 128;
    float* VS = K + CH * 128;
    float* YS = VS + CH * 32;
    float* BE = YS + CH * 32;
    float* AD = BE + CH;
    int role = -1, lcol = 0, ccol = 0;
    if (tid < 128) { role = 0; lcol = tid; ccol = hh * 128 + lcol; }
    else if (tid < 256) { role = 1; lcol = tid - 128; ccol = 512 + hh * 128 + lcol; }
    else if (tid < 288) { role = 2; lcol = tid - 256; ccol = 1024 + hh * 128 + cg * 32 + lcol; }
    float cw0 = 0.f, cw1 = 0.f, cw2 = 0.f, cw3 = 0.f;
    if (role >= 0) { cw0 = p.gd_conv[ccol]; cw1 = p.gd_conv[1536 + ccol]; cw2 = p.gd_conv[2 * 1536 + ccol]; cw3 = p.gd_conv[3 * 1536 + ccol]; }
    const bf16_t* pbase = P + (size_t)(bb * SEQ) * ODD_IN + ccol;
    float x1 = 0.f, x2 = 0.f, x3 = 0.f;
    float praw[CH];
    if (role >= 0) {
#pragma unroll
        for (int i = 0; i < CH; ++i) praw[i] = bf2f(pbase[(size_t)i * ODD_IN]);
    }
    const float negA = -__expf(p.gd_a_log[hh]), dtb = p.gd_dt_bias[hh];
    const int vcol = tid >> 4, dq = tid & 15;
    float S[8];
#pragma unroll
    for (int j = 0; j < 8; ++j) S[j] = 0.f;
    for (int c0 = 0; c0 < SEQ; c0 += CH) {
        if (role >= 0) {
#pragma unroll
            for (int i = 0; i < CH; ++i) {
                const float cur = praw[i];
                const float yv = siluf_(cw0 * x3 + cw1 * x2 + cw2 * x1 + cw3 * cur);
                x3 = x2; x2 = x1; x1 = cur;
                if (role == 0) Q[i * 128 + lcol] = yv; else if (role == 1) K[i * 128 + lcol] = yv; else VS[i * 32 + lcol] = yv;
            }
        }
        if (tid >= 320 && tid < 320 + CH) { const int i = tid - 320; const size_t tok = (size_t)bb * SEQ + c0 + i;
            BE[i] = sigmoidf_(GT[tok * 16 + hh]); AD[i] = __expf(negA * softplusf_(GT[tok * 16 + 4 + hh] + dtb)); }
        __syncthreads();
        if (role >= 0 && c0 + CH < SEQ) {
#pragma unroll
            for (int i = 0; i < CH; ++i) praw[i] = bf2f(pbase[(size_t)(c0 + CH + i) * ODD_IN]);
        }
        {
            const int t = tid >> 4, c8 = (tid & 15) * 8;
            float4 qa = *(const float4*)(Q + t * 128 + c8), qb = *(const float4*)(Q + t * 128 + c8 + 4);
            float4 ka = *(const float4*)(K + t * 128 + c8), kb = *(const float4*)(K + t * 128 + c8 + 4);
            const float sq = red16(qa.x * qa.x + qa.y * qa.y + qa.z * qa.z + qa.w * qa.w + qb.x * qb.x + qb.y * qb.y + qb.z * qb.z + qb.w * qb.w);
            const float sk = red16(ka.x * ka.x + ka.y * ka.y + ka.z * ka.z + ka.w * ka.w + kb.x * kb.x + kb.y * kb.y + kb.z * kb.z + kb.w * kb.w);
            const float nq = rsqrtf(sq + 1e-6f) * 0.08838834764831845f, nk = rsqrtf(sk + 1e-6f);
            qa.x *= nq; qa.y *= nq; qa.z *= nq; qa.w *= nq; qb.x *= nq; qb.y *= nq; qb.z *= nq; qb.w *= nq;
            ka.x *= nk; ka.y *= nk; ka.z *= nk; ka.w *= nk; kb.x *= nk; kb.y *= nk; kb.z *= nk; kb.w *= nk;
            *(float4*)(Q + t * 128 + c8) = qa; *(float4*)(Q + t * 128 + c8 + 4) = qb; *(float4*)(K + t * 128 + c8) = ka; *(float4*)(K + t * 128 + c8 + 4) = kb;
        }
        __syncthreads();
#pragma unroll 2
        for (int i = 0; i < CH; ++i) {
            const float4 ka = *(const float4*)(K + i * 128 + dq * 8), kb = *(const float4*)(K + i * 128 + dq * 8 + 4);
            const float4 qa = *(const float4*)(Q + i * 128 + dq * 8), qb = *(const float4*)(Q + i * 128 + dq * 8 + 4);
            const float v = VS[i * 32 + vcol], be = BE[i], a = AD[i];
            const float ks = red16(ka.x * S[0] + ka.y * S[1] + ka.z * S[2] + ka.w * S[3] + kb.x * S[4] + kb.y * S[5] + kb.z * S[6] + kb.w * S[7]);
            const float vn = be * (v - a * ks);
            S[0] = a * S[0] + ka.x * vn; S[1] = a * S[1] + ka.y * vn; S[2] = a * S[2] + ka.z * vn; S[3] = a * S[3] + ka.w * vn;
            S[4] = a * S[4] + kb.x * vn; S[5] = a * S[5] + kb.y * vn; S[6] = a * S[6] + kb.z * vn; S[7] = a * S[7] + kb.w * vn;
            const float y = red16(qa.x * S[0] + qa.y * S[1] + qa.z * S[2] + qa.w * S[3] + qb.x * S[4] + qb.y * S[5] + qb.z * S[6] + qb.w * S[7]);
            if (dq == 0) YS[i * 32 + vcol] = y;
        }
        __syncthreads();
        {
            const int ft = tid >> 4, fc = (tid & 15) * 2;
            const unsigned o = pack2(YS[ft * 32 + fc], YS[ft * 32 + fc + 1]);
            *(unsigned*)(O16 + ((size_t)bb * SEQ + c0 + ft) * D + hh * 128 + cg * 32 + fc) = o;
        }
        __syncthreads();
    }
}

__device__ __forceinline__ void mlstm_unit(const Params& p, char* lds, int bb, int hh, int cg) {
    const int tid = threadIdx.x, lane = tid & 63;
    unsigned char* ws = p.ws;
    const bf16_t* P = (const bf16_t*)(ws + WS_P);
    const float* GT = (const float*)(ws + WS_GATES);
    bf16_t* O16 = (bf16_t*)(ws + WS_XN);
    float* Q = (float*)lds;
    float* K = Q + CH * 128;
    float* VS = K + CH * 128;
    float* YS = VS + CH * 32;
    float* IG = YS + CH * 32;
    float* LF = IG + CH;
    int role = -1, lcol = 0, pcol = 0;
    if (tid < 128) { role = 0; lcol = tid; pcol = 2048 + hh * 128 + lcol; }
    else if (tid < 256) { role = 1; lcol = tid - 128; pcol = 2560 + hh * 128 + lcol; }
    else if (tid < 288) { role = 2; lcol = tid - 256; pcol = 3072 + hh * 128 + cg * 32 + lcol; }
    const bf16_t* pbase = P + (size_t)(bb * SEQ) * ODD_IN + pcol;
    float praw[CH];
    if (role >= 0) {
#pragma unroll
        for (int i = 0; i < CH; ++i) praw[i] = bf2f(pbase[(size_t)i * ODD_IN]);
    }
    const float ib = p.ml_i_bias[hh], fb = p.ml_f_bias[hh];
    const int vcol = tid >> 4, dq = tid & 15;
    float C[8];
#pragma unroll
    for (int j = 0; j < 8; ++j) C[j] = 0.f;
    float n0 = 0.f, n1 = 0.f;
    float m = 0.f;
    for (int c0 = 0; c0 < SEQ; c0 += CH) {
        if (role >= 0) {
#pragma unroll
            for (int i = 0; i < CH; ++i) {
                const float s = praw[i];
                if (role == 0) Q[i * 128 + lcol] = s; else if (role == 1) K[i * 128 + lcol] = s * 0.08838834764831845f; else VS[i * 32 + lcol] = s;
            }
        }
        if (tid >= 320 && tid < 320 + CH) { const int i = tid - 320; const size_t tok = (size_t)bb * SEQ + c0 + i;
            IG[i] = GT[tok * 16 + 8 + hh] + ib; const float z = GT[tok * 16 + 12 + hh] + fb; LF[i] = -softplusf_(-z); }
        __syncthreads();
        if (role >= 0 && c0 + CH < SEQ) {
#pragma unroll
            for (int i = 0; i < CH; ++i) praw[i] = bf2f(pbase[(size_t)(c0 + CH + i) * ODD_IN]);
        }
#pragma unroll 2
        for (int i = 0; i < CH; ++i) {
            const float4 ka = *(const float4*)(K + i * 128 + dq * 8), kb = *(const float4*)(K + i * 128 + dq * 8 + 4);
            const float4 qa = *(const float4*)(Q + i * 128 + dq * 8), qb = *(const float4*)(Q + i * 128 + dq * 8 + 4);
            const float2 kn = *(const float2*)(K + i * 128 + lane * 2), qn = *(const float2*)(Q + i * 128 + lane * 2);
            const float v = VS[i * 32 + vcol];
            const float xm = LF[i] + m, ig = IG[i];
            const float mn = fmaxf(xm, ig);
            const float fd = __expf(xm - mn), iw = __expf(ig - mn);
            m = mn;
            const float iv = iw * v;
            C[0] = fd * C[0] + ka.x * iv; C[1] = fd * C[1] + ka.y * iv; C[2] = fd * C[2] + ka.z * iv; C[3] = fd * C[3] + ka.w * iv;
            C[4] = fd * C[4] + kb.x * iv; C[5] = fd * C[5] + kb.y * iv; C[6] = fd * C[6] + kb.z * iv; C[7] = fd * C[7] + kb.w * iv;
            n0 = fd * n0 + iw * kn.x; n1 = fd * n1 + iw * kn.y;
            const float num = red16(qa.x * C[0] + qa.y * C[1] + qa.z * C[2] + qa.w * C[3] + qb.x * C[4] + qb.y * C[5] + qb.z * C[6] + qb.w * C[7]);
            const float den = red64(qn.x * n0 + qn.y * n1);
            const float y = num / fmaxf(fabsf(den), __expf(-mn));
            if (dq == 0) YS[i * 32 + vcol] = y;
        }
        __syncthreads();
        {
            const int ft = tid >> 4, fc = (tid & 15) * 2;
            const unsigned o = pack2(YS[ft * 32 + fc], YS[ft * 32 + fc + 1]);
            *(unsigned*)(O16 + ((size_t)bb * SEQ + c0 + ft) * D + 512 + hh * 128 + cg * 32 + fc) = o;
        }
        __syncthreads();
    }
}

__device__ __forceinline__ void phase_mix1(const Params& p, char* lds) {
    for (int u = blockIdx.x; u < 256; u += gridDim.x) {
        const int v = u & 127, bb = v >> 4, hh = (v >> 2) & 3, cg = v & 3;
        if (u < 128) gdn_unit(p, lds, bb, hh, cg); else mlstm_unit(p, lds, bb, hh, cg);
        __syncthreads();
    }
}

__device__ __forceinline__ void phase_post1(const Params& p) {
    const int tid = threadIdx.x, lane = tid & 63, wave = tid >> 6;
    unsigned char* ws = p.ws;
    bf16_t* O16 = (bf16_t*)(ws + WS_XN);
    const bf16_t* P = (const bf16_t*)(ws + WS_P);
    const int c0 = lane * 16;
    for (int tok = blockIdx.x * 8 + wave; tok < M; tok += gridDim.x * 8) {
        const u32x4 r0 = *(const u32x4*)(O16 + (size_t)tok * D + c0), r1 = *(const u32x4*)(O16 + (size_t)tok * D + c0 + 8);
        float y[16];
        y[0] = lo16(r0.x); y[1] = hi16(r0.x); y[2] = lo16(r0.y); y[3] = hi16(r0.y); y[4] = lo16(r0.z); y[5] = hi16(r0.z); y[6] = lo16(r0.w); y[7] = hi16(r0.w);
        y[8] = lo16(r1.x); y[9] = hi16(r1.x); y[10] = lo16(r1.y); y[11] = hi16(r1.y); y[12] = lo16(r1.z); y[13] = hi16(r1.z); y[14] = lo16(r1.w); y[15] = hi16(r1.w);
        float q = 0.f;
#pragma unroll
        for (int j = 0; j < 16; ++j) q += y[j] * y[j];
        q += dppf<0xB1>(q); q += dppf<0x4E>(q); q += dppf<0x141>(q);
        const float rstd = rsqrtf(q * (1.0f / 128.0f) + 1e-6f);
        const int gcol = lane < 32 ? 1536 + c0 : 3584 + (c0 - 512);
        const u32x4 g0 = *(const u32x4*)(P + (size_t)tok * ODD_IN + gcol), g1 = *(const u32x4*)(P + (size_t)tok * ODD_IN + gcol + 8);
        float gt[16];
        gt[0] = lo16(g0.x); gt[1] = hi16(g0.x); gt[2] = lo16(g0.y); gt[3] = hi16(g0.y); gt[4] = lo16(g0.z); gt[5] = hi16(g0.z); gt[6] = lo16(g0.w); gt[7] = hi16(g0.w);
        gt[8] = lo16(g1.x); gt[9] = hi16(g1.x); gt[10] = lo16(g1.y); gt[11] = hi16(g1.y); gt[12] = lo16(g1.z); gt[13] = hi16(g1.z); gt[14] = lo16(g1.w); gt[15] = hi16(g1.w);
        float o[16];
        if (lane < 32) {
#pragma unroll
            for (int j = 0; j < 16; ++j) o[j] = y[j] * rstd * p.gd_norm[(c0 + j) & 127] * siluf_(gt[j]);
        } else {
#pragma unroll
            for (int j = 0; j < 16; ++j) o[j] = y[j] * rstd * p.ml_norm[c0 - 512 + j] * sigmoidf_(gt[j]);
        }
        u32x4 w0, w1;
        w0.x = pack2(o[0], o[1]); w0.y = pack2(o[2], o[3]); w0.z = pack2(o[4], o[5]); w0.w = pack2(o[6], o[7]);
        w1.x = pack2(o[8], o[9]); w1.y = pack2(o[10], o[11]); w1.z = pack2(o[12], o[13]); w1.w = pack2(o[14], o[15]);
        *(u32x4*)(O16 + (size_t)tok * D + c0) = w0; *(u32x4*)(O16 + (size_t)tok * D + c0 + 8) = w1;
    }
}


#define XB_TMO      128
#define XB_XCNT(j)  (256  + 64 * (j))
#define XB_XSUB(j)  (1280 + 64 * (j))
#define XB_XGEN(j)  (2304 + 64 * (j))
#define XB_TOP      3328
#define XB_TOPGEN   3392
#define XCD_BAR_WORDS 3456
#define XB_SPIN_CAP (1u << 22)
#define LAS __attribute__((address_space(3)))
__device__ __forceinline__ unsigned xb_ld(unsigned* p)              { return __hip_atomic_load(p, __ATOMIC_RELAXED, __HIP_MEMORY_SCOPE_AGENT); }
__device__ __forceinline__ unsigned xb_add(unsigned* p, unsigned v) { return __hip_atomic_fetch_add(p, v, __ATOMIC_RELAXED, __HIP_MEMORY_SCOPE_AGENT); }
__device__ __forceinline__ unsigned xb_xcc_id() { return (unsigned)__builtin_amdgcn_s_getreg((3 << 11) | 20) & 0xFu; }
#define XB_SPIN(cond, bar) do { unsigned _sp = 0; while (cond) { __builtin_amdgcn_s_sleep(1); \
    if ((++_sp & 255u) == 0u) { if (xb_ld(&(bar)[XB_TMO])) break; if (_sp > XB_SPIN_CAP) { atomicAdd(&(bar)[XB_TMO], 1u); break; } } } } while (0)
struct XcdBarrier { unsigned* bar; unsigned x; volatile LAS unsigned* st; };
__device__ __forceinline__ XcdBarrier xcd_barrier_post(unsigned* bar, volatile LAS unsigned* st) {
    XcdBarrier b; b.bar = bar; b.x = xb_xcc_id(); b.st = st;
    if (threadIdx.x == 0) (void)xb_add(&bar[XB_XCNT(b.x)], 1u);
    return b;
}
__device__ __forceinline__ void xcd_barrier_complete(unsigned* bar, unsigned x, unsigned& nloc, unsigned& nx) {
    const unsigned G = gridDim.x * gridDim.y * gridDim.z;
    unsigned sum, cnt, mine, sp = 0u;
    for (;;) {
        sum = 0u; cnt = 0u; mine = 0u;
#pragma unroll
        for (unsigned j = 0; j < 16; ++j) { const unsigned c = xb_ld(&bar[XB_XCNT(j)]); sum += c; cnt += (c > 0u) ? 1u : 0u; mine = (j == x) ? c : mine; }
        if (sum == G) break;
        __builtin_amdgcn_s_sleep(1);
        if ((++sp & 255u) == 0u) { if (xb_ld(&bar[XB_TMO])) break; if (sp > XB_SPIN_CAP) { atomicAdd(&bar[XB_TMO], 1u); break; } }
    }
    nloc = mine > 0u ? mine : 1u; nx = cnt > 0u ? cnt : 1u;
}
__device__ __forceinline__ void xcd_barrier(const XcdBarrier& b) {
    asm volatile("s_waitcnt vmcnt(0)" ::: "memory");
    __syncthreads();
    if (threadIdx.x == 0) {
        unsigned* bar = b.bar;
        __builtin_amdgcn_s_waitcnt(0);
        unsigned nloc = b.st[0], nx = b.st[1];
        if (nloc == 0u) { xcd_barrier_complete(bar, b.x, nloc, nx); b.st[0] = nloc; b.st[1] = nx; }
        const unsigned old = xb_add(&bar[XB_XSUB(b.x)], 1u);
        const unsigned gen = old / nloc;
        if (old + 1u == (gen + 1u) * nloc) {
            __builtin_amdgcn_fence(__ATOMIC_RELEASE, "agent");
            asm volatile("s_waitcnt vmcnt(0)" ::: "memory");
            const unsigned og = xb_add(&bar[XB_TOP], 1u);
            const unsigned tg = og / nx;
            if (og + 1u == (tg + 1u) * nx) xb_add(&bar[XB_TOPGEN], 1u);
            else XB_SPIN(xb_ld(&bar[XB_TOPGEN]) == tg, bar);
            __builtin_amdgcn_fence(__ATOMIC_ACQUIRE, "agent");
            xb_add(&bar[XB_XGEN(b.x)], 1u);
            asm volatile("s_waitcnt vmcnt(0)" ::: "memory");
        } else {
            XB_SPIN(xb_ld(&bar[XB_XGEN(b.x)]) == gen, bar);
            __builtin_amdgcn_fence(__ATOMIC_ACQUIRE, "agent");
            asm volatile("s_waitcnt vmcnt(0)" ::: "memory");
        }
    }
    __syncthreads();
}
__global__ void __launch_bounds__(NT) fwd_kernel(Params p) {
    extern __shared__ __attribute__((aligned(16))) char lds[];
    const int lo = p.ph_lo, hi = p.ph_hi;
    volatile LAS unsigned* bst = (volatile LAS unsigned*)(lds + LDS_BYTES - 16);
    if (threadIdx.x < 4) bst[threadIdx.x] = 0u;
    __syncthreads();
    XcdBarrier bar; bar.bar = (unsigned*)(p.ws + WS_CTL) + CTL_BAR; bar.x = 0; bar.st = bst;
    if (hi - lo > 1) bar = xcd_barrier_post((unsigned*)(p.ws + WS_CTL) + CTL_BAR, bst);
    if (hi > 1000) cooperative_groups::this_grid().sync();
#define IN(k) (lo <= (k) && (k) < hi)
#define SEAM(k) do { if (IN(k) && IN((k) + 1)) xcd_barrier(bar); } while (0)
    if (IN(0)) { phase_convert(p, lds); phase_rows<0>(p, lds, 0); }   SEAM(0);
    if (IN(1)) phase_dense_gemm<0>(p, lds);                           SEAM(1);
    if (IN(2)) phase_mix0(p, lds);                                    SEAM(2);
    if (IN(3)) phase_post0(p);                                        SEAM(3);
    if (IN(4)) phase_dense_gemm<1>(p, lds);                           SEAM(4);
    if (IN(5)) phase_rows<1>(p, lds, 0);                              SEAM(5);
    if (IN(6)) phase_moe_gemm<0>(p, lds, 0);                          SEAM(6);
    if (IN(7)) phase_moe_gemm<1>(p, lds, 0);                          SEAM(7);
    if (IN(8)) phase_rows<2>(p, lds, 1);                              SEAM(8);
    if (IN(9)) phase_dense_gemm<2>(p, lds);                           SEAM(9);
    if (IN(10)) phase_mix1(p, lds);                                   SEAM(10);
    if (IN(11)) phase_post1(p);                                       SEAM(11);
    if (IN(12)) phase_dense_gemm<3>(p, lds);                          SEAM(12);
    if (IN(13)) phase_rows<1>(p, lds, 1);                             SEAM(13);
    if (IN(14)) phase_moe_gemm<0>(p, lds, 1);                         SEAM(14);
    if (IN(15)) phase_moe_gemm<1>(p, lds, 1);                         SEAM(15);
    if (IN(16)) phase_rows<3>(p, lds, 0);
#undef IN
#undef SEAM
}

extern "C" void kernel_launch(void* const* d_in, const int* in_sizes, int n_in, void* d_out, int out_size, void* d_ws, size_t ws_size, hipStream_t stream) {
    static int ok = 0, grid = 0;
    if (ok == 0) {
        ok = 1;
        if (n_in != 35 || out_size != M * D || ws_size < WS_END) { fprintf(stderr, "kernel_launch: unexpected sizes n_in=%d out=%d ws=%zu need=%zu\n", n_in, out_size, ws_size, (size_t)WS_END); ok = -1; }
        if (hipFuncSetAttribute((const void*)fwd_kernel, hipFuncAttributeMaxDynamicSharedMemorySize, LDS_BYTES) != hipSuccess) { fprintf(stderr, "kernel_launch: hipFuncSetAttribute failed\n"); ok = -1; }
        int dev = 0, cus = 0, per_cu = 0;
        hipGetDevice(&dev); hipDeviceGetAttribute(&cus, hipDeviceAttributeMultiprocessorCount, dev);
        if (hipOccupancyMaxActiveBlocksPerMultiprocessor(&per_cu, (const void*)fwd_kernel, NT, LDS_BYTES) != hipSuccess || per_cu < 1) { fprintf(stderr, "kernel_launch: occupancy query failed (%d)\n", per_cu); per_cu = 1; }
        (void)hipGetLastError();
        grid = cus * (per_cu > 1 ? 1 : per_cu);
        if (grid > 256) grid = 256;
        if (grid < 1) ok = -1;
    }
    if (ok < 0) return;
    Params p{};
    const float** f = (const float**)&p;
    for (int i = 0; i < 35; ++i) f[i] = (const float*)d_in[i];
    p.out = (float*)d_out; p.ws = (unsigned char*)d_ws;
    (void)hipMemsetAsync((char*)d_ws + WS_CTL, 0, 65536, stream);
#if SINGLE_LAUNCH
    p.ph_lo = 0; p.ph_hi = NPHASE;
    void* args[] = {&p};
    hipError_t e = hipLaunchCooperativeKernel((const void*)fwd_kernel, dim3(grid), dim3(NT), args, LDS_BYTES, stream);
    if (e != hipSuccess) fprintf(stderr, "kernel_launch: cooperative launch failed: %s (grid %d)\n", hipGetErrorString(e), grid);
#else
    for (int ph = 0; ph < NPHASE; ++ph) {
        p.ph_lo = ph; p.ph_hi = ph + 1;
        hipLaunchKernelGGL(fwd_kernel, dim3(grid), dim3(NT), LDS_BYTES, stream, p);
    }
#endif
}
```

```cpp
#include <hip/hip_runtime.h>
#include <hip/hip_cooperative_groups.h>
#include <stdint.h>
#include <stdio.h>

#ifndef REP_PHASE
#define REP_PHASE -1
#endif
#ifndef REP_UNIT
#define REP_UNIT 0
#endif
#ifndef SINGLE_LAUNCH
#define SINGLE_LAUNCH 1
#endif

typedef unsigned short bf16_t;
typedef short bf16x8 __attribute__((ext_vector_type(8)));
typedef float f32x16 __attribute__((ext_vector_type(16)));
typedef float f32x4 __attribute__((ext_vector_type(4)));
typedef unsigned u32x4 __attribute__((ext_vector_type(4)));
typedef unsigned u32x2 __attribute__((ext_vector_type(2)));

#define NT 512
#define LAS __attribute__((address_space(3)))
constexpr int D = 1024, NBATCH = 8, SEQ = 2048, M = NBATCH * SEQ;
constexpr int EVEN_IN = 3840, ODD_SRC = 4112, ODD_IN = 4096;
constexpr int NPHASE = 18;
constexpr int LDS_BYTES = 144 * 1024;

constexpr size_t WS_CTL = 0;
constexpr size_t WS_WIN0 = 65536;
constexpr size_t WS_WOUT0 = WS_WIN0 + (size_t)EVEN_IN * D * 2;
constexpr size_t WS_WIN1 = WS_WOUT0 + (size_t)D * D * 2;
constexpr size_t WS_WOUT1 = WS_WIN1 + (size_t)ODD_IN * D * 2;
constexpr size_t WS_XN = WS_WOUT1 + (size_t)D * D * 2;
constexpr size_t WS_P = WS_XN + (size_t)M * D * 2;
constexpr size_t WS_LTOK = WS_P + (size_t)100 * 1024 * 1024;
constexpr size_t WS_LGATE = WS_LTOK + (size_t)32 * M * 4;
constexpr size_t WS_GATES = WS_P + (size_t)M * 4096 * 2;
constexpr size_t WS_ARENA = WS_GATES + (size_t)M * 16 * 4;
constexpr size_t WS_WGU = WS_ARENA;
constexpr size_t WS_WD = WS_WGU + (size_t)2 * 32 * 512 * 1024 * 2;
constexpr size_t WS_CHK_RW = WS_ARENA;
constexpr size_t CHK_RW_ITEM = 32768;
constexpr size_t WS_CHK_HG = WS_CHK_RW + (size_t)2048 * CHK_RW_ITEM;
constexpr size_t CHK_HG_ITEM = 24576 + 256;
constexpr size_t WS_END = WS_CHK_HG + (size_t)2048 * CHK_HG_ITEM;
static_assert(WS_END >= WS_WD + (size_t)2 * 32 * 1024 * 256 * 2, "arena");
static_assert(WS_END <= 310000000, "workspace budget");
static_assert(WS_LGATE + (size_t)32 * M * 4 <= WS_P + (size_t)M * 4096 * 2, "lists inside P");
constexpr size_t P_HID = 0;
constexpr size_t P_Y = (size_t)32 * 1024 * 1024;
constexpr int CTL_CNT = 0;
constexpr int CTL_BAR = 1024;

struct Params {
    const float* x; const float* norm_mix; const float* norm_ffn; const float* norm_final;
    const float* ev_w_in; const float* ev_mu; const float* rw_w0; const float* rw_w2; const float* rw_a0; const float* rw_a2; const float* rw_g2;
    const float* rw_k_k; const float* rw_k_a; const float* rw_r_k; const float* rw_ln_w; const float* rw_ln_b; const float* hg_lb; const float* hg_norm;
    const float* ev_w_out; const float* od_w_in; const float* gd_conv; const float* gd_a_log; const float* gd_dt_bias; const float* gd_norm;
    const float* ml_i_bias; const float* ml_f_bias; const float* ml_norm; const float* od_w_out;
    const float* moe_w_group; const float* moe_b_group; const float* moe_w_router; const float* moe_b_router;
    const float* moe_w_gate; const float* moe_w_up; const float* moe_w_down;
    float* out; unsigned char* ws;
    int ph_lo, ph_hi;
};

__device__ __forceinline__ float bf2f(unsigned short u) { return __uint_as_float(((unsigned)u) << 16); }
__device__ __forceinline__ unsigned short f2bf(float f) { const __bf16 h = (__bf16)f; return __builtin_bit_cast(unsigned short, h); }
typedef __bf16 bf16x2_t __attribute__((ext_vector_type(2)));
typedef float f32x2_t __attribute__((ext_vector_type(2)));
__device__ __forceinline__ unsigned pack2(float a, float b) { f32x2_t f; f.x = a; f.y = b; const bf16x2_t h = __builtin_convertvector(f, bf16x2_t); return __builtin_bit_cast(unsigned, h); }
__device__ __forceinline__ float lo16(unsigned u) { return __uint_as_float(u << 16); }
__device__ __forceinline__ float hi16(unsigned u) { return __uint_as_float(u & 0xffff0000u); }
__device__ __forceinline__ float sigmoidf_(float x) { return __builtin_amdgcn_rcpf(1.0f + __expf(-x)); }
__device__ __forceinline__ float siluf_(float x) { return x * __builtin_amdgcn_rcpf(1.0f + __expf(-x)); }
__device__ __forceinline__ float softplusf_(float x) { return x > 20.f ? x : log1pf(__expf(x)); }

template <int CTRL> __device__ __forceinline__ float dppf(float x) {
    return __int_as_float(__builtin_amdgcn_update_dpp(0, __float_as_int(x), CTRL, 0xF, 0xF, false));
}
__device__ __forceinline__ float red16(float x) {
    x += dppf<0xB1>(x);
    x += dppf<0x4E>(x);
    x += dppf<0x141>(x);
    x += dppf<0x140>(x);
    return x;
}
__device__ __forceinline__ float red64(float x) {
    x = red16(x);
    x += __shfl_xor(x, 16);
    x += __shfl_xor(x, 32);
    return x;
}

__device__ __forceinline__ void conv_tile(float* tile, const float* s0, const float* s1, size_t ld, bf16_t* d, size_t ldd) {
    const int tid = threadIdx.x;
#pragma unroll
    for (int i = 0; i < 2; ++i) {
        const int k = (tid >> 4) + 32 * i, nn = (tid & 15) * 4;
        const float* s = nn < 32 ? s0 + (size_t)k * ld + nn : s1 + (size_t)k * ld + (nn - 32);
        const float4 v = *(const float4*)s;
        float* t = tile + k * 65 + nn;
        t[0] = v.x; t[1] = v.y; t[2] = v.z; t[3] = v.w;
    }
    __syncthreads();
    const int n = tid >> 3, kc = (tid & 7) * 8;
    float f0 = tile[(kc + 0) * 65 + n], f1 = tile[(kc + 1) * 65 + n], f2 = tile[(kc + 2) * 65 + n], f3 = tile[(kc + 3) * 65 + n];
    float f4 = tile[(kc + 4) * 65 + n], f5 = tile[(kc + 5) * 65 + n], f6 = tile[(kc + 6) * 65 + n], f7 = tile[(kc + 7) * 65 + n];
    u32x4 o; o.x = pack2(f0, f1); o.y = pack2(f2, f3); o.z = pack2(f4, f5); o.w = pack2(f6, f7);
    *(u32x4*)(d + (size_t)n * ldd + kc) = o;
    __syncthreads();
}

template <int PART>
__device__ __forceinline__ void phase_convert(const Params& p, char* lds) {
    float* tile = (float*)lds;
    unsigned char* ws = p.ws;
    const int total = PART == 0 ? (960 + 256 + 1024 + 256) : (8192 + 4096);
    for (int g0 = blockIdx.x; g0 < total; g0 += gridDim.x) {
        int g = g0;
        if (PART == 0) {
            if (g < 960) { const int kt = g & 15, nt = g >> 4;
                const float* s0 = p.ev_w_in + (size_t)(kt * 64) * EVEN_IN + nt * 64;
                conv_tile(tile, s0, s0 + 32, EVEN_IN, (bf16_t*)(ws + WS_WIN0) + (size_t)(nt * 64) * D + kt * 64, D); continue; }
            g -= 960;
            if (g < 256) { const int kt = g & 15, nt = g >> 4;
                const float* s0 = p.ev_w_out + (size_t)(kt * 64) * D + nt * 64;
                conv_tile(tile, s0, s0 + 32, D, (bf16_t*)(ws + WS_WOUT0) + (size_t)(nt * 64) * D + kt * 64, D); continue; }
            g -= 256;
            if (g < 1024) { const int kt = g & 15, nt = g >> 4;
                const float* s0 = p.od_w_in + (size_t)(kt * 64) * ODD_SRC + nt * 64 + (nt >= 32 ? 8 : 0);
                conv_tile(tile, s0, s0 + 32, ODD_SRC, (bf16_t*)(ws + WS_WIN1) + (size_t)(nt * 64) * D + kt * 64, D); continue; }
            g -= 1024;
            { const int kt = g & 15, nt = g >> 4;
                const float* s0 = p.od_w_out + (size_t)(kt * 64) * D + nt * 64;
                conv_tile(tile, s0, s0 + 32, D, (bf16_t*)(ws + WS_WOUT1) + (size_t)(nt * 64) * D + kt * 64, D); }
        } else {
            if (g < 8192) { const int le = g >> 7, r = g & 127, kt = r & 15, s = r >> 4;
                const size_t so = (size_t)le * 1024 * 256 + (size_t)(kt * 64) * 256 + s * 32;
                conv_tile(tile, p.moe_w_gate + so, p.moe_w_up + so, 256, (bf16_t*)(ws + WS_WGU) + (size_t)le * 512 * 1024 + (size_t)(s * 64) * 1024 + kt * 64, 1024); continue; }
            g -= 8192;
            { const int le = g >> 6, r = g & 63, kt = r & 3, nt = r >> 2;
                const float* s0 = p.moe_w_down + (size_t)le * 256 * 1024 + (size_t)(kt * 64) * 1024 + nt * 64;
                conv_tile(tile, s0, s0 + 32, 1024, (bf16_t*)(ws + WS_WD) + (size_t)le * 1024 * 256 + (size_t)(nt * 64) * 256 + kt * 64, 256); }
        }
    }
}

template <int MODE>
__device__ __forceinline__ void phase_rows(const Params& p, char* lds, int layer) {
    const int tid = threadIdx.x, lane = tid & 63, wave = tid >> 6;
    unsigned char* ws = p.ws;
    const float* src = (MODE == 0) ? p.x : p.out;
    const float* gain = (MODE == 0) ? p.norm_mix : (MODE == 1) ? p.norm_ffn + layer * D : (MODE == 2) ? p.norm_mix + D : p.norm_final;
    bf16_t* XN = (bf16_t*)(ws + WS_XN);
    const bf16_t* Y0 = (const bf16_t*)(ws + WS_P + P_Y);
    const bf16_t* Y1 = Y0 + (size_t)M * D;
    float* rstd_s = (float*)lds;
    float* Ht = (float*)(lds + 1024);
    float* Wt = Ht + 64 * 132;
    float* lg = Wt + 40 * 132;
    constexpr int NO = (MODE == 1) ? 5 : 2;
    constexpr int NOUT = (MODE == 1) ? 36 : 16;
    for (int grp = blockIdx.x; grp < M / 64; grp += gridDim.x) {
        const int t0 = grp * 64;
        for (int q = 0; q < 8; ++q) {
            const int tl = wave * 8 + q, tok = t0 + tl;
            float4 v[4];
#pragma unroll
            for (int i = 0; i < 4; ++i) v[i] = *(const float4*)(src + (size_t)tok * D + i * 256 + lane * 4);
            if (MODE == 2 || MODE == 3) {
#pragma unroll
                for (int i = 0; i < 4; ++i) {
                    const u32x2 a = *(const u32x2*)(Y0 + (size_t)tok * D + i * 256 + lane * 4);
                    const u32x2 b = *(const u32x2*)(Y1 + (size_t)tok * D + i * 256 + lane * 4);
                    v[i].x += lo16(a.x) + lo16(b.x); v[i].y += hi16(a.x) + hi16(b.x); v[i].z += lo16(a.y) + lo16(b.y); v[i].w += hi16(a.y) + hi16(b.y);
                }
            }
            float ss = 0.f;
#pragma unroll
            for (int i = 0; i < 4; ++i) ss += v[i].x * v[i].x + v[i].y * v[i].y + v[i].z * v[i].z + v[i].w * v[i].w;
            ss = red64(ss);
            const float rstd = rsqrtf(ss * (1.0f / D) + 1e-6f);
            if (lane == 0) rstd_s[tl] = rstd;
#pragma unroll
            for (int i = 0; i < 4; ++i) {
                const float4 g4 = *(const float4*)(gain + i * 256 + lane * 4);
                if (MODE == 2) *(float4*)(p.out + (size_t)tok * D + i * 256 + lane * 4) = v[i];
                const float o0 = v[i].x * rstd * g4.x, o1 = v[i].y * rstd * g4.y, o2 = v[i].z * rstd * g4.z, o3 = v[i].w * rstd * g4.w;
                if (MODE == 3) { float4 o; o.x = o0; o.y = o1; o.z = o2; o.w = o3; *(float4*)(p.out + (size_t)tok * D + i * 256 + lane * 4) = o; }
                else { u32x2 o; o.x = pack2(o0, o1); o.y = pack2(o2, o3); *(u32x2*)(XN + (size_t)tok * D + i * 256 + lane * 4) = o; }
            }
        }
        if (MODE == 1 || MODE == 2) {
            float acc[NO];
#pragma unroll
            for (int o = 0; o < NO; ++o) acc[o] = 0.f;
            const int btok = tid & 63, og = tid >> 6;
            for (int dc = 0; dc < 8; ++dc) {
                __syncthreads();
                {
                    const int tk = tid >> 3, part = tid & 7;
#pragma unroll
                    for (int q = 0; q < 4; ++q) {
                        const float4 h = *(const float4*)(p.out + (size_t)(t0 + tk) * D + dc * 128 + part * 16 + q * 4);
                        *(float4*)(Ht + tk * 132 + part * 16 + q * 4) = h;
                    }
                }
                for (int idx = tid; idx < 128 * 40; idx += NT) {
                    const int d = idx & 127, o = idx >> 7, dd = dc * 128 + d;
                    float w = 0.f;
                    if (MODE == 1) {
                        if (o < 4) w = p.moe_w_group[(size_t)layer * D * 4 + dd * 4 + o];
                        else if (o < 36) w = p.moe_w_router[(size_t)layer * D * 32 + dd * 32 + (o - 4)];
                    } else {
                        if (o < 16) w = p.od_w_in[(size_t)dd * ODD_SRC + (o < 8 ? 2048 + o : 4104 + (o - 8))];
                    }
                    Wt[o * 132 + d] = w * gain[dd];
                }
                __syncthreads();
#pragma unroll 4
                for (int d4 = 0; d4 < 32; ++d4) {
                    const float4 h = *(const float4*)(Ht + btok * 132 + d4 * 4);
#pragma unroll
                    for (int o = 0; o < NO; ++o) {
                        const float4 w = *(const float4*)(Wt + (og * NO + o) * 132 + d4 * 4);
                        acc[o] += h.x * w.x + h.y * w.y + h.z * w.z + h.w * w.w;
                    }
                }
            }
            const float rs = rstd_s[btok];
            if (MODE == 2) {
                float* G = (float*)(ws + WS_GATES);
#pragma unroll
                for (int o = 0; o < NO; ++o) G[(size_t)(t0 + btok) * 16 + og * NO + o] = acc[o] * rs;
            } else {
#pragma unroll
                for (int o = 0; o < NO; ++o) { const int oo = og * NO + o;
                    if (oo < NOUT) lg[btok * 40 + oo] = acc[o] * rs + (oo < 4 ? p.moe_b_group[layer * 4 + oo] : p.moe_b_router[layer * 32 + oo - 4]); }
                __syncthreads();
                if (tid < 64) {
                    const float* l = lg + tid * 40;
                    int gi = 0; float gm = l[0];
#pragma unroll
                    for (int j = 1; j < 4; ++j) if (l[j] > gm) { gm = l[j]; gi = j; }
                    float se = 0.f;
#pragma unroll
                    for (int j = 0; j < 4; ++j) se += __expf(l[j] - gm);
                    const float ptop = 1.0f / se;
                    const float* f = l + 4 + gi * 8;
                    int i1 = 0; float v1 = f[0];
#pragma unroll
                    for (int j = 1; j < 8; ++j) if (f[j] > v1) { v1 = f[j]; i1 = j; }
                    int i2 = -1; float v2 = -3.0e38f;
#pragma unroll
                    for (int j = 0; j < 8; ++j) if (j != i1 && f[j] > v2) { v2 = f[j]; i2 = j; }
                    const float w1 = 1.0f / (1.0f + __expf(v2 - v1)), w2 = 1.0f - w1;
                    int* cnt = (int*)(ws + WS_CTL) + CTL_CNT + layer * 32;
                    int* ltok = (int*)(ws + WS_LTOK); float* lgate = (float*)(ws + WS_LGATE);
                    const int tok = t0 + tid;
                    const int e1 = gi * 8 + i1, e2 = gi * 8 + i2;
                    const int p1 = atomicAdd(cnt + e1, 1); ltok[(size_t)e1 * M + p1] = tok * 2; lgate[(size_t)e1 * M + p1] = ptop * w1;
                    const int p2 = atomicAdd(cnt + e2, 1); ltok[(size_t)e2 * M + p2] = tok * 2 + 1; lgate[(size_t)e2 * M + p2] = ptop * w2;
                }
            }
        }
        __syncthreads();
    }
}

template <class Epi>
__device__ __forceinline__ void gemm_tile(char* lds, const bf16_t* a0, const bf16_t* a1, const bf16_t* a2, const bf16_t* a3,
                                          const bf16_t* b0, const bf16_t* b1, int nk, Epi& epi) {
    const int tid = threadIdx.x, lane = tid & 63, wave = tid >> 6, wm = wave >> 1, wn = wave & 1;
    const int lr = tid >> 3, lc = tid & 7, lsw = (lr >> 1) & 7;
    const int wofs = lr * 128 + ((lc ^ lsw) * 16);
    f32x16 acc[2][2];
#pragma unroll
    for (int i = 0; i < 2; ++i)
#pragma unroll
        for (int j = 0; j < 2; ++j)
#pragma unroll
            for (int r = 0; r < 16; ++r) acc[i][j][r] = 0.f;
    u32x4 ra0, ra1, ra2, ra3, rb0, rb1;
    ra0 = *(const u32x4*)a0; ra1 = *(const u32x4*)a1; ra2 = *(const u32x4*)a2; ra3 = *(const u32x4*)a3;
    rb0 = *(const u32x4*)b0; rb1 = *(const u32x4*)b1;
    {
        char* st = lds;
        *(u32x4*)(st + wofs) = ra0; *(u32x4*)(st + wofs + 8192) = ra1; *(u32x4*)(st + wofs + 16384) = ra2; *(u32x4*)(st + wofs + 24576) = ra3;
        *(u32x4*)(st + 32768 + wofs) = rb0; *(u32x4*)(st + 32768 + wofs + 8192) = rb1;
    }
    __syncthreads();
    const int fr = lane & 31, fh = lane >> 5, fsw = (fr >> 1) & 7;
    const int aofs = (wm * 64 + fr) * 128, bofs = 32768 + (wn * 64 + fr) * 128;
    for (int kt = 0; kt < nk; ++kt) {
        const char* st = lds + (kt & 1) * 49152;
        if (kt + 1 < nk) {
            const int ko = (kt + 1) * 64;
            ra0 = *(const u32x4*)(a0 + ko); ra1 = *(const u32x4*)(a1 + ko); ra2 = *(const u32x4*)(a2 + ko); ra3 = *(const u32x4*)(a3 + ko);
            rb0 = *(const u32x4*)(b0 + ko); rb1 = *(const u32x4*)(b1 + ko);
        }
#pragma unroll
        for (int kk = 0; kk < 4; ++kk) {
            const int co = (((kk * 2 + fh) ^ fsw) * 16);
            const bf16x8 af0 = *(const bf16x8*)(st + aofs + co), af1 = *(const bf16x8*)(st + aofs + 4096 + co);
            const bf16x8 wf0 = *(const bf16x8*)(st + bofs + co), wf1 = *(const bf16x8*)(st + bofs + 4096 + co);
            acc[0][0] = __builtin_amdgcn_mfma_f32_32x32x16_bf16(wf0, af0, acc[0][0], 0, 0, 0);
            acc[0][1] = __builtin_amdgcn_mfma_f32_32x32x16_bf16(wf1, af0, acc[0][1], 0, 0, 0);
            acc[1][0] = __builtin_amdgcn_mfma_f32_32x32x16_bf16(wf0, af1, acc[1][0], 0, 0, 0);
            acc[1][1] = __builtin_amdgcn_mfma_f32_32x32x16_bf16(wf1, af1, acc[1][1], 0, 0, 0);
        }
        if (kt + 1 < nk) {
            char* sn = lds + ((kt + 1) & 1) * 49152;
            *(u32x4*)(sn + wofs) = ra0; *(u32x4*)(sn + wofs + 8192) = ra1; *(u32x4*)(sn + wofs + 16384) = ra2; *(u32x4*)(sn + wofs + 24576) = ra3;
            *(u32x4*)(sn + 32768 + wofs) = rb0; *(u32x4*)(sn + 32768 + wofs + 8192) = rb1;
        }
        __syncthreads();
    }
    epi(acc, wm, wn, fr, fh);
}

struct EpiStoreBf16 { bf16_t* C; int ldc, m0, n0;
    __device__ __forceinline__ void operator()(const f32x16 (&acc)[2][2], int wm, int wn, int fr, int fh) const {
#pragma unroll
        for (int i = 0; i < 2; ++i) { bf16_t* rowp = C + (size_t)(m0 + wm * 64 + i * 32 + fr) * ldc + n0 + wn * 64 + 4 * fh;
#pragma unroll
            for (int j = 0; j < 2; ++j)
#pragma unroll
                for (int g = 0; g < 4; ++g) { u32x2 o; o.x = pack2(acc[i][j][4 * g], acc[i][j][4 * g + 1]); o.y = pack2(acc[i][j][4 * g + 2], acc[i][j][4 * g + 3]);
                    *(u32x2*)(rowp + j * 32 + 8 * g) = o; } }
    } };
struct EpiResidF32 { const float* R; float* C; int m0, n0;
    __device__ __forceinline__ void operator()(const f32x16 (&acc)[2][2], int wm, int wn, int fr, int fh) const {
#pragma unroll
        for (int i = 0; i < 2; ++i) { const size_t ro = (size_t)(m0 + wm * 64 + i * 32 + fr) * D + n0 + wn * 64 + 4 * fh;
#pragma unroll
            for (int j = 0; j < 2; ++j)
#pragma unroll
                for (int g = 0; g < 4; ++g) { const float4 r = *(const float4*)(R + ro + j * 32 + 8 * g);
                    float4 o; o.x = r.x + acc[i][j][4 * g]; o.y = r.y + acc[i][j][4 * g + 1]; o.z = r.z + acc[i][j][4 * g + 2]; o.w = r.w + acc[i][j][4 * g + 3];
                    *(float4*)(C + ro + j * 32 + 8 * g) = o; } }
    } };

template <int WHICH>
__device__ __forceinline__ void phase_dense_gemm(const Params& p, char* lds) {
    unsigned char* ws = p.ws;
    const bf16_t* A = (const bf16_t*)(ws + WS_XN);
    const bf16_t* Bt = (const bf16_t*)(ws + (WHICH == 0 ? WS_WIN0 : WHICH == 1 ? WS_WOUT0 : WHICH == 2 ? WS_WIN1 : WS_WOUT1));
    constexpr int N = (WHICH == 0) ? EVEN_IN : (WHICH == 2) ? ODD_IN : D;
    constexpr int nN = N / 128, nM = M / 256;
    const int G = gridDim.x, b = blockIdx.x;
    const int tid = threadIdx.x, lr = tid >> 3, lc = tid & 7;
    const bool xs = (G % 8 == 0);
    const int per = xs ? G / 8 : G, xcd = xs ? b % 8 : 0, lb = xs ? b / 8 : b;
    const int tiles_local = xs ? (nM / 8) * nN : nM * nN;
    for (int lt = lb; lt < tiles_local; lt += per) {
        int mt, nt;
        if (xs) { mt = xcd * 8 + (lt & 7); nt = lt >> 3; } else { mt = lt % nM; nt = lt / nM; }
        const int m0 = mt * 256, n0 = nt * 128;
        const bf16_t* a0 = A + (size_t)(m0 + lr) * D + lc * 8;
        const bf16_t* b0 = Bt + (size_t)(n0 + lr) * D + lc * 8;
        if (WHICH == 0 || WHICH == 2) { EpiStoreBf16 e{(bf16_t*)(ws + WS_P), N, m0, n0};
            gemm_tile(lds, a0, a0 + 64 * D, a0 + 128 * D, a0 + 192 * D, b0, b0 + 64 * D, D / 64, e); }
        else { EpiResidF32 e{WHICH == 1 ? p.x : p.out, p.out, m0, n0};
            gemm_tile(lds, a0, a0 + 64 * D, a0 + 128 * D, a0 + 192 * D, b0, b0 + 64 * D, D / 64, e); }
    }
}

struct EpiGateUp { bf16_t* HID; const float* lgate; int cnt, mloc0, slot0, f0;
    __device__ __forceinline__ void operator()(const f32x16 (&acc)[2][2], int wm, int wn, int fr, int fh) const {
#pragma unroll
        for (int i = 0; i < 2; ++i) { const int ml = mloc0 + wm * 64 + i * 32 + fr;
            if (ml < cnt) { const float gt = lgate[ml]; bf16_t* rowp = HID + (size_t)(slot0 + ml) * 256 + f0 + wn * 32 + 4 * fh;
#pragma unroll
                for (int g = 0; g < 4; ++g) { float h[4];
#pragma unroll
                    for (int e = 0; e < 4; ++e) { const float a = acc[i][0][4 * g + e], u = acc[i][1][4 * g + e]; h[e] = siluf_(a) * u * gt; }
                    u32x2 o; o.x = pack2(h[0], h[1]); o.y = pack2(h[2], h[3]); *(u32x2*)(rowp + 8 * g) = o; } } }
    } };
struct EpiDown { bf16_t* Y; const int* ltok; int cnt, mloc0, n0;
    __device__ __forceinline__ void operator()(const f32x16 (&acc)[2][2], int wm, int wn, int fr, int fh) const {
#pragma unroll
        for (int i = 0; i < 2; ++i) { const int ml = mloc0 + wm * 64 + i * 32 + fr;
            if (ml < cnt) { const int tk = ltok[ml]; bf16_t* rowp = Y + ((size_t)(tk & 1) * M + (tk >> 1)) * D + n0 + wn * 64 + 4 * fh;
#pragma unroll
                for (int j = 0; j < 2; ++j)
#pragma unroll
                    for (int g = 0; g < 4; ++g) { u32x2 o; o.x = pack2(acc[i][j][4 * g], acc[i][j][4 * g + 1]); o.y = pack2(acc[i][j][4 * g + 2], acc[i][j][4 * g + 3]);
                        *(u32x2*)(rowp + j * 32 + 8 * g) = o; } } }
    } };

template <int DOWN>
__device__ __forceinline__ void phase_moe_gemm(const Params& p, char* lds, int layer) {
    unsigned char* ws = p.ws;
    const int tid = threadIdx.x, lr = tid >> 3, lc = tid & 7;
    int* sh = (int*)(lds + 98304);
    const int* cntg = (const int*)(ws + WS_CTL) + CTL_CNT + layer * 32;
    constexpr int NTN = DOWN ? 8 : 4;
    if (tid == 0) { int tp = 0, sp = 0;
        for (int e = 0; e < 32; ++e) { const int c = cntg[e]; sh[e] = tp; sh[64 + e] = sp; sh[128 + e] = c; tp += ((c + 255) >> 8) * NTN; sp += c; }
        sh[32] = tp; }
    __syncthreads();
    const int total = sh[32];
    const int* ltok_all = (const int*)(ws + WS_LTOK); const float* lgate_all = (const float*)(ws + WS_LGATE);
    bf16_t* HID = (bf16_t*)(ws + WS_P + P_HID); bf16_t* Y = (bf16_t*)(ws + WS_P + P_Y);
    const bf16_t* XN = (const bf16_t*)(ws + WS_XN);
    for (int t = blockIdx.x; t < total; t += gridDim.x) {
        int e = 0;
#pragma unroll 1
        for (int q = 1; q < 32; ++q) if (t >= sh[q]) e = q;
        const int r = t - sh[e], mt = r / NTN, nt = r % NTN;
        const int cnt = sh[128 + e], slot0 = sh[64 + e], mloc0 = mt * 256;
        const int* ltok = ltok_all + (size_t)e * M; const float* lgate = lgate_all + (size_t)e * M;
        int rows[4];
#pragma unroll
        for (int i = 0; i < 4; ++i) { int ml = mloc0 + lr + 64 * i; rows[i] = ml < cnt ? ml : cnt - 1; }
        if (!DOWN) {
            const bf16_t* Bt = (const bf16_t*)(ws + WS_WGU) + ((size_t)(layer * 32 + e) * 512 + nt * 128 + lr) * 1024 + lc * 8;
            const bf16_t* a0 = XN + (size_t)(ltok[rows[0]] >> 1) * D + lc * 8;
            const bf16_t* a1 = XN + (size_t)(ltok[rows[1]] >> 1) * D + lc * 8;
            const bf16_t* a2 = XN + (size_t)(ltok[rows[2]] >> 1) * D + lc * 8;
            const bf16_t* a3 = XN + (size_t)(ltok[rows[3]] >> 1) * D + lc * 8;
            EpiGateUp ep{HID, lgate, cnt, mloc0, slot0, nt * 64};
            gemm_tile(lds, a0, a1, a2, a3, Bt, Bt + (size_t)64 * 1024, 16, ep);
        } else {
            const bf16_t* Bt = (const bf16_t*)(ws + WS_WD) + ((size_t)(layer * 32 + e) * 1024 + nt * 128 + lr) * 256 + lc * 8;
            const bf16_t* a0 = HID + (size_t)(slot0 + rows[0]) * 256 + lc * 8;
            const bf16_t* a1 = HID + (size_t)(slot0 + rows[1]) * 256 + lc * 8;
            const bf16_t* a2 = HID + (size_t)(slot0 + rows[2]) * 256 + lc * 8;
            const bf16_t* a3 = HID + (size_t)(slot0 + rows[3]) * 256 + lc * 8;
            EpiDown ep{Y, ltok, cnt, mloc0, nt * 128};
            gemm_tile(lds, a0, a1, a2, a3, Bt, Bt + (size_t)64 * 256, 4, ep);
        }
    }
    __syncthreads();
}

constexpr int CH = 32;

__device__ __forceinline__ void rwkv_unit(const Params& p, char* lds, int bb, int hh, int cg) {
    const int tid = threadIdx.x;
    unsigned char* ws = p.ws;
    const bf16_t* P = (const bf16_t*)(ws + WS_P);
    bf16_t* O16 = (bf16_t*)(ws + WS_XN);
    float* AUX = p.out;
    float* w2s = (float*)lds;
    float* a2s = w2s + 4096;
    float* g2s = a2s + 4096;
    float* TW = g2s + 4096;
    float* AL = TW + CH * 64;
    float* SG = AL + CH * 64;
    float* R = SG + CH * 128;
    float* KS = R + CH * 64;
    float* WD = KS + CH * 64;
    float* KK = WD + CH * 64;
    float* BB = KK + CH * 64;
    float* VS = BB + CH * 64;
    float* YS = VS + CH * 32;
    for (int i = tid; i < 4096; i += NT) { const int j = i >> 6, c = i & 63; w2s[i] = p.rw_w2[j * 512 + hh * 64 + c]; a2s[i] = p.rw_a2[j * 512 + hh * 64 + c]; }
    for (int i = tid; i < 4096; i += NT) { const int j = i >> 5, c = i & 31; g2s[i] = p.rw_g2[j * 512 + hh * 64 + cg * 32 + c]; }
    int pcol = 0, role = -1, lcol = 0;
    if (tid < 64) { role = 0; lcol = tid; pcol = hh * 64 + lcol; }
    else if (tid < 128) { role = 1; lcol = tid - 64; pcol = 512 + hh * 64 + lcol; }
    else if (tid < 160) { role = 2; lcol = tid - 128; pcol = 1024 + hh * 64 + cg * 32 + lcol; }
    else if (tid < 224) { role = 3; lcol = tid - 160; pcol = 1536 + lcol; }
    else if (tid < 288) { role = 4; lcol = tid - 224; pcol = 1600 + lcol; }
    else if (tid < 416) { role = 5; lcol = tid - 288; pcol = 1664 + lcol; }
    const float mu = role >= 0 ? p.ev_mu[pcol] : 0.f;
    const bf16_t* pbase = P + (size_t)(bb * SEQ) * EVEN_IN + pcol;
    float prev = 0.f;
    float praw[CH];
    if (role >= 0) {
#pragma unroll
        for (int i = 0; i < CH; ++i) praw[i] = bf2f(pbase[(size_t)i * EVEN_IN]);
    }
    const int vrow = tid >> 4, kq = tid & 15;
    float S0 = 0.f, S1 = 0.f, S2 = 0.f, S3 = 0.f;
    const int pt = tid >> 4, pc4 = (tid & 15) * 4;
    const int hc = hh * 64 + pc4;
    const float4 w0v = *(const float4*)(p.rw_w0 + hc), a0v = *(const float4*)(p.rw_a0 + hc), kkv = *(const float4*)(p.rw_k_k + hc), kav = *(const float4*)(p.rw_k_a + hc), rkv = *(const float4*)(p.rw_r_k + hc);
    __syncthreads();
    for (int c0 = 0; c0 < SEQ; c0 += CH) {
        if (role >= 0) {
#pragma unroll
            for (int i = 0; i < CH; ++i) {
                const float cur = praw[i];
                const float s = cur + mu * (prev - cur);
                prev = cur;
                if (role == 0) R[i * 64 + lcol] = s;
                else if (role == 1) KS[i * 64 + lcol] = s;
                else if (role == 2) VS[i * 32 + lcol] = s;
                else if (role == 3) TW[i * 64 + lcol] = tanhf(s);
                else if (role == 4) AL[i * 64 + lcol] = s;
                else SG[i * 128 + lcol] = sigmoidf_(s);
            }
        }
        __syncthreads();
        if (role >= 0 && c0 + CH < SEQ) {
#pragma unroll
            for (int i = 0; i < CH; ++i) praw[i] = bf2f(pbase[(size_t)(c0 + CH + i) * EVEN_IN]);
        }
        {
            float wp0 = w0v.x, wp1 = w0v.y, wp2 = w0v.z, wp3 = w0v.w, ap0 = a0v.x, ap1 = a0v.y, ap2 = a0v.z, ap3 = a0v.w;
#pragma unroll 8
            for (int j = 0; j < 64; ++j) {
                const float tw = TW[pt * 64 + j], al = AL[pt * 64 + j];
                const float4 w2 = *(const float4*)(w2s + j * 64 + pc4), a2 = *(const float4*)(a2s + j * 64 + pc4);
                wp0 += tw * w2.x; wp1 += tw * w2.y; wp2 += tw * w2.z; wp3 += tw * w2.w;
                ap0 += al * a2.x; ap1 += al * a2.y; ap2 += al * a2.z; ap3 += al * a2.w;
            }
            const int gc = (tid & 15) * 2;
            float g0 = 0.f, g1 = 0.f;
#pragma unroll 8
            for (int j = 0; j < 128; ++j) { const float sg = SG[pt * 128 + j]; const float2 g2 = *(const float2*)(g2s + j * 32 + gc); g0 += sg * g2.x; g1 += sg * g2.y; }
            const float4 ks = *(const float4*)(KS + pt * 64 + pc4);
            const float4 rs = *(const float4*)(R + pt * 64 + pc4);
            float d0 = __expf(-__expf(-softplusf_(-wp0) - 0.5f)), d1 = __expf(-__expf(-softplusf_(-wp1) - 0.5f));
            float d2 = __expf(-__expf(-softplusf_(-wp2) - 0.5f)), d3 = __expf(-__expf(-softplusf_(-wp3) - 0.5f));
            const float A0 = sigmoidf_(ap0), A1 = sigmoidf_(ap1), A2 = sigmoidf_(ap2), A3 = sigmoidf_(ap3);
            float q0 = ks.x * kkv.x, q1 = ks.y * kkv.y, q2 = ks.z * kkv.z, q3 = ks.w * kkv.w;
            const float nrm = rsqrtf(red16(q0 * q0 + q1 * q1 + q2 * q2 + q3 * q3) + 1e-6f);
            q0 *= nrm; q1 *= nrm; q2 *= nrm; q3 *= nrm;
            const float k20 = ks.x * (1.f + (A0 - 1.f) * kav.x), k21 = ks.y * (1.f + (A1 - 1.f) * kav.y), k22 = ks.z * (1.f + (A2 - 1.f) * kav.z), k23 = ks.w * (1.f + (A3 - 1.f) * kav.w);
            const float bonus = red16(rs.x * k20 * rkv.x + rs.y * k21 * rkv.y + rs.z * k22 * rkv.z + rs.w * k23 * rkv.w);
            float4 o;
            o.x = d0; o.y = d1; o.z = d2; o.w = d3; *(float4*)(WD + pt * 64 + pc4) = o;
            o.x = q0; o.y = q1; o.z = q2; o.w = q3; *(float4*)(KK + pt * 64 + pc4) = o;
            o.x = q0 * A0; o.y = q1 * A1; o.z = q2 * A2; o.w = q3 * A3; *(float4*)(BB + pt * 64 + pc4) = o;
            __syncthreads();
            o.x = k20; o.y = k21; o.z = k22; o.w = k23; *(float4*)(KS + pt * 64 + pc4) = o;
            const float2 vv = *(const float2*)(VS + pt * 32 + gc);
            const size_t tok = (size_t)bb * SEQ + c0 + pt;
            const int oc = hh * 64 + cg * 32 + gc;
            float2 bo; bo.x = bonus * vv.x; bo.y = bonus * vv.y; *(float2*)(AUX + tok * D + oc) = bo;
            float2 go; go.x = g0; go.y = g1; *(float2*)(AUX + tok * D + 512 + oc) = go;
        }
        __syncthreads();
#pragma unroll 2
        for (int i = 0; i < CH; ++i) {
            const float4 kk = *(const float4*)(KK + i * 64 + kq * 4), wd = *(const float4*)(WD + i * 64 + kq * 4), b4 = *(const float4*)(BB + i * 64 + kq * 4);
            const float4 k2 = *(const float4*)(KS + i * 64 + kq * 4), r4 = *(const float4*)(R + i * 64 + kq * 4);
            const float v = VS[i * 32 + vrow];
            const float sa = -red16(S0 * kk.x + S1 * kk.y + S2 * kk.z + S3 * kk.w);
            S0 = S0 * wd.x + v * k2.x + sa * b4.x; S1 = S1 * wd.y + v * k2.y + sa * b4.y; S2 = S2 * wd.z + v * k2.z + sa * b4.z; S3 = S3 * wd.w + v * k2.w + sa * b4.w;
            const float y = red16(S0 * r4.x + S1 * r4.y + S2 * r4.z + S3 * r4.w);
            if (kq == 0) YS[i * 32 + vrow] = y;
        }
        __syncthreads();
        {
            const int ft = tid >> 4, fc = (tid & 15) * 2;
            const unsigned o = pack2(YS[ft * 32 + fc], YS[ft * 32 + fc + 1]);
            *(unsigned*)(O16 + ((size_t)bb * SEQ + c0 + ft) * D + hh * 64 + cg * 32 + fc) = o;
        }
    }
    __syncthreads();
}

__device__ __forceinline__ void hgrn_unit(const Params& p, char* lds, int bb, int hh, int cg) {
    const int tid = threadIdx.x;
    unsigned char* ws = p.ws;
    const bf16_t* P = (const bf16_t*)(ws + WS_P);
    bf16_t* O16 = (bf16_t*)(ws + WS_XN);
    float* Q = (float*)lds;
    float* FG = Q + CH * 64;
    float* KM = FG + CH * 64;
    float* VS = KM + CH * 64;
    float* YS = VS + CH * 32;
    int pcol = 0, role = -1, lcol = 0;
    if (tid < 64) { role = 0; lcol = tid; pcol = 1792 + hh * 64 + lcol; }
    else if (tid < 128) { role = 1; lcol = tid - 64; pcol = 1792 + 512 + hh * 64 + lcol; }
    else if (tid < 160) { role = 2; lcol = tid - 128; pcol = 1792 + 1024 + hh * 64 + cg * 32 + lcol; }
    float lb = 0.f;
    if (role == 1) { const float l0 = p.hg_lb[hh * 64 + lcol], l1 = p.hg_lb[512 + hh * 64 + lcol]; const float mx = fmaxf(l0, l1); const float e0 = __expf(l0 - mx), e1 = __expf(l1 - mx); lb = e0 / (e0 + e1); }
    const bf16_t* pbase = P + (size_t)(bb * SEQ) * EVEN_IN + pcol;
    float praw[CH];
    if (role >= 0) {
#pragma unroll
        for (int i = 0; i < CH; ++i) praw[i] = bf2f(pbase[(size_t)i * EVEN_IN]);
    }
    const int vcol = tid >> 4, dq = tid & 15;
    float S0 = 0.f, S1 = 0.f, S2 = 0.f, S3 = 0.f;
    for (int c0 = 0; c0 < SEQ; c0 += CH) {
        if (role >= 0) {
#pragma unroll
            for (int i = 0; i < CH; ++i) {
                const float s = praw[i];
                if (role == 0) Q[i * 64 + lcol] = siluf_(s);
                else if (role == 1) { const float fg = lb + (1.f - lb) * sigmoidf_(s); FG[i * 64 + lcol] = fg; KM[i * 64 + lcol] = 1.f - fg; }
                else VS[i * 32 + lcol] = s;
            }
        }
        __syncthreads();
        if (role >= 0 && c0 + CH < SEQ) {
#pragma unroll
            for (int i = 0; i < CH; ++i) praw[i] = bf2f(pbase[(size_t)(c0 + CH + i) * EVEN_IN]);
        }
#pragma unroll 2
        for (int i = 0; i < CH; ++i) {
            const float4 fg = *(const float4*)(FG + i * 64 + dq * 4), km = *(const float4*)(KM + i * 64 + dq * 4), q4 = *(const float4*)(Q + i * 64 + dq * 4);
            const float v = VS[i * 32 + vcol];
            S0 = fg.x * S0 + km.x * v; S1 = fg.y * S1 + km.y * v; S2 = fg.z * S2 + km.z * v; S3 = fg.w * S3 + km.w * v;
            const float y = red16(S0 * q4.x + S1 * q4.y + S2 * q4.z + S3 * q4.w);
            if (dq == 0) YS[i * 32 + vcol] = y;
        }
        __syncthreads();
        {
            const int ft = tid >> 4, fc = (tid & 15) * 2;
            const unsigned o = pack2(YS[ft * 32 + fc], YS[ft * 32 + fc + 1]);
            *(unsigned*)(O16 + ((size_t)bb * SEQ + c0 + ft) * D + 512 + hh * 64 + cg * 32 + fc) = o;
        }
        __syncthreads();
    }
}

__device__ __forceinline__ void phase_post0(const Params& p) {
    const int tid = threadIdx.x, lane = tid & 63, wave = tid >> 6;
    unsigned char* ws = p.ws;
    bf16_t* O16 = (bf16_t*)(ws + WS_XN);
    const bf16_t* P = (const bf16_t*)(ws + WS_P);
    const float* AUX = p.out;
    const int c0 = lane * 16;
    for (int tok = blockIdx.x * 8 + wave; tok < M; tok += gridDim.x * 8) {
        const u32x4 r0 = *(const u32x4*)(O16 + (size_t)tok * D + c0), r1 = *(const u32x4*)(O16 + (size_t)tok * D + c0 + 8);
        float y[16];
        y[0] = lo16(r0.x); y[1] = hi16(r0.x); y[2] = lo16(r0.y); y[3] = hi16(r0.y); y[4] = lo16(r0.z); y[5] = hi16(r0.z); y[6] = lo16(r0.w); y[7] = hi16(r0.w);
        y[8] = lo16(r1.x); y[9] = hi16(r1.x); y[10] = lo16(r1.y); y[11] = hi16(r1.y); y[12] = lo16(r1.z); y[13] = hi16(r1.z); y[14] = lo16(r1.w); y[15] = hi16(r1.w);
        float o[16];
        if (lane < 32) {
            float s = 0.f;
#pragma unroll
            for (int j = 0; j < 16; ++j) s += y[j];
            s += dppf<0xB1>(s); s += dppf<0x4E>(s);
            const float mean = s * (1.0f / 64.0f);
            float q = 0.f;
#pragma unroll
            for (int j = 0; j < 16; ++j) { const float d = y[j] - mean; q += d * d; }
            q += dppf<0xB1>(q); q += dppf<0x4E>(q);
            const float rstd = rsqrtf(q * (1.0f / 64.0f) + 64e-5f);
#pragma unroll
            for (int j4 = 0; j4 < 4; ++j4) {
                const float4 lw = *(const float4*)(p.rw_ln_w + c0 + j4 * 4), lb = *(const float4*)(p.rw_ln_b + c0 + j4 * 4);
                const float4 bv = *(const float4*)(AUX + (size_t)tok * D + c0 + j4 * 4), gv = *(const float4*)(AUX + (size_t)tok * D + 512 + c0 + j4 * 4);
                o[j4 * 4 + 0] = ((y[j4 * 4 + 0] - mean) * rstd * lw.x + lb.x + bv.x) * gv.x;
                o[j4 * 4 + 1] = ((y[j4 * 4 + 1] - mean) * rstd * lw.y + lb.y + bv.y) * gv.y;
                o[j4 * 4 + 2] = ((y[j4 * 4 + 2] - mean) * rstd * lw.z + lb.z + bv.z) * gv.z;
                o[j4 * 4 + 3] = ((y[j4 * 4 + 3] - mean) * rstd * lw.w + lb.w + bv.w) * gv.w;
            }
        } else {
            float q = 0.f;
#pragma unroll
            for (int j = 0; j < 16; ++j) q += y[j] * y[j];
            q += dppf<0xB1>(q); q += dppf<0x4E>(q);
            const float rstd = rsqrtf(q * (1.0f / 64.0f) + 1e-6f);
            const int cc = c0 - 512;
            const u32x4 g0 = *(const u32x4*)(P + (size_t)tok * EVEN_IN + 1792 + 1536 + cc), g1 = *(const u32x4*)(P + (size_t)tok * EVEN_IN + 1792 + 1536 + cc + 8);
            float gt[16];
            gt[0] = lo16(g0.x); gt[1] = hi16(g0.x); gt[2] = lo16(g0.y); gt[3] = hi16(g0.y); gt[4] = lo16(g0.z); gt[5] = hi16(g0.z); gt[6] = lo16(g0.w); gt[7] = hi16(g0.w);
            gt[8] = lo16(g1.x); gt[9] = hi16(g1.x); gt[10] = lo16(g1.y); gt[11] = hi16(g1.y); gt[12] = lo16(g1.z); gt[13] = hi16(g1.z); gt[14] = lo16(g1.w); gt[15] = hi16(g1.w);
#pragma unroll
            for (int j = 0; j < 16; ++j) o[j] = y[j] * rstd * p.hg_norm[(cc + j) & 63] * siluf_(gt[j]);
        }
        u32x4 w0, w1;
        w0.x = pack2(o[0], o[1]); w0.y = pack2(o[2], o[3]); w0.z = pack2(o[4], o[5]); w0.w = pack2(o[6], o[7]);
        w1.x = pack2(o[8], o[9]); w1.y = pack2(o[10], o[11]); w1.z = pack2(o[12], o[13]); w1.w = pack2(o[14], o[15]);
        *(u32x4*)(O16 + (size_t)tok * D + c0) = w0; *(u32x4*)(O16 + (size_t)tok * D + c0 + 8) = w1;
    }
}

__device__ __forceinline__ void gdn_unit(const Params& p, char* lds, int bb, int hh, int cg) {
    const int tid = threadIdx.x;
    unsigned char* ws = p.ws;
    const bf16_t* P = (const bf16_t*)(ws + WS_P);
    const float* GT = (const float*)(ws + WS_GATES);
    bf16_t* O16 = (bf16_t*)(ws + WS_XN);
    float* Q = (float*)lds;
    float* K = Q + CH * 128;
    float* VS = K + CH * 128;
    float* YS = VS + CH * 32;
    float* BE = YS + CH * 32;
    float* AD = BE + CH;
    int role = -1, lcol = 0, ccol = 0;
    if (tid < 128) { role = 0; lcol = tid; ccol = hh * 128 + lcol; }
    else if (tid < 256) { role = 1; lcol = tid - 128; ccol = 512 + hh * 128 + lcol; }
    else if (tid < 288) { role = 2; lcol = tid - 256; ccol = 1024 + hh * 128 + cg * 32 + lcol; }
    float cw0 = 0.f, cw1 = 0.f, cw2 = 0.f, cw3 = 0.f;
    if (role >= 0) { cw0 = p.gd_conv[ccol]; cw1 = p.gd_conv[1536 + ccol]; cw2 = p.gd_conv[2 * 1536 + ccol]; cw3 = p.gd_conv[3 * 1536 + ccol]; }
    const bf16_t* pbase = P + (size_t)(bb * SEQ) * ODD_IN + ccol;
    float x1 = 0.f, x2 = 0.f, x3 = 0.f;
    float praw[CH];
    if (role >= 0) {
#pragma unroll
        for (int i = 0; i < CH; ++i) praw[i] = bf2f(pbase[(size_t)i * ODD_IN]);
    }
    const float negA = -__expf(p.gd_a_log[hh]), dtb = p.gd_dt_bias[hh];
    const int vcol = tid >> 4, dq = tid & 15;
    float S[8];
#pragma unroll
    for (int j = 0; j < 8; ++j) S[j] = 0.f;
    for (int c0 = 0; c0 < SEQ; c0 += CH) {
        if (role >= 0) {
#pragma unroll
            for (int i = 0; i < CH; ++i) {
                const float cur = praw[i];
                const float yv = siluf_(cw0 * x3 + cw1 * x2 + cw2 * x1 + cw3 * cur);
                x3 = x2; x2 = x1; x1 = cur;
                if (role == 0) Q[i * 128 + lcol] = yv; else if (role == 1) K[i * 128 + lcol] = yv; else VS[i * 32 + lcol] = yv;
            }
        }
        if (tid >= 320 && tid < 320 + CH) { const int i = tid - 320; const size_t tok = (size_t)bb * SEQ + c0 + i;
            BE[i] = sigmoidf_(GT[tok * 16 + hh]); AD[i] = __expf(negA * softplusf_(GT[tok * 16 + 4 + hh] + dtb)); }
        __syncthreads();
        if (role >= 0 && c0 + CH < SEQ) {
#pragma unroll
            for (int i = 0; i < CH; ++i) praw[i] = bf2f(pbase[(size_t)(c0 + CH + i) * ODD_IN]);
        }
        {
            const int t = tid >> 4, c8 = (tid & 15) * 8;
            float4 qa = *(const float4*)(Q + t * 128 + c8), qb = *(const float4*)(Q + t * 128 + c8 + 4);
            float4 ka = *(const float4*)(K + t * 128 + c8), kb = *(const float4*)(K + t * 128 + c8 + 4);
            const float sq = red16(qa.x * qa.x + qa.y * qa.y + qa.z * qa.z + qa.w * qa.w + qb.x * qb.x + qb.y * qb.y + qb.z * qb.z + qb.w * qb.w);
            const float sk = red16(ka.x * ka.x + ka.y * ka.y + ka.z * ka.z + ka.w * ka.w + kb.x * kb.x + kb.y * kb.y + kb.z * kb.z + kb.w * kb.w);
            const float nq = rsqrtf(sq + 1e-6f) * 0.08838834764831845f, nk = rsqrtf(sk + 1e-6f);
            qa.x *= nq; qa.y *= nq; qa.z *= nq; qa.w *= nq; qb.x *= nq; qb.y *= nq; qb.z *= nq; qb.w *= nq;
            ka.x *= nk; ka.y *= nk; ka.z *= nk; ka.w *= nk; kb.x *= nk; kb.y *= nk; kb.z *= nk; kb.w *= nk;
            *(float4*)(Q + t * 128 + c8) = qa; *(float4*)(Q + t * 128 + c8 + 4) = qb; *(float4*)(K + t * 128 + c8) = ka; *(float4*)(K + t * 128 + c8 + 4) = kb;
        }
        __syncthreads();
#pragma unroll 2
        for (int i = 0; i < CH; ++i) {
            const float4 ka = *(const float4*)(K + i * 128 + dq * 8), kb = *(const float4*)(K + i * 128 + dq * 8 + 4);
            const float4 qa = *(const float4*)(Q + i * 128 + dq * 8), qb = *(const float4*)(Q + i * 128 + dq * 8 + 4);
            const float v = VS[i * 32 + vcol], be = BE[i], a = AD[i];
            const float ks = red16(ka.x * S[0] + ka.y * S[1] + ka.z * S[2] + ka.w * S[3] + kb.x * S[4] + kb.y * S[5] + kb.z * S[6] + kb.w * S[7]);
            const float vn = be * (v - a * ks);
            S[0] = a * S[0] + ka.x * vn; S[1] = a * S[1] + ka.y * vn; S[2] = a * S[2] + ka.z * vn; S[3] = a * S[3] + ka.w * vn;
            S[4] = a * S[4] + kb.x * vn; S[5] = a * S[5] + kb.y * vn; S[6] = a * S[6] + kb.z * vn; S[7] = a * S[7] + kb.w * vn;
            const float y = red16(qa.x * S[0] + qa.y * S[1] + qa.z * S[2] + qa.w * S[3] + qb.x * S[4] + qb.y * S[5] + qb.z * S[6] + qb.w * S[7]);
            if (dq == 0) YS[i * 32 + vcol] = y;
        }
        __syncthreads();
        {
            const int ft = tid >> 4, fc = (tid & 15) * 2;
            const unsigned o = pack2(YS[ft * 32 + fc], YS[ft * 32 + fc + 1]);
            *(unsigned*)(O16 + ((size_t)bb * SEQ + c0 + ft) * D + hh * 128 + cg * 32 + fc) = o;
        }
        __syncthreads();
    }
}

__device__ __forceinline__ void mlstm_unit(const Params& p, char* lds, int bb, int hh, int cg) {
    const int tid = threadIdx.x, lane = tid & 63;
    unsigned char* ws = p.ws;
    const bf16_t* P = (const bf16_t*)(ws + WS_P);
    const float* GT = (const float*)(ws + WS_GATES);
    bf16_t* O16 = (bf16_t*)(ws + WS_XN);
    float* Q = (float*)lds;
    float* K = Q + CH * 128;
    float* VS = K + CH * 128;
    float* YS = VS + CH * 32;
    float* IG = YS + CH * 32;
    float* LF = IG + CH;
    int role = -1, lcol = 0, pcol = 0;
    if (tid < 128) { role = 0; lcol = tid; pcol = 2048 + hh * 128 + lcol; }
    else if (tid < 256) { role = 1; lcol = tid - 128; pcol = 2560 + hh * 128 + lcol; }
    else if (tid < 288) { role = 2; lcol = tid - 256; pcol = 3072 + hh * 128 + cg * 32 + lcol; }
    const bf16_t* pbase = P + (size_t)(bb * SEQ) * ODD_IN + pcol;
    float praw[CH];
    if (role >= 0) {
#pragma unroll
        for (int i = 0; i < CH; ++i) praw[i] = bf2f(pbase[(size_t)i * ODD_IN]);
    }
    const float ib = p.ml_i_bias[hh], fb = p.ml_f_bias[hh];
    const int vcol = tid >> 4, dq = tid & 15;
    float C[8];
#pragma unroll
    for (int j = 0; j < 8; ++j) C[j] = 0.f;
    float n0 = 0.f, n1 = 0.f;
    float m = 0.f;
    for (int c0 = 0; c0 < SEQ; c0 += CH) {
        if (role >= 0) {
#pragma unroll
            for (int i = 0; i < CH; ++i) {
                const float s = praw[i];
                if (role == 0) Q[i * 128 + lcol] = s; else if (role == 1) K[i * 128 + lcol] = s * 0.08838834764831845f; else VS[i * 32 + lcol] = s;
            }
        }
        if (tid >= 320 && tid < 320 + CH) { const int i = tid - 320; const size_t tok = (size_t)bb * SEQ + c0 + i;
            IG[i] = GT[tok * 16 + 8 + hh] + ib; const float z = GT[tok * 16 + 12 + hh] + fb; LF[i] = -softplusf_(-z); }
        __syncthreads();
        if (role >= 0 && c0 + CH < SEQ) {
#pragma unroll
            for (int i = 0; i < CH; ++i) praw[i] = bf2f(pbase[(size_t)(c0 + CH + i) * ODD_IN]);
        }
#pragma unroll 2
        for (int i = 0; i < CH; ++i) {
            const float4 ka = *(const float4*)(K + i * 128 + dq * 8), kb = *(const float4*)(K + i * 128 + dq * 8 + 4);
            const float4 qa = *(const float4*)(Q + i * 128 + dq * 8), qb = *(const float4*)(Q + i * 128 + dq * 8 + 4);
            const float2 kn = *(const float2*)(K + i * 128 + lane * 2), qn = *(const float2*)(Q + i * 128 + lane * 2);
            const float v = VS[i * 32 + vcol];
            const float xm = LF[i] + m, ig = IG[i];
            const float mn = fmaxf(xm, ig);
            const float fd = __expf(xm - mn), iw = __expf(ig - mn);
            m = mn;
            const float iv = iw * v;
            C[0] = fd * C[0] + ka.x * iv; C[1] = fd * C[1] + ka.y * iv; C[2] = fd * C[2] + ka.z * iv; C[3] = fd * C[3] + ka.w * iv;
            C[4] = fd * C[4] + kb.x * iv; C[5] = fd * C[5] + kb.y * iv; C[6] = fd * C[6] + kb.z * iv; C[7] = fd * C[7] + kb.w * iv;
            n0 = fd * n0 + iw * kn.x; n1 = fd * n1 + iw * kn.y;
            const float num = red16(qa.x * C[0] + qa.y * C[1] + qa.z * C[2] + qa.w * C[3] + qb.x * C[4] + qb.y * C[5] + qb.z * C[6] + qb.w * C[7]);
            const float den = red64(qn.x * n0 + qn.y * n1);
            const float y = num / fmaxf(fabsf(den), __expf(-mn));
            if (dq == 0) YS[i * 32 + vcol] = y;
        }
        __syncthreads();
        {
            const int ft = tid >> 4, fc = (tid & 15) * 2;
            const unsigned o = pack2(YS[ft * 32 + fc], YS[ft * 32 + fc + 1]);
            *(unsigned*)(O16 + ((size_t)bb * SEQ + c0 + ft) * D + 512 + hh * 128 + cg * 32 + fc) = o;
        }
        __syncthreads();
    }
}


typedef short s16x4 __attribute__((ext_vector_type(4)));
typedef float f32x4v __attribute__((ext_vector_type(4)));
#define MFMA16(a, b, c) __builtin_amdgcn_mfma_f32_16x16x32_bf16((a), (b), (c), 0, 0, 0)
__device__ __forceinline__ bf16x8 frag_rm(const bf16_t* base, int ld, int lane) { return *(const bf16x8*)(base + (lane & 15) * ld + 8 * (lane >> 4)); }
__device__ __forceinline__ bf16x8 frag_tr(const bf16_t* base, int ld, int lane) {
    const int g = lane >> 4, i = lane & 15;
    const bf16_t* a0 = base + (8 * g + (i >> 2)) * ld + 4 * (i & 3);
    const s16x4 lo = __builtin_amdgcn_ds_read_tr16_b64_v4i16((LAS s16x4*)a0);
    const s16x4 hi = __builtin_amdgcn_ds_read_tr16_b64_v4i16((LAS s16x4*)(a0 + 4 * ld));
    bf16x8 r; r[0] = lo[0]; r[1] = lo[1]; r[2] = lo[2]; r[3] = lo[3]; r[4] = hi[0]; r[5] = hi[1]; r[6] = hi[2]; r[7] = hi[3];
    return r;
}
__device__ __forceinline__ float red8(float x) { x += dppf<0xB1>(x); x += dppf<0x4E>(x); x += dppf<0x141>(x); return x; }

__device__ __forceinline__ void mlstm_chunk_unit(const Params& p, char* lds, int bb, int hh, int cg) {
    const int tid = threadIdx.x, lane = tid & 63, wave = tid >> 6, g = lane >> 4, li = lane & 15;
    unsigned char* ws = p.ws;
    const bf16_t* P = (const bf16_t*)(ws + WS_P);
    const float* GT = (const float*)(ws + WS_GATES);
    bf16_t* O16 = (bf16_t*)(ws + WS_XN);
    constexpr int LQ = 136, LV = 40, LS = 72;
    bf16_t* Qs = (bf16_t*)lds;
    bf16_t* Ks = Qs + 64 * LQ;
    bf16_t* Vs = Ks + 64 * LQ;
    bf16_t* VWs = Vs + 64 * LV;
    bf16_t* SC = VWs + 64 * LV;
    bf16_t* Ct = SC + 64 * LS;
    float* fl = (float*)(Ct + 2 * 32 * LQ);
    float* nvec = fl; float* zs = fl + 128; float* Mt = zs + 64; float* iw = Mt + 64; float* emt = iw + 64; float* wsc = emt + 64; float* rsum = wsc + 64; float* qn = rsum + 64; float* misc = qn + 64;
    const float scale = 0.08838834764831845f;
    for (int i = tid; i < 32 * LQ / 2; i += NT) ((unsigned*)Ct)[i] = 0u;
    if (tid < 128) nvec[tid] = 0.f;
    f32x4v cacc[2];
#pragma unroll
    for (int v = 0; v < 2; ++v) { cacc[v][0] = 0.f; cacc[v][1] = 0.f; cacc[v][2] = 0.f; cacc[v][3] = 0.f; }
    float m = 0.f;
    const float ib = p.ml_i_bias[hh], fb = p.ml_f_bias[hh];
    const int qt0 = tid >> 4, qc = tid & 15;
    const int vt = tid >> 2, vc = tid & 3;
    const bf16_t* qsrc = P + ((size_t)bb * SEQ + qt0) * ODD_IN + 2048 + hh * 128 + qc * 8;
    const bf16_t* ksrc = qsrc + 512;
    const bf16_t* vsrc = P + ((size_t)bb * SEQ + vt) * ODD_IN + 3072 + hh * 128 + cg * 32 + vc * 8;
    u32x4 rq0, rq1, rk0, rk1, rv; float rig = 0.f, rfg = 0.f;
    rq0 = *(const u32x4*)qsrc; rq1 = *(const u32x4*)(qsrc + (size_t)32 * ODD_IN); rk0 = *(const u32x4*)ksrc; rk1 = *(const u32x4*)(ksrc + (size_t)32 * ODD_IN);
    rv = rq0; if (tid < 256) rv = *(const u32x4*)vsrc;
    if (tid < 64) { const size_t tok = (size_t)bb * SEQ + tid; rig = GT[tok * 16 + 8 + hh]; rfg = GT[tok * 16 + 12 + hh]; }
    __syncthreads();
    for (int c0 = 0; c0 < SEQ; c0 += 64) {
        const int cur = (c0 >> 6) & 1, nxt = cur ^ 1;
        *(u32x4*)(Qs + qt0 * LQ + qc * 8) = rq0; *(u32x4*)(Qs + (qt0 + 32) * LQ + qc * 8) = rq1;
        *(u32x4*)(Ks + qt0 * LQ + qc * 8) = rk0; *(u32x4*)(Ks + (qt0 + 32) * LQ + qc * 8) = rk1;
        if (tid < 256) *(u32x4*)(Vs + vt * LV + vc * 8) = rv;
        if (wave == 0) {
            const float z0 = rfg + fb;
            const float lf = -softplusf_(-z0), ig = rig + ib;
            float bc = lf;
#pragma unroll
            for (int off = 1; off < 64; off <<= 1) { const float y = __shfl_up(bc, off); if (lane >= off) bc += y; }
            const float z = ig - bc;
            float cz = z;
#pragma unroll
            for (int off = 1; off < 64; off <<= 1) { const float y = __shfl_up(cz, off); if (lane >= off) cz = fmaxf(cz, y); }
            const float Mtv = fmaxf(m, cz);
            const float Ml = __shfl(Mtv, 63), bl = __shfl(bc, 63);
            zs[lane] = z; Mt[lane] = Mtv; iw[lane] = __expf(m - Mtv); emt[lane] = __expf(-(bc + Mtv)); wsc[lane] = __expf(z - Ml) * scale; rsum[lane] = 0.f;
            if (lane == 0) misc[0] = __expf(m - Ml);
            m = bl + Ml;
        }
        __syncthreads();
        if (tid < 256) {
            const float w = wsc[vt];
            u32x4 o; o.x = pack2(lo16(rv.x) * w, hi16(rv.x) * w); o.y = pack2(lo16(rv.y) * w, hi16(rv.y) * w); o.z = pack2(lo16(rv.z) * w, hi16(rv.z) * w); o.w = pack2(lo16(rv.w) * w, hi16(rv.w) * w);
            *(u32x4*)(VWs + vt * LV + vc * 8) = o;
        }
        if (c0 + 64 < SEQ) {
            const size_t adv = (size_t)(c0 + 64) * ODD_IN;
            rq0 = *(const u32x4*)(qsrc + adv); rq1 = *(const u32x4*)(qsrc + adv + (size_t)32 * ODD_IN); rk0 = *(const u32x4*)(ksrc + adv); rk1 = *(const u32x4*)(ksrc + adv + (size_t)32 * ODD_IN);
            if (tid < 256) rv = *(const u32x4*)(vsrc + adv);
            if (tid < 64) { const size_t tok = (size_t)bb * SEQ + c0 + 64 + tid; rig = GT[tok * 16 + 8 + hh]; rfg = GT[tok * 16 + 12 + hh]; }
        }
        {
            const int ti = wave >> 1;
            float rs0 = 0.f, rs1 = 0.f, rs2 = 0.f, rs3 = 0.f;
#pragma unroll
            for (int jj = 0; jj < 2; ++jj) {
                const int tj = (wave & 1) * 2 + jj;
                f32x4v acc; acc[0] = 0.f; acc[1] = 0.f; acc[2] = 0.f; acc[3] = 0.f;
                if (tj <= ti) {
#pragma unroll
                    for (int k0 = 0; k0 < 128; k0 += 32) acc = MFMA16(frag_rm(Qs + ti * 16 * LQ + k0, LQ, lane), frag_rm(Ks + tj * 16 * LQ + k0, LQ, lane), acc);
                    const int s = tj * 16 + li; const float zv = zs[s];
#pragma unroll
                    for (int r = 0; r < 4; ++r) { const int t = ti * 16 + 4 * g + r; acc[r] = (s <= t) ? acc[r] * scale * __expf(zv - Mt[t]) : 0.f; }
                    rs0 += acc[0]; rs1 += acc[1]; rs2 += acc[2]; rs3 += acc[3];
                }
                const int s = tj * 16 + li;
#pragma unroll
                for (int r = 0; r < 4; ++r) SC[(ti * 16 + 4 * g + r) * LS + s] = f2bf(acc[r]);
            }
            rs0 = red16(rs0); rs1 = red16(rs1); rs2 = red16(rs2); rs3 = red16(rs3);
            if (li == 0) { atomicAdd(&rsum[ti * 16 + 4 * g + 0], rs0); atomicAdd(&rsum[ti * 16 + 4 * g + 1], rs1); atomicAdd(&rsum[ti * 16 + 4 * g + 2], rs2); atomicAdd(&rsum[ti * 16 + 4 * g + 3], rs3); }
            const int t = tid >> 3, part = tid & 7;
            float a = 0.f;
#pragma unroll
            for (int j = 0; j < 16; ++j) a += bf2f(Qs[t * LQ + part * 16 + j]) * nvec[part * 16 + j];
            a = red8(a);
            if (part == 0) qn[t] = a;
        }
        __syncthreads();
        {
            const int ti = wave >> 1, vj = wave & 1;
            f32x4v acc; acc[0] = 0.f; acc[1] = 0.f; acc[2] = 0.f; acc[3] = 0.f;
            const bf16_t* Cc = Ct + cur * 32 * LQ;
#pragma unroll
            for (int k0 = 0; k0 < 128; k0 += 32) acc = MFMA16(frag_rm(Qs + ti * 16 * LQ + k0, LQ, lane), frag_rm(Cc + vj * 16 * LQ + k0, LQ, lane), acc);
#pragma unroll
            for (int r = 0; r < 4; ++r) acc[r] *= iw[ti * 16 + 4 * g + r];
#pragma unroll
            for (int k0 = 0; k0 < 64; k0 += 32) acc = MFMA16(frag_rm(SC + ti * 16 * LS + k0, LS, lane), frag_tr(Vs + k0 * LV + vj * 16, LV, lane), acc);
#pragma unroll
            for (int r = 0; r < 4; ++r) {
                const int t = ti * 16 + 4 * g + r;
                const float den = iw[t] * qn[t] + rsum[t];
                const float h = acc[r] / fmaxf(fabsf(den), emt[t]);
                O16[((size_t)bb * SEQ + c0 + t) * D + 512 + hh * 128 + cg * 32 + vj * 16 + li] = f2bf(h);
            }
        }
        {
            const float dec = misc[0];
            bf16_t* Cn = Ct + nxt * 32 * LQ;
#pragma unroll
            for (int vi = 0; vi < 2; ++vi) {
                f32x4v t4; t4[0] = 0.f; t4[1] = 0.f; t4[2] = 0.f; t4[3] = 0.f;
#pragma unroll
                for (int k0 = 0; k0 < 64; k0 += 32) t4 = MFMA16(frag_tr(Ks + k0 * LQ + wave * 16, LQ, lane), frag_tr(VWs + k0 * LV + vi * 16, LV, lane), t4);
                cacc[vi][0] = dec * cacc[vi][0] + t4[0]; cacc[vi][1] = dec * cacc[vi][1] + t4[1]; cacc[vi][2] = dec * cacc[vi][2] + t4[2]; cacc[vi][3] = dec * cacc[vi][3] + t4[3];
                u32x2 o; o.x = pack2(cacc[vi][0], cacc[vi][1]); o.y = pack2(cacc[vi][2], cacc[vi][3]);
                *(u32x2*)(Cn + (vi * 16 + li) * LQ + wave * 16 + 4 * g) = o;
            }
            if (tid < 128) {
                float a = dec * nvec[tid];
#pragma unroll 8
                for (int s = 0; s < 64; ++s) a += wsc[s] * bf2f(Ks[s * LQ + tid]);
                nvec[tid] = a;
            }
        }
        __syncthreads();
    }
}


__device__ __forceinline__ void tri_inverse_wave(const float* Nf, const bf16_t* Nb, bf16_t* Tb, bf16_t* Wb, int lane) {
    const int g = lane >> 4, li = lane & 15;
    {
        float Tc[16];
        const float* Nrow = Nf + (16 * g) * 68 + 16 * g;
#pragma unroll
        for (int i = 0; i < 16; ++i) {
            float acc = (i == li) ? 1.f : 0.f;
#pragma unroll
            for (int j = 0; j < i; ++j) acc -= Nrow[i * 68 + j] * Tc[j];
            Tc[i] = acc;
        }
#pragma unroll
        for (int i = 0; i < 16; ++i) Tb[(16 * g + i) * 72 + 16 * g + li] = f2bf(Tc[i]);
    }
    asm volatile("s_waitcnt lgkmcnt(0)" ::: "memory");
#pragma unroll
    for (int dl = 1; dl < 4; ++dl) {
#pragma unroll
        for (int j = 0; j + dl < 4; ++j) {
            const int i = j + dl;
            f32x4v w; w[0] = 0.f; w[1] = 0.f; w[2] = 0.f; w[3] = 0.f;
#pragma unroll
            for (int k0 = 0; k0 < 16 * dl; k0 += 32) {
                bf16x8 a = frag_rm(Nb + (16 * i) * 72 + 16 * j + k0, 72, lane);
                const bf16x8 b = frag_tr(Tb + (16 * j + k0) * 72 + 16 * j, 72, lane);
                if (k0 + 8 * g >= 16 * dl) { a[0] = 0; a[1] = 0; a[2] = 0; a[3] = 0; a[4] = 0; a[5] = 0; a[6] = 0; a[7] = 0; }
                w = MFMA16(a, b, w);
            }
#pragma unroll
            for (int r = 0; r < 4; ++r) Wb[(4 * g + r) * 24 + li] = f2bf(w[r]);
            asm volatile("s_waitcnt lgkmcnt(0)" ::: "memory");
            bf16x8 a = frag_rm(Tb + (16 * i) * 72 + 16 * i, 72, lane);
            if (g >= 2) { a[0] = 0; a[1] = 0; a[2] = 0; a[3] = 0; a[4] = 0; a[5] = 0; a[6] = 0; a[7] = 0; }
            const bf16x8 b = frag_tr(Wb, 24, lane);
            f32x4v t; t[0] = 0.f; t[1] = 0.f; t[2] = 0.f; t[3] = 0.f;
            t = MFMA16(a, b, t);
#pragma unroll
            for (int r = 0; r < 4; ++r) Tb[(16 * i + 4 * g + r) * 72 + 16 * j + li] = f2bf(-t[r]);
            asm volatile("s_waitcnt lgkmcnt(0)" ::: "memory");
        }
    }
}

__device__ __forceinline__ void gdn_chunk_unit(const Params& p, char* lds, int bb, int hh, int cg) {
    const int tid = threadIdx.x, lane = tid & 63, wave = tid >> 6, g = lane >> 4, li = lane & 15;
    unsigned char* ws = p.ws;
    const bf16_t* P = (const bf16_t*)(ws + WS_P);
    const float* GT = (const float*)(ws + WS_GATES);
    bf16_t* O16 = (bf16_t*)(ws + WS_XN);
    constexpr int LQ = 136, LV = 40, LS = 72, LR = 296;
#define GDN_BUFS(LB) \
    bf16_t* Qs = (bf16_t*)LB; \
    bf16_t* Ks = (bf16_t*)(LB + 17408); \
    bf16_t* Vs = (bf16_t*)(LB + 34816); \
    bf16_t* Rb = (bf16_t*)(LB + 39936); \
    bf16_t* Vnb = (bf16_t*)(LB + 45056); \
    bf16_t* VnD = (bf16_t*)(LB + 50176); \
    bf16_t* Ct = (bf16_t*)(LB + 55296); \
    float* CW = (float*)(LB + 72704); \
    bf16_t* HALO = (bf16_t*)(LB + 77312); \
    bf16_t* Wb = (bf16_t*)(LB + 80896); \
    float* gam = (float*)(LB + 82432); float* be = gam + 64; float* egam = be + 64; float* edl = egam + 64; float* misc = edl + 64; \
    bf16_t* RAW = (bf16_t*)(LB + 83712); \
    bf16_t* A1b = (bf16_t*)(LB + 83712); \
    bf16_t* A2b = (bf16_t*)(LB + 83712 + 9216); \
    bf16_t* Tb = (bf16_t*)(LB + 83712 + 18432); \
    float* A2f = (float*)(LB + 83712 + 27648); \

    GDN_BUFS(lds)
    for (int i = tid; i < 32 * LQ / 2; i += NT) ((unsigned*)Ct)[i] = 0u;
    for (int i = tid; i < 2 * 3 * LR / 2; i += NT) ((unsigned*)HALO)[i] = 0u;
    for (int i = tid; i < 32 * 24 / 2; i += NT) ((unsigned*)Wb)[i] = 0u;
    for (int i = tid; i < 4 * 288; i += NT) { const int r = i / 288, c = i % 288; const int ch = c < 128 ? hh * 128 + c : c < 256 ? 512 + hh * 128 + (c - 128) : 1024 + hh * 128 + cg * 32 + (c - 256); CW[i] = p.gd_conv[r * 1536 + ch]; }
    f32x4v cacc[2];
#pragma unroll
    for (int v = 0; v < 2; ++v) { cacc[v][0] = 0.f; cacc[v][1] = 0.f; cacc[v][2] = 0.f; cacc[v][3] = 0.f; }
    const float negA = -__expf(p.gd_a_log[hh]), dtb = p.gd_dt_bias[hh];
    const int lt = tid >> 4, lc = tid & 15, vt = tid >> 2, vc = tid & 3;
    const bf16_t* qsrc = P + ((size_t)bb * SEQ + lt) * ODD_IN + hh * 128 + lc * 8;
    const bf16_t* ksrc = qsrc + 512;
    const bf16_t* vsrc = P + ((size_t)bb * SEQ + vt) * ODD_IN + 1024 + hh * 128 + cg * 32 + vc * 8;
    u32x4 rq0, rq1, rk0, rk1, rv; float rb_ = 0.f, rg_ = 0.f;
    rq0 = *(const u32x4*)qsrc; rq1 = *(const u32x4*)(qsrc + (size_t)32 * ODD_IN); rk0 = *(const u32x4*)ksrc; rk1 = *(const u32x4*)(ksrc + (size_t)32 * ODD_IN);
    rv = rq0; if (tid < 256) rv = *(const u32x4*)vsrc;
    if (tid < 64) { const size_t tok = (size_t)bb * SEQ + tid; rb_ = GT[tok * 16 + hh]; rg_ = GT[tok * 16 + 4 + hh]; }
    __syncthreads();
    for (int c0 = 0; c0 < SEQ; c0 += 64) {
        const int ci = c0 >> 6, cur = ci & 1, nxt = cur ^ 1;
        int lz = 0; asm volatile("" : "+s"(lz));
        char* LB2 = lds + lz;
        GDN_BUFS(LB2)
        *(u32x4*)(RAW + lt * LR + lc * 8) = rq0; *(u32x4*)(RAW + (lt + 32) * LR + lc * 8) = rq1;
        *(u32x4*)(RAW + lt * LR + 128 + lc * 8) = rk0; *(u32x4*)(RAW + (lt + 32) * LR + 128 + lc * 8) = rk1;
        if (tid < 256) *(u32x4*)(RAW + vt * LR + 256 + vc * 8) = rv;
        if (lt + 32 >= 61) { bf16_t* hrow = HALO + (nxt * 3 + (lt + 32 - 61)) * LR; *(u32x4*)(hrow + lc * 8) = rq1; *(u32x4*)(hrow + 128 + lc * 8) = rk1; }
        if (tid < 256 && vt >= 61) *(u32x4*)(HALO + (nxt * 3 + (vt - 61)) * LR + 256 + vc * 8) = rv;
        if (wave == 0) {
            const float bev = sigmoidf_(rb_);
            const float gg = negA * softplusf_(rg_ + dtb);
            float gc = gg;
#pragma unroll
            for (int off = 1; off < 64; off <<= 1) { const float y = __shfl_up(gc, off); if (lane >= off) gc += y; }
            const float gl = __shfl(gc, 63);
            gam[lane] = gc; be[lane] = bev; egam[lane] = __expf(gc); edl[lane] = __expf(gl - gc);
            if (lane == 0) misc[0] = __expf(gl);
        }
        __syncthreads();
        {
            const bf16_t* halo = HALO + cur * 3 * LR;
#pragma unroll 1
            for (int grp = 0; grp < 3; ++grp) {
                if (grp == 2 && lc >= 4) break;
                const int col = grp * 128 + lc * 8;
                float4 wA[4], wB[4];
#pragma unroll
                for (int r = 0; r < 4; ++r) { wA[r] = *(const float4*)(CW + r * 288 + col); wB[r] = *(const float4*)(CW + r * 288 + col + 4); }
#pragma unroll 1
                for (int tt = 0; tt < 2; ++tt) {
                    const int t = lt + 32 * tt;
                    float y[8];
#pragma unroll
                    for (int e = 0; e < 8; ++e) y[e] = 0.f;
#pragma unroll
                    for (int r = 0; r < 4; ++r) {
                        const int row = t + r - 3;
                        const bf16_t* rp = (row >= 0) ? RAW + row * LR : halo + (row + 3) * LR;
                        const u32x4 x = *(const u32x4*)(rp + col);
                        y[0] += wA[r].x * lo16(x.x); y[1] += wA[r].y * hi16(x.x); y[2] += wA[r].z * lo16(x.y); y[3] += wA[r].w * hi16(x.y);
                        y[4] += wB[r].x * lo16(x.z); y[5] += wB[r].y * hi16(x.z); y[6] += wB[r].z * lo16(x.w); y[7] += wB[r].w * hi16(x.w);
                    }
                    float ss = 0.f;
#pragma unroll
                    for (int e = 0; e < 8; ++e) { y[e] = siluf_(y[e]); ss += y[e] * y[e]; }
                    float nrm = 1.f;
                    if (grp < 2) { ss = red16(ss); nrm = rsqrtf(ss + 1e-6f) * (grp == 0 ? 0.08838834764831845f : 1.f); }
                    u32x4 o; o.x = pack2(y[0] * nrm, y[1] * nrm); o.y = pack2(y[2] * nrm, y[3] * nrm); o.z = pack2(y[4] * nrm, y[5] * nrm); o.w = pack2(y[6] * nrm, y[7] * nrm);
                    bf16_t* dst = grp == 0 ? Qs + t * LQ + lc * 8 : grp == 1 ? Ks + t * LQ + lc * 8 : Vs + t * LV + lc * 8;
                    *(u32x4*)dst = o;
                }
            }
        }
        if (c0 + 64 < SEQ) {
            const size_t adv = (size_t)(c0 + 64) * ODD_IN;
            rq0 = *(const u32x4*)(qsrc + adv); rq1 = *(const u32x4*)(qsrc + adv + (size_t)32 * ODD_IN); rk0 = *(const u32x4*)(ksrc + adv); rk1 = *(const u32x4*)(ksrc + adv + (size_t)32 * ODD_IN);
            if (tid < 256) rv = *(const u32x4*)(vsrc + adv);
            if (tid < 64) { const size_t tok = (size_t)bb * SEQ + c0 + 64 + tid; rb_ = GT[tok * 16 + hh]; rg_ = GT[tok * 16 + 4 + hh]; }
        }
        __syncthreads();
        {
            for (int i = tid; i < 64 * LS / 2; i += NT) ((unsigned*)Tb)[i] = 0u;
            const int ti = wave >> 1;
#pragma unroll
            for (int jj = 0; jj < 2; ++jj) {
                const int tj = (wave & 1) * 2 + jj;
                f32x4v aq, ak; aq[0] = 0.f; aq[1] = 0.f; aq[2] = 0.f; aq[3] = 0.f; ak = aq;
                const int s = tj * 16 + li;
                if (tj <= ti) {
#pragma unroll
                    for (int k0 = 0; k0 < 128; k0 += 32) {
                        const bf16x8 kb = frag_rm(Ks + tj * 16 * LQ + k0, LQ, lane);
                        aq = MFMA16(frag_rm(Qs + ti * 16 * LQ + k0, LQ, lane), kb, aq);
                        ak = MFMA16(frag_rm(Ks + ti * 16 * LQ + k0, LQ, lane), kb, ak);
                    }
                    const float gs = gam[s];
#pragma unroll
                    for (int r = 0; r < 4; ++r) { const int t = ti * 16 + 4 * g + r; const float dcy = __expf(fminf(gam[t] - gs, 0.f));
                        aq[r] = (s <= t) ? aq[r] * dcy : 0.f; ak[r] = (s < t) ? ak[r] * be[t] * dcy : 0.f; }
                }
#pragma unroll
                for (int r = 0; r < 4; ++r) { const int t = ti * 16 + 4 * g + r; A1b[t * LS + s] = f2bf(aq[r]); A2b[t * LS + s] = f2bf(ak[r]); A2f[t * 68 + s] = ak[r]; }
            }
        }
        __syncthreads();
        if (wave == 0) tri_inverse_wave(A2f, A2b, Tb, Wb, lane);
        else {
            const bf16_t* Cc = Ct + cur * 32 * LQ;
#pragma unroll
            for (int rep = 0; rep < 2; ++rep) {
                const int tile = (rep == 0) ? wave : 0;
                if (rep == 1 && wave != 1) break;
                const int ti = tile >> 1, vj = tile & 1;
                f32x4v acc; acc[0] = 0.f; acc[1] = 0.f; acc[2] = 0.f; acc[3] = 0.f;
#pragma unroll
                for (int k0 = 0; k0 < 128; k0 += 32) acc = MFMA16(frag_rm(Ks + ti * 16 * LQ + k0, LQ, lane), frag_rm(Cc + vj * 16 * LQ + k0, LQ, lane), acc);
#pragma unroll
                for (int r = 0; r < 4; ++r) { const int t = ti * 16 + 4 * g + r; const float vv = bf2f(Vs[t * LV + vj * 16 + li]);
                    Rb[t * LV + vj * 16 + li] = f2bf(be[t] * (vv - egam[t] * acc[r])); }
            }
        }
        __syncthreads();
        {
            const int ti = wave >> 1, vj = wave & 1;
            f32x4v acc; acc[0] = 0.f; acc[1] = 0.f; acc[2] = 0.f; acc[3] = 0.f;
#pragma unroll
            for (int k0 = 0; k0 < 64; k0 += 32) acc = MFMA16(frag_rm(Tb + ti * 16 * LS + k0, LS, lane), frag_tr(Rb + k0 * LV + vj * 16, LV, lane), acc);
#pragma unroll
            for (int r = 0; r < 4; ++r) { const int t = ti * 16 + 4 * g + r; Vnb[t * LV + vj * 16 + li] = f2bf(acc[r]); VnD[t * LV + vj * 16 + li] = f2bf(acc[r] * edl[t]); }
        }
        __syncthreads();
        {
            const int ti = wave >> 1, vj = wave & 1;
            const bf16_t* Cc = Ct + cur * 32 * LQ;
            f32x4v acc; acc[0] = 0.f; acc[1] = 0.f; acc[2] = 0.f; acc[3] = 0.f;
#pragma unroll
            for (int k0 = 0; k0 < 128; k0 += 32) acc = MFMA16(frag_rm(Qs + ti * 16 * LQ + k0, LQ, lane), frag_rm(Cc + vj * 16 * LQ + k0, LQ, lane), acc);
#pragma unroll
            for (int r = 0; r < 4; ++r) acc[r] *= egam[ti * 16 + 4 * g + r];
#pragma unroll
            for (int k0 = 0; k0 < 64; k0 += 32) acc = MFMA16(frag_rm(A1b + ti * 16 * LS + k0, LS, lane), frag_tr(Vnb + k0 * LV + vj * 16, LV, lane), acc);
#pragma unroll
            for (int r = 0; r < 4; ++r) { const int t = ti * 16 + 4 * g + r;
                O16[((size_t)bb * SEQ + c0 + t) * D + hh * 128 + cg * 32 + vj * 16 + li] = f2bf(acc[r]); }
            const float gl = misc[0];
            bf16_t* Cn = Ct + nxt * 32 * LQ;
#pragma unroll
            for (int vi = 0; vi < 2; ++vi) {
                f32x4v t4; t4[0] = 0.f; t4[1] = 0.f; t4[2] = 0.f; t4[3] = 0.f;
#pragma unroll
                for (int k0 = 0; k0 < 64; k0 += 32) t4 = MFMA16(frag_tr(Ks + k0 * LQ + wave * 16, LQ, lane), frag_tr(VnD + k0 * LV + vi * 16, LV, lane), t4);
                cacc[vi][0] = gl * cacc[vi][0] + t4[0]; cacc[vi][1] = gl * cacc[vi][1] + t4[1]; cacc[vi][2] = gl * cacc[vi][2] + t4[2]; cacc[vi][3] = gl * cacc[vi][3] + t4[3];
                u32x2 o; o.x = pack2(cacc[vi][0], cacc[vi][1]); o.y = pack2(cacc[vi][2], cacc[vi][3]);
                *(u32x2*)(Cn + (vi * 16 + li) * LQ + wave * 16 + 4 * g) = o;
            }
        }
        __syncthreads();
    }
}


__device__ __forceinline__ void hg_pre_item(const Params& p, char* lds, int id) {
    const int tid = threadIdx.x, lane = tid & 63, wave = tid >> 6, g = lane >> 4, li = lane & 15;
    const int bb = id >> 8, hh = (id >> 5) & 7, c = id & 31;
    unsigned char* ws = p.ws;
    const bf16_t* P = (const bf16_t*)(ws + WS_P);
    unsigned char* item = ws + WS_CHK_HG + (size_t)id * CHK_HG_ITEM;
    float* LG = (float*)lds;
    bf16_t* QV = (bf16_t*)(lds + 17408);
    bf16_t* KV = (bf16_t*)(lds + 26624);
    bf16_t* QT = (bf16_t*)(lds + 35840);
    bf16_t* KT = (bf16_t*)(lds + 45056);
    bf16_t* AyS = (bf16_t*)(lds + 81920);
    const int t = tid >> 3, part = tid & 7, d0 = part * 8;
    const size_t tok = (size_t)bb * SEQ + c * 64 + t;
    {
        const u32x4 q8 = *(const u32x4*)(P + tok * EVEN_IN + 1792 + hh * 64 + d0);
        const u32x4 f8 = *(const u32x4*)(P + tok * EVEN_IN + 1792 + 512 + hh * 64 + d0);
        float qv[8], fv[8];
        qv[0] = lo16(q8.x); qv[1] = hi16(q8.x); qv[2] = lo16(q8.y); qv[3] = hi16(q8.y); qv[4] = lo16(q8.z); qv[5] = hi16(q8.z); qv[6] = lo16(q8.w); qv[7] = hi16(q8.w);
        fv[0] = lo16(f8.x); fv[1] = hi16(f8.x); fv[2] = lo16(f8.y); fv[3] = hi16(f8.y); fv[4] = lo16(f8.z); fv[5] = hi16(f8.z); fv[6] = lo16(f8.w); fv[7] = hi16(f8.w);
        float kq[8];
#pragma unroll
        for (int e = 0; e < 8; ++e) {
            const float lbv = sigmoidf_(p.hg_lb[hh * 64 + d0 + e] - p.hg_lb[512 + hh * 64 + d0 + e]);
            const float fg = lbv + (1.f - lbv) * sigmoidf_(fv[e]);
            LG[t * 68 + d0 + e] = __logf(fg);
            qv[e] = siluf_(qv[e]); kq[e] = 1.f - fg;
        }
        u32x4 o; o.x = pack2(qv[0], qv[1]); o.y = pack2(qv[2], qv[3]); o.z = pack2(qv[4], qv[5]); o.w = pack2(qv[6], qv[7]);
        *(u32x4*)(QV + t * 72 + d0) = o;
        o.x = pack2(kq[0], kq[1]); o.y = pack2(kq[2], kq[3]); o.z = pack2(kq[4], kq[5]); o.w = pack2(kq[6], kq[7]);
        *(u32x4*)(KV + t * 72 + d0) = o;
    }
    __syncthreads();
    if (tid < 64) { float run = 0.f;
#pragma unroll 8
        for (int s = 0; s < 64; ++s) { run += LG[s * 68 + tid]; LG[s * 68 + tid] = run; } }
    __syncthreads();
    {
        const int blk = t >> 4;
        const u32x4 q8 = *(const u32x4*)(QV + t * 72 + d0), k8 = *(const u32x4*)(KV + t * 72 + d0);
        float qv[8], kv[8];
        qv[0] = lo16(q8.x); qv[1] = hi16(q8.x); qv[2] = lo16(q8.y); qv[3] = hi16(q8.y); qv[4] = lo16(q8.z); qv[5] = hi16(q8.z); qv[6] = lo16(q8.w); qv[7] = hi16(q8.w);
        kv[0] = lo16(k8.x); kv[1] = hi16(k8.x); kv[2] = lo16(k8.y); kv[3] = hi16(k8.y); kv[4] = lo16(k8.z); kv[5] = hi16(k8.z); kv[6] = lo16(k8.w); kv[7] = hi16(k8.w);
        float lc[8], rp[8], kc[8], qt[8];
#pragma unroll
        for (int e = 0; e < 8; ++e) {
            lc[e] = LG[t * 68 + d0 + e];
            const float lcl = LG[63 * 68 + d0 + e];
            const float ref = blk ? LG[(16 * blk - 1) * 68 + d0 + e] : 0.f;
            rp[e] = qv[e] * __expf(lc[e]); kc[e] = kv[e] * __expf(lcl - lc[e]); qt[e] = qv[e] * __expf(lc[e] - ref);
            if (t == 0) ((float*)(item + 24576))[d0 + e] = __expf(lcl);
        }
        u32x4 o; o.x = pack2(rp[0], rp[1]); o.y = pack2(rp[2], rp[3]); o.z = pack2(rp[4], rp[5]); o.w = pack2(rp[6], rp[7]);
        *(u32x4*)(item + t * 128 + part * 16) = o;
        o.x = pack2(kc[0], kc[1]); o.y = pack2(kc[2], kc[3]); o.z = pack2(kc[4], kc[5]); o.w = pack2(kc[6], kc[7]);
        *(u32x4*)(item + 16384 + t * 128 + part * 16) = o;
        o.x = pack2(qt[0], qt[1]); o.y = pack2(qt[2], qt[3]); o.z = pack2(qt[4], qt[5]); o.w = pack2(qt[6], qt[7]);
        *(u32x4*)(QT + t * 72 + d0) = o;
#pragma unroll
        for (int ib = 0; ib < 4; ++ib) {
            if (ib >= blk) {
                float kt[8];
#pragma unroll
                for (int e = 0; e < 8; ++e) { const float ref = ib ? LG[(16 * ib - 1) * 68 + d0 + e] : 0.f; kt[e] = kv[e] * __expf(fminf(ref - lc[e], 80.f)); }
                o.x = pack2(kt[0], kt[1]); o.y = pack2(kt[2], kt[3]); o.z = pack2(kt[4], kt[5]); o.w = pack2(kt[6], kt[7]);
                *(u32x4*)(KT + (ib * 64 + t) * 72 + d0) = o;
            }
        }
    }
    __syncthreads();
    {
        const int ti = wave >> 1;
#pragma unroll
        for (int jj = 0; jj < 2; ++jj) {
            const int tj = (wave & 1) * 2 + jj, s = tj * 16 + li;
            f32x4v acc; acc[0] = 0.f; acc[1] = 0.f; acc[2] = 0.f; acc[3] = 0.f;
            if (tj <= ti) {
#pragma unroll
                for (int k0 = 0; k0 < 64; k0 += 32) acc = MFMA16(frag_rm(QT + ti * 16 * 72 + k0, 72, lane), frag_rm(KT + (ti * 64 + tj * 16) * 72 + k0, 72, lane), acc);
#pragma unroll
                for (int r = 0; r < 4; ++r) if (s > ti * 16 + 4 * g + r) acc[r] = 0.f;
            }
#pragma unroll
            for (int r = 0; r < 4; ++r) AyS[(ti * 16 + 4 * g + r) * 72 + s] = f2bf(acc[r]);
        }
    }
    __syncthreads();
    *(u32x4*)(item + 8192 + t * 128 + part * 16) = *(const u32x4*)(AyS + t * 72 + d0);
    __syncthreads();
}


__device__ __forceinline__ float tanhf_(float x) { return 1.0f - 2.0f * __builtin_amdgcn_rcpf(1.0f + __expf(2.0f * x)); }
__device__ __forceinline__ void unpack8(const u32x4& v, float* f) { f[0] = lo16(v.x); f[1] = hi16(v.x); f[2] = lo16(v.y); f[3] = hi16(v.y); f[4] = lo16(v.z); f[5] = hi16(v.z); f[6] = lo16(v.w); f[7] = hi16(v.w); }
__device__ __forceinline__ u32x4 pack8(const float* f) { u32x4 o; o.x = pack2(f[0], f[1]); o.y = pack2(f[2], f[3]); o.z = pack2(f[4], f[5]); o.w = pack2(f[6], f[7]); return o; }

__device__ __forceinline__ void rw_pre_item(const Params& p, char* lds0, int id) {
    const int tid = threadIdx.x, lane = tid & 63, wave = tid >> 6, g = lane >> 4, li = lane & 15;
    const int bb = id >> 8, hh = (id >> 5) & 7, c = id & 31;
    int lz = 0; asm volatile("" : "+s"(lz));
    char* lds = lds0 + lz;
    unsigned char* ws = p.ws;
    const bf16_t* P = (const bf16_t*)(ws + WS_P);
    unsigned char* item = ws + WS_CHK_RW + (size_t)id * CHK_RW_ITEM;
    float* AUX = p.out;
    bf16_t* w2h = (bf16_t*)(lds + 0);
    bf16_t* a2h = (bf16_t*)(lds + 9216);
    bf16_t* g2h = (bf16_t*)(lds + 18432);
    bf16_t* TW = (bf16_t*)(lds + 36864);
    bf16_t* AL = (bf16_t*)(lds + 46080);
    bf16_t* SG = (bf16_t*)(lds + 55296);
    bf16_t* Rt = (bf16_t*)(lds + 0);
    bf16_t* At = (bf16_t*)(lds + 9216);
    bf16_t* Kh = (bf16_t*)(lds + 18432);
    bf16_t* Bh = (bf16_t*)(lds + 27648);
    bf16_t* Kt = (bf16_t*)(lds + 36864);
    bf16_t* Bt = (bf16_t*)(lds + 46080);
    bf16_t* Ap = (bf16_t*)(lds + 36864);
    bf16_t* Wv = (bf16_t*)(lds + 46080);
    bf16_t* Tb = (bf16_t*)(lds + 55296);
    bf16_t* Wb = (bf16_t*)(lds + 64512);
    float* GLs = (float*)(lds + 66048);
    bf16_t* RS = (bf16_t*)(lds + 72704);
    bf16_t* KS = (bf16_t*)(lds + 81920);
    bf16_t* VS = (bf16_t*)(lds + 91136);
    float* LD = (float*)(lds + 100352);
    bf16_t* AG = (bf16_t*)(lds + 117760);
    bf16_t* Ark = (bf16_t*)(lds + 72704);
    bf16_t* Arb = (bf16_t*)(lds + 81920);
    bf16_t* Aak = (bf16_t*)(lds + 91136);
    bf16_t* Nb = (bf16_t*)(lds + 100352);
    float* Nf = (float*)(lds + 109568);
    bf16_t* OutA = Aak; bf16_t* OutB = Nb; bf16_t* OutC = Ark; bf16_t* OutD = Arb;
    const size_t tok0 = (size_t)bb * SEQ + c * 64;
    for (int i = tid; i < 4096; i += NT) { const int j = i >> 6, cc = i & 63; w2h[j * 72 + cc] = f2bf(p.rw_w2[j * 512 + hh * 64 + cc]); a2h[j * 72 + cc] = f2bf(p.rw_a2[j * 512 + hh * 64 + cc]); }
    for (int i = tid; i < 8192; i += NT) { const int j = i >> 6, cc = i & 63; g2h[j * 72 + cc] = f2bf(p.rw_g2[j * 512 + hh * 64 + cc]); }
    if (tid < 448) {
        int role, lcol, pcol;
        if (tid < 64) { role = 0; lcol = tid; pcol = hh * 64 + lcol; }
        else if (tid < 128) { role = 1; lcol = tid - 64; pcol = 512 + hh * 64 + lcol; }
        else if (tid < 192) { role = 2; lcol = tid - 128; pcol = 1024 + hh * 64 + lcol; }
        else if (tid < 256) { role = 3; lcol = tid - 192; pcol = 1536 + lcol; }
        else if (tid < 320) { role = 4; lcol = tid - 256; pcol = 1600 + lcol; }
        else { role = 5; lcol = tid - 320; pcol = 1664 + lcol; }
        const float mu = p.ev_mu[pcol];
        const bf16_t* pb = P + tok0 * EVEN_IN + pcol;
        float prev = (c > 0) ? bf2f(*(pb - EVEN_IN)) : 0.f;
#pragma unroll 1
        for (int t8 = 0; t8 < 64; t8 += 8) {
            float x[8];
#pragma unroll
            for (int i = 0; i < 8; ++i) x[i] = bf2f(pb[(size_t)(t8 + i) * EVEN_IN]);
#pragma unroll
            for (int i = 0; i < 8; ++i) {
                const float s = x[i] + mu * (prev - x[i]); prev = x[i];
                const int t = t8 + i;
                if (role == 0) RS[t * 72 + lcol] = f2bf(s);
                else if (role == 1) KS[t * 72 + lcol] = f2bf(s);
                else if (role == 2) VS[t * 72 + lcol] = f2bf(s);
                else if (role == 3) TW[t * 72 + lcol] = f2bf(tanhf_(s));
                else if (role == 4) AL[t * 72 + lcol] = f2bf(s);
                else SG[t * 136 + lcol] = f2bf(sigmoidf_(s));
            }
        }
    }
    __syncthreads();
#pragma unroll 1
    for (int q = 0; q < 2; ++q) {
        const int T = wave * 2 + q, ti = T >> 2, cj = T & 3;
        f32x4v aw, aa, ag; aw[0] = 0.f; aw[1] = 0.f; aw[2] = 0.f; aw[3] = 0.f; aa = aw; ag = aw;
#pragma unroll
        for (int k0 = 0; k0 < 64; k0 += 32) {
            aw = MFMA16(frag_rm(TW + ti * 16 * 72 + k0, 72, lane), frag_tr(w2h + k0 * 72 + cj * 16, 72, lane), aw);
            aa = MFMA16(frag_rm(AL + ti * 16 * 72 + k0, 72, lane), frag_tr(a2h + k0 * 72 + cj * 16, 72, lane), aa);
        }
#pragma unroll
        for (int k0 = 0; k0 < 128; k0 += 32) ag = MFMA16(frag_rm(SG + ti * 16 * 136 + k0, 136, lane), frag_tr(g2h + k0 * 72 + cj * 16, 72, lane), ag);
        const int cc = cj * 16 + li;
        const float w0 = p.rw_w0[hh * 64 + cc], a0 = p.rw_a0[hh * 64 + cc];
#pragma unroll
        for (int r = 0; r < 4; ++r) {
            const int t = ti * 16 + 4 * g + r;
            const float wl = -softplusf_(-(aw[r] + w0)) - 0.5f;
            LD[t * 68 + cc] = -__expf(wl);
            AG[t * 72 + cc] = f2bf(sigmoidf_(aa[r] + a0));
            AUX[(tok0 + t) * D + 512 + hh * 64 + cc] = ag[r];
        }
    }
    __syncthreads();
    if (tid < 64) {
        float v[64];
#pragma unroll
        for (int s = 0; s < 64; ++s) v[s] = LD[s * 68 + tid];
#pragma unroll
        for (int s = 1; s < 64; ++s) v[s] += v[s - 1];
#pragma unroll
        for (int s = 0; s < 64; ++s) LD[s * 68 + tid] = v[s];
    }
    __syncthreads();
    {
        const int t = tid >> 3, part = tid & 7, c0 = part * 8;
        float rs[8], ks[8], vs[8], ag[8];
        unpack8(*(const u32x4*)(RS + t * 72 + c0), rs); unpack8(*(const u32x4*)(KS + t * 72 + c0), ks); unpack8(*(const u32x4*)(VS + t * 72 + c0), vs); unpack8(*(const u32x4*)(AG + t * 72 + c0), ag);
        float kk[8], k2[8], bv[8], ss = 0.f, bon = 0.f;
#pragma unroll
        for (int e = 0; e < 8; ++e) {
            const int ch = hh * 64 + c0 + e;
            kk[e] = ks[e] * p.rw_k_k[ch]; ss += kk[e] * kk[e];
            k2[e] = ks[e] * (1.f + (ag[e] - 1.f) * p.rw_k_a[ch]);
            bon += rs[e] * k2[e] * p.rw_r_k[ch];
        }
        ss = red8(ss); bon = red8(bon);
        const float nrm = rsqrtf(ss + 1e-6f);
        float o1[8], o2[8], o3[8], o4[8], o5[8], o6[8];
#pragma unroll
        for (int e = 0; e < 8; ++e) {
            kk[e] *= nrm; bv[e] = kk[e] * ag[e];
            const float lc = LD[t * 68 + c0 + e], lcp = t ? LD[(t - 1) * 68 + c0 + e] : 0.f, lcl = LD[63 * 68 + c0 + e];
            const float eg = __expf(lc), egp = __expf(lcp), ei = __expf(-lc), eh = __expf(lcl - lc);
            o1[e] = rs[e] * eg; o2[e] = -kk[e] * egp; o3[e] = k2[e] * ei; o4[e] = bv[e] * ei; o5[e] = k2[e] * eh; o6[e] = bv[e] * eh;
            if (t == 0) GLs[c0 + e] = __expf(lcl);
            vs[e] *= bon;
        }
        float4 b0; b0.x = vs[0]; b0.y = vs[1]; b0.z = vs[2]; b0.w = vs[3]; float4 b1; b1.x = vs[4]; b1.y = vs[5]; b1.z = vs[6]; b1.w = vs[7];
        *(float4*)(AUX + (tok0 + t) * D + hh * 64 + c0) = b0; *(float4*)(AUX + (tok0 + t) * D + hh * 64 + c0 + 4) = b1;
        __syncthreads();
        *(u32x4*)(Rt + t * 72 + c0) = pack8(o1); *(u32x4*)(At + t * 72 + c0) = pack8(o2); *(u32x4*)(Kt + t * 72 + c0) = pack8(o3);
        *(u32x4*)(Bt + t * 72 + c0) = pack8(o4); *(u32x4*)(Kh + t * 72 + c0) = pack8(o5); *(u32x4*)(Bh + t * 72 + c0) = pack8(o6);
        for (int i = tid; i < 64 * 72 / 2; i += NT) ((unsigned*)Tb)[i] = 0u;
        for (int i = tid; i < 32 * 24 / 2; i += NT) ((unsigned*)Wb)[i] = 0u;
    }
    __syncthreads();
    {
        const int ti = wave >> 1;
#pragma unroll 1
        for (int jj = 0; jj < 2; ++jj) {
            const int tj = (wave & 1) * 2 + jj, s = tj * 16 + li;
            f32x4v rk, rb, ak, ab; rk[0] = 0.f; rk[1] = 0.f; rk[2] = 0.f; rk[3] = 0.f; rb = rk; ak = rk; ab = rk;
            if (tj <= ti) {
#pragma unroll
                for (int k0 = 0; k0 < 64; k0 += 32) {
                    const bf16x8 fr = frag_rm(Rt + ti * 16 * 72 + k0, 72, lane), fa = frag_rm(At + ti * 16 * 72 + k0, 72, lane);
                    const bf16x8 fk = frag_rm(Kt + tj * 16 * 72 + k0, 72, lane), fb = frag_rm(Bt + tj * 16 * 72 + k0, 72, lane);
                    rk = MFMA16(fr, fk, rk); rb = MFMA16(fr, fb, rb); ak = MFMA16(fa, fk, ak); ab = MFMA16(fa, fb, ab);
                }
#pragma unroll
                for (int r = 0; r < 4; ++r) { const int t = ti * 16 + 4 * g + r;
                    if (s > t) { rk[r] = 0.f; rb[r] = 0.f; } if (s >= t) { ak[r] = 0.f; ab[r] = 0.f; } }
            }
#pragma unroll
            for (int r = 0; r < 4; ++r) { const int t = ti * 16 + 4 * g + r;
                Ark[t * 72 + s] = f2bf(rk[r]); Arb[t * 72 + s] = f2bf(rb[r]); Aak[t * 72 + s] = f2bf(ak[r]); Nb[t * 72 + s] = f2bf(-ab[r]); Nf[t * 68 + s] = -ab[r]; }
        }
    }
    __syncthreads();
    if (wave == 0) tri_inverse_wave(Nf, Nb, Tb, Wb, lane);
    __syncthreads();
#pragma unroll 1
    for (int q = 0; q < 2; ++q) {
        const int T = wave * 2 + q, ti = T >> 2, nj = T & 3;
        f32x4v x1, x2; x1[0] = 0.f; x1[1] = 0.f; x1[2] = 0.f; x1[3] = 0.f; x2 = x1;
#pragma unroll
        for (int k0 = 0; k0 < 64; k0 += 32) {
            const bf16x8 ft = frag_rm(Tb + ti * 16 * 72 + k0, 72, lane);
            x1 = MFMA16(ft, frag_tr(At + k0 * 72 + nj * 16, 72, lane), x1);
            x2 = MFMA16(ft, frag_tr(Aak + k0 * 72 + nj * 16, 72, lane), x2);
        }
#pragma unroll
        for (int r = 0; r < 4; ++r) { const int t = ti * 16 + 4 * g + r; Ap[t * 72 + nj * 16 + li] = f2bf(x1[r]); Wv[t * 72 + nj * 16 + li] = f2bf(x2[r]); }
    }
    __syncthreads();
#pragma unroll 1
    for (int q = 0; q < 2; ++q) {
        const int T = wave * 2 + q, ti = T >> 2, nj = T & 3;
        f32x4v x1, x2; x1[0] = 0.f; x1[1] = 0.f; x1[2] = 0.f; x1[3] = 0.f; x2 = x1;
#pragma unroll
        for (int k0 = 0; k0 < 64; k0 += 32) {
            const bf16x8 fb = frag_rm(Arb + ti * 16 * 72 + k0, 72, lane);
            x1 = MFMA16(fb, frag_tr(Ap + k0 * 72 + nj * 16, 72, lane), x1);
            x2 = MFMA16(fb, frag_tr(Wv + k0 * 72 + nj * 16, 72, lane), x2);
        }
#pragma unroll
        for (int r = 0; r < 4; ++r) { const int t = ti * 16 + 4 * g + r, n = nj * 16 + li;
            OutA[t * 72 + n] = f2bf(x1[r] + bf2f(Rt[t * 72 + n])); OutB[t * 72 + n] = f2bf(x2[r] + bf2f(Ark[t * 72 + n])); }
    }
    __syncthreads();
    {
        const int t = tid >> 3, part = tid & 7;
        *(u32x4*)(item + t * 128 + part * 16) = *(const u32x4*)(OutA + t * 72 + part * 8);
        *(u32x4*)(item + 8192 + t * 128 + part * 16) = *(const u32x4*)(OutB + t * 72 + part * 8);
    }
#pragma unroll 1
    for (int q = 0; q < 2; ++q) {
        const int T = wave * 2 + q, mi = T >> 2, nj = T & 3;
        f32x4v x1, x2; x1[0] = 0.f; x1[1] = 0.f; x1[2] = 0.f; x1[3] = 0.f; x2 = x1;
#pragma unroll
        for (int k0 = 0; k0 < 64; k0 += 32) {
            const bf16x8 fb = frag_tr(Bh + k0 * 72 + nj * 16, 72, lane);
            x1 = MFMA16(frag_tr(Ap + k0 * 72 + mi * 16, 72, lane), fb, x1);
            x2 = MFMA16(frag_tr(Wv + k0 * 72 + mi * 16, 72, lane), fb, x2);
        }
#pragma unroll
        for (int r = 0; r < 4; ++r) { const int m = mi * 16 + 4 * g + r, n = nj * 16 + li;
            OutC[m * 72 + n] = f2bf(x1[r] + (m == n ? GLs[n] : 0.f)); OutD[m * 72 + n] = f2bf(x2[r] + bf2f(Kh[m * 72 + n])); }
    }
    __syncthreads();
    {
        const int t = tid >> 3, part = tid & 7;
        *(u32x4*)(item + 16384 + t * 128 + part * 16) = *(const u32x4*)(OutC + t * 72 + part * 8);
        *(u32x4*)(item + 24576 + t * 128 + part * 16) = *(const u32x4*)(OutD + t * 72 + part * 8);
    }
    __syncthreads();
}

__device__ __forceinline__ void phase_pre0(const Params& p, char* lds) {
    for (int i = blockIdx.x; i < 4096; i += gridDim.x) {
        if (i < 2048) rw_pre_item(p, lds, i);
        else hg_pre_item(p, lds, i - 2048);
    }
}

template <bool RW>
__device__ __forceinline__ void seq64_unit(const Params& p, char* lds, int bb, int hh, int cg) {
    const int tid = threadIdx.x, lane = tid & 63, wave = tid >> 6, g = lane >> 4, li = lane & 15;
    unsigned char* ws = p.ws;
    const bf16_t* P = (const bf16_t*)(ws + WS_P);
    bf16_t* O16 = (bf16_t*)(ws + WS_XN);
    constexpr size_t ITEM = RW ? CHK_RW_ITEM : CHK_HG_ITEM;
    const unsigned char* chk = ws + (RW ? WS_CHK_RW : WS_CHK_HG) + (size_t)((bb * 8 + hh) * 32) * ITEM;
    constexpr int STG = 41984 + 512;
    bf16_t* St = (bf16_t*)(lds + 2 * STG);
    const int vcol = RW ? 1024 + hh * 64 + cg * 32 : 1792 + 1024 + hh * 64 + cg * 32;
    const int ocol = RW ? hh * 64 + cg * 32 : 512 + hh * 64 + cg * 32;
    const int mrow = tid >> 3, mc8 = tid & 7;
    const int vt = tid >> 2, vc = tid & 3;
    float mu[8];
#pragma unroll
    for (int e = 0; e < 8; ++e) mu[e] = RW ? p.ev_mu[vcol + vc * 8 + e] : 0.f;
    u32x4 rm0, rm1, rm2, rm3, rv, rvp; float rgl = 0.f;
    rm3 = u32x4{0u, 0u, 0u, 0u}; rvp = rm3; rv = rm3;
#define SEQ_LOAD(c) do { const unsigned char* it = chk + (size_t)(c) * ITEM; \
        rm0 = *(const u32x4*)(it + mrow * 128 + mc8 * 16); rm1 = *(const u32x4*)(it + 8192 + mrow * 128 + mc8 * 16); rm2 = *(const u32x4*)(it + 16384 + mrow * 128 + mc8 * 16); \
        if (RW) rm3 = *(const u32x4*)(it + 24576 + mrow * 128 + mc8 * 16); else if (tid < 64) rgl = ((const float*)(it + 24576))[tid]; \
        if (tid < 256) { const size_t tk = (size_t)bb * SEQ + (c) * 64 + vt; rv = *(const u32x4*)(P + tk * EVEN_IN + vcol + vc * 8); \
            if (RW) { if ((c) * 64 + vt > 0) rvp = *(const u32x4*)(P + (tk - 1) * EVEN_IN + vcol + vc * 8); else rvp = u32x4{0u, 0u, 0u, 0u}; } } } while (0)
#define SEQ_STAGE(sb) do { char* sg_ = lds + (sb) * STG; \
        *(u32x4*)(sg_ + mrow * 144 + mc8 * 16) = rm0; *(u32x4*)(sg_ + 9216 + mrow * 144 + mc8 * 16) = rm1; \
        if (RW) { *(u32x4*)(sg_ + 18432 + mrow * 144 + mc8 * 16) = rm2; *(u32x4*)(sg_ + 27648 + mrow * 144 + mc8 * 16) = rm3; } \
        else { *(u32x4*)(sg_ + 27648 + mrow * 144 + mc8 * 16) = rm2; if (tid < 64) ((float*)(sg_ + 41984))[tid] = rgl; } \
        if (tid < 256) { u32x4 o_ = rv; \
            if (RW) { float a_[8], b_[8]; a_[0] = lo16(rv.x); a_[1] = hi16(rv.x); a_[2] = lo16(rv.y); a_[3] = hi16(rv.y); a_[4] = lo16(rv.z); a_[5] = hi16(rv.z); a_[6] = lo16(rv.w); a_[7] = hi16(rv.w); \
                b_[0] = lo16(rvp.x); b_[1] = hi16(rvp.x); b_[2] = lo16(rvp.y); b_[3] = hi16(rvp.y); b_[4] = lo16(rvp.z); b_[5] = hi16(rvp.z); b_[6] = lo16(rvp.w); b_[7] = hi16(rvp.w); \
                _Pragma("unroll") for (int e_ = 0; e_ < 8; ++e_) a_[e_] = a_[e_] + mu[e_] * (b_[e_] - a_[e_]); \
                o_.x = pack2(a_[0], a_[1]); o_.y = pack2(a_[2], a_[3]); o_.z = pack2(a_[4], a_[5]); o_.w = pack2(a_[6], a_[7]); } \
            *(u32x4*)(sg_ + 36864 + vt * 80 + vc * 16) = o_; } } while (0)
    SEQ_LOAD(0);
    for (int i = tid; i < 2 * 32 * 72 / 2; i += NT) ((unsigned*)St)[i] = 0u;
    SEQ_STAGE(0);
    SEQ_LOAD(1);
    f32x4v sacc; sacc[0] = 0.f; sacc[1] = 0.f; sacc[2] = 0.f; sacc[3] = 0.f;
    __syncthreads();
    for (int c = 0; c < 32; ++c) {
        const int cur = c & 1;
        if (c + 1 < 32) SEQ_STAGE(cur ^ 1);
        if (c + 2 < 32) SEQ_LOAD(c + 2);
        const char* sg = lds + cur * STG;
        const bf16_t* Rp = (const bf16_t*)sg; const bf16_t* Ay = (const bf16_t*)(sg + 9216); const bf16_t* Gc = (const bf16_t*)(sg + 18432); const bf16_t* Kc = (const bf16_t*)(sg + 27648);
        const bf16_t* Vs = (const bf16_t*)(sg + 36864); const float* gL = (const float*)(sg + 41984);
        const bf16_t* Sc = St + cur * 32 * 72; bf16_t* Sn = St + (cur ^ 1) * 32 * 72;
        {
            const int ti = wave >> 1, vj = wave & 1;
            f32x4v acc; acc[0] = 0.f; acc[1] = 0.f; acc[2] = 0.f; acc[3] = 0.f;
#pragma unroll
            for (int k0 = 0; k0 < 64; k0 += 32) acc = MFMA16(frag_rm(Rp + ti * 16 * 72 + k0, 72, lane), frag_rm(Sc + vj * 16 * 72 + k0, 72, lane), acc);
#pragma unroll
            for (int k0 = 0; k0 < 64; k0 += 32) acc = MFMA16(frag_rm(Ay + ti * 16 * 72 + k0, 72, lane), frag_tr(Vs + k0 * 40 + vj * 16, 40, lane), acc);
#pragma unroll
            for (int r = 0; r < 4; ++r) O16[((size_t)bb * SEQ + c * 64 + ti * 16 + 4 * g + r) * D + ocol + vj * 16 + li] = f2bf(acc[r]);
        }
        {
            const int vi = wave >> 2, kj = wave & 3;
            f32x4v t4; t4[0] = 0.f; t4[1] = 0.f; t4[2] = 0.f; t4[3] = 0.f;
#pragma unroll
            for (int k0 = 0; k0 < 64; k0 += 32) t4 = MFMA16(frag_tr(Vs + k0 * 40 + vi * 16, 40, lane), frag_tr(Kc + k0 * 72 + kj * 16, 72, lane), t4);
            if (RW) {
#pragma unroll
                for (int k0 = 0; k0 < 64; k0 += 32) t4 = MFMA16(frag_rm(Sc + vi * 16 * 72 + k0, 72, lane), frag_tr(Gc + k0 * 72 + kj * 16, 72, lane), t4);
                sacc = t4;
            } else { const float gl = gL[kj * 16 + li];
#pragma unroll
                for (int r = 0; r < 4; ++r) sacc[r] = sacc[r] * gl + t4[r]; }
#pragma unroll
            for (int r = 0; r < 4; ++r) Sn[(vi * 16 + 4 * g + r) * 72 + kj * 16 + li] = f2bf(sacc[r]);
        }
        __syncthreads();
    }
#undef SEQ_LOAD
#undef SEQ_STAGE
}

__device__ __forceinline__ void phase_mix0(const Params& p, char* lds) {
    for (int u = blockIdx.x; u < 256; u += gridDim.x) {
        const int v = u & 127, bb = v >> 4, hh = (v >> 1) & 7, cg = v & 1;
        if (u < 128) seq64_unit<true>(p, lds, bb, hh, cg); else seq64_unit<false>(p, lds, bb, hh, cg);
        __syncthreads();
    }
}

__device__ __forceinline__ void phase_mix1(const Params& p, char* lds) {
    for (int u = blockIdx.x; u < 256; u += gridDim.x) {
        const int v = u & 127, bb = v >> 4, hh = (v >> 2) & 3, cg = v & 3;
        if (u < 128) { gdn_chunk_unit(p, lds, bb, hh, cg); if (REP_UNIT == 1) { __syncthreads(); gdn_chunk_unit(p, lds, bb, hh, cg); } }
        else { mlstm_chunk_unit(p, lds, bb, hh, cg); if (REP_UNIT == 2) { __syncthreads(); mlstm_chunk_unit(p, lds, bb, hh, cg); } }
        __syncthreads();
    }
}

__device__ __forceinline__ void phase_post1(const Params& p) {
    const int tid = threadIdx.x, lane = tid & 63, wave = tid >> 6;
    unsigned char* ws = p.ws;
    bf16_t* O16 = (bf16_t*)(ws + WS_XN);
    const bf16_t* P = (const bf16_t*)(ws + WS_P);
    const int c0 = lane * 16;
    for (int tok = blockIdx.x * 8 + wave; tok < M; tok += gridDim.x * 8) {
        const u32x4 r0 = *(const u32x4*)(O16 + (size_t)tok * D + c0), r1 = *(const u32x4*)(O16 + (size_t)tok * D + c0 + 8);
        float y[16];
        y[0] = lo16(r0.x); y[1] = hi16(r0.x); y[2] = lo16(r0.y); y[3] = hi16(r0.y); y[4] = lo16(r0.z); y[5] = hi16(r0.z); y[6] = lo16(r0.w); y[7] = hi16(r0.w);
        y[8] = lo16(r1.x); y[9] = hi16(r1.x); y[10] = lo16(r1.y); y[11] = hi16(r1.y); y[12] = lo16(r1.z); y[13] = hi16(r1.z); y[14] = lo16(r1.w); y[15] = hi16(r1.w);
        float q = 0.f;
#pragma unroll
        for (int j = 0; j < 16; ++j) q += y[j] * y[j];
        q += dppf<0xB1>(q); q += dppf<0x4E>(q); q += dppf<0x141>(q);
        const float rstd = rsqrtf(q * (1.0f / 128.0f) + 1e-6f);
        const int gcol = lane < 32 ? 1536 + c0 : 3584 + (c0 - 512);
        const u32x4 g0 = *(const u32x4*)(P + (size_t)tok * ODD_IN + gcol), g1 = *(const u32x4*)(P + (size_t)tok * ODD_IN + gcol + 8);
        float gt[16];
        gt[0] = lo16(g0.x); gt[1] = hi16(g0.x); gt[2] = lo16(g0.y); gt[3] = hi16(g0.y); gt[4] = lo16(g0.z); gt[5] = hi16(g0.z); gt[6] = lo16(g0.w); gt[7] = hi16(g0.w);
        gt[8] = lo16(g1.x); gt[9] = hi16(g1.x); gt[10] = lo16(g1.y); gt[11] = hi16(g1.y); gt[12] = lo16(g1.z); gt[13] = hi16(g1.z); gt[14] = lo16(g1.w); gt[15] = hi16(g1.w);
        float o[16];
        if (lane < 32) {
#pragma unroll
            for (int j = 0; j < 16; ++j) o[j] = y[j] * rstd * p.gd_norm[(c0 + j) & 127] * siluf_(gt[j]);
        } else {
#pragma unroll
            for (int j = 0; j < 16; ++j) o[j] = y[j] * rstd * p.ml_norm[c0 - 512 + j] * sigmoidf_(gt[j]);
        }
        u32x4 w0, w1;
        w0.x = pack2(o[0], o[1]); w0.y = pack2(o[2], o[3]); w0.z = pack2(o[4], o[5]); w0.w = pack2(o[6], o[7]);
        w1.x = pack2(o[8], o[9]); w1.y = pack2(o[10], o[11]); w1.z = pack2(o[12], o[13]); w1.w = pack2(o[14], o[15]);
        *(u32x4*)(O16 + (size_t)tok * D + c0) = w0; *(u32x4*)(O16 + (size_t)tok * D + c0 + 8) = w1;
    }
}


#define XB_TMO      128
#define XB_XCNT(j)  (256  + 64 * (j))
#define XB_XSUB(j)  (1280 + 64 * (j))
#define XB_XGEN(j)  (2304 + 64 * (j))
#define XB_TOP      3328
#define XB_TOPGEN   3392
#define XCD_BAR_WORDS 3456
#define XB_SPIN_CAP (1u << 22)
__device__ __forceinline__ unsigned xb_ld(unsigned* p)              { return __hip_atomic_load(p, __ATOMIC_RELAXED, __HIP_MEMORY_SCOPE_AGENT); }
__device__ __forceinline__ unsigned xb_add(unsigned* p, unsigned v) { return __hip_atomic_fetch_add(p, v, __ATOMIC_RELAXED, __HIP_MEMORY_SCOPE_AGENT); }
__device__ __forceinline__ unsigned xb_xcc_id() { return (unsigned)__builtin_amdgcn_s_getreg((3 << 11) | 20) & 0xFu; }
#define XB_SPIN(cond, bar) do { unsigned _sp = 0; while (cond) { __builtin_amdgcn_s_sleep(1); \
    if ((++_sp & 255u) == 0u) { if (xb_ld(&(bar)[XB_TMO])) break; if (_sp > XB_SPIN_CAP) { atomicAdd(&(bar)[XB_TMO], 1u); break; } } } } while (0)
struct XcdBarrier { unsigned* bar; unsigned x; volatile LAS unsigned* st; };
__device__ __forceinline__ XcdBarrier xcd_barrier_post(unsigned* bar, volatile LAS unsigned* st) {
    XcdBarrier b; b.bar = bar; b.x = xb_xcc_id(); b.st = st;
    if (threadIdx.x == 0) (void)xb_add(&bar[XB_XCNT(b.x)], 1u);
    return b;
}
__device__ __forceinline__ void xcd_barrier_complete(unsigned* bar, unsigned x, unsigned& nloc, unsigned& nx) {
    const unsigned G = gridDim.x * gridDim.y * gridDim.z;
    unsigned sum, cnt, mine, sp = 0u;
    for (;;) {
        sum = 0u; cnt = 0u; mine = 0u;
#pragma unroll
        for (unsigned j = 0; j < 16; ++j) { const unsigned c = xb_ld(&bar[XB_XCNT(j)]); sum += c; cnt += (c > 0u) ? 1u : 0u; mine = (j == x) ? c : mine; }
        if (sum == G) break;
        __builtin_amdgcn_s_sleep(1);
        if ((++sp & 255u) == 0u) { if (xb_ld(&bar[XB_TMO])) break; if (sp > XB_SPIN_CAP) { atomicAdd(&bar[XB_TMO], 1u); break; } }
    }
    nloc = mine > 0u ? mine : 1u; nx = cnt > 0u ? cnt : 1u;
}
__device__ __forceinline__ void xcd_barrier(const XcdBarrier& b) {
    asm volatile("s_waitcnt vmcnt(0)" ::: "memory");
    __syncthreads();
    if (threadIdx.x == 0) {
        unsigned* bar = b.bar;
        __builtin_amdgcn_s_waitcnt(0);
        unsigned nloc = b.st[0], nx = b.st[1];
        if (nloc == 0u) { xcd_barrier_complete(bar, b.x, nloc, nx); b.st[0] = nloc; b.st[1] = nx; }
        const unsigned old = xb_add(&bar[XB_XSUB(b.x)], 1u);
        const unsigned gen = old / nloc;
        if (old + 1u == (gen + 1u) * nloc) {
            __builtin_amdgcn_fence(__ATOMIC_RELEASE, "agent");
            asm volatile("s_waitcnt vmcnt(0)" ::: "memory");
            const unsigned og = xb_add(&bar[XB_TOP], 1u);
            const unsigned tg = og / nx;
            if (og + 1u == (tg + 1u) * nx) xb_add(&bar[XB_TOPGEN], 1u);
            else XB_SPIN(xb_ld(&bar[XB_TOPGEN]) == tg, bar);
            __builtin_amdgcn_fence(__ATOMIC_ACQUIRE, "agent");
            xb_add(&bar[XB_XGEN(b.x)], 1u);
            asm volatile("s_waitcnt vmcnt(0)" ::: "memory");
        } else {
            XB_SPIN(xb_ld(&bar[XB_XGEN(b.x)]) == gen, bar);
            __builtin_amdgcn_fence(__ATOMIC_ACQUIRE, "agent");
            asm volatile("s_waitcnt vmcnt(0)" ::: "memory");
        }
    }
    __syncthreads();
}
__global__ void __launch_bounds__(NT) fwd_kernel(Params p) {
    extern __shared__ __attribute__((aligned(16))) char lds[];
    const int lo = p.ph_lo, hi = p.ph_hi;
    volatile LAS unsigned* bst = (volatile LAS unsigned*)(lds + LDS_BYTES - 16);
    if (threadIdx.x < 4) bst[threadIdx.x] = 0u;
    __syncthreads();
    XcdBarrier bar; bar.bar = (unsigned*)(p.ws + WS_CTL) + CTL_BAR; bar.x = 0; bar.st = bst;
    if (hi - lo > 1) bar = xcd_barrier_post((unsigned*)(p.ws + WS_CTL) + CTL_BAR, bst);
    if (hi > 1000) cooperative_groups::this_grid().sync();
#define IN(k) (lo <= (k) && (k) < hi)
#define SEAM(k) do { if (IN(k) && IN((k) + 1)) xcd_barrier(bar); } while (0)
#define RUN(k, ...) do { if (IN(k)) { __VA_ARGS__; if (REP_PHASE == (k)) { xcd_barrier(bar); __VA_ARGS__; } } SEAM(k); } while (0)
    RUN(0, phase_convert<0>(p, lds); phase_rows<0>(p, lds, 0));
    RUN(1, phase_dense_gemm<0>(p, lds));
    RUN(2, phase_pre0(p, lds));
    RUN(3, phase_mix0(p, lds));
    RUN(4, phase_post0(p); phase_convert<1>(p, lds));
    RUN(5, phase_dense_gemm<1>(p, lds));
    RUN(6, phase_rows<1>(p, lds, 0));
    RUN(7, phase_moe_gemm<0>(p, lds, 0));
    RUN(8, phase_moe_gemm<1>(p, lds, 0));
    RUN(9, phase_rows<2>(p, lds, 1));
    RUN(10, phase_dense_gemm<2>(p, lds));
    RUN(11, phase_mix1(p, lds));
    RUN(12, phase_post1(p));
    RUN(13, phase_dense_gemm<3>(p, lds));
    RUN(14, phase_rows<1>(p, lds, 1));
    RUN(15, phase_moe_gemm<0>(p, lds, 1));
    RUN(16, phase_moe_gemm<1>(p, lds, 1));
    RUN(17, phase_rows<3>(p, lds, 0));
#undef RUN
#undef IN
#undef SEAM
}

extern "C" void kernel_launch(void* const* d_in, const int* in_sizes, int n_in, void* d_out, int out_size, void* d_ws, size_t ws_size, hipStream_t stream) {
    static int ok = 0, grid = 0;
    if (ok == 0) {
        ok = 1;
        if (n_in != 35 || out_size != M * D || ws_size < WS_END) { fprintf(stderr, "kernel_launch: unexpected sizes n_in=%d out=%d ws=%zu need=%zu\n", n_in, out_size, ws_size, (size_t)WS_END); ok = -1; }
        if (hipFuncSetAttribute((const void*)fwd_kernel, hipFuncAttributeMaxDynamicSharedMemorySize, LDS_BYTES) != hipSuccess) { fprintf(stderr, "kernel_launch: hipFuncSetAttribute failed\n"); ok = -1; }
        int dev = 0, cus = 0, per_cu = 0;
        hipGetDevice(&dev); hipDeviceGetAttribute(&cus, hipDeviceAttributeMultiprocessorCount, dev);
        if (hipOccupancyMaxActiveBlocksPerMultiprocessor(&per_cu, (const void*)fwd_kernel, NT, LDS_BYTES) != hipSuccess || per_cu < 1) { fprintf(stderr, "kernel_launch: occupancy query failed (%d)\n", per_cu); per_cu = 1; }
        (void)hipGetLastError();
        grid = cus * (per_cu > 1 ? 1 : per_cu);
        if (grid > 256) grid = 256;
        if (grid < 1) ok = -1;
    }
    if (ok < 0) return;
    Params p{};
    const float** f = (const float**)&p;
    for (int i = 0; i < 35; ++i) f[i] = (const float*)d_in[i];
    p.out = (float*)d_out; p.ws = (unsigned char*)d_ws;
    (void)hipMemsetAsync((char*)d_ws + WS_CTL, 0, 65536, stream);
#if SINGLE_LAUNCH
    p.ph_lo = 0; p.ph_hi = NPHASE;
    void* args[] = {&p};
    hipError_t e = hipLaunchCooperativeKernel((const void*)fwd_kernel, dim3(grid), dim3(NT), args, LDS_BYTES, stream);
    if (e != hipSuccess) fprintf(stderr, "kernel_launch: cooperative launch failed: %s (grid %d)\n", hipGetErrorString(e), grid);
#else
    for (int ph = 0; ph < NPHASE; ++ph) {
        p.ph_lo = ph; p.ph_hi = ph + 1;
        hipLaunchKernelGGL(fwd_kernel, dim3(grid), dim3(NT), LDS_BYTES, stream, p);
    }
#endif
}
```

```cpp
#include <hip/hip_runtime.h>
#include <hip/hip_cooperative_groups.h>
#include <stdint.h>
#include <stdio.h>

#ifndef REP_PHASE
#define REP_PHASE -1
#endif
#ifndef REP_UNIT
#define REP_UNIT 0
#endif
#ifndef SINGLE_LAUNCH
#define SINGLE_LAUNCH 1
#endif

typedef unsigned short bf16_t;
typedef short bf16x8 __attribute__((ext_vector_type(8)));
typedef float f32x16 __attribute__((ext_vector_type(16)));
typedef float f32x4 __attribute__((ext_vector_type(4)));
typedef unsigned u32x4 __attribute__((ext_vector_type(4)));
typedef unsigned u32x2 __attribute__((ext_vector_type(2)));

#define NT 512
typedef short s16x4 __attribute__((ext_vector_type(4)));
typedef float f32x4v __attribute__((ext_vector_type(4)));
#define MFMA16(a, b, c) __builtin_amdgcn_mfma_f32_16x16x32_bf16((a), (b), (c), 0, 0, 0)
#define LAS __attribute__((address_space(3)))
constexpr int D = 1024, NBATCH = 8, SEQ = 2048, M = NBATCH * SEQ;
constexpr int EVEN_IN = 3840, ODD_SRC = 4112, ODD_IN = 4096;
constexpr int NPHASE = 17;
constexpr int LDS_BYTES = 150 * 1024;

constexpr size_t WS_CTL = 0;
constexpr size_t WS_WIN0 = 163840;
constexpr size_t WS_WOUT0 = WS_WIN0 + (size_t)EVEN_IN * D * 2;
constexpr size_t WS_WIN1 = WS_WOUT0 + (size_t)D * D * 2;
constexpr size_t WS_WOUT1 = WS_WIN1 + (size_t)ODD_IN * D * 2;
constexpr size_t WS_XN = WS_WOUT1 + (size_t)D * D * 2;
constexpr size_t WS_P = WS_XN + (size_t)M * D * 2;
constexpr size_t WS_LTOK = WS_P + (size_t)100 * 1024 * 1024;
constexpr size_t WS_LGATE = WS_LTOK + (size_t)32 * M * 4;
constexpr size_t WS_GATES = WS_P + (size_t)M * 4096 * 2;
constexpr size_t WS_WR = WS_GATES + (size_t)M * 16 * 4;
constexpr size_t WS_WRB = WS_WR + (size_t)(2 * 40 + 16) * 1024 * 4;
constexpr size_t WS_RWW = WS_WRB + (size_t)(2 * 2 * 48 + 2 * 16) * 1024 * 2;
constexpr size_t WS_ARENA = WS_RWW + (size_t)8 * 256 * 64 * 2;
constexpr size_t WS_WGU = WS_ARENA;
constexpr size_t WS_WD = WS_WGU + (size_t)2 * 32 * 512 * 1024 * 2;
constexpr size_t WS_CHK_RW = WS_ARENA;
constexpr size_t CHK_RW_ITEM = 32768;
constexpr size_t WS_CHK_HG = WS_CHK_RW + (size_t)2048 * CHK_RW_ITEM;
constexpr size_t CHK_HG_ITEM = 24576 + 256;
constexpr size_t WS_END = WS_CHK_HG + (size_t)2048 * CHK_HG_ITEM;
static_assert(WS_END >= WS_WD + (size_t)2 * 32 * 1024 * 256 * 2, "arena");
static_assert(WS_END <= 310000000, "workspace budget");
static_assert(WS_LGATE + (size_t)32 * M * 4 <= WS_P + (size_t)M * 4096 * 2, "lists inside P");
constexpr size_t P_HID = 0;
constexpr size_t P_Y = (size_t)32 * 1024 * 1024;
constexpr size_t H16_OFF = (size_t)M * D * 2;
constexpr int CTL_CNT = 0;
constexpr int CTL_BAR = 1024;
constexpr int CTL_MOE = 16384;
constexpr int CTL_READY = 8192;

struct Params {
    const float* x; const float* norm_mix; const float* norm_ffn; const float* norm_final;
    const float* ev_w_in; const float* ev_mu; const float* rw_w0; const float* rw_w2; const float* rw_a0; const float* rw_a2; const float* rw_g2;
    const float* rw_k_k; const float* rw_k_a; const float* rw_r_k; const float* rw_ln_w; const float* rw_ln_b; const float* hg_lb; const float* hg_norm;
    const float* ev_w_out; const float* od_w_in; const float* gd_conv; const float* gd_a_log; const float* gd_dt_bias; const float* gd_norm;
    const float* ml_i_bias; const float* ml_f_bias; const float* ml_norm; const float* od_w_out;
    const float* moe_w_group; const float* moe_b_group; const float* moe_w_router; const float* moe_b_router;
    const float* moe_w_gate; const float* moe_w_up; const float* moe_w_down;
    float* out; unsigned char* ws;
    int ph_lo, ph_hi;
};

__device__ __forceinline__ float bf2f(unsigned short u) { return __uint_as_float(((unsigned)u) << 16); }
__device__ __forceinline__ unsigned short f2bf(float f) { const __bf16 h = (__bf16)f; return __builtin_bit_cast(unsigned short, h); }
typedef __bf16 bf16x2_t __attribute__((ext_vector_type(2)));
typedef float f32x2_t __attribute__((ext_vector_type(2)));
__device__ __forceinline__ unsigned pack2(float a, float b) { f32x2_t f; f.x = a; f.y = b; const bf16x2_t h = __builtin_convertvector(f, bf16x2_t); return __builtin_bit_cast(unsigned, h); }
__device__ __forceinline__ float lo16(unsigned u) { return __uint_as_float(u << 16); }
__device__ __forceinline__ float hi16(unsigned u) { return __uint_as_float(u & 0xffff0000u); }
__device__ __forceinline__ float sigmoidf_(float x) { return __builtin_amdgcn_rcpf(1.0f + __expf(-x)); }
__device__ __forceinline__ float siluf_(float x) { return x * __builtin_amdgcn_rcpf(1.0f + __expf(-x)); }
__device__ __forceinline__ float softplusf_(float x) { return x > 20.f ? x : log1pf(__expf(x)); }

template <int CTRL> __device__ __forceinline__ float dppf(float x) {
    return __int_as_float(__builtin_amdgcn_update_dpp(0, __float_as_int(x), CTRL, 0xF, 0xF, false));
}
__device__ __forceinline__ float red16(float x) {
    x += dppf<0xB1>(x);
    x += dppf<0x4E>(x);
    x += dppf<0x141>(x);
    x += dppf<0x140>(x);
    return x;
}
__device__ __forceinline__ float red64(float x) {
    x = red16(x);
    x += __shfl_xor(x, 16);
    x += __shfl_xor(x, 32);
    return x;
}

__device__ __forceinline__ void conv_tile(float* tile, const float* s0, const float* s1, size_t ld, bf16_t* d, size_t ldd, unsigned* ready = nullptr, bf16_t* d1 = nullptr) {
    const int tid = threadIdx.x;
#pragma unroll
    for (int i = 0; i < 2; ++i) {
        const int k = (tid >> 4) + 32 * i, nn = (tid & 15) * 4;
        const float* s = nn < 32 ? s0 + (size_t)k * ld + nn : s1 + (size_t)k * ld + (nn - 32);
        const float4 v = *(const float4*)s;
        float* t = tile + k * 65 + nn;
        t[0] = v.x; t[1] = v.y; t[2] = v.z; t[3] = v.w;
    }
    __syncthreads();
    const int n = tid >> 3, kc = (tid & 7) * 8;
    float f0 = tile[(kc + 0) * 65 + n], f1 = tile[(kc + 1) * 65 + n], f2 = tile[(kc + 2) * 65 + n], f3 = tile[(kc + 3) * 65 + n];
    float f4 = tile[(kc + 4) * 65 + n], f5 = tile[(kc + 5) * 65 + n], f6 = tile[(kc + 6) * 65 + n], f7 = tile[(kc + 7) * 65 + n];
    u32x4 o; o.x = pack2(f0, f1); o.y = pack2(f2, f3); o.z = pack2(f4, f5); o.w = pack2(f6, f7);
    if (ready) {
        unsigned long long* dp = (unsigned long long*)(d + (size_t)n * ldd + kc);
        __hip_atomic_store(dp, ((unsigned long long)o.y << 32) | o.x, __ATOMIC_RELAXED, __HIP_MEMORY_SCOPE_AGENT);
        __hip_atomic_store(dp + 1, ((unsigned long long)o.w << 32) | o.z, __ATOMIC_RELAXED, __HIP_MEMORY_SCOPE_AGENT);
        asm volatile("s_waitcnt vmcnt(0)" ::: "memory");
        __syncthreads();
        if (tid == 0) __hip_atomic_fetch_add(ready, 1u, __ATOMIC_RELAXED, __HIP_MEMORY_SCOPE_AGENT);
    } else {
        bf16_t* dd = (d1 && n >= 32) ? d1 + (size_t)(n - 32) * ldd : d + (size_t)n * ldd;
        *(u32x4*)(dd + kc) = o;
        __syncthreads();
    }
}

template <int PART>
__device__ __forceinline__ void phase_convert(const Params& p, char* lds) {
    float* tile = (float*)lds;
    unsigned char* ws = p.ws;
    const int total = PART == 0 ? (960 + 256 + 1024 + 256) : (4096 + 2048);
    for (int g0 = blockIdx.x; g0 < total; g0 += gridDim.x) {
        int g = g0;
        if (PART == 0) {
            if (g < 960) { const int kt = g & 15, nt = g >> 4;
                const float* s0 = p.ev_w_in + (size_t)(kt * 64) * EVEN_IN + nt * 64;
                conv_tile(tile, s0, s0 + 32, EVEN_IN, (bf16_t*)(ws + WS_WIN0) + (size_t)(nt * 64) * D + kt * 64, D, (unsigned*)(ws + WS_CTL) + CTL_READY + 4096 + 64 * (nt >> 2)); continue; }
            g -= 960;
            if (g < 256) { const int kt = g & 15, nt = g >> 4;
                const float* s0 = p.ev_w_out + (size_t)(kt * 64) * D + nt * 64;
                conv_tile(tile, s0, s0 + 32, D, (bf16_t*)(ws + WS_WOUT0) + (size_t)(nt * 64) * D + kt * 64, D); continue; }
            g -= 256;
            if (g < 1024) { const int kt = g & 15, nt = g >> 4;
                const float* s0 = p.od_w_in + (size_t)(kt * 64) * ODD_SRC + nt * 64 + (nt >= 32 ? 8 : 0);
                conv_tile(tile, s0, s0 + 32, ODD_SRC, (bf16_t*)(ws + WS_WIN1) + (size_t)(nt * 64) * D + kt * 64, D); continue; }
            g -= 1024;
            { const int kt = g & 15, nt = g >> 4;
                const float* s0 = p.od_w_out + (size_t)(kt * 64) * D + nt * 64;
                conv_tile(tile, s0, s0 + 32, D, (bf16_t*)(ws + WS_WOUT1) + (size_t)(nt * 64) * D + kt * 64, D); }
        } else {
            if (g < 4096) { const int le = (g >> 7) + (PART == 2 ? 32 : 0), r = g & 127, kt = r & 15, s = r >> 4;
                const size_t so = (size_t)le * 1024 * 256 + (size_t)(kt * 64) * 256 + s * 32;
                bf16_t* dg = (bf16_t*)(ws + WS_WGU) + (size_t)le * 512 * 1024 + (size_t)((s >> 2) * 256 + (s & 3) * 32) * 1024 + kt * 64;
                conv_tile(tile, p.moe_w_gate + so, p.moe_w_up + so, 256, dg, 1024, nullptr, dg + (size_t)128 * 1024); continue; }
            g -= 4096;
            { const int le = (g >> 6) + (PART == 2 ? 32 : 0), r = g & 63, kt = r & 3, nt = r >> 2;
                const float* s0 = p.moe_w_down + (size_t)le * 256 * 1024 + (size_t)(kt * 64) * 1024 + nt * 64;
                conv_tile(tile, s0, s0 + 32, 1024, (bf16_t*)(ws + WS_WD) + (size_t)le * 1024 * 256 + (size_t)(nt * 64) * 256 + kt * 64, 256); }
        }
    }
}


__device__ __forceinline__ void phase_prep_router(const Params& p) {
    float* WR = (float*)(p.ws + WS_WR);
    bf16_t* RWW = (bf16_t*)(p.ws + WS_RWW);
    for (int i = blockIdx.x * NT + threadIdx.x; i < 8 * 256 * 64; i += gridDim.x * NT) {
        const int hh = i >> 14, r = (i >> 6) & 255, cc = i & 63;
        const float w = r < 64 ? p.rw_w2[r * 512 + hh * 64 + cc] : r < 128 ? p.rw_a2[(r - 64) * 512 + hh * 64 + cc] : p.rw_g2[(r - 128) * 512 + hh * 64 + cc];
        RWW[i] = f2bf(w);
    }
    for (int i = blockIdx.x * NT + threadIdx.x; i < 96 * 1024; i += gridDim.x * NT) {
        const int o = i >> 10, d = i & 1023;
        float w = 0.f;
        if (o < 80) { const int l = o / 40, oo = o % 40;
            if (oo < 4) w = p.moe_w_group[(size_t)l * D * 4 + d * 4 + oo]; else if (oo < 36) w = p.moe_w_router[(size_t)l * D * 32 + d * 32 + (oo - 4)];
        } else { const int oo = o - 80; w = p.od_w_in[(size_t)d * ODD_SRC + (oo < 8 ? 2048 + oo : 4104 + (oo - 8))]; }
        WR[i] = w;
        bf16_t* WRB = (bf16_t*)(p.ws + WS_WRB);
        const unsigned short hi = f2bf(w), lo = f2bf(w - bf2f(hi));
        if (o < 80) { const int l = o / 40, oo = o % 40; WRB[((size_t)(l * 2 + 0) * 48 + oo) * 1024 + d] = hi; WRB[((size_t)(l * 2 + 1) * 48 + oo) * 1024 + d] = lo; }
        else { const int oo = o - 80; WRB[(size_t)192 * 1024 + (size_t)oo * 1024 + d] = hi; WRB[(size_t)192 * 1024 + (size_t)(16 + oo) * 1024 + d] = lo; }
    }
    for (int i = blockIdx.x * NT + threadIdx.x; i < 4 * 8 * 1024; i += gridDim.x * NT) {
        const int blk = i >> 13, r = 40 + ((i >> 10) & 7), d = i & 1023; ((bf16_t*)(p.ws + WS_WRB))[((size_t)blk * 48 + r) * 1024 + d] = 0; }
}

template <int MODE>
__device__ __forceinline__ void phase_rows(const Params& p, char* lds, int layer) {
    const int tid = threadIdx.x, lane = tid & 63, wave = tid >> 6;
    unsigned char* ws = p.ws;
    const float* src = p.x;
    bf16_t* H16 = (bf16_t*)((char*)p.out + H16_OFF);
    const float* gain = (MODE == 0) ? p.norm_mix : (MODE == 1) ? p.norm_ffn + layer * D : (MODE == 2) ? p.norm_mix + D : p.norm_final;
    bf16_t* XN = (bf16_t*)(ws + WS_XN);
    const bf16_t* Y0 = (const bf16_t*)(ws + WS_P + P_Y);
    const bf16_t* Y1 = Y0 + (size_t)M * D;
    float* rstd_s = (float*)lds;
    constexpr int LOS = 1032;
    bf16_t* LO = (bf16_t*)(lds + 1024);
    float* lg = (float*)(lds + 1024 + 64 * LOS * 2);
    constexpr int NO = (MODE == 1) ? 5 : 2;
    constexpr int NOUT = (MODE == 1) ? 36 : 16;
    for (int gi = blockIdx.x; gi < M / 64; gi += gridDim.x) {
        const int grp = (gridDim.x == 256) ? ((gi & 7) * 32 + (gi >> 3)) : gi;
        const int t0 = grp * 64;
#pragma unroll 1
        for (int q4 = 0; q4 < 2; ++q4) {
            float4 v[4][4];
#pragma unroll
            for (int j = 0; j < 4; ++j) { const int tok = t0 + wave * 8 + q4 * 4 + j;
#pragma unroll
                for (int i = 0; i < 4; ++i) {
                    if (MODE == 0) v[j][i] = *(const float4*)(src + (size_t)tok * D + i * 256 + lane * 4);
                    else { const u32x2 h = *(const u32x2*)(H16 + (size_t)tok * D + i * 256 + lane * 4); v[j][i].x = lo16(h.x); v[j][i].y = hi16(h.x); v[j][i].z = lo16(h.y); v[j][i].w = hi16(h.y); } } }
            if (MODE == 2 || MODE == 3) {
#pragma unroll
                for (int j = 0; j < 4; ++j) { const int tok = t0 + wave * 8 + q4 * 4 + j;
                    u32x2 a[4], b[4];
#pragma unroll
                    for (int i = 0; i < 4; ++i) { a[i] = *(const u32x2*)(Y0 + (size_t)tok * D + i * 256 + lane * 4); b[i] = *(const u32x2*)(Y1 + (size_t)tok * D + i * 256 + lane * 4); }
#pragma unroll
                    for (int i = 0; i < 4; ++i) { v[j][i].x += lo16(a[i].x) + lo16(b[i].x); v[j][i].y += hi16(a[i].x) + hi16(b[i].x); v[j][i].z += lo16(a[i].y) + lo16(b[i].y); v[j][i].w += hi16(a[i].y) + hi16(b[i].y); }
                }
            }
            float4 g4[4];
#pragma unroll
            for (int i = 0; i < 4; ++i) g4[i] = *(const float4*)(gain + i * 256 + lane * 4);
#pragma unroll
            for (int j = 0; j < 4; ++j) {
                const int tl = wave * 8 + q4 * 4 + j, tok = t0 + tl;
                float ss = 0.f;
#pragma unroll
                for (int i = 0; i < 4; ++i) ss += v[j][i].x * v[j][i].x + v[j][i].y * v[j][i].y + v[j][i].z * v[j][i].z + v[j][i].w * v[j][i].w;
                ss = red64(ss);
                const float rstd = rsqrtf(ss * (1.0f / D) + 1e-6f);
                if (lane == 0) rstd_s[tl] = rstd;
#pragma unroll
                for (int i = 0; i < 4; ++i) {
                    if (MODE == 2) { u32x2 hw; hw.x = pack2(v[j][i].x, v[j][i].y); hw.y = pack2(v[j][i].z, v[j][i].w); *(u32x2*)(H16 + (size_t)tok * D + i * 256 + lane * 4) = hw; }
                    const float o0 = v[j][i].x * rstd * g4[i].x, o1 = v[j][i].y * rstd * g4[i].y, o2 = v[j][i].z * rstd * g4[i].z, o3 = v[j][i].w * rstd * g4[i].w;
                    if (MODE == 3) { float4 o; o.x = o0; o.y = o1; o.z = o2; o.w = o3; *(float4*)(p.out + (size_t)tok * D + i * 256 + lane * 4) = o; }
                    else { u32x2 o; o.x = pack2(o0, o1); o.y = pack2(o2, o3);
                        if (MODE == 1 || MODE == 2) { u32x2 l2; l2.x = pack2(o0 - lo16(o.x), o1 - hi16(o.x)); l2.y = pack2(o2 - lo16(o.y), o3 - hi16(o.y)); *(u32x2*)(LO + tl * LOS + i * 256 + lane * 4) = l2; }
                        if (MODE == 0) __hip_atomic_store((unsigned long long*)(XN + (size_t)tok * D + i * 256 + lane * 4), ((unsigned long long)o.y << 32) | o.x, __ATOMIC_RELAXED, __HIP_MEMORY_SCOPE_AGENT);
                        else *(u32x2*)(XN + (size_t)tok * D + i * 256 + lane * 4) = o; }
                }
            }
        }
        if (MODE == 0) {
            asm volatile("s_waitcnt vmcnt(0)" ::: "memory");
            __syncthreads();
            if (tid == 0) __hip_atomic_fetch_add((unsigned*)(ws + WS_CTL) + CTL_READY + 64 * (grp >> 2), 1u, __ATOMIC_RELAXED, __HIP_MEMORY_SCOPE_AGENT);
        }
        if (MODE == 1 || MODE == 2) {
            const int btok = tid & 63, og = tid >> 6;
            for (int i = tid; i < 64 * 48; i += NT) lg[i] = 0.f;
            asm volatile("s_waitcnt vmcnt(0)" ::: "memory");
            __syncthreads();
            {
                const bf16_t* Whi = (const bf16_t*)(ws + WS_WRB) + (MODE == 1 ? (size_t)(layer * 2) * 48 * 1024 : (size_t)192 * 1024);
                const bf16_t* Wlo = Whi + (MODE == 1 ? (size_t)48 * 1024 : (size_t)16 * 1024);
                constexpr int NTN = (MODE == 1) ? 3 : 1, NJOB = 4 * NTN * 2;
                const int lane16 = lane & 15, g4 = lane >> 4;
                for (int job = wave; job < NJOB; job += 8) {
                    const int kh = job & 1, tq = job >> 1, ti = tq / NTN, nj = tq - ti * NTN;
                    const bf16_t* ah = XN + (size_t)(t0 + ti * 16 + lane16) * D + kh * 512 + 8 * g4;
                    const bf16_t* al = LO + (ti * 16 + lane16) * LOS + kh * 512 + 8 * g4;
                    const bf16_t* bh = Whi + (size_t)(nj * 16 + lane16) * 1024 + kh * 512 + 8 * g4;
                    const bf16_t* bl = Wlo + (size_t)(nj * 16 + lane16) * 1024 + kh * 512 + 8 * g4;
                    f32x4v acc; acc[0] = 0.f; acc[1] = 0.f; acc[2] = 0.f; acc[3] = 0.f;
#pragma unroll 4
                    for (int k0 = 0; k0 < 512; k0 += 32) {
                        const bf16x8 fah = *(const bf16x8*)(ah + k0), fal = *(const bf16x8*)(al + k0), fbh = *(const bf16x8*)(bh + k0), fbl = *(const bf16x8*)(bl + k0);
                        acc = MFMA16(fah, fbh, acc); acc = MFMA16(fah, fbl, acc); acc = MFMA16(fal, fbh, acc);
                    }
#pragma unroll
                    for (int r = 0; r < 4; ++r) atomicAdd(&lg[(ti * 16 + 4 * g4 + r) * 48 + nj * 16 + lane16], acc[r]);
                }
            }
            __syncthreads();
            float acc[NO];
#pragma unroll
            for (int o = 0; o < NO; ++o) acc[o] = lg[btok * 48 + og * NO + o];
            __syncthreads();
            if (MODE == 2) {
                float* G = (float*)(ws + WS_GATES);
#pragma unroll
                for (int o = 0; o < NO; ++o) G[(size_t)(t0 + btok) * 16 + og * NO + o] = acc[o];
            } else {
#pragma unroll
                for (int o = 0; o < NO; ++o) { const int oo = og * NO + o;
                    if (oo < NOUT) lg[btok * 48 + oo] = acc[o] + (oo < 4 ? p.moe_b_group[layer * 4 + oo] : p.moe_b_router[layer * 32 + oo - 4]); }
                __syncthreads();
                if (tid < 64) {
                    const float* l = lg + tid * 48;
                    int gi = 0; float gm = l[0];
#pragma unroll
                    for (int j = 1; j < 4; ++j) if (l[j] > gm) { gm = l[j]; gi = j; }
                    float se = 0.f;
#pragma unroll
                    for (int j = 0; j < 4; ++j) se += __expf(l[j] - gm);
                    const float ptop = 1.0f / se;
                    const float* f = l + 4 + gi * 8;
                    int i1 = 0; float v1 = f[0];
#pragma unroll
                    for (int j = 1; j < 8; ++j) if (f[j] > v1) { v1 = f[j]; i1 = j; }
                    int i2 = -1; float v2 = -3.0e38f;
#pragma unroll
                    for (int j = 0; j < 8; ++j) if (j != i1 && f[j] > v2) { v2 = f[j]; i2 = j; }
                    if (i2 < 0) { i2 = (i1 + 1) & 7; v2 = v1; }
                    const float w1 = 1.0f / (1.0f + __expf(v2 - v1)), w2 = 1.0f - w1;
                    int* cnt = (int*)(ws + WS_CTL) + CTL_CNT + layer * 32;
                    int* ltok = (int*)(ws + WS_LTOK); float* lgate = (float*)(ws + WS_LGATE);
                    const int tok = t0 + tid;
                    const int e1 = gi * 8 + i1, e2 = gi * 8 + i2;
                    const int p1 = atomicAdd(cnt + e1, 1); ltok[(size_t)e1 * M + p1] = tok * 2; lgate[(size_t)e1 * M + p1] = ptop * w1;
                    const int p2 = atomicAdd(cnt + e2, 1); ltok[(size_t)e2 * M + p2] = tok * 2 + 1; lgate[(size_t)e2 * M + p2] = ptop * w2;
                }
            }
        }
        __syncthreads();
    }
}

namespace pg8 {
#define PG8_LAS __attribute__((address_space(3)))
typedef float f32x4 __attribute__((ext_vector_type(4)));
constexpr int BM = 256, BK = 64, HALF = 128, HTB = HALF * BK * 2  , STAGE_BYTES = 8 * HTB, NXCD = 8, WGM = 8;
__host__ __device__ __forceinline__ int lds_byte(int r, int c) { const int st = (r >> 4) * 2 + (c >> 5), rr = r & 15, cc = c & 31, ob = rr * 64 + cc * 2; return st * 1024 + (ob ^ (((ob >> 9) & 1) << 5)); }
__host__ __device__ __forceinline__ void stage_rc(int b, int& R, int& C) { const int st = b / 1024, sb = b % 1024, swz = sb ^ (((sb >> 9) & 1) << 5); R = (st >> 1) * 16 + swz / 64; C = (st & 1) * 32 + (swz % 64) / 2; }
__host__ __device__ __forceinline__ int perm32(int rho) { const int n = rho >> 4, i = rho & 15; return 8 * (i >> 2) + 4 * n + (i & 3); }

struct Unit { int pm, pn; };
struct Gemm { const bf16_t* A; const bf16_t* Bt; int M, N, K; };
struct StaticOrder {
    int nM, nN, nwg, G, c;
    __device__ void init(int M_, int N_, int G_, int c_) { nM = M_ / BM; nN = N_ / BM; nwg = nM * nN; G = G_; c = c_; }
    __device__ bool next(int i, Unit& u) const {
        const long L = (long)i * G + c; if (L >= nwg) return false;
        int wgid = (int)L; { const int q = nwg / NXCD, r = nwg % NXCD, xcd = wgid % NXCD, off = wgid / NXCD; wgid = (xcd < r ? xcd * (q + 1) : r * (q + 1) + (xcd - r) * q) + off; }
        const int nig = WGM * nN, gid = wgid / nig, fm = gid * WGM, gsz = (nM - fm) < WGM ? (nM - fm) : WGM;
        u.pm = fm + ((wgid % nig) % gsz); u.pn = (wgid % nig) / gsz; return true;
    }
    __device__ __forceinline__ void a_ready(const Unit&) const {}
    __device__ __forceinline__ void done(const Unit&) const {}
};


struct CountedOrder : StaticOrder {
    unsigned* ready; unsigned need; unsigned* readyb; unsigned needb;
    __device__ __forceinline__ void a_ready(const Unit& u) const {
        if (threadIdx.x < 64) {
            unsigned polls = 0;
            while ((unsigned)__builtin_amdgcn_readfirstlane(__hip_atomic_load(ready + 64 * u.pm, __ATOMIC_RELAXED, __HIP_MEMORY_SCOPE_AGENT)) < need) {
                if (++polls > (1u << 22)) break;
                __builtin_amdgcn_s_sleep(2); }
            if (readyb) { polls = 0;
                while ((unsigned)__builtin_amdgcn_readfirstlane(__hip_atomic_load(readyb + 64 * u.pn, __ATOMIC_RELAXED, __HIP_MEMORY_SCOPE_AGENT)) < needb) {
                    if (++polls > (1u << 22)) break;
                    __builtin_amdgcn_s_sleep(2); } }
            __builtin_amdgcn_fence(__ATOMIC_ACQUIRE, "agent");
            asm volatile("s_waitcnt vmcnt(0)" ::: "memory");
        }
        asm volatile("" ::: "memory"); __builtin_amdgcn_s_barrier(); asm volatile("" ::: "memory");
    }
};

struct EpiResid16 {
    static constexpr bool PERM = true, AFTER_DRAIN = false;
    const float* X; bf16_t* H; int ldc;
    __device__ __forceinline__ void operator()(const f32x4 (&acc)[2][2][4][2], const Unit& u, int wr, int wc, int fr, int fq) const {
        const int row0 = u.pm * BM + wr * 64 + fr, col0 = u.pn * BM + wc * 32 + 8 * fq;
#pragma unroll
        for (int ai = 0; ai < 2; ++ai)
#pragma unroll
            for (int m = 0; m < 4; ++m) { const size_t ro = (size_t)(row0 + ai * HALF + m * 16) * ldc + col0;
#pragma unroll
                for (int bj = 0; bj < 2; ++bj) { f32x4 v0 = acc[ai][bj][m][0], v1 = acc[ai][bj][m][1];
                    if (X) { v0 += *(const f32x4*)(X + ro + bj * HALF); v1 += *(const f32x4*)(X + ro + bj * HALF + 4); }
                    else { const u32x4 r = *(const u32x4*)(H + ro + bj * HALF);
                        v0[0] += lo16(r.x); v0[1] += hi16(r.x); v0[2] += lo16(r.y); v0[3] += hi16(r.y); v1[0] += lo16(r.z); v1[1] += hi16(r.z); v1[2] += lo16(r.w); v1[3] += hi16(r.w); }
                    u32x4 w; w.x = pack2(v0[0], v0[1]); w.y = pack2(v0[2], v0[3]); w.z = pack2(v1[0], v1[1]); w.w = pack2(v1[2], v1[3]);
                    *(u32x4*)(H + ro + bj * HALF) = w; } }
    }
};
struct EpiStore16 {
    static constexpr bool PERM = true, AFTER_DRAIN = false;
    bf16_t* O; int ldc;
    __device__ __forceinline__ void operator()(const f32x4 (&acc)[2][2][4][2], const Unit& u, int wr, int wc, int fr, int fq) const {
        const int row0 = u.pm * BM + wr * 64 + fr, col0 = u.pn * BM + wc * 32 + 8 * fq;
#pragma unroll
        for (int ai = 0; ai < 2; ++ai)
#pragma unroll
            for (int m = 0; m < 4; ++m) { bf16_t* rowp = O + (size_t)(row0 + ai * HALF + m * 16) * ldc + col0;
#pragma unroll
                for (int bj = 0; bj < 2; ++bj) { const f32x4 v0 = acc[ai][bj][m][0], v1 = acc[ai][bj][m][1];
                    u32x4 w; w.x = pack2(v0[0], v0[1]); w.y = pack2(v0[2], v0[3]); w.z = pack2(v1[0], v1[1]); w.w = pack2(v1[2], v1[3]);
                    *(u32x4*)(rowp + bj * HALF) = w; } }
    }
};

template <class Epi, class Sched, bool STAMP = false>
__device__ __forceinline__ void gemm_phase(PG8_LAS unsigned char* lds, const Gemm g, const Sched& S, const Epi& E, unsigned long long* stamps) {
    const int tid = threadIdx.x, wid = __builtin_amdgcn_readfirstlane(tid >> 6), lane = tid & 63, wr = wid >> 2, wc = wid & 3, fr = lane & 15, fq = lane >> 4;
    const int K = g.K, nt = K / BK;
    int ts_lo = 0, ts_hi = 0, nts = 0; const unsigned long long rt_entry = STAMP ? 0ull : 0ull;
#define PG8_STAMP() do { if (STAMP && wid == 0 && nts < 64) { const unsigned long long _c = (unsigned long long)clock64(); \
        ts_lo = (lane == nts) ? (int)(unsigned)_c : ts_lo; ts_hi = (lane == nts) ? (int)(unsigned)(_c >> 32) : ts_hi; ++nts; } } while (0)
    PG8_STAMP();
    unsigned voffA[2], voffB[2];
#pragma unroll
    for (int i = 0; i < 2; ++i) { int R, C; stage_rc(tid * 16 + i * 8192, R, C); const int Rb = Epi::PERM ? ((R & ~31) + perm32(R & 31)) : R;
        voffA[i] = (unsigned)(R * K + C) * 2u; voffB[i] = (unsigned)(Rb * K + C) * 2u; }
    const size_t kstep = (size_t)(BK * 2);
    const size_t hstep = (size_t)HALF * K * 2;
    const size_t tstep = 2 * hstep;
    const unsigned ldsw = (unsigned)wid * 1024u;
    const int aoff = lds_byte(wr * 64 + fr, fq * 8), boff = lds_byte(wc * 32 + fr, fq * 8);
#define PG8_SA(b, h) (((b) * 2 + (h)) * HTB)
#define PG8_SB(b, h) ((4 + (b) * 2 + (h)) * HTB)
#define PG8_STAGE(bufoff, gbase, voff) do { _Pragma("unroll") for (int _i = 0; _i < 2; ++_i) \
        __builtin_amdgcn_global_load_lds((const unsigned*)((const char*)(gbase) + (voff)[_i]), (PG8_LAS unsigned*)(lds + (bufoff) + ldsw + _i * 8192), 16, 0, 0); } while (0)
#define PG8_LDA(dst, b, h) do { _Pragma("unroll") for (int m = 0; m < 4; ++m) _Pragma("unroll") for (int k = 0; k < 2; ++k) dst[m][k] = *(const PG8_LAS bf16x8*)(lds + PG8_SA(b, h) + aoff + m * 2048 + k * 1024); } while (0)
#define PG8_LDB(dst, b, h) do { _Pragma("unroll") for (int n = 0; n < 2; ++n) _Pragma("unroll") for (int k = 0; k < 2; ++k) dst[n][k] = *(const PG8_LAS bf16x8*)(lds + PG8_SB(b, h) + boff + n * 2048 + k * 1024); } while (0)
#define PG8_MMA(ai, bj, At, Bt) do { __builtin_amdgcn_s_setprio(1); _Pragma("unroll") for (int m = 0; m < 4; ++m) _Pragma("unroll") for (int n = 0; n < 2; ++n) _Pragma("unroll") for (int k = 0; k < 2; ++k) \
        acc[ai][bj][m][n] = __builtin_amdgcn_mfma_f32_16x16x32_bf16(Bt[n][k], At[m][k], acc[ai][bj][m][n], 0, 0, 0); __builtin_amdgcn_s_setprio(0); } while (0)
#define PG8_WAIT_V(n) asm volatile("s_waitcnt vmcnt(" #n ")" ::: "memory")
#define PG8_WAIT_L(n) asm volatile("s_waitcnt lgkmcnt(" #n ")" ::: "memory")
#define PG8_BAR __builtin_amdgcn_s_barrier()
#define PG8_SCHED __builtin_amdgcn_sched_barrier(0)
    Unit cur, nxt; int ui = 0;
    if (!S.next(0, cur)) return;
    f32x4 acc[2][2][4][2];
#pragma unroll
    for (int a = 0; a < 2; ++a)
#pragma unroll
        for (int b = 0; b < 2; ++b)
#pragma unroll
            for (int m = 0; m < 4; ++m)
#pragma unroll
                for (int n = 0; n < 2; ++n) acc[a][b][m][n] = (f32x4){0.f, 0.f, 0.f, 0.f};
    bf16x8 At[4][2], B0[2][2], B1[2][2];
    const char* cA = (const char*)g.A + (size_t)cur.pm * tstep; const char* cB = (const char*)g.Bt + (size_t)cur.pn * tstep;
    S.a_ready(cur);
    PG8_STAGE(PG8_SB(0, 0), cB, voffB); PG8_STAGE(PG8_SA(0, 0), cA, voffA); PG8_STAGE(PG8_SB(0, 1), cB + hstep, voffB); PG8_STAGE(PG8_SA(0, 1), cA + hstep, voffA);
    if (wr == 1) PG8_BAR;
    PG8_WAIT_V(4); PG8_BAR;
    PG8_STAGE(PG8_SB(1, 0), cB + kstep, voffB); PG8_STAGE(PG8_SA(1, 0), cA + kstep, voffA); PG8_STAGE(PG8_SB(1, 1), cB + hstep + kstep, voffB);
    PG8_WAIT_V(6); PG8_BAR;
    PG8_STAMP();
    for (;;) {
        const bool has_next = S.next(ui + 1, nxt);
        const char* nA = has_next ? (const char*)g.A + (size_t)nxt.pm * tstep : cA; const char* nB = has_next ? (const char*)g.Bt + (size_t)nxt.pn * tstep : cB;
        for (int t = 0; t < nt; t += 2) {
            const bool last = (t == nt - 2);
            const char* a1 = cA + (size_t)(t + 1) * kstep;
            const char* a2 = last ? nA : cA + (size_t)(t + 2) * kstep; const char* b2 = last ? nB : cB + (size_t)(t + 2) * kstep;
            const char* a3 = a2 + kstep; const char* b3 = b2 + kstep;
            if (last && has_next) S.a_ready(nxt);
            PG8_LDB(B0, 0, 0); PG8_SCHED; PG8_LDA(At, 0, 0); PG8_STAGE(PG8_SA(1, 1), a1 + hstep, voffA);
            PG8_WAIT_L(8); PG8_BAR; PG8_WAIT_L(0); PG8_MMA(0, 0, At, B0); PG8_BAR; PG8_SCHED;
            PG8_LDB(B1, 0, 1); PG8_STAGE(PG8_SB(0, 0), b2, voffB);
            PG8_BAR; PG8_WAIT_L(0); PG8_MMA(0, 1, At, B1); PG8_BAR;
            PG8_LDA(At, 0, 1); PG8_STAGE(PG8_SA(0, 0), a2, voffA);
            PG8_BAR; PG8_WAIT_L(0); PG8_MMA(1, 0, At, B0); PG8_BAR; PG8_SCHED;
            PG8_STAGE(PG8_SB(0, 1), b2 + hstep, voffB);
            PG8_WAIT_V(6); PG8_BAR; PG8_MMA(1, 1, At, B1); PG8_BAR;
            PG8_LDB(B0, 1, 0); PG8_SCHED; PG8_LDA(At, 1, 0); PG8_STAGE(PG8_SA(0, 1), a2 + hstep, voffA);
            PG8_WAIT_L(8); PG8_BAR; PG8_WAIT_L(0); PG8_MMA(0, 0, At, B0); PG8_BAR; PG8_SCHED;
            PG8_LDB(B1, 1, 1); PG8_STAGE(PG8_SB(1, 0), b3, voffB);
            PG8_BAR; PG8_WAIT_L(0); PG8_MMA(0, 1, At, B1); PG8_BAR;
            PG8_LDA(At, 1, 1); PG8_STAGE(PG8_SA(1, 0), a3, voffA);
            PG8_BAR; PG8_WAIT_L(0); PG8_MMA(1, 0, At, B0); PG8_BAR; PG8_SCHED;
            PG8_STAGE(PG8_SB(1, 1), b3 + hstep, voffB);
            PG8_WAIT_V(6); PG8_BAR; PG8_MMA(1, 1, At, B1); PG8_BAR;
        }
        PG8_STAMP();
        if constexpr (!Epi::AFTER_DRAIN) { E(acc, cur, wr, wc, fr, fq); S.done(cur); }
        PG8_STAMP();
        if (!has_next) break;
#pragma unroll
        for (int a = 0; a < 2; ++a)
#pragma unroll
            for (int b = 0; b < 2; ++b)
#pragma unroll
                for (int m = 0; m < 4; ++m)
#pragma unroll
                    for (int n = 0; n < 2; ++n) acc[a][b][m][n] = (f32x4){0.f, 0.f, 0.f, 0.f};
        cur = nxt; cA = nA; cB = nB; ++ui;
    }
    PG8_WAIT_V(0);
    if (wr == 0) PG8_BAR;
    PG8_BAR;
    if constexpr (Epi::AFTER_DRAIN) { E.fused(acc, cur, wr, wc, fr, fq, lds, wid, lane); S.done(cur); }
    PG8_STAMP();
    if (STAMP && wid == 0) { stamps[lane] = lane < nts ? (((unsigned long long)(unsigned)ts_hi << 32) | (unsigned)ts_lo) : 0ull;
        if (lane == 62) stamps[62] = rt_entry; if (lane == 63) stamps[63] = 0ull; }
#undef PG8_STAMP
#undef PG8_SA
#undef PG8_SB
#undef PG8_STAGE
#undef PG8_LDA
#undef PG8_LDB
#undef PG8_MMA
#undef PG8_WAIT_V
#undef PG8_WAIT_L
#undef PG8_BAR
#undef PG8_SCHED
}
template <class Epi, class Sched, int K>
__device__ __forceinline__ void gemm_phase_g(PG8_LAS unsigned char* lds, const Sched& S, const Epi& E) {
    constexpr bool STAMP = false; unsigned long long* stamps = nullptr;
    const int tid = threadIdx.x, wid = __builtin_amdgcn_readfirstlane(tid >> 6), lane = tid & 63, wr = wid >> 2, wc = wid & 3, fr = lane & 15, fq = lane >> 4;
    constexpr int nt = K / BK;
    int ts_lo = 0, ts_hi = 0, nts = 0; const unsigned long long rt_entry = STAMP ? 0ull : 0ull;
#define PG8_STAMP() do { if (STAMP && wid == 0 && nts < 64) { const unsigned long long _c = (unsigned long long)clock64(); \
        ts_lo = (lane == nts) ? (int)(unsigned)_c : ts_lo; ts_hi = (lane == nts) ? (int)(unsigned)(_c >> 32) : ts_hi; ++nts; } } while (0)
    PG8_STAMP();
    unsigned voffB[2], cu0[2], cu1[2];
    PG8_LAS unsigned* const nxs = (PG8_LAS unsigned*)(lds + 131072) + tid * 4;
#pragma unroll
    for (int i = 0; i < 2; ++i) { int R, C; stage_rc(tid * 16 + i * 8192, R, C); const int Rb = Epi::PERM ? ((R & ~31) + perm32(R & 31)) : R;
        voffB[i] = (unsigned)(Rb * K + C) * 2u; }
    const size_t kstep = (size_t)(BK * 2);
    const size_t hstep = (size_t)HALF * K * 2;
    const size_t tstep = 2 * hstep;
    const unsigned ldsw = (unsigned)wid * 1024u;
    const int aoff = lds_byte(wr * 64 + fr, fq * 8), boff = lds_byte(wc * 32 + fr, fq * 8);
#define PG8_SA(b, h) (((b) * 2 + (h)) * HTB)
#define PG8_SB(b, h) ((4 + (b) * 2 + (h)) * HTB)
#define PG8_STAGE(bufoff, gbase, voff) do { _Pragma("unroll") for (int _i = 0; _i < 2; ++_i) \
        __builtin_amdgcn_global_load_lds((const unsigned*)((const char*)(gbase) + (voff)[_i]), (PG8_LAS unsigned*)(lds + (bufoff) + ldsw + _i * 8192), 16, 0, 0); } while (0)
#define PG8_LDA(dst, b, h) do { _Pragma("unroll") for (int m = 0; m < 4; ++m) _Pragma("unroll") for (int k = 0; k < 2; ++k) dst[m][k] = *(const PG8_LAS bf16x8*)(lds + PG8_SA(b, h) + aoff + m * 2048 + k * 1024); } while (0)
#define PG8_LDB(dst, b, h) do { _Pragma("unroll") for (int n = 0; n < 2; ++n) _Pragma("unroll") for (int k = 0; k < 2; ++k) dst[n][k] = *(const PG8_LAS bf16x8*)(lds + PG8_SB(b, h) + boff + n * 2048 + k * 1024); } while (0)
#define PG8_MMA(ai, bj, At, Bt) do { __builtin_amdgcn_s_setprio(1); _Pragma("unroll") for (int m = 0; m < 4; ++m) _Pragma("unroll") for (int n = 0; n < 2; ++n) _Pragma("unroll") for (int k = 0; k < 2; ++k) \
        acc[ai][bj][m][n] = __builtin_amdgcn_mfma_f32_16x16x32_bf16(Bt[n][k], At[m][k], acc[ai][bj][m][n], 0, 0, 0); __builtin_amdgcn_s_setprio(0); } while (0)
#define PG8_WAIT_V(n) asm volatile("s_waitcnt vmcnt(" #n ")" ::: "memory")
#define PG8_WAIT_L(n) asm volatile("s_waitcnt lgkmcnt(" #n ")" ::: "memory")
#define PG8_BAR __builtin_amdgcn_s_barrier()
#define PG8_SCHED __builtin_amdgcn_sched_barrier(0)
    typename Sched::UnitT cur, nxt; int ui = 0;
    if (!S.next(0, cur)) return;
    f32x4 acc[2][2][4][2];
#pragma unroll
    for (int a = 0; a < 2; ++a)
#pragma unroll
        for (int b = 0; b < 2; ++b)
#pragma unroll
            for (int m = 0; m < 4; ++m)
#pragma unroll
                for (int n = 0; n < 2; ++n) acc[a][b][m][n] = (f32x4){0.f, 0.f, 0.f, 0.f};
    bf16x8 At[4][2], B0[2][2], B1[2][2];
    const char* const Ab = S.a_base(); const char* cB = S.b_base(cur);
#pragma unroll
    for (int i = 0; i < 2; ++i) { int R, C; stage_rc(tid * 16 + i * 8192, R, C); cu0[i] = S.row_off(cur, R) + C * 2; cu1[i] = S.row_off(cur, R + HALF) + C * 2; }
    S.a_ready(cur);
    PG8_STAGE(PG8_SB(0, 0), cB, voffB); PG8_STAGE(PG8_SA(0, 0), Ab, cu0); PG8_STAGE(PG8_SB(0, 1), cB + hstep, voffB); PG8_STAGE(PG8_SA(0, 1), Ab, cu1);
    if (wr == 1) PG8_BAR;
    PG8_WAIT_V(4); PG8_BAR;
    PG8_STAGE(PG8_SB(1, 0), cB + kstep, voffB); PG8_STAGE(PG8_SA(1, 0), Ab + kstep, cu0); PG8_STAGE(PG8_SB(1, 1), cB + hstep + kstep, voffB);
    PG8_WAIT_V(6); PG8_BAR;
    PG8_STAMP();
    for (;;) {
        const bool has_next = S.next(ui + 1, nxt);
        const char* nB = has_next ? S.b_base(nxt) : cB;
#pragma unroll
        for (int i = 0; i < 2; ++i) { int R, C; stage_rc(tid * 16 + i * 8192, R, C);
            nxs[i] = has_next ? S.row_off(nxt, R) + C * 2 : cu0[i]; nxs[2 + i] = has_next ? S.row_off(nxt, R + HALF) + C * 2 : cu1[i]; }
#pragma unroll 1
        for (int t = 0; t < nt; t += 2) {
            const bool last = (t == nt - 2);
            const char* a1 = Ab + (size_t)(t + 1) * kstep;
            const char* a2 = last ? Ab : Ab + (size_t)(t + 2) * kstep; const char* b2 = last ? nB : cB + (size_t)(t + 2) * kstep;
            unsigned o0[2], o1[2];
#pragma unroll
            for (int i = 0; i < 2; ++i) { o0[i] = cu0[i]; o1[i] = cu1[i]; }
            if (last) {
#pragma unroll
                for (int i = 0; i < 2; ++i) { o0[i] = nxs[i]; o1[i] = nxs[2 + i]; } }
            const char* a3 = a2 + kstep; const char* b3 = b2 + kstep;
            if (last && has_next) S.a_ready(nxt);
            PG8_LDB(B0, 0, 0); PG8_SCHED; PG8_LDA(At, 0, 0); PG8_STAGE(PG8_SA(1, 1), a1, cu1);
            PG8_WAIT_L(8); PG8_BAR; PG8_WAIT_L(0); PG8_MMA(0, 0, At, B0); PG8_BAR; PG8_SCHED;
            PG8_LDB(B1, 0, 1); PG8_STAGE(PG8_SB(0, 0), b2, voffB);
            PG8_BAR; PG8_WAIT_L(0); PG8_MMA(0, 1, At, B1); PG8_BAR;
            PG8_LDA(At, 0, 1); PG8_STAGE(PG8_SA(0, 0), a2, o0);
            PG8_BAR; PG8_WAIT_L(0); PG8_MMA(1, 0, At, B0); PG8_BAR; PG8_SCHED;
            PG8_STAGE(PG8_SB(0, 1), b2 + hstep, voffB);
            PG8_WAIT_V(6); PG8_BAR; PG8_MMA(1, 1, At, B1); PG8_BAR;
            PG8_LDB(B0, 1, 0); PG8_SCHED; PG8_LDA(At, 1, 0); PG8_STAGE(PG8_SA(0, 1), a2, o1);
            PG8_WAIT_L(8); PG8_BAR; PG8_WAIT_L(0); PG8_MMA(0, 0, At, B0); PG8_BAR; PG8_SCHED;
            PG8_LDB(B1, 1, 1); PG8_STAGE(PG8_SB(1, 0), b3, voffB);
            PG8_BAR; PG8_WAIT_L(0); PG8_MMA(0, 1, At, B1); PG8_BAR;
            PG8_LDA(At, 1, 1); PG8_STAGE(PG8_SA(1, 0), a3, o0);
            PG8_BAR; PG8_WAIT_L(0); PG8_MMA(1, 0, At, B0); PG8_BAR; PG8_SCHED;
            PG8_STAGE(PG8_SB(1, 1), b3 + hstep, voffB);
            PG8_WAIT_V(6); PG8_BAR; PG8_MMA(1, 1, At, B1); PG8_BAR;
        }
        PG8_STAMP();
        if constexpr (!Epi::AFTER_DRAIN) { E(acc, cur, wr, wc, fr, fq); S.done(cur); }
        PG8_STAMP();
        if (!has_next) break;
#pragma unroll
        for (int a = 0; a < 2; ++a)
#pragma unroll
            for (int b = 0; b < 2; ++b)
#pragma unroll
                for (int m = 0; m < 4; ++m)
#pragma unroll
                    for (int n = 0; n < 2; ++n) acc[a][b][m][n] = (f32x4){0.f, 0.f, 0.f, 0.f};
        cur = nxt; cB = nB; ++ui;
#pragma unroll
        for (int i = 0; i < 2; ++i) { cu0[i] = nxs[i]; cu1[i] = nxs[2 + i]; }
    }
    PG8_WAIT_V(0);
    if (wr == 0) PG8_BAR;
    PG8_BAR;
    if constexpr (Epi::AFTER_DRAIN) { E.fused(acc, cur, wr, wc, fr, fq, lds, wid, lane); S.done(cur); }
    PG8_STAMP();
    if (STAMP && wid == 0) { stamps[lane] = lane < nts ? (((unsigned long long)(unsigned)ts_hi << 32) | (unsigned)ts_lo) : 0ull;
        if (lane == 62) stamps[62] = rt_entry; if (lane == 63) stamps[63] = 0ull; }
#undef PG8_STAMP
#undef PG8_SA
#undef PG8_SB
#undef PG8_STAGE
#undef PG8_LDA
#undef PG8_LDB
#undef PG8_MMA
#undef PG8_WAIT_V
#undef PG8_WAIT_L
#undef PG8_BAR
#undef PG8_SCHED
}


}

template <int WHICH>
__device__ __forceinline__ void phase_dense_gemm(const Params& p, char* lds) {
    unsigned char* ws = p.ws;
    constexpr int N = (WHICH == 0) ? EVEN_IN : (WHICH == 2) ? ODD_IN : D;
    pg8::Gemm g{(const bf16_t*)(ws + WS_XN), (const bf16_t*)(ws + (WHICH == 0 ? WS_WIN0 : WHICH == 1 ? WS_WOUT0 : WHICH == 2 ? WS_WIN1 : WS_WOUT1)), M, N, D};
    pg8::StaticOrder S; S.init(M, N, (int)gridDim.x, (int)blockIdx.x);
    if (WHICH == 0) { pg8::CountedOrder SC; SC.init(M, N, (int)gridDim.x, (int)blockIdx.x); SC.ready = (unsigned*)(ws + WS_CTL) + CTL_READY; SC.need = 4u; SC.readyb = (unsigned*)(ws + WS_CTL) + CTL_READY + 4096; SC.needb = 64u;
        pg8::EpiStore16 E{(bf16_t*)(ws + WS_P), N}; pg8::gemm_phase<pg8::EpiStore16, pg8::CountedOrder, false>((PG8_LAS unsigned char*)lds, g, SC, E, nullptr); }
    else if (WHICH == 2) { pg8::EpiStore16 E{(bf16_t*)(ws + WS_P), N}; pg8::gemm_phase<pg8::EpiStore16, pg8::StaticOrder, false>((PG8_LAS unsigned char*)lds, g, S, E, nullptr); }
    else { pg8::EpiResid16 E{WHICH == 1 ? p.x : nullptr, (bf16_t*)((char*)p.out + H16_OFF), D}; pg8::gemm_phase<pg8::EpiResid16, pg8::StaticOrder, false>((PG8_LAS unsigned char*)lds, g, S, E, nullptr); }
    __syncthreads();
}

struct MUnit { int e, mt, pn, cnt, slot0, mtg; };
struct MoeSchedBase {
    const int* sh;
    int nbx, lb, layer; unsigned char* ws;
    int xe0, xp1, xp2, xp3, xp4;
    __device__ __forceinline__ void decode(int lmt, MUnit& u) const {
        const int k = (lmt >= xp1) + (lmt >= xp2) + (lmt >= xp3), e = xe0 + 8 * k, pk = k == 0 ? 0 : k == 1 ? xp1 : k == 2 ? xp2 : xp3;
        u.e = e; u.mt = lmt - pk; u.cnt = sh[128 + e]; u.slot0 = sh[64 + e]; u.mtg = sh[e] + u.mt;
    }
    __device__ __forceinline__ unsigned* counter(int mtg) const { return (unsigned*)(ws + WS_CTL) + CTL_MOE + (layer * 160 + mtg) * 64; }
};
struct GuSched : MoeSchedBase {
    typedef MUnit UnitT;
    __device__ __forceinline__ bool next(int i, MUnit& u) const { const int ug = i * nbx + lb; if (ug >= 2 * xp4) return false; decode(ug >> 1, u); u.pn = ug & 1; return true; }
    __device__ __forceinline__ const char* a_base() const { return (const char*)(ws + WS_XN); }
    __device__ __forceinline__ unsigned row_off(const MUnit& u, int R) const { int ml = u.mt * 256 + R; ml = ml < u.cnt ? ml : u.cnt - 1;
        return (unsigned)(((const int*)(ws + WS_LTOK))[(size_t)u.e * M + ml] >> 1) * 2048u; }
    __device__ __forceinline__ const char* b_base(const MUnit& u) const { return (const char*)(ws + WS_WGU) + ((size_t)((layer * 32 + u.e) * 2 + u.pn) * 256) * 2048; }
    __device__ __forceinline__ void a_ready(const MUnit&) const {}
    __device__ __forceinline__ void done(const MUnit& u) const {
        asm volatile("s_waitcnt vmcnt(0)" ::: "memory");
        if ((threadIdx.x & 63) == 0) __hip_atomic_fetch_add(counter(u.mtg), 1u, __ATOMIC_RELAXED, __HIP_MEMORY_SCOPE_AGENT);
    }
};
struct DnSched : MoeSchedBase {
    typedef MUnit UnitT;
    int x, nb1;
    __device__ __forceinline__ bool next(int i, MUnit& u) const { if (lb < x) return false; const int ud = i * nb1 + (lb - x); if (ud >= 4 * xp4) return false; decode(ud >> 2, u); u.pn = ud & 3; return true; }
    __device__ __forceinline__ const char* a_base() const { return (const char*)(ws + WS_P + P_HID); }
    __device__ __forceinline__ unsigned row_off(const MUnit& u, int R) const { return (unsigned)(u.slot0 + u.mt * 256 + R) * 512u; }
    __device__ __forceinline__ const char* b_base(const MUnit& u) const { return (const char*)(ws + WS_WD) + ((size_t)(layer * 32 + u.e) * 1024 + u.pn * 256) * 512; }
    __device__ __forceinline__ void a_ready(const MUnit& u) const {
        if (threadIdx.x < 64) {
            unsigned polls = 0; unsigned* c = counter(u.mtg);
            while ((unsigned)__builtin_amdgcn_readfirstlane(__hip_atomic_load(c, __ATOMIC_RELAXED, __HIP_MEMORY_SCOPE_AGENT)) < 16u) { if (++polls > (1u << 22)) break; __builtin_amdgcn_s_sleep(2); }
            __builtin_amdgcn_fence(__ATOMIC_ACQUIRE, "agent");
            asm volatile("s_waitcnt vmcnt(0)" ::: "memory");
        }
        asm volatile("" ::: "memory"); __builtin_amdgcn_s_barrier(); asm volatile("" ::: "memory");
    }
    __device__ __forceinline__ void done(const MUnit&) const {}
};
struct EpiGU {
    static constexpr bool PERM = true, AFTER_DRAIN = false;
    unsigned char* ws;
    __device__ __forceinline__ void operator()(const pg8::f32x4 (&acc)[2][2][4][2], const MUnit& u, int wr, int wc, int fr, int fq) const {
        bf16_t* HID = (bf16_t*)(ws + WS_P + P_HID); const float* lgate = (const float*)(ws + WS_LGATE) + (size_t)u.e * M;
#pragma unroll
        for (int ai = 0; ai < 2; ++ai)
#pragma unroll
            for (int m = 0; m < 4; ++m) { const int ml = u.mt * 256 + ai * 128 + wr * 64 + m * 16 + fr;
                if (ml < u.cnt) { const float gt = lgate[ml]; float h[8];
#pragma unroll
                    for (int n = 0; n < 2; ++n)
#pragma unroll
                        for (int e = 0; e < 4; ++e) h[n * 4 + e] = siluf_(acc[ai][0][m][n][e]) * acc[ai][1][m][n][e] * gt;
                    unsigned long long* dp = (unsigned long long*)(HID + (size_t)(u.slot0 + ml) * 256 + u.pn * 128 + wc * 32 + 8 * fq);
                    __hip_atomic_store(dp, ((unsigned long long)pack2(h[2], h[3]) << 32) | pack2(h[0], h[1]), __ATOMIC_RELAXED, __HIP_MEMORY_SCOPE_AGENT);
                    __hip_atomic_store(dp + 1, ((unsigned long long)pack2(h[6], h[7]) << 32) | pack2(h[4], h[5]), __ATOMIC_RELAXED, __HIP_MEMORY_SCOPE_AGENT); } }
    }
};
struct EpiDn {
    static constexpr bool PERM = true, AFTER_DRAIN = false;
    unsigned char* ws;
    __device__ __forceinline__ void operator()(const pg8::f32x4 (&acc)[2][2][4][2], const MUnit& u, int wr, int wc, int fr, int fq) const {
        bf16_t* Y = (bf16_t*)(ws + WS_P + P_Y); const int* ltok = (const int*)(ws + WS_LTOK) + (size_t)u.e * M;
#pragma unroll
        for (int ai = 0; ai < 2; ++ai)
#pragma unroll
            for (int m = 0; m < 4; ++m) { const int ml = u.mt * 256 + ai * 128 + wr * 64 + m * 16 + fr;
                if (ml < u.cnt) { const int tk = ltok[ml]; bf16_t* rowp = Y + ((size_t)(tk & 1) * M + (tk >> 1)) * D + u.pn * 256 + wc * 32 + 8 * fq;
#pragma unroll
                    for (int bj = 0; bj < 2; ++bj) { const pg8::f32x4 v0 = acc[ai][bj][m][0], v1 = acc[ai][bj][m][1];
                        u32x4 w; w.x = pack2(v0[0], v0[1]); w.y = pack2(v0[2], v0[3]); w.z = pack2(v1[0], v1[1]); w.w = pack2(v1[2], v1[3]);
                        *(u32x4*)(rowp + bj * 128) = w; } } }
    }
};
__device__ __forceinline__ void phase_moe_merged(const Params& p, char* lds, int layer) {
    unsigned char* ws = p.ws;
    int* sh = (int*)(lds + 147456);
    const int* cntg = (const int*)(ws + WS_CTL) + CTL_CNT + layer * 32;
    if (threadIdx.x == 0) { int tp = 0, sp = 0;
        for (int e = 0; e < 32; ++e) { const int c = cntg[e]; sh[e] = tp; sh[64 + e] = sp; sh[128 + e] = c; tp += (c + 255) >> 8; sp += c; }
        sh[32] = tp; }
    __syncthreads();
    const int G = (int)gridDim.x, b = (int)blockIdx.x;
    GuSched SG; DnSched SD;
    {
        const int grp = b & 7, nbx = (G - grp + 7) >> 3, lb = b >> 3;
        const int m0 = sh[grp + 1] - sh[grp], m1 = sh[grp + 9] - sh[grp + 8], m2 = sh[grp + 17] - sh[grp + 16], m3 = sh[grp + 25] - sh[grp + 24];
        SG.sh = sh; SG.nbx = nbx; SG.lb = lb; SG.layer = layer; SG.ws = ws; SG.xe0 = grp; SG.xp1 = m0; SG.xp2 = m0 + m1; SG.xp3 = m0 + m1 + m2; SG.xp4 = m0 + m1 + m2 + m3;
        SD.sh = sh; SD.nbx = nbx; SD.lb = lb; SD.layer = layer; SD.ws = ws; SD.xe0 = grp; SD.xp1 = SG.xp1; SD.xp2 = SG.xp2; SD.xp3 = SG.xp3; SD.xp4 = SG.xp4;
        const int ngu = 2 * SG.xp4;
        SD.x = (ngu > nbx && ngu < 2 * nbx) ? ngu - nbx : 0; SD.nb1 = nbx - SD.x;
    }
    EpiGU EG{ws}; EpiDn ED{ws};
    pg8::gemm_phase_g<EpiGU, GuSched, 1024>((PG8_LAS unsigned char*)lds, SG, EG);
    pg8::gemm_phase_g<EpiDn, DnSched, 256>((PG8_LAS unsigned char*)lds, SD, ED);
    __syncthreads();
}

__device__ __forceinline__ void phase_post0(const Params& p) {
    const int tid = threadIdx.x, lane = tid & 63, wave = tid >> 6;
    unsigned char* ws = p.ws;
    bf16_t* O16 = (bf16_t*)(ws + WS_XN);
    const bf16_t* P = (const bf16_t*)(ws + WS_P);
    const bf16_t* AUX = (const bf16_t*)p.out;
    const int c0 = lane * 16;
    for (int ti_ = blockIdx.x * 8 + wave; ti_ < M; ti_ += gridDim.x * 8) {
        const int tok = (gridDim.x == 256) ? (((ti_ >> 3) & 7) * 2048 + ((ti_ >> 6) & 31) * 64 + (ti_ >> 11) * 8 + (ti_ & 7)) : ti_;
        const u32x4 r0 = *(const u32x4*)(O16 + (size_t)tok * D + c0), r1 = *(const u32x4*)(O16 + (size_t)tok * D + c0 + 8);
        float y[16];
        y[0] = lo16(r0.x); y[1] = hi16(r0.x); y[2] = lo16(r0.y); y[3] = hi16(r0.y); y[4] = lo16(r0.z); y[5] = hi16(r0.z); y[6] = lo16(r0.w); y[7] = hi16(r0.w);
        y[8] = lo16(r1.x); y[9] = hi16(r1.x); y[10] = lo16(r1.y); y[11] = hi16(r1.y); y[12] = lo16(r1.z); y[13] = hi16(r1.z); y[14] = lo16(r1.w); y[15] = hi16(r1.w);
        float o[16];
        if (lane < 32) {
            float s = 0.f;
#pragma unroll
            for (int j = 0; j < 16; ++j) s += y[j];
            s += dppf<0xB1>(s); s += dppf<0x4E>(s);
            const float mean = s * (1.0f / 64.0f);
            float q = 0.f;
#pragma unroll
            for (int j = 0; j < 16; ++j) { const float d = y[j] - mean; q += d * d; }
            q += dppf<0xB1>(q); q += dppf<0x4E>(q);
            const float rstd = rsqrtf(q * (1.0f / 64.0f) + 64e-5f);
#pragma unroll
            for (int j4 = 0; j4 < 4; ++j4) {
                const float4 lw = *(const float4*)(p.rw_ln_w + c0 + j4 * 4), lb = *(const float4*)(p.rw_ln_b + c0 + j4 * 4);
                const u32x2 bq = *(const u32x2*)(AUX + (size_t)tok * D + c0 + j4 * 4), gq = *(const u32x2*)(AUX + (size_t)tok * D + 512 + c0 + j4 * 4);
                float4 bv, gv; bv.x = lo16(bq.x); bv.y = hi16(bq.x); bv.z = lo16(bq.y); bv.w = hi16(bq.y); gv.x = lo16(gq.x); gv.y = hi16(gq.x); gv.z = lo16(gq.y); gv.w = hi16(gq.y);
                o[j4 * 4 + 0] = ((y[j4 * 4 + 0] - mean) * rstd * lw.x + lb.x + bv.x) * gv.x;
                o[j4 * 4 + 1] = ((y[j4 * 4 + 1] - mean) * rstd * lw.y + lb.y + bv.y) * gv.y;
                o[j4 * 4 + 2] = ((y[j4 * 4 + 2] - mean) * rstd * lw.z + lb.z + bv.z) * gv.z;
                o[j4 * 4 + 3] = ((y[j4 * 4 + 3] - mean) * rstd * lw.w + lb.w + bv.w) * gv.w;
            }
        } else {
            float q = 0.f;
#pragma unroll
            for (int j = 0; j < 16; ++j) q += y[j] * y[j];
            q += dppf<0xB1>(q); q += dppf<0x4E>(q);
            const float rstd = rsqrtf(q * (1.0f / 64.0f) + 1e-6f);
            const int cc = c0 - 512;
            const u32x4 g0 = *(const u32x4*)(P + (size_t)tok * EVEN_IN + 1792 + 1536 + cc), g1 = *(const u32x4*)(P + (size_t)tok * EVEN_IN + 1792 + 1536 + cc + 8);
            float gt[16];
            gt[0] = lo16(g0.x); gt[1] = hi16(g0.x); gt[2] = lo16(g0.y); gt[3] = hi16(g0.y); gt[4] = lo16(g0.z); gt[5] = hi16(g0.z); gt[6] = lo16(g0.w); gt[7] = hi16(g0.w);
            gt[8] = lo16(g1.x); gt[9] = hi16(g1.x); gt[10] = lo16(g1.y); gt[11] = hi16(g1.y); gt[12] = lo16(g1.z); gt[13] = hi16(g1.z); gt[14] = lo16(g1.w); gt[15] = hi16(g1.w);
#pragma unroll
            for (int j = 0; j < 16; ++j) o[j] = y[j] * rstd * p.hg_norm[(cc + j) & 63] * siluf_(gt[j]);
        }
        u32x4 w0, w1;
        w0.x = pack2(o[0], o[1]); w0.y = pack2(o[2], o[3]); w0.z = pack2(o[4], o[5]); w0.w = pack2(o[6], o[7]);
        w1.x = pack2(o[8], o[9]); w1.y = pack2(o[10], o[11]); w1.z = pack2(o[12], o[13]); w1.w = pack2(o[14], o[15]);
        *(u32x4*)(O16 + (size_t)tok * D + c0) = w0; *(u32x4*)(O16 + (size_t)tok * D + c0 + 8) = w1;
    }
}


__device__ __forceinline__ bf16x8 frag_rm(const bf16_t* base, int ld, int lane) { return *(const bf16x8*)(base + (lane & 15) * ld + 8 * (lane >> 4)); }
__device__ __forceinline__ bf16x8 frag_tr(const bf16_t* base, int ld, int lane) {
    const int g = lane >> 4, i = lane & 15;
    const bf16_t* a0 = base + (8 * g + (i >> 2)) * ld + 4 * (i & 3);
    const s16x4 lo = __builtin_amdgcn_ds_read_tr16_b64_v4i16((LAS s16x4*)a0);
    const s16x4 hi = __builtin_amdgcn_ds_read_tr16_b64_v4i16((LAS s16x4*)(a0 + 4 * ld));
    bf16x8 r; r[0] = lo[0]; r[1] = lo[1]; r[2] = lo[2]; r[3] = lo[3]; r[4] = hi[0]; r[5] = hi[1]; r[6] = hi[2]; r[7] = hi[3];
    return r;
}
__device__ __forceinline__ float red8(float x) { x += dppf<0xB1>(x); x += dppf<0x4E>(x); x += dppf<0x141>(x); return x; }


__device__ __forceinline__ void tri_inverse_wave(const float* Nf, const bf16_t* Nb, bf16_t* Tb, bf16_t* Wb, int lane) {
    const int g = lane >> 4, li = lane & 15;
    {
        float Tc[16];
        const float* Nrow = Nf + (16 * g) * 68 + 16 * g;
#pragma unroll
        for (int i = 0; i < 16; ++i) {
            float acc = (i == li) ? 1.f : 0.f;
#pragma unroll
            for (int j = 0; j < i; ++j) acc -= Nrow[i * 68 + j] * Tc[j];
            Tc[i] = acc;
        }
#pragma unroll
        for (int i = 0; i < 16; ++i) Tb[(16 * g + i) * 72 + 16 * g + li] = f2bf(Tc[i]);
    }
    asm volatile("s_waitcnt lgkmcnt(0)" ::: "memory");
#pragma unroll
    for (int dl = 1; dl < 4; ++dl) {
#pragma unroll
        for (int j = 0; j + dl < 4; ++j) {
            const int i = j + dl;
            f32x4v w; w[0] = 0.f; w[1] = 0.f; w[2] = 0.f; w[3] = 0.f;
#pragma unroll
            for (int k0 = 0; k0 < 16 * dl; k0 += 32) {
                bf16x8 a = frag_rm(Nb + (16 * i) * 72 + 16 * j + k0, 72, lane);
                const bf16x8 b = frag_tr(Tb + (16 * j + k0) * 72 + 16 * j, 72, lane);
                if (k0 + 8 * g >= 16 * dl) { a[0] = 0; a[1] = 0; a[2] = 0; a[3] = 0; a[4] = 0; a[5] = 0; a[6] = 0; a[7] = 0; }
                w = MFMA16(a, b, w);
            }
#pragma unroll
            for (int r = 0; r < 4; ++r) Wb[(4 * g + r) * 24 + li] = f2bf(w[r]);
            asm volatile("s_waitcnt lgkmcnt(0)" ::: "memory");
            bf16x8 a = frag_rm(Tb + (16 * i) * 72 + 16 * i, 72, lane);
            if (g >= 2) { a[0] = 0; a[1] = 0; a[2] = 0; a[3] = 0; a[4] = 0; a[5] = 0; a[6] = 0; a[7] = 0; }
            const bf16x8 b = frag_tr(Wb, 24, lane);
            f32x4v t; t[0] = 0.f; t[1] = 0.f; t[2] = 0.f; t[3] = 0.f;
            t = MFMA16(a, b, t);
#pragma unroll
            for (int r = 0; r < 4; ++r) Tb[(16 * i + 4 * g + r) * 72 + 16 * j + li] = f2bf(-t[r]);
            asm volatile("s_waitcnt lgkmcnt(0)" ::: "memory");
        }
    }
}


__device__ __forceinline__ void hg_pre_item(const Params& p, char* lds, int id) {
    const int tid = threadIdx.x, lane = tid & 63, wave = tid >> 6, g = lane >> 4, li = lane & 15;
    const int bb = id >> 8, hh = (id >> 5) & 7, c = id & 31;
    unsigned char* ws = p.ws;
    const bf16_t* P = (const bf16_t*)(ws + WS_P);
    unsigned char* item = ws + WS_CHK_HG + (size_t)id * CHK_HG_ITEM;
    float* LG = (float*)lds;
    bf16_t* QV = (bf16_t*)(lds + 17408);
    bf16_t* KV = (bf16_t*)(lds + 26624);
    bf16_t* QT = (bf16_t*)(lds + 35840);
    bf16_t* KT = (bf16_t*)(lds + 45056);
    bf16_t* AyS = (bf16_t*)(lds + 81920);
    const int t = tid >> 3, part = tid & 7, d0 = part * 8;
    const size_t tok = (size_t)bb * SEQ + c * 64 + t;
    {
        const u32x4 q8 = *(const u32x4*)(P + tok * EVEN_IN + 1792 + hh * 64 + d0);
        const u32x4 f8 = *(const u32x4*)(P + tok * EVEN_IN + 1792 + 512 + hh * 64 + d0);
        float qv[8], fv[8];
        qv[0] = lo16(q8.x); qv[1] = hi16(q8.x); qv[2] = lo16(q8.y); qv[3] = hi16(q8.y); qv[4] = lo16(q8.z); qv[5] = hi16(q8.z); qv[6] = lo16(q8.w); qv[7] = hi16(q8.w);
        fv[0] = lo16(f8.x); fv[1] = hi16(f8.x); fv[2] = lo16(f8.y); fv[3] = hi16(f8.y); fv[4] = lo16(f8.z); fv[5] = hi16(f8.z); fv[6] = lo16(f8.w); fv[7] = hi16(f8.w);
        float kq[8];
#pragma unroll
        for (int e = 0; e < 8; ++e) {
            const float lbv = ((const float*)(lds + 131072))[320 + d0 + e];
            const float fg = lbv + (1.f - lbv) * sigmoidf_(fv[e]);
            LG[t * 68 + d0 + e] = __logf(fg);
            qv[e] = siluf_(qv[e]); kq[e] = 1.f - fg;
        }
        u32x4 o; o.x = pack2(qv[0], qv[1]); o.y = pack2(qv[2], qv[3]); o.z = pack2(qv[4], qv[5]); o.w = pack2(qv[6], qv[7]);
        *(u32x4*)(QV + t * 72 + d0) = o;
        o.x = pack2(kq[0], kq[1]); o.y = pack2(kq[2], kq[3]); o.z = pack2(kq[4], kq[5]); o.w = pack2(kq[6], kq[7]);
        *(u32x4*)(KV + t * 72 + d0) = o;
    }
    __syncthreads();
    if (tid < 64) { float run = 0.f;
#pragma unroll 8
        for (int s = 0; s < 64; ++s) { run += LG[s * 68 + tid]; LG[s * 68 + tid] = run; } }
    __syncthreads();
    {
        const int blk = t >> 4;
        const u32x4 q8 = *(const u32x4*)(QV + t * 72 + d0), k8 = *(const u32x4*)(KV + t * 72 + d0);
        float qv[8], kv[8];
        qv[0] = lo16(q8.x); qv[1] = hi16(q8.x); qv[2] = lo16(q8.y); qv[3] = hi16(q8.y); qv[4] = lo16(q8.z); qv[5] = hi16(q8.z); qv[6] = lo16(q8.w); qv[7] = hi16(q8.w);
        kv[0] = lo16(k8.x); kv[1] = hi16(k8.x); kv[2] = lo16(k8.y); kv[3] = hi16(k8.y); kv[4] = lo16(k8.z); kv[5] = hi16(k8.z); kv[6] = lo16(k8.w); kv[7] = hi16(k8.w);
        float lc[8], rp[8], kc[8], qt[8];
#pragma unroll
        for (int e = 0; e < 8; ++e) {
            lc[e] = LG[t * 68 + d0 + e];
            const float lcl = LG[63 * 68 + d0 + e];
            const float ref = blk ? LG[(16 * blk - 1) * 68 + d0 + e] : 0.f;
            rp[e] = qv[e] * __expf(lc[e]); kc[e] = kv[e] * __expf(lcl - lc[e]); qt[e] = qv[e] * __expf(lc[e] - ref);
            if (t == 0) ((float*)(item + 24576))[d0 + e] = __expf(lcl);
        }
        u32x4 o; o.x = pack2(rp[0], rp[1]); o.y = pack2(rp[2], rp[3]); o.z = pack2(rp[4], rp[5]); o.w = pack2(rp[6], rp[7]);
        *(u32x4*)(item + t * 128 + part * 16) = o;
        o.x = pack2(kc[0], kc[1]); o.y = pack2(kc[2], kc[3]); o.z = pack2(kc[4], kc[5]); o.w = pack2(kc[6], kc[7]);
        *(u32x4*)(item + 16384 + t * 128 + part * 16) = o;
        o.x = pack2(qt[0], qt[1]); o.y = pack2(qt[2], qt[3]); o.z = pack2(qt[4], qt[5]); o.w = pack2(qt[6], qt[7]);
        *(u32x4*)(QT + t * 72 + d0) = o;
#pragma unroll
        for (int ib = 0; ib < 4; ++ib) {
            if (ib >= blk) {
                float kt[8];
#pragma unroll
                for (int e = 0; e < 8; ++e) { const float ref = ib ? LG[(16 * ib - 1) * 68 + d0 + e] : 0.f; kt[e] = kv[e] * __expf(fminf(ref - lc[e], 80.f)); }
                o.x = pack2(kt[0], kt[1]); o.y = pack2(kt[2], kt[3]); o.z = pack2(kt[4], kt[5]); o.w = pack2(kt[6], kt[7]);
                *(u32x4*)(KT + (ib * 64 + t) * 72 + d0) = o;
            }
        }
    }
    __syncthreads();
    {
        const int ti = wave >> 1;
#pragma unroll
        for (int jj = 0; jj < 2; ++jj) {
            const int tj = (wave & 1) * 2 + jj, s = tj * 16 + li;
            f32x4v acc; acc[0] = 0.f; acc[1] = 0.f; acc[2] = 0.f; acc[3] = 0.f;
            if (tj <= ti) {
#pragma unroll
                for (int k0 = 0; k0 < 64; k0 += 32) acc = MFMA16(frag_rm(QT + ti * 16 * 72 + k0, 72, lane), frag_rm(KT + (ti * 64 + tj * 16) * 72 + k0, 72, lane), acc);
#pragma unroll
                for (int r = 0; r < 4; ++r) if (s > ti * 16 + 4 * g + r) acc[r] = 0.f;
            }
#pragma unroll
            for (int r = 0; r < 4; ++r) AyS[(ti * 16 + 4 * g + r) * 72 + s] = f2bf(acc[r]);
        }
    }
    __syncthreads();
    *(u32x4*)(item + 8192 + t * 128 + part * 16) = *(const u32x4*)(AyS + t * 72 + d0);
    __syncthreads();
}


__device__ __forceinline__ void rw_pre_load(const Params& p, int id, u32x4 (&rw)[9]) {
    const int tid = threadIdx.x;
    if (tid < 448) {
        const int bb = id >> 8, hh = (id >> 5) & 7, c = id & 31;
        const int q = tid % 56, tg = tid / 56;
        int pcol;
        if (q < 24) pcol = (q >> 3) * 512 + hh * 64 + (q & 7) * 8; else if (q < 32) pcol = 1536 + (q - 24) * 8; else if (q < 40) pcol = 1600 + (q - 32) * 8; else pcol = 1664 + (q - 40) * 8;
        const bf16_t* src_ = (const bf16_t*)(p.ws + WS_P) + ((size_t)bb * SEQ + c * 64 + tg * 8) * EVEN_IN + pcol;
        rw[0].x = 0u; rw[0].y = 0u; rw[0].z = 0u; rw[0].w = 0u;
        if (c * 64 + tg * 8 > 0) rw[0] = *(const u32x4*)(src_ - EVEN_IN);
#pragma unroll
        for (int i = 0; i < 8; ++i) rw[i + 1] = *(const u32x4*)(src_ + (size_t)i * EVEN_IN);
    }
}

__device__ __forceinline__ float tanhf_(float x) { return 1.0f - 2.0f * __builtin_amdgcn_rcpf(1.0f + __expf(2.0f * x)); }
__device__ __forceinline__ void unpack8(const u32x4& v, float* f) { f[0] = lo16(v.x); f[1] = hi16(v.x); f[2] = lo16(v.y); f[3] = hi16(v.y); f[4] = lo16(v.z); f[5] = hi16(v.z); f[6] = lo16(v.w); f[7] = hi16(v.w); }
__device__ __forceinline__ u32x4 pack8(const float* f) { u32x4 o; o.x = pack2(f[0], f[1]); o.y = pack2(f[2], f[3]); o.z = pack2(f[4], f[5]); o.w = pack2(f[6], f[7]); return o; }

__device__ __forceinline__ void rw_pre_item(const Params& p, char* lds0, int id, u32x4 (&rw)[9], int next_id) {
    const int tid = threadIdx.x, lane = tid & 63, wave = tid >> 6, g = lane >> 4, li = lane & 15;
    const int bb = id >> 8, hh = (id >> 5) & 7, c = id & 31;
    int lz = 0; asm volatile("" : "+s"(lz));
    char* lds = lds0 + lz;
    unsigned char* ws = p.ws;
    const bf16_t* P = (const bf16_t*)(ws + WS_P);
    unsigned char* item = ws + WS_CHK_RW + (size_t)id * CHK_RW_ITEM;
    bf16_t* AUX = (bf16_t*)p.out;
    bf16_t* w2h = (bf16_t*)(lds + 0);
    bf16_t* a2h = (bf16_t*)(lds + 9216);
    bf16_t* g2h = (bf16_t*)(lds + 18432);
    bf16_t* TW = (bf16_t*)(lds + 36864);
    bf16_t* AL = (bf16_t*)(lds + 46080);
    bf16_t* SG = (bf16_t*)(lds + 55296);
    bf16_t* Rt = (bf16_t*)(lds + 0);
    bf16_t* At = (bf16_t*)(lds + 9216);
    bf16_t* Kh = (bf16_t*)(lds + 18432);
    bf16_t* Bh = (bf16_t*)(lds + 27648);
    bf16_t* Kt = (bf16_t*)(lds + 36864);
    bf16_t* Bt = (bf16_t*)(lds + 46080);
    bf16_t* Ap = (bf16_t*)(lds + 36864);
    bf16_t* Wv = (bf16_t*)(lds + 46080);
    bf16_t* Tb = (bf16_t*)(lds + 55296);
    bf16_t* Wb = (bf16_t*)(lds + 64512);
    float* GLs = (float*)(lds + 66048);
    float* TT = (float*)(lds + 132608);
    bf16_t* RS = (bf16_t*)(lds + 72704);
    bf16_t* KS = (bf16_t*)(lds + 81920);
    bf16_t* VS = (bf16_t*)(lds + 91136);
    float* LD = (float*)(lds + 100352);
    bf16_t* AG = (bf16_t*)(lds + 117760);
    bf16_t* Ark = (bf16_t*)(lds + 72704);
    bf16_t* Arb = (bf16_t*)(lds + 81920);
    bf16_t* Aak = (bf16_t*)(lds + 91136);
    bf16_t* Nb = (bf16_t*)(lds + 100352);
    float* Nf = (float*)(lds + 109568);
    bf16_t* OutA = Aak; bf16_t* OutB = Nb; bf16_t* OutC = Tb; bf16_t* OutD = (bf16_t*)Nf;
    const size_t tok0 = (size_t)bb * SEQ + c * 64;
    {
        const bf16_t* RWW = (const bf16_t*)(ws + WS_RWW) + (size_t)hh * 256 * 64;
#pragma unroll
        for (int i = 0; i < 4; ++i) { const int idx = tid + NT * i, r = idx >> 3, c8 = idx & 7; *(u32x4*)(w2h + r * 72 + c8 * 8) = *(const u32x4*)(RWW + r * 64 + c8 * 8); }
    }
    if (tid < 448) {
        const int q = tid % 56, tg = tid / 56;
        int pcol, role, lc;
        if (q < 24) { role = q >> 3; lc = (q & 7) * 8; pcol = role * 512 + hh * 64 + lc; }
        else if (q < 32) { role = 3; lc = (q - 24) * 8; pcol = 1536 + lc; }
        else if (q < 40) { role = 4; lc = (q - 32) * 8; pcol = 1600 + lc; }
        else { role = 5; lc = (q - 40) * 8; pcol = 1664 + lc; }
        const float4 m0 = *(const float4*)(p.ev_mu + pcol), m1 = *(const float4*)(p.ev_mu + pcol + 4);
        float y[8]; unpack8(rw[0], y);
        bf16_t* dst = (role == 0 ? RS : role == 1 ? KS : role == 2 ? VS : role == 3 ? TW : role == 4 ? AL : SG) + lc;
        const int dstride = role == 5 ? 136 : 72;
#pragma unroll
        for (int i = 0; i < 8; ++i) {
            float x[8], s[8]; unpack8(rw[i + 1], x);
            s[0] = x[0] + m0.x * (y[0] - x[0]); s[1] = x[1] + m0.y * (y[1] - x[1]); s[2] = x[2] + m0.z * (y[2] - x[2]); s[3] = x[3] + m0.w * (y[3] - x[3]);
            s[4] = x[4] + m1.x * (y[4] - x[4]); s[5] = x[5] + m1.y * (y[5] - x[5]); s[6] = x[6] + m1.z * (y[6] - x[6]); s[7] = x[7] + m1.w * (y[7] - x[7]);
#pragma unroll
            for (int e = 0; e < 8; ++e) y[e] = x[e];
            if (role == 3) {
#pragma unroll
                for (int e = 0; e < 8; ++e) s[e] = tanhf_(s[e]);
            } else if (role == 5) {
#pragma unroll
                for (int e = 0; e < 8; ++e) s[e] = sigmoidf_(s[e]);
            }
            *(u32x4*)(dst + (tg * 8 + i) * dstride) = pack8(s);
        }
    }
    if (next_id >= 0) rw_pre_load(p, next_id, rw);
    __syncthreads();
#pragma unroll 1
    for (int q = 0; q < 2; ++q) {
        const int T = wave * 2 + q, ti = T >> 2, cj = T & 3;
        f32x4v aw, aa, ag; aw[0] = 0.f; aw[1] = 0.f; aw[2] = 0.f; aw[3] = 0.f; aa = aw; ag = aw;
#pragma unroll
        for (int k0 = 0; k0 < 64; k0 += 32) {
            aw = MFMA16(frag_rm(TW + ti * 16 * 72 + k0, 72, lane), frag_tr(w2h + k0 * 72 + cj * 16, 72, lane), aw);
            aa = MFMA16(frag_rm(AL + ti * 16 * 72 + k0, 72, lane), frag_tr(a2h + k0 * 72 + cj * 16, 72, lane), aa);
        }
#pragma unroll
        for (int k0 = 0; k0 < 128; k0 += 32) ag = MFMA16(frag_rm(SG + ti * 16 * 136 + k0, 136, lane), frag_tr(g2h + k0 * 72 + cj * 16, 72, lane), ag);
        const int cc = cj * 16 + li;
        const float* PRM = (const float*)(lds0 + 131072);
        const float w0 = PRM[cc], a0 = PRM[64 + cc];
        float ldv[4];
#pragma unroll
        for (int r = 0; r < 4; ++r) {
            const int t = ti * 16 + 4 * g + r;
            ldv[r] = -0.6065306597126334f * sigmoidf_(aw[r] + w0);
            AG[t * 72 + cc] = f2bf(sigmoidf_(aa[r] + a0));
            AUX[(tok0 + t) * D + 512 + hh * 64 + cc] = f2bf(ag[r]);
        }
        ldv[1] += ldv[0]; ldv[2] += ldv[1]; ldv[3] += ldv[2];
        const float s16 = __shfl_up(ldv[3], 16), s32 = __shfl_up(ldv[3], 32), s48 = __shfl_up(ldv[3], 48);
        const float off = (g >= 1 ? s16 : 0.f) + (g >= 2 ? s32 : 0.f) + (g >= 3 ? s48 : 0.f);
#pragma unroll
        for (int r = 0; r < 4; ++r) LD[(ti * 16 + 4 * g + r) * 68 + cc] = ldv[r] + off;
        if (g == 3) TT[ti * 64 + cc] = ldv[3] + off;
    }
    __syncthreads();
    {
        const int t = tid >> 3, part = tid & 7, c0 = part * 8;
        float rs[8], ks[8], vs[8], ag[8];
        unpack8(*(const u32x4*)(RS + t * 72 + c0), rs); unpack8(*(const u32x4*)(KS + t * 72 + c0), ks); unpack8(*(const u32x4*)(VS + t * 72 + c0), vs); unpack8(*(const u32x4*)(AG + t * 72 + c0), ag);
        const float* PRM2 = (const float*)(lds0 + 131072);
        float kk[8], k2[8], bv[8], ss = 0.f, bon = 0.f;
#pragma unroll
        for (int e = 0; e < 8; ++e) {
            kk[e] = ks[e] * PRM2[128 + c0 + e]; ss += kk[e] * kk[e];
            k2[e] = ks[e] * (1.f + (ag[e] - 1.f) * PRM2[192 + c0 + e]);
            bon += rs[e] * k2[e] * PRM2[256 + c0 + e];
        }
        ss = red8(ss); bon = red8(bon);
        const float nrm = rsqrtf(ss + 1e-6f);
        float o1[8], o2[8], o3[8], o4[8], o5[8], o6[8];
#pragma unroll
        for (int e = 0; e < 8; ++e) {
            kk[e] *= nrm; bv[e] = kk[e] * ag[e];
            const int tiq = t >> 4; const float t0_ = TT[c0 + e], t1_ = TT[64 + c0 + e], t2_ = TT[128 + c0 + e];
            const float toff = (tiq >= 1 ? t0_ : 0.f) + (tiq >= 2 ? t1_ : 0.f) + (tiq >= 3 ? t2_ : 0.f);
            const float poff = ((t & 15) == 0 && t > 0) ? toff - (tiq == 1 ? t0_ : tiq == 2 ? t1_ : t2_) : toff;
            const float lc = LD[t * 68 + c0 + e] + toff, lcp = t ? LD[(t - 1) * 68 + c0 + e] + poff : 0.f, lcl = LD[63 * 68 + c0 + e] + t0_ + t1_ + t2_;
            const float eg = __expf(lc), egp = __expf(lcp), ei = __expf(-lc), eh = __expf(lcl - lc);
            o1[e] = rs[e] * eg; o2[e] = -kk[e] * egp; o3[e] = k2[e] * ei; o4[e] = bv[e] * ei; o5[e] = k2[e] * eh; o6[e] = bv[e] * eh;
            if (t == 0) GLs[c0 + e] = __expf(lcl);
            vs[e] *= bon;
        }
        *(u32x4*)(AUX + (tok0 + t) * D + hh * 64 + c0) = pack8(vs);
        *(u32x4*)(Rt + t * 72 + c0) = pack8(o1); *(u32x4*)(At + t * 72 + c0) = pack8(o2); *(u32x4*)(Kt + t * 72 + c0) = pack8(o3);
        *(u32x4*)(Bt + t * 72 + c0) = pack8(o4); *(u32x4*)(Kh + t * 72 + c0) = pack8(o5); *(u32x4*)(Bh + t * 72 + c0) = pack8(o6);
        for (int i = tid; i < 64 * 72 / 2; i += NT) ((unsigned*)Tb)[i] = 0u;
        for (int i = tid; i < 32 * 24 / 2; i += NT) ((unsigned*)Wb)[i] = 0u;
    }
    __syncthreads();
    {
        const int ti = wave >> 1;
#pragma unroll 1
        for (int jj = 0; jj < 2; ++jj) {
            const int tj = (wave & 1) * 2 + jj, s = tj * 16 + li;
            f32x4v ab; ab[0] = 0.f; ab[1] = 0.f; ab[2] = 0.f; ab[3] = 0.f;
            if (tj <= ti) {
#pragma unroll
                for (int k0 = 0; k0 < 64; k0 += 32) ab = MFMA16(frag_rm(At + ti * 16 * 72 + k0, 72, lane), frag_rm(Bt + tj * 16 * 72 + k0, 72, lane), ab);
#pragma unroll
                for (int r = 0; r < 4; ++r) if (s >= ti * 16 + 4 * g + r) ab[r] = 0.f;
            }
#pragma unroll
            for (int r = 0; r < 4; ++r) { const int t = ti * 16 + 4 * g + r; Nb[t * 72 + s] = f2bf(-ab[r]); Nf[t * 68 + s] = -ab[r]; }
        }
    }
    __syncthreads();
    if (wave == 0) tri_inverse_wave(Nf, Nb, Tb, Wb, lane);
    else {
#pragma unroll 1
        for (int pos = wave - 1; pos < 16; pos += 7) {
            const int ti = pos >> 2, tj = pos & 3, s = tj * 16 + li;
            f32x4v rk, rb, ak; rk[0] = 0.f; rk[1] = 0.f; rk[2] = 0.f; rk[3] = 0.f; rb = rk; ak = rk;
            if (tj <= ti) {
#pragma unroll
                for (int k0 = 0; k0 < 64; k0 += 32) {
                    const bf16x8 fr = frag_rm(Rt + ti * 16 * 72 + k0, 72, lane), fa = frag_rm(At + ti * 16 * 72 + k0, 72, lane);
                    const bf16x8 fk = frag_rm(Kt + tj * 16 * 72 + k0, 72, lane), fb = frag_rm(Bt + tj * 16 * 72 + k0, 72, lane);
                    rk = MFMA16(fr, fk, rk); rb = MFMA16(fr, fb, rb); ak = MFMA16(fa, fk, ak);
                }
#pragma unroll
                for (int r = 0; r < 4; ++r) { const int t = ti * 16 + 4 * g + r;
                    if (s > t) { rk[r] = 0.f; rb[r] = 0.f; } if (s >= t) ak[r] = 0.f; }
            }
#pragma unroll
            for (int r = 0; r < 4; ++r) { const int t = ti * 16 + 4 * g + r; Ark[t * 72 + s] = f2bf(rk[r]); Arb[t * 72 + s] = f2bf(rb[r]); Aak[t * 72 + s] = f2bf(ak[r]); }
        }
    }
    __syncthreads();
#pragma unroll 1
    for (int q = 0; q < 2; ++q) {
        const int T = wave * 2 + q, ti = T >> 2, nj = T & 3;
        f32x4v x1, x2; x1[0] = 0.f; x1[1] = 0.f; x1[2] = 0.f; x1[3] = 0.f; x2 = x1;
#pragma unroll
        for (int k0 = 0; k0 < 64; k0 += 32) {
            const bf16x8 ft = frag_rm(Tb + ti * 16 * 72 + k0, 72, lane);
            x1 = MFMA16(ft, frag_tr(At + k0 * 72 + nj * 16, 72, lane), x1);
            x2 = MFMA16(ft, frag_tr(Aak + k0 * 72 + nj * 16, 72, lane), x2);
        }
#pragma unroll
        for (int r = 0; r < 4; ++r) { const int t = ti * 16 + 4 * g + r; Ap[t * 72 + nj * 16 + li] = f2bf(x1[r]); Wv[t * 72 + nj * 16 + li] = f2bf(x2[r]); }
    }
    __syncthreads();
#pragma unroll 1
    for (int q = 0; q < 2; ++q) {
        const int T = wave * 2 + q, ti = T >> 2, nj = T & 3;
        f32x4v x1, x2; x1[0] = 0.f; x1[1] = 0.f; x1[2] = 0.f; x1[3] = 0.f; x2 = x1;
#pragma unroll
        for (int k0 = 0; k0 < 64; k0 += 32) {
            const bf16x8 fb = frag_rm(Arb + ti * 16 * 72 + k0, 72, lane);
            x1 = MFMA16(fb, frag_tr(Ap + k0 * 72 + nj * 16, 72, lane), x1);
            x2 = MFMA16(fb, frag_tr(Wv + k0 * 72 + nj * 16, 72, lane), x2);
        }
#pragma unroll
        for (int r = 0; r < 4; ++r) { const int t = ti * 16 + 4 * g + r, n = nj * 16 + li;
            OutA[t * 72 + n] = f2bf(x1[r] + bf2f(Rt[t * 72 + n])); OutB[t * 72 + n] = f2bf(x2[r] + bf2f(Ark[t * 72 + n])); }
    }
#pragma unroll 1
    for (int q = 0; q < 2; ++q) {
        const int T = wave * 2 + q, mi = T >> 2, nj = T & 3;
        f32x4v x1, x2; x1[0] = 0.f; x1[1] = 0.f; x1[2] = 0.f; x1[3] = 0.f; x2 = x1;
#pragma unroll
        for (int k0 = 0; k0 < 64; k0 += 32) {
            const bf16x8 fb = frag_tr(Bh + k0 * 72 + nj * 16, 72, lane);
            x1 = MFMA16(frag_tr(Ap + k0 * 72 + mi * 16, 72, lane), fb, x1);
            x2 = MFMA16(frag_tr(Wv + k0 * 72 + mi * 16, 72, lane), fb, x2);
        }
#pragma unroll
        for (int r = 0; r < 4; ++r) { const int m = mi * 16 + 4 * g + r, n = nj * 16 + li;
            OutC[m * 72 + n] = f2bf(x1[r] + (m == n ? GLs[n] : 0.f)); OutD[m * 72 + n] = f2bf(x2[r] + bf2f(Kh[m * 72 + n])); }
    }
    __syncthreads();
    {
        const int t = tid >> 3, part = tid & 7;
        *(u32x4*)(item + t * 128 + part * 16) = *(const u32x4*)(OutA + t * 72 + part * 8);
        *(u32x4*)(item + 8192 + t * 128 + part * 16) = *(const u32x4*)(OutB + t * 72 + part * 8);
        *(u32x4*)(item + 16384 + t * 128 + part * 16) = *(const u32x4*)(OutC + t * 72 + part * 8);
        *(u32x4*)(item + 24576 + t * 128 + part * 16) = *(const u32x4*)(OutD + t * 72 + part * 8);
    }
    __syncthreads();
}

__device__ __forceinline__ void phase_pre0(const Params& p, char* lds) {
    u32x4 rw[9];
    if ((int)blockIdx.x < 2048) rw_pre_load(p, blockIdx.x, rw);
    int tab_hh = -1;
    for (int i = blockIdx.x; i < 4096; i += gridDim.x) {
        const int hh_i = (i >> 5) & 7;
        if (hh_i != tab_hh) {
            __syncthreads();
            float* PRM = (float*)(lds + 131072);
            if (threadIdx.x < 64) { const int ch = hh_i * 64 + threadIdx.x;
                PRM[threadIdx.x] = p.rw_w0[ch]; PRM[64 + threadIdx.x] = p.rw_a0[ch]; PRM[128 + threadIdx.x] = p.rw_k_k[ch]; PRM[192 + threadIdx.x] = p.rw_k_a[ch]; PRM[256 + threadIdx.x] = p.rw_r_k[ch];
                PRM[320 + threadIdx.x] = sigmoidf_(p.hg_lb[ch] - p.hg_lb[512 + ch]); }
            __syncthreads();
            tab_hh = hh_i;
        }
        if (i < 2048) rw_pre_item(p, lds, i, rw, (i + (int)gridDim.x < 2048) ? i + (int)gridDim.x : -1);
        else hg_pre_item(p, lds, i - 2048);
    }
}

template <bool RW>
__device__ __forceinline__ void seq64_unit(const Params& p, char* lds, int bb, int hh, int cg) {
    const int tid = threadIdx.x, lane = tid & 63, wave = tid >> 6, g = lane >> 4, li = lane & 15;
    unsigned char* ws = p.ws;
    const bf16_t* P = (const bf16_t*)(ws + WS_P);
    bf16_t* O16 = (bf16_t*)(ws + WS_XN);
    constexpr size_t ITEM = RW ? CHK_RW_ITEM : CHK_HG_ITEM;
    const unsigned char* chk = ws + (RW ? WS_CHK_RW : WS_CHK_HG) + (size_t)((bb * 8 + hh) * 32) * ITEM;
    constexpr int STG = 41984 + 512;
    bf16_t* St = (bf16_t*)(lds + 2 * STG);
    const int vcol = RW ? 1024 + hh * 64 + cg * 32 : 1792 + 1024 + hh * 64 + cg * 32;
    const int ocol = RW ? hh * 64 + cg * 32 : 512 + hh * 64 + cg * 32;
    const int mrow = tid >> 3, mc8 = tid & 7;
    const int vt = tid >> 2, vc = tid & 3;
    float mu[8];
#pragma unroll
    for (int e = 0; e < 8; ++e) mu[e] = RW ? p.ev_mu[vcol + vc * 8 + e] : 0.f;
    u32x4 rm0, rm1, rm2, rm3, rv, rvp; float rgl = 0.f;
    rm3 = u32x4{0u, 0u, 0u, 0u}; rvp = rm3; rv = rm3;
#define SEQ_LOAD(c) do { const unsigned char* it = chk + (size_t)(c) * ITEM; \
        rm0 = *(const u32x4*)(it + mrow * 128 + mc8 * 16); rm1 = *(const u32x4*)(it + 8192 + mrow * 128 + mc8 * 16); rm2 = *(const u32x4*)(it + 16384 + mrow * 128 + mc8 * 16); \
        if (RW) rm3 = *(const u32x4*)(it + 24576 + mrow * 128 + mc8 * 16); else if (tid < 64) rgl = ((const float*)(it + 24576))[tid]; \
        if (tid < 256) { const size_t tk = (size_t)bb * SEQ + (c) * 64 + vt; rv = *(const u32x4*)(P + tk * EVEN_IN + vcol + vc * 8); \
            if (RW) { if ((c) * 64 + vt > 0) rvp = *(const u32x4*)(P + (tk - 1) * EVEN_IN + vcol + vc * 8); else rvp = u32x4{0u, 0u, 0u, 0u}; } } } while (0)
#define SEQ_STAGE(sb) do { char* sg_ = lds + (sb) * STG; \
        *(u32x4*)(sg_ + mrow * 144 + mc8 * 16) = rm0; *(u32x4*)(sg_ + 9216 + mrow * 144 + mc8 * 16) = rm1; \
        if (RW) { *(u32x4*)(sg_ + 18432 + mrow * 144 + mc8 * 16) = rm2; *(u32x4*)(sg_ + 27648 + mrow * 144 + mc8 * 16) = rm3; } \
        else { *(u32x4*)(sg_ + 27648 + mrow * 144 + mc8 * 16) = rm2; if (tid < 64) ((float*)(sg_ + 41984))[tid] = rgl; } \
        if (tid < 256) { u32x4 o_ = rv; \
            if (RW) { float a_[8], b_[8]; a_[0] = lo16(rv.x); a_[1] = hi16(rv.x); a_[2] = lo16(rv.y); a_[3] = hi16(rv.y); a_[4] = lo16(rv.z); a_[5] = hi16(rv.z); a_[6] = lo16(rv.w); a_[7] = hi16(rv.w); \
                b_[0] = lo16(rvp.x); b_[1] = hi16(rvp.x); b_[2] = lo16(rvp.y); b_[3] = hi16(rvp.y); b_[4] = lo16(rvp.z); b_[5] = hi16(rvp.z); b_[6] = lo16(rvp.w); b_[7] = hi16(rvp.w); \
                _Pragma("unroll") for (int e_ = 0; e_ < 8; ++e_) a_[e_] = a_[e_] + mu[e_] * (b_[e_] - a_[e_]); \
                o_.x = pack2(a_[0], a_[1]); o_.y = pack2(a_[2], a_[3]); o_.z = pack2(a_[4], a_[5]); o_.w = pack2(a_[6], a_[7]); } \
            *(u32x4*)(sg_ + 36864 + vt * 80 + vc * 16) = o_; } } while (0)
    SEQ_LOAD(0);
    for (int i = tid; i < 2 * 32 * 72 / 2; i += NT) ((unsigned*)St)[i] = 0u;
    SEQ_STAGE(0);
    SEQ_LOAD(1);
    f32x4v sacc; sacc[0] = 0.f; sacc[1] = 0.f; sacc[2] = 0.f; sacc[3] = 0.f;
    __syncthreads();
    for (int c = 0; c < 32; ++c) {
        const int cur = c & 1;
        if (c + 1 < 32) SEQ_STAGE(cur ^ 1);
        if (c + 2 < 32) SEQ_LOAD(c + 2);
        const char* sg = lds + cur * STG;
        const bf16_t* Rp = (const bf16_t*)sg; const bf16_t* Ay = (const bf16_t*)(sg + 9216); const bf16_t* Gc = (const bf16_t*)(sg + 18432); const bf16_t* Kc = (const bf16_t*)(sg + 27648);
        const bf16_t* Vs = (const bf16_t*)(sg + 36864); const float* gL = (const float*)(sg + 41984);
        const bf16_t* Sc = St + cur * 32 * 72; bf16_t* Sn = St + (cur ^ 1) * 32 * 72;
        {
            const int ti = wave >> 1, vj = wave & 1;
            f32x4v acc; acc[0] = 0.f; acc[1] = 0.f; acc[2] = 0.f; acc[3] = 0.f;
#pragma unroll
            for (int k0 = 0; k0 < 64; k0 += 32) acc = MFMA16(frag_rm(Rp + ti * 16 * 72 + k0, 72, lane), frag_rm(Sc + vj * 16 * 72 + k0, 72, lane), acc);
#pragma unroll
            for (int k0 = 0; k0 < 64; k0 += 32) acc = MFMA16(frag_rm(Ay + ti * 16 * 72 + k0, 72, lane), frag_tr(Vs + k0 * 40 + vj * 16, 40, lane), acc);
#pragma unroll
            for (int r = 0; r < 4; ++r) O16[((size_t)bb * SEQ + c * 64 + ti * 16 + 4 * g + r) * D + ocol + vj * 16 + li] = f2bf(acc[r]);
        }
        {
            const int vi = wave >> 2, kj = wave & 3;
            f32x4v t4; t4[0] = 0.f; t4[1] = 0.f; t4[2] = 0.f; t4[3] = 0.f;
#pragma unroll
            for (int k0 = 0; k0 < 64; k0 += 32) t4 = MFMA16(frag_tr(Vs + k0 * 40 + vi * 16, 40, lane), frag_tr(Kc + k0 * 72 + kj * 16, 72, lane), t4);
            if (RW) {
#pragma unroll
                for (int k0 = 0; k0 < 64; k0 += 32) t4 = MFMA16(frag_rm(Sc + vi * 16 * 72 + k0, 72, lane), frag_tr(Gc + k0 * 72 + kj * 16, 72, lane), t4);
                sacc = t4;
            } else { const float gl = gL[kj * 16 + li];
#pragma unroll
                for (int r = 0; r < 4; ++r) sacc[r] = sacc[r] * gl + t4[r]; }
#pragma unroll
            for (int r = 0; r < 4; ++r) Sn[(vi * 16 + 4 * g + r) * 72 + kj * 16 + li] = f2bf(sacc[r]);
        }
        __syncthreads();
    }
#undef SEQ_LOAD
#undef SEQ_STAGE
}

__device__ __forceinline__ void phase_mix0(const Params& p, char* lds) {
    for (int u = blockIdx.x; u < 256; u += gridDim.x) {
        const int v = u & 127, x = v & 7, j = v >> 3, pair = x * 8 + (j >> 1), bb = pair >> 3, hh = pair & 7, cg = j & 1;
        if (u < 128) seq64_unit<true>(p, lds, bb, hh, cg); else seq64_unit<false>(p, lds, bb, hh, cg);
        __syncthreads();
    }
}


constexpr size_t CHK_GD_ITEM = 90112;
constexpr size_t WS_CHK_GD = WS_ARENA;
static_assert(WS_CHK_GD + (size_t)1024 * CHK_GD_ITEM <= WS_END, "gdn chunk matrices fit the arena");

__device__ __forceinline__ void gdn_pre_item(const Params& p, char* lds0, int id) {
    const int tid = threadIdx.x, lane = tid & 63, wave = tid >> 6, g = lane >> 4, li = lane & 15;
    const int bb = id >> 7, hh = (id >> 5) & 3, c = id & 31;
    int lz = 0; asm volatile("" : "+s"(lz));
    char* lds = lds0 + lz;
    unsigned char* ws = p.ws;
    const bf16_t* P = (const bf16_t*)(ws + WS_P);
    const float* GT = (const float*)(ws + WS_GATES);
    unsigned char* item = ws + WS_CHK_GD + (size_t)id * CHK_GD_ITEM;
    constexpr int LQ = 136, LS = 72, LRQ = 264, LRV = 136;
    bf16_t* Qs = (bf16_t*)(lds + 0);
    bf16_t* Ks = (bf16_t*)(lds + 17408);
    bf16_t* RAWqk = (bf16_t*)(lds + 34816);
    bf16_t* Kt = (bf16_t*)(lds + 34816);
    bf16_t* Kte = (bf16_t*)(lds + 52224);
    bf16_t* RAWv = (bf16_t*)(lds + 70208);
    bf16_t* A1b = (bf16_t*)(lds + 70208);
    bf16_t* A2b = (bf16_t*)(lds + 79424);
    bf16_t* Tb = (bf16_t*)(lds + 88640);
    bf16_t* Tg = (bf16_t*)(lds + 97856);
    bf16_t* Wv = (bf16_t*)(lds + 107072);
    bf16_t* Wve = (bf16_t*)(lds + 116288);
    float* A2f = (float*)(lds + 125504);
    bf16_t* Wb = (bf16_t*)(lds + 142912);
    float* gam = (float*)(lds + 144448); float* be = gam + 64; float* egam = be + 64; float* edl = egam + 64; float* misc = edl + 64;
    const size_t tok0 = (size_t)bb * SEQ + c * 64;
    for (int i = tid; i < 67 * 32; i += NT) { const int row = i >> 5, ch = i & 31; const int t = row - 3;
        u32x4 v; v.x = 0u; v.y = 0u; v.z = 0u; v.w = 0u;
        if (c * 64 + t >= 0) v = *(const u32x4*)(P + (tok0 + t) * ODD_IN + (ch < 16 ? hh * 128 + ch * 8 : 512 + hh * 128 + (ch - 16) * 8));
        *(u32x4*)(RAWqk + row * LRQ + ch * 8) = v; }
    for (int i = tid; i < 67 * 16; i += NT) { const int row = i >> 4, ch = i & 15; const int t = row - 3;
        u32x4 v; v.x = 0u; v.y = 0u; v.z = 0u; v.w = 0u;
        if (c * 64 + t >= 0) v = *(const u32x4*)(P + (tok0 + t) * ODD_IN + 1024 + hh * 128 + ch * 8);
        *(u32x4*)(RAWv + row * LRV + ch * 8) = v; }
    if (wave == 0) {
        const float negA = -__expf(p.gd_a_log[hh]), dtb = p.gd_dt_bias[hh];
        const float bev = sigmoidf_(GT[(tok0 + lane) * 16 + hh]);
        const float gg = negA * softplusf_(GT[(tok0 + lane) * 16 + 4 + hh] + dtb);
        float gc = gg;
#pragma unroll
        for (int off = 1; off < 64; off <<= 1) { const float y = __shfl_up(gc, off); if (lane >= off) gc += y; }
        const float gl = __shfl(gc, 63);
        gam[lane] = gc; be[lane] = bev; egam[lane] = __expf(gc); edl[lane] = __expf(gl - gc);
        if (lane == 0) misc[0] = __expf(gl);
    }
    __syncthreads();
    {
        const int lt = tid >> 4, lc = tid & 15;
        const float* CWT = (const float*)(lds0 + 145664);
#pragma unroll 1
        for (int grp = 0; grp < 3; ++grp) {
            float4 wA[4], wB[4];
#pragma unroll
            for (int r = 0; r < 4; ++r) { wA[r] = *(const float4*)(CWT + r * 384 + grp * 128 + lc * 8); wB[r] = *(const float4*)(CWT + r * 384 + grp * 128 + lc * 8 + 4); }
#pragma unroll 1
            for (int tt = 0; tt < 2; ++tt) {
                const int t = lt + 32 * tt;
                float y[8];
#pragma unroll
                for (int e = 0; e < 8; ++e) y[e] = 0.f;
#pragma unroll
                for (int r = 0; r < 4; ++r) {
                    const bf16_t* rp = grp < 2 ? RAWqk + (t + r) * LRQ + grp * 128 + lc * 8 : RAWv + (t + r) * LRV + lc * 8;
                    float x[8]; unpack8(*(const u32x4*)rp, x);
                    y[0] += wA[r].x * x[0]; y[1] += wA[r].y * x[1]; y[2] += wA[r].z * x[2]; y[3] += wA[r].w * x[3];
                    y[4] += wB[r].x * x[4]; y[5] += wB[r].y * x[5]; y[6] += wB[r].z * x[6]; y[7] += wB[r].w * x[7];
                }
                float ss = 0.f;
#pragma unroll
                for (int e = 0; e < 8; ++e) { y[e] = siluf_(y[e]); ss += y[e] * y[e]; }
                if (grp < 2) { ss = red16(ss); const float nrm = rsqrtf(ss + 1e-6f) * (grp == 0 ? 0.08838834764831845f : 1.f);
#pragma unroll
                    for (int e = 0; e < 8; ++e) y[e] *= nrm;
                    *(u32x4*)((grp == 0 ? Qs : Ks) + t * LQ + lc * 8) = pack8(y);
                } else *(u32x4*)(item + 73728 + t * 256 + lc * 16) = pack8(y);
            }
        }
    }
    __syncthreads();
    {
        for (int i = tid; i < 64 * LS / 2; i += NT) ((unsigned*)Tb)[i] = 0u;
        for (int i = tid; i < 32 * 24 / 2; i += NT) ((unsigned*)Wb)[i] = 0u;
        const int ti = wave >> 1;
#pragma unroll 1
        for (int jj = 0; jj < 2; ++jj) {
            const int tj = (wave & 1) * 2 + jj, s = tj * 16 + li;
            f32x4v aq, ak; aq[0] = 0.f; aq[1] = 0.f; aq[2] = 0.f; aq[3] = 0.f; ak = aq;
            if (tj <= ti) {
#pragma unroll
                for (int k0 = 0; k0 < 128; k0 += 32) {
                    const bf16x8 kb = frag_rm(Ks + tj * 16 * LQ + k0, LQ, lane);
                    aq = MFMA16(frag_rm(Qs + ti * 16 * LQ + k0, LQ, lane), kb, aq);
                    ak = MFMA16(frag_rm(Ks + ti * 16 * LQ + k0, LQ, lane), kb, ak);
                }
                const float gs = gam[s];
#pragma unroll
                for (int r = 0; r < 4; ++r) { const int t = ti * 16 + 4 * g + r; const float dcy = __expf(fminf(gam[t] - gs, 0.f));
                    aq[r] = (s <= t) ? aq[r] * dcy : 0.f; ak[r] = (s < t) ? ak[r] * be[t] * dcy : 0.f; }
            }
#pragma unroll
            for (int r = 0; r < 4; ++r) { const int t = ti * 16 + 4 * g + r; A1b[t * LS + s] = f2bf(aq[r]); A2b[t * LS + s] = f2bf(ak[r]); A2f[t * 68 + s] = ak[r]; }
        }
    }
    __syncthreads();
    if (wave == 0) tri_inverse_wave(A2f, A2b, Tb, Wb, lane);
    __syncthreads();
    {
        const int t = tid >> 3, s0 = (tid & 7) * 8;
        float tv[8], a[8], b[8], cc[8]; unpack8(*(const u32x4*)(Tb + t * LS + s0), tv);
        const float ed = edl[t];
#pragma unroll
        for (int e = 0; e < 8; ++e) { const float bs = be[s0 + e]; b[e] = tv[e] * bs; a[e] = b[e] * egam[s0 + e]; cc[e] = b[e] * ed; }
        *(u32x4*)(Tg + t * LS + s0) = pack8(a); *(u32x4*)(Wv + t * LS + s0) = pack8(b); *(u32x4*)(Wve + t * LS + s0) = pack8(cc);
    }
    __syncthreads();
#pragma unroll 1
    for (int q = 0; q < 4; ++q) {
        const int T = wave * 4 + q, ti = T >> 3, nj = T & 7;
        f32x4v x; x[0] = 0.f; x[1] = 0.f; x[2] = 0.f; x[3] = 0.f;
#pragma unroll
        for (int k0 = 0; k0 < 64; k0 += 32) x = MFMA16(frag_rm(Tg + ti * 16 * LS + k0, LS, lane), frag_tr(Ks + k0 * LQ + nj * 16, LQ, lane), x);
#pragma unroll
        for (int r = 0; r < 4; ++r) { const int t = ti * 16 + 4 * g + r; Kt[t * LQ + nj * 16 + li] = f2bf(x[r]); Kte[t * LQ + nj * 16 + li] = f2bf(x[r] * edl[t]); }
    }
    __syncthreads();
#pragma unroll 1
    for (int q = 0; q < 4; ++q) {
        const int T = wave * 4 + q, ti = T >> 3, nj = T & 7;
        f32x4v x; x[0] = 0.f; x[1] = 0.f; x[2] = 0.f; x[3] = 0.f;
#pragma unroll
        for (int k0 = 0; k0 < 64; k0 += 32) x = MFMA16(frag_rm(A1b + ti * 16 * LS + k0, LS, lane), frag_tr(Kt + k0 * LQ + nj * 16, LQ, lane), x);
#pragma unroll
        for (int r = 0; r < 4; ++r) { const int t = ti * 16 + 4 * g + r; bf16_t* qp = Qs + t * LQ + nj * 16 + li; *qp = f2bf(egam[t] * bf2f(*qp) - x[r]); }
    }
#pragma unroll 1
    for (int q = 0; q < 2; ++q) {
        const int T = wave * 2 + q, ti = T >> 2, nj = T & 3;
        f32x4v x; x[0] = 0.f; x[1] = 0.f; x[2] = 0.f; x[3] = 0.f;
#pragma unroll
        for (int k0 = 0; k0 < 64; k0 += 32) x = MFMA16(frag_rm(A1b + ti * 16 * LS + k0, LS, lane), frag_tr(Wv + k0 * LS + nj * 16, LS, lane), x);
#pragma unroll
        for (int r = 0; r < 4; ++r) { const int t = ti * 16 + 4 * g + r; ((bf16_t*)(item + 16384))[t * 64 + nj * 16 + li] = f2bf(x[r]); }
    }
    __syncthreads();
    {
        const int t = tid >> 3, part = tid & 7;
        *(u32x4*)(item + t * 256 + part * 32) = *(const u32x4*)(Qs + t * LQ + part * 16);
        *(u32x4*)(item + t * 256 + part * 32 + 16) = *(const u32x4*)(Qs + t * LQ + part * 16 + 8);
    }
    {
        const float gl = misc[0];
#pragma unroll 1
        for (int q = 0; q < 8; ++q) {
            const int T = wave * 8 + q, mi = T >> 3, nj = T & 7;
            f32x4v x; x[0] = 0.f; x[1] = 0.f; x[2] = 0.f; x[3] = 0.f;
#pragma unroll
            for (int k0 = 0; k0 < 64; k0 += 32) x = MFMA16(frag_tr(Kte + k0 * LQ + mi * 16, LQ, lane), frag_tr(Ks + k0 * LQ + nj * 16, LQ, lane), x);
#pragma unroll
            for (int r = 0; r < 4; ++r) { const int m = mi * 16 + 4 * g + r, n = nj * 16 + li; ((bf16_t*)(item + 24576))[m * 128 + n] = f2bf((m == n ? gl : 0.f) - x[r]); }
        }
#pragma unroll 1
        for (int q = 0; q < 4; ++q) {
            const int T = wave * 4 + q, mi = T >> 3, nj = T & 7;
            f32x4v x; x[0] = 0.f; x[1] = 0.f; x[2] = 0.f; x[3] = 0.f;
#pragma unroll
            for (int k0 = 0; k0 < 64; k0 += 32) x = MFMA16(frag_tr(Wve + k0 * LS + mi * 16, LS, lane), frag_tr(Ks + k0 * LQ + nj * 16, LQ, lane), x);
#pragma unroll
            for (int r = 0; r < 4; ++r) { const int m = mi * 16 + 4 * g + r, n = nj * 16 + li; ((bf16_t*)(item + 57344))[m * 128 + n] = f2bf(x[r]); }
        }
    }
    __syncthreads();
}

__device__ __forceinline__ void gdn_seq_unit(const Params& p, char* lds, int bb, int hh, int cg) {
    const int tid = threadIdx.x, lane = tid & 63, wave = tid >> 6, g = lane >> 4, li = lane & 15;
    unsigned char* ws = p.ws;
    bf16_t* O16 = (bf16_t*)(ws + WS_XN);
    const unsigned char* chk = ws + WS_CHK_GD + (size_t)((bb * 4 + hh) * 32) * CHK_GD_ITEM;
    constexpr int LQ = 136, LS = 72, LV = 40;
    bf16_t* Rp = (bf16_t*)(lds + 0);
    bf16_t* Ay = (bf16_t*)(lds + 17408);
    bf16_t* Gc = (bf16_t*)(lds + 26624);
    bf16_t* Kc = (bf16_t*)(lds + 61440);
    bf16_t* Vs = (bf16_t*)(lds + 78848);
    bf16_t* St = (bf16_t*)(lds + 83968);
    const int r8 = tid >> 3, c8 = tid & 7;
    const int r16 = tid >> 4, c16 = tid & 15, vt = tid >> 2, vc = tid & 3;
    u32x4 q0, q1, ao, g0, g1, g2, g3, k0r, k1r, rv;
    rv.x = 0u; rv.y = 0u; rv.z = 0u; rv.w = 0u;
#define GSEQ_LOAD(c) do { const unsigned char* it = chk + (size_t)(c) * CHK_GD_ITEM; \
        q0 = *(const u32x4*)(it + r16 * 256 + c16 * 16); q1 = *(const u32x4*)(it + (r16 + 32) * 256 + c16 * 16); \
        ao = *(const u32x4*)(it + 16384 + r8 * 128 + c8 * 16); \
        g0 = *(const u32x4*)(it + 24576 + r16 * 256 + c16 * 16); g1 = *(const u32x4*)(it + 24576 + (r16 + 32) * 256 + c16 * 16); \
        g2 = *(const u32x4*)(it + 24576 + (r16 + 64) * 256 + c16 * 16); g3 = *(const u32x4*)(it + 24576 + (r16 + 96) * 256 + c16 * 16); \
        k0r = *(const u32x4*)(it + 57344 + r16 * 256 + c16 * 16); k1r = *(const u32x4*)(it + 57344 + (r16 + 32) * 256 + c16 * 16); \
        if (tid < 256) rv = *(const u32x4*)(it + 73728 + vt * 256 + cg * 64 + vc * 16); } while (0)
#define GSEQ_STAGE() do { \
        *(u32x4*)(Rp + r16 * LQ + c16 * 8) = q0; *(u32x4*)(Rp + (r16 + 32) * LQ + c16 * 8) = q1; *(u32x4*)(Ay + r8 * LS + c8 * 8) = ao; \
        *(u32x4*)(Gc + r16 * LQ + c16 * 8) = g0; *(u32x4*)(Gc + (r16 + 32) * LQ + c16 * 8) = g1; *(u32x4*)(Gc + (r16 + 64) * LQ + c16 * 8) = g2; *(u32x4*)(Gc + (r16 + 96) * LQ + c16 * 8) = g3; \
        *(u32x4*)(Kc + r16 * LQ + c16 * 8) = k0r; *(u32x4*)(Kc + (r16 + 32) * LQ + c16 * 8) = k1r; \
        if (tid < 256) *(u32x4*)(Vs + vt * LV + vc * 8) = rv; } while (0)
    GSEQ_LOAD(0);
    for (int i = tid; i < 2 * 32 * LQ / 2; i += NT) ((unsigned*)St)[i] = 0u;
    for (int c = 0; c < 32; ++c) {
        const int cur = c & 1;
        GSEQ_STAGE();
        __syncthreads();
        if (c + 1 < 32) GSEQ_LOAD(c + 1);
        const bf16_t* Sc = St + cur * 32 * LQ; bf16_t* Sn = St + (cur ^ 1) * 32 * LQ;
        {
            const int ti = wave >> 1, vj = wave & 1;
            f32x4v acc; acc[0] = 0.f; acc[1] = 0.f; acc[2] = 0.f; acc[3] = 0.f;
#pragma unroll
            for (int k0 = 0; k0 < 128; k0 += 32) acc = MFMA16(frag_rm(Rp + ti * 16 * LQ + k0, LQ, lane), frag_rm(Sc + vj * 16 * LQ + k0, LQ, lane), acc);
#pragma unroll
            for (int k0 = 0; k0 < 64; k0 += 32) acc = MFMA16(frag_rm(Ay + ti * 16 * LS + k0, LS, lane), frag_tr(Vs + k0 * LV + vj * 16, LV, lane), acc);
#pragma unroll
            for (int r = 0; r < 4; ++r) O16[((size_t)bb * SEQ + c * 64 + ti * 16 + 4 * g + r) * D + hh * 128 + cg * 32 + vj * 16 + li] = f2bf(acc[r]);
        }
#pragma unroll
        for (int vi = 0; vi < 2; ++vi) {
            f32x4v t4; t4[0] = 0.f; t4[1] = 0.f; t4[2] = 0.f; t4[3] = 0.f;
#pragma unroll
            for (int k0 = 0; k0 < 64; k0 += 32) t4 = MFMA16(frag_tr(Vs + k0 * LV + vi * 16, LV, lane), frag_tr(Kc + k0 * LQ + wave * 16, LQ, lane), t4);
#pragma unroll
            for (int k0 = 0; k0 < 128; k0 += 32) t4 = MFMA16(frag_rm(Sc + vi * 16 * LQ + k0, LQ, lane), frag_tr(Gc + k0 * LQ + wave * 16, LQ, lane), t4);
#pragma unroll
            for (int r = 0; r < 4; ++r) Sn[(vi * 16 + 4 * g + r) * LQ + wave * 16 + li] = f2bf(t4[r]);
        }
        __syncthreads();
    }
#undef GSEQ_LOAD
#undef GSEQ_STAGE
}


constexpr size_t CHK_ML_ITEM = 9472;
constexpr size_t WS_CHK_ML = WS_CHK_GD + (size_t)1024 * CHK_GD_ITEM;
static_assert(WS_CHK_ML + (size_t)1024 * CHK_ML_ITEM <= WS_END, "mlstm chunk data fits the arena");

__device__ __forceinline__ void mlstm_pre_item(const Params& p, char* lds, int id) {
    const int tid = threadIdx.x, lane = tid & 63, wave = tid >> 6, g = lane >> 4, li = lane & 15;
    const int bb = id >> 7, hh = (id >> 5) & 3, c = id & 31;
    unsigned char* ws = p.ws;
    const bf16_t* P = (const bf16_t*)(ws + WS_P);
    const float* GT = (const float*)(ws + WS_GATES);
    unsigned char* item = ws + WS_CHK_ML + (size_t)id * CHK_ML_ITEM;
    constexpr int LQ = 136, LS = 72;
    bf16_t* Qs = (bf16_t*)lds;
    bf16_t* Ks = Qs + 64 * LQ;
    bf16_t* SC = Ks + 64 * LQ;
    float* fl = (float*)(SC + 64 * LS);
    float* zs = fl; float* Mt = fl + 64; float* rsum = fl + 128; float* summ = fl + 192;
    const float scale = 0.08838834764831845f;
    const float ib = p.ml_i_bias[hh], fb = p.ml_f_bias[hh];
    const size_t tokb = (size_t)bb * SEQ;
    {
        const int qt0 = tid >> 4, qc = tid & 15;
        const bf16_t* qsrc = P + (tokb + c * 64 + qt0) * ODD_IN + 2048 + hh * 128 + qc * 8;
        *(u32x4*)(Qs + qt0 * LQ + qc * 8) = *(const u32x4*)qsrc; *(u32x4*)(Qs + (qt0 + 32) * LQ + qc * 8) = *(const u32x4*)(qsrc + (size_t)32 * ODD_IN);
        *(u32x4*)(Ks + qt0 * LQ + qc * 8) = *(const u32x4*)(qsrc + 512); *(u32x4*)(Ks + (qt0 + 32) * LQ + qc * 8) = *(const u32x4*)(qsrc + 512 + (size_t)32 * ODD_IN);
    }
    for (int cp = wave; cp < c; cp += 8) {
        const size_t tok = tokb + cp * 64 + lane;
        const float lf = -softplusf_(-(GT[tok * 16 + 12 + hh] + fb)), ig = GT[tok * 16 + 8 + hh] + ib;
        float bc = lf;
#pragma unroll
        for (int off = 1; off < 64; off <<= 1) { const float y = __shfl_up(bc, off); if (lane >= off) bc += y; }
        float z = ig - bc;
#pragma unroll
        for (int off = 32; off >= 1; off >>= 1) z = fmaxf(z, __shfl_xor(z, off));
        if (lane == 63) { summ[cp * 2] = bc; summ[cp * 2 + 1] = z; }
    }
    __syncthreads();
    if (wave == 0) {
        float m = 0.f;
        for (int cp = 0; cp < c; ++cp) m = summ[cp * 2] + fmaxf(m, summ[cp * 2 + 1]);
        const size_t tok = tokb + c * 64 + lane;
        const float lf = -softplusf_(-(GT[tok * 16 + 12 + hh] + fb)), ig = GT[tok * 16 + 8 + hh] + ib;
        float bc = lf;
#pragma unroll
        for (int off = 1; off < 64; off <<= 1) { const float y = __shfl_up(bc, off); if (lane >= off) bc += y; }
        const float z = ig - bc;
        float cz = z;
#pragma unroll
        for (int off = 1; off < 64; off <<= 1) { const float y = __shfl_up(cz, off); if (lane >= off) cz = fmaxf(cz, y); }
        const float Mtv = fmaxf(m, cz);
        const float Ml = __shfl(Mtv, 63);
        zs[lane] = z; Mt[lane] = Mtv; rsum[lane] = 0.f;
        float* sc_f = (float*)(item + 8192);
        sc_f[lane] = __expf(m - Mtv); sc_f[64 + lane] = __expf(-(bc + Mtv)); sc_f[128 + lane] = __expf(z - Ml) * scale;
        if (lane == 0) sc_f[256] = __expf(m - Ml);
    }
    __syncthreads();
    {
        const int ti = wave >> 1;
        float rs0 = 0.f, rs1 = 0.f, rs2 = 0.f, rs3 = 0.f;
#pragma unroll 1
        for (int jj = 0; jj < 2; ++jj) {
            const int tj = (wave & 1) * 2 + jj, s = tj * 16 + li;
            f32x4v acc; acc[0] = 0.f; acc[1] = 0.f; acc[2] = 0.f; acc[3] = 0.f;
            if (tj <= ti) {
#pragma unroll
                for (int k0 = 0; k0 < 128; k0 += 32) acc = MFMA16(frag_rm(Qs + ti * 16 * LQ + k0, LQ, lane), frag_rm(Ks + tj * 16 * LQ + k0, LQ, lane), acc);
                const float zv = zs[s];
#pragma unroll
                for (int r = 0; r < 4; ++r) { const int t = ti * 16 + 4 * g + r; acc[r] = (s <= t) ? acc[r] * scale * __expf(zv - Mt[t]) : 0.f; }
                rs0 += acc[0]; rs1 += acc[1]; rs2 += acc[2]; rs3 += acc[3];
            }
#pragma unroll
            for (int r = 0; r < 4; ++r) SC[(ti * 16 + 4 * g + r) * LS + s] = f2bf(acc[r]);
        }
        rs0 = red16(rs0); rs1 = red16(rs1); rs2 = red16(rs2); rs3 = red16(rs3);
        if (li == 0) { atomicAdd(&rsum[ti * 16 + 4 * g + 0], rs0); atomicAdd(&rsum[ti * 16 + 4 * g + 1], rs1); atomicAdd(&rsum[ti * 16 + 4 * g + 2], rs2); atomicAdd(&rsum[ti * 16 + 4 * g + 3], rs3); }
    }
    __syncthreads();
    { const int t = tid >> 3, part = tid & 7; *(u32x4*)(item + t * 128 + part * 16) = *(const u32x4*)(SC + t * LS + part * 8); }
    if (tid < 64) ((float*)(item + 8192))[192 + tid] = rsum[tid];
    __syncthreads();
}

__device__ __forceinline__ void mlstm_seq_unit(const Params& p, char* lds, int bb, int hh, int cg) {
    const int tid = threadIdx.x, lane = tid & 63, wave = tid >> 6, g = lane >> 4, li = lane & 15;
    unsigned char* ws = p.ws;
    const bf16_t* P = (const bf16_t*)(ws + WS_P);
    bf16_t* O16 = (bf16_t*)(ws + WS_XN);
    const unsigned char* chk = ws + WS_CHK_ML + (size_t)((bb * 4 + hh) * 32) * CHK_ML_ITEM;
    constexpr int LQ = 136, LV = 40, LS = 72;
    bf16_t* Qs = (bf16_t*)lds;
    bf16_t* Ks = Qs + 64 * LQ;
    bf16_t* Vs = Ks + 64 * LQ;
    bf16_t* VWs = Vs + 64 * LV;
    bf16_t* SC = VWs + 64 * LV;
    bf16_t* Ct = SC + 64 * LS;
    float* fl = (float*)(Ct + 2 * 32 * LQ);
    float* nvec = fl; float* iw = fl + 256; float* emt = iw + 64; float* wsc = emt + 64; float* rsum = wsc + 64; float* misc = rsum + 64;
    for (int i = tid; i < 2 * 32 * LQ / 2; i += NT) ((unsigned*)Ct)[i] = 0u;
    if (tid < 256) nvec[tid] = 0.f;
    f32x4v cacc[2];
#pragma unroll
    for (int v = 0; v < 2; ++v) { cacc[v][0] = 0.f; cacc[v][1] = 0.f; cacc[v][2] = 0.f; cacc[v][3] = 0.f; }
    const int qt0 = tid >> 4, qc = tid & 15, vt = tid >> 2, vc = tid & 3, st = tid >> 3, sp = tid & 7;
    const bf16_t* qsrc = P + ((size_t)bb * SEQ + qt0) * ODD_IN + 2048 + hh * 128 + qc * 8;
    const bf16_t* ksrc = qsrc + 512;
    const bf16_t* vsrc = P + ((size_t)bb * SEQ + vt) * ODD_IN + 3072 + hh * 128 + cg * 32 + vc * 8;
    u32x4 rq0, rq1, rk0, rk1, rv, rs; float s_iw = 0.f, s_emt = 0.f, s_wsc = 0.f, s_rs = 0.f, s_dec = 0.f, v_wsc = 0.f;
    rv.x = 0u; rv.y = 0u; rv.z = 0u; rv.w = 0u;
#define MSEQ_LOAD(c) do { const size_t adv = (size_t)((c) * 64) * ODD_IN; const unsigned char* it = chk + (size_t)(c) * CHK_ML_ITEM; const float* sf = (const float*)(it + 8192); \
        rq0 = *(const u32x4*)(qsrc + adv); rq1 = *(const u32x4*)(qsrc + adv + (size_t)32 * ODD_IN); rk0 = *(const u32x4*)(ksrc + adv); rk1 = *(const u32x4*)(ksrc + adv + (size_t)32 * ODD_IN); \
        rs = *(const u32x4*)(it + st * 128 + sp * 16); \
        if (tid < 256) { rv = *(const u32x4*)(vsrc + adv); v_wsc = sf[128 + vt]; } \
        if (tid < 64) { s_iw = sf[tid]; s_emt = sf[64 + tid]; s_wsc = sf[128 + tid]; s_rs = sf[192 + tid]; s_dec = sf[256]; } } while (0)
    MSEQ_LOAD(0);
    for (int c = 0; c < 32; ++c) {
        const int cur = c & 1, nxt = cur ^ 1;
        *(u32x4*)(Qs + qt0 * LQ + qc * 8) = rq0; *(u32x4*)(Qs + (qt0 + 32) * LQ + qc * 8) = rq1;
        *(u32x4*)(Ks + qt0 * LQ + qc * 8) = rk0; *(u32x4*)(Ks + (qt0 + 32) * LQ + qc * 8) = rk1;
        *(u32x4*)(SC + st * LS + sp * 8) = rs;
        if (tid < 256) { *(u32x4*)(Vs + vt * LV + vc * 8) = rv; float x[8]; unpack8(rv, x);
#pragma unroll
            for (int e = 0; e < 8; ++e) x[e] *= v_wsc;
            *(u32x4*)(VWs + vt * LV + vc * 8) = pack8(x); }
        if (tid < 64) { iw[tid] = s_iw; emt[tid] = s_emt; wsc[tid] = s_wsc; rsum[tid] = s_rs; if (tid == 0) misc[0] = s_dec; }
        __syncthreads();
        if (c + 1 < 32) MSEQ_LOAD(c + 1);
        const float* ncur = nvec + cur * 128; float* nnxt = nvec + nxt * 128;
        {
            const int ti = wave >> 1, vj = wave & 1;
            f32x4v acc; acc[0] = 0.f; acc[1] = 0.f; acc[2] = 0.f; acc[3] = 0.f;
            const bf16_t* Cc = Ct + cur * 32 * LQ;
#pragma unroll
            for (int k0 = 0; k0 < 128; k0 += 32) acc = MFMA16(frag_rm(Qs + ti * 16 * LQ + k0, LQ, lane), frag_rm(Cc + vj * 16 * LQ + k0, LQ, lane), acc);
#pragma unroll
            for (int r = 0; r < 4; ++r) acc[r] *= iw[ti * 16 + 4 * g + r];
#pragma unroll
            for (int k0 = 0; k0 < 64; k0 += 32) acc = MFMA16(frag_rm(SC + ti * 16 * LS + k0, LS, lane), frag_tr(Vs + k0 * LV + vj * 16, LV, lane), acc);
            float qn = 0.f;
#pragma unroll
            for (int j8 = 0; j8 < 4; ++j8) { float x[8]; unpack8(*(const u32x4*)(Qs + (ti * 16 + li) * LQ + g * 32 + j8 * 8), x);
                const float4 n0 = *(const float4*)(ncur + g * 32 + j8 * 8), n1 = *(const float4*)(ncur + g * 32 + j8 * 8 + 4);
                qn += x[0] * n0.x + x[1] * n0.y + x[2] * n0.z + x[3] * n0.w + x[4] * n1.x + x[5] * n1.y + x[6] * n1.z + x[7] * n1.w; }
            qn += __shfl_xor(qn, 16); qn += __shfl_xor(qn, 32);
#pragma unroll
            for (int r = 0; r < 4; ++r) {
                const int t = ti * 16 + 4 * g + r;
                const float qr = __shfl(qn, 4 * g + r);
                const float den = iw[t] * qr + rsum[t];
                O16[((size_t)bb * SEQ + c * 64 + t) * D + 512 + hh * 128 + cg * 32 + vj * 16 + li] = f2bf(acc[r] / fmaxf(fabsf(den), emt[t]));
            }
        }
        {
            const float dec = misc[0];
            bf16_t* Cn = Ct + nxt * 32 * LQ;
#pragma unroll
            for (int vi = 0; vi < 2; ++vi) {
                f32x4v t4; t4[0] = 0.f; t4[1] = 0.f; t4[2] = 0.f; t4[3] = 0.f;
#pragma unroll
                for (int k0 = 0; k0 < 64; k0 += 32) t4 = MFMA16(frag_tr(Ks + k0 * LQ + wave * 16, LQ, lane), frag_tr(VWs + k0 * LV + vi * 16, LV, lane), t4);
                cacc[vi][0] = dec * cacc[vi][0] + t4[0]; cacc[vi][1] = dec * cacc[vi][1] + t4[1]; cacc[vi][2] = dec * cacc[vi][2] + t4[2]; cacc[vi][3] = dec * cacc[vi][3] + t4[3];
                u32x2 o; o.x = pack2(cacc[vi][0], cacc[vi][1]); o.y = pack2(cacc[vi][2], cacc[vi][3]);
                *(u32x2*)(Cn + (vi * 16 + li) * LQ + wave * 16 + 4 * g) = o;
            }
            if (tid < 128) {
                float a = dec * ncur[tid];
#pragma unroll 8
                for (int s = 0; s < 64; ++s) a += wsc[s] * bf2f(Ks[s * LQ + tid]);
                nnxt[tid] = a;
            }
        }
        __syncthreads();
    }
#undef MSEQ_LOAD
}

__device__ __forceinline__ void phase_pre1(const Params& p, char* lds) {
    int tab_hh = -1;
    for (int i = blockIdx.x; i < 2048; i += gridDim.x) {
        if (i < 1024) {
            const int hh_i = (i >> 5) & 3;
            if (hh_i != tab_hh) {
                __syncthreads();
                float* CWT = (float*)(lds + 145664);
                for (int j = threadIdx.x; j < 4 * 384; j += NT) { const int r = j / 384, cc = j % 384; CWT[j] = p.gd_conv[r * 1536 + (cc >> 7) * 512 + hh_i * 128 + (cc & 127)]; }
                __syncthreads();
                tab_hh = hh_i;
            }
            gdn_pre_item(p, lds, i);
        } else mlstm_pre_item(p, lds, i - 1024);
    }
}

__device__ __forceinline__ void phase_mix1(const Params& p, char* lds) {
    for (int u = blockIdx.x; u < 256; u += gridDim.x) {
        const int v = u & 127, x = v & 7, j = v >> 3, pair = x * 4 + (j >> 2), bb = pair >> 2, hh = pair & 3, cg = j & 3;
        if (u < 128) gdn_seq_unit(p, lds, bb, hh, cg);
        else mlstm_seq_unit(p, lds, bb, hh, cg);
        __syncthreads();
    }
}

__device__ __forceinline__ void phase_post1(const Params& p) {
    const int tid = threadIdx.x, lane = tid & 63, wave = tid >> 6;
    unsigned char* ws = p.ws;
    bf16_t* O16 = (bf16_t*)(ws + WS_XN);
    const bf16_t* P = (const bf16_t*)(ws + WS_P);
    const int c0 = lane * 16;
    for (int ti_ = blockIdx.x * 8 + wave; ti_ < M; ti_ += gridDim.x * 8) {
        const int tok = (gridDim.x == 256) ? (((ti_ >> 3) & 7) * 2048 + ((ti_ >> 6) & 31) * 64 + (ti_ >> 11) * 8 + (ti_ & 7)) : ti_;
        const u32x4 r0 = *(const u32x4*)(O16 + (size_t)tok * D + c0), r1 = *(const u32x4*)(O16 + (size_t)tok * D + c0 + 8);
        float y[16];
        y[0] = lo16(r0.x); y[1] = hi16(r0.x); y[2] = lo16(r0.y); y[3] = hi16(r0.y); y[4] = lo16(r0.z); y[5] = hi16(r0.z); y[6] = lo16(r0.w); y[7] = hi16(r0.w);
        y[8] = lo16(r1.x); y[9] = hi16(r1.x); y[10] = lo16(r1.y); y[11] = hi16(r1.y); y[12] = lo16(r1.z); y[13] = hi16(r1.z); y[14] = lo16(r1.w); y[15] = hi16(r1.w);
        float q = 0.f;
#pragma unroll
        for (int j = 0; j < 16; ++j) q += y[j] * y[j];
        q += dppf<0xB1>(q); q += dppf<0x4E>(q); q += dppf<0x141>(q);
        const float rstd = rsqrtf(q * (1.0f / 128.0f) + 1e-6f);
        const int gcol = lane < 32 ? 1536 + c0 : 3584 + (c0 - 512);
        const u32x4 g0 = *(const u32x4*)(P + (size_t)tok * ODD_IN + gcol), g1 = *(const u32x4*)(P + (size_t)tok * ODD_IN + gcol + 8);
        float gt[16];
        gt[0] = lo16(g0.x); gt[1] = hi16(g0.x); gt[2] = lo16(g0.y); gt[3] = hi16(g0.y); gt[4] = lo16(g0.z); gt[5] = hi16(g0.z); gt[6] = lo16(g0.w); gt[7] = hi16(g0.w);
        gt[8] = lo16(g1.x); gt[9] = hi16(g1.x); gt[10] = lo16(g1.y); gt[11] = hi16(g1.y); gt[12] = lo16(g1.z); gt[13] = hi16(g1.z); gt[14] = lo16(g1.w); gt[15] = hi16(g1.w);
        float o[16];
        if (lane < 32) {
#pragma unroll
            for (int j = 0; j < 16; ++j) o[j] = y[j] * rstd * p.gd_norm[(c0 + j) & 127] * siluf_(gt[j]);
        } else {
#pragma unroll
            for (int j = 0; j < 16; ++j) o[j] = y[j] * rstd * p.ml_norm[c0 - 512 + j] * sigmoidf_(gt[j]);
        }
        u32x4 w0, w1;
        w0.x = pack2(o[0], o[1]); w0.y = pack2(o[2], o[3]); w0.z = pack2(o[4], o[5]); w0.w = pack2(o[6], o[7]);
        w1.x = pack2(o[8], o[9]); w1.y = pack2(o[10], o[11]); w1.z = pack2(o[12], o[13]); w1.w = pack2(o[14], o[15]);
        *(u32x4*)(O16 + (size_t)tok * D + c0) = w0; *(u32x4*)(O16 + (size_t)tok * D + c0 + 8) = w1;
    }
}


#define XB_TMO      128
#define XB_XCNT(j)  (256  + 64 * (j))
#define XB_XSUB(j)  (1280 + 64 * (j))
#define XB_XGEN(j)  (2304 + 64 * (j))
#define XB_TOP      3328
#define XB_TOPGEN   3392
#define XCD_BAR_WORDS 3456
#define XB_SPIN_CAP (1u << 22)
__device__ __forceinline__ unsigned xb_ld(unsigned* p)              { return __hip_atomic_load(p, __ATOMIC_RELAXED, __HIP_MEMORY_SCOPE_AGENT); }
__device__ __forceinline__ unsigned xb_add(unsigned* p, unsigned v) { return __hip_atomic_fetch_add(p, v, __ATOMIC_RELAXED, __HIP_MEMORY_SCOPE_AGENT); }
__device__ __forceinline__ unsigned xb_xcc_id() { return (unsigned)__builtin_amdgcn_s_getreg((3 << 11) | 20) & 0xFu; }
#define XB_SPIN(cond, bar) do { unsigned _sp = 0; while (cond) { __builtin_amdgcn_s_sleep(1); \
    if ((++_sp & 255u) == 0u) { if (xb_ld(&(bar)[XB_TMO])) break; if (_sp > XB_SPIN_CAP) { atomicAdd(&(bar)[XB_TMO], 1u); break; } } } } while (0)
struct XcdBarrier { unsigned* bar; unsigned x; volatile LAS unsigned* st; };
__device__ __forceinline__ XcdBarrier xcd_barrier_post(unsigned* bar, volatile LAS unsigned* st) {
    XcdBarrier b; b.bar = bar; b.x = xb_xcc_id(); b.st = st;
    if (threadIdx.x == 0) (void)xb_add(&bar[XB_XCNT(b.x)], 1u);
    return b;
}
__device__ __forceinline__ void xcd_barrier_complete(unsigned* bar, unsigned x, unsigned& nloc, unsigned& nx) {
    const unsigned G = gridDim.x * gridDim.y * gridDim.z;
    unsigned sum, cnt, mine, sp = 0u;
    for (;;) {
        sum = 0u; cnt = 0u; mine = 0u;
#pragma unroll
        for (unsigned j = 0; j < 16; ++j) { const unsigned c = xb_ld(&bar[XB_XCNT(j)]); sum += c; cnt += (c > 0u) ? 1u : 0u; mine = (j == x) ? c : mine; }
        if (sum == G) break;
        __builtin_amdgcn_s_sleep(1);
        if ((++sp & 255u) == 0u) { if (xb_ld(&bar[XB_TMO])) break; if (sp > XB_SPIN_CAP) { atomicAdd(&bar[XB_TMO], 1u); break; } }
    }
    nloc = mine > 0u ? mine : 1u; nx = cnt > 0u ? cnt : 1u;
}
__device__ __forceinline__ void xcd_barrier(const XcdBarrier& b) {
    asm volatile("s_waitcnt vmcnt(0)" ::: "memory");
    __syncthreads();
    if (threadIdx.x == 0) {
        unsigned* bar = b.bar;
        __builtin_amdgcn_s_waitcnt(0);
        unsigned nloc = b.st[0], nx = b.st[1];
        if (nloc == 0u) { xcd_barrier_complete(bar, b.x, nloc, nx); b.st[0] = nloc; b.st[1] = nx; }
        const unsigned old = xb_add(&bar[XB_XSUB(b.x)], 1u);
        const unsigned gen = old / nloc;
        if (old + 1u == (gen + 1u) * nloc) {
            __builtin_amdgcn_fence(__ATOMIC_RELEASE, "agent");
            asm volatile("s_waitcnt vmcnt(0)" ::: "memory");
            const unsigned og = xb_add(&bar[XB_TOP], 1u);
            const unsigned tg = og / nx;
            if (og + 1u == (tg + 1u) * nx) xb_add(&bar[XB_TOPGEN], 1u);
            else XB_SPIN(xb_ld(&bar[XB_TOPGEN]) == tg, bar);
            __builtin_amdgcn_fence(__ATOMIC_ACQUIRE, "agent");
            xb_add(&bar[XB_XGEN(b.x)], 1u);
            asm volatile("s_waitcnt vmcnt(0)" ::: "memory");
        } else {
            XB_SPIN(xb_ld(&bar[XB_XGEN(b.x)]) == gen, bar);
            __builtin_amdgcn_fence(__ATOMIC_ACQUIRE, "agent");
            asm volatile("s_waitcnt vmcnt(0)" ::: "memory");
        }
    }
    __syncthreads();
}

__device__ __forceinline__ void final_row(const Params& p, int tok, int lane, float* dst  ) {
    const bf16_t* H16 = (const bf16_t*)((const char*)p.out + H16_OFF);
    const bf16_t* Y0 = (const bf16_t*)(p.ws + WS_P + P_Y); const bf16_t* Y1 = Y0 + (size_t)M * D;
    float4 v[4];
#pragma unroll
    for (int i = 0; i < 4; ++i) {
        const u32x2 h = *(const u32x2*)(H16 + (size_t)tok * D + i * 256 + lane * 4), a = *(const u32x2*)(Y0 + (size_t)tok * D + i * 256 + lane * 4), b = *(const u32x2*)(Y1 + (size_t)tok * D + i * 256 + lane * 4);
        v[i].x = lo16(h.x) + lo16(a.x) + lo16(b.x); v[i].y = hi16(h.x) + hi16(a.x) + hi16(b.x); v[i].z = lo16(h.y) + lo16(a.y) + lo16(b.y); v[i].w = hi16(h.y) + hi16(a.y) + hi16(b.y);
    }
    float ss = 0.f;
#pragma unroll
    for (int i = 0; i < 4; ++i) ss += v[i].x * v[i].x + v[i].y * v[i].y + v[i].z * v[i].z + v[i].w * v[i].w;
    ss = red64(ss);
    const float rstd = rsqrtf(ss * (1.0f / D) + 1e-6f);
#pragma unroll
    for (int i = 0; i < 4; ++i) { const float4 g4 = *(const float4*)(p.norm_final + i * 256 + lane * 4);
        float4 o; o.x = v[i].x * rstd * g4.x; o.y = v[i].y * rstd * g4.y; o.z = v[i].z * rstd * g4.z; o.w = v[i].w * rstd * g4.w;
        *(float4*)(dst + i * 256 + lane * 4) = o; }
}
__device__ __forceinline__ void phase_final(const Params& p, char* lds, const XcdBarrier& bar) {
    const int tid = threadIdx.x, lane = tid & 63, wave = tid >> 6, G = (int)gridDim.x, b = (int)blockIdx.x;
    float* stage = (float*)lds;
    for (int base = b * 32; base < M / 2; base += G * 32)
#pragma unroll 1
        for (int q = 0; q < 4; ++q) { const int tok = base + wave * 4 + q; final_row(p, tok, lane, p.out + (size_t)tok * D); }
    for (int r0 = 0; r0 < M / 2; r0 += G * 32) {
        const int base = M / 2 + r0 + b * 32;
        if (base < M) {
#pragma unroll 1
            for (int q = 0; q < 4; ++q) { const int tl = wave * 4 + q; final_row(p, base + tl, lane, stage + tl * 1024); }
        }
        xcd_barrier(bar);
        if (base < M) {
            for (int i = tid; i < 32 * 256; i += NT) { const int tl = i >> 8, c4 = i & 255; *(float4*)(p.out + (size_t)(base + tl) * D + c4 * 4) = *(const float4*)(stage + tl * 1024 + c4 * 4); }
        }
        __syncthreads();
    }
}

__global__ void __launch_bounds__(NT) fwd_kernel(Params p) {
    extern __shared__ __attribute__((aligned(16))) char lds[];
    const int lo = p.ph_lo, hi = p.ph_hi;
    volatile LAS unsigned* bst = (volatile LAS unsigned*)(lds + LDS_BYTES - 16);
    if (threadIdx.x < 4) bst[threadIdx.x] = 0u;
    __syncthreads();
    XcdBarrier bar; bar.bar = (unsigned*)(p.ws + WS_CTL) + CTL_BAR; bar.x = 0; bar.st = bst;
    if (hi - lo > 1) bar = xcd_barrier_post((unsigned*)(p.ws + WS_CTL) + CTL_BAR, bst);
    if (hi > 1000) cooperative_groups::this_grid().sync();
#define IN(k) (lo <= (k) && (k) < hi)
#define SEAM(k) do { if (IN(k) && IN((k) + 1)) xcd_barrier(bar); } while (0)
#define RUN(k, ...) do { if (IN(k)) { __VA_ARGS__; if (REP_PHASE == (k)) { xcd_barrier(bar); __VA_ARGS__; } } SEAM(k); } while (0)
    RUN(1, phase_prep_router(p); phase_convert<0>(p, lds); phase_rows<0>(p, lds, 0); phase_dense_gemm<0>(p, lds));
    RUN(2, phase_pre0(p, lds));
    RUN(3, phase_mix0(p, lds));
    RUN(4, phase_post0(p); phase_convert<1>(p, lds));
    RUN(5, phase_dense_gemm<1>(p, lds));
    RUN(6, phase_rows<1>(p, lds, 0));
    RUN(7, phase_moe_merged(p, lds, 0));
    RUN(8, phase_rows<2>(p, lds, 1));
    RUN(9, phase_dense_gemm<2>(p, lds));
    RUN(10, phase_pre1(p, lds));
    RUN(11, phase_mix1(p, lds));
    RUN(12, phase_post1(p); phase_convert<2>(p, lds));
    RUN(13, phase_dense_gemm<3>(p, lds));
    RUN(14, phase_rows<1>(p, lds, 1));
    RUN(15, phase_moe_merged(p, lds, 1));
    RUN(16, phase_final(p, lds, bar));
#undef RUN
#undef IN
#undef SEAM
}

extern "C" void kernel_launch(void* const* d_in, const int* in_sizes, int n_in, void* d_out, int out_size, void* d_ws, size_t ws_size, hipStream_t stream) {
    static int ok = 0, grid = 0;
    if (ok == 0) {
        ok = 1;
        if (n_in != 35 || out_size != M * D || ws_size < WS_END) { fprintf(stderr, "kernel_launch: unexpected sizes n_in=%d out=%d ws=%zu need=%zu\n", n_in, out_size, ws_size, (size_t)WS_END); ok = -1; }
        if (hipFuncSetAttribute((const void*)fwd_kernel, hipFuncAttributeMaxDynamicSharedMemorySize, LDS_BYTES) != hipSuccess) { fprintf(stderr, "kernel_launch: hipFuncSetAttribute failed\n"); ok = -1; }
        int dev = 0, cus = 0, per_cu = 0;
        hipGetDevice(&dev); hipDeviceGetAttribute(&cus, hipDeviceAttributeMultiprocessorCount, dev);
        if (hipOccupancyMaxActiveBlocksPerMultiprocessor(&per_cu, (const void*)fwd_kernel, NT, LDS_BYTES) != hipSuccess || per_cu < 1) { fprintf(stderr, "kernel_launch: occupancy query failed (%d)\n", per_cu); per_cu = 1; }
        (void)hipGetLastError();
        grid = cus * (per_cu > 1 ? 1 : per_cu);
        if (grid > 256) grid = 256;
        if (grid < 1) ok = -1;
    }
    if (ok < 0) return;
    Params p{};
    const float** f = (const float**)&p;
    for (int i = 0; i < 35; ++i) f[i] = (const float*)d_in[i];
    p.out = (float*)d_out; p.ws = (unsigned char*)d_ws;
    (void)hipMemsetAsync((char*)d_ws + WS_CTL, 0, 163840, stream);
#if SINGLE_LAUNCH
    p.ph_lo = 0; p.ph_hi = NPHASE;
    void* args[] = {&p};
    hipError_t e = hipLaunchCooperativeKernel((const void*)fwd_kernel, dim3(grid), dim3(NT), args, LDS_BYTES, stream);
    if (e != hipSuccess) fprintf(stderr, "kernel_launch: cooperative launch failed: %s (grid %d)\n", hipGetErrorString(e), grid);
#else
    for (int ph = 0; ph < NPHASE; ++ph) {
        p.ph_lo = ph; p.ph_hi = ph + 1;
        hipLaunchKernelGGL(fwd_kernel, dim3(grid), dim3(NT), LDS_BYTES, stream, p);
    }
#endif
}
```

```cpp
#include <hip/hip_runtime.h>
#include <hip/hip_cooperative_groups.h>
#include <stdint.h>
#include <stdio.h>

#ifndef REP_PHASE
#define REP_PHASE -1
#endif
#ifndef REP_UNIT
#define REP_UNIT 0
#endif
#ifndef SINGLE_LAUNCH
#define SINGLE_LAUNCH 1
#endif

typedef unsigned short bf16_t;
typedef short bf16x8 __attribute__((ext_vector_type(8)));
typedef float f32x16 __attribute__((ext_vector_type(16)));
typedef float f32x4 __attribute__((ext_vector_type(4)));
typedef unsigned u32x4 __attribute__((ext_vector_type(4)));
typedef unsigned u32x2 __attribute__((ext_vector_type(2)));

#define NT 512
typedef short s16x4 __attribute__((ext_vector_type(4)));
typedef float f32x4v __attribute__((ext_vector_type(4)));
#define MFMA16(a, b, c) __builtin_amdgcn_mfma_f32_16x16x32_bf16((a), (b), (c), 0, 0, 0)
#define LAS __attribute__((address_space(3)))
constexpr int D = 1024, NBATCH = 8, SEQ = 2048, M = NBATCH * SEQ;
constexpr int EVEN_IN = 3840, ODD_SRC = 4112, ODD_IN = 4096;
constexpr int NPHASE = 17;
constexpr int LDS_BYTES = 150 * 1024;

constexpr size_t WS_CTL = 0;
constexpr size_t WS_WIN0 = 163840;
constexpr size_t WS_WOUT0 = WS_WIN0 + (size_t)EVEN_IN * D * 2;
constexpr size_t WS_WIN1 = WS_WOUT0 + (size_t)D * D * 2;
constexpr size_t WS_WOUT1 = WS_WIN1 + (size_t)ODD_IN * D * 2;
constexpr size_t WS_XN = WS_WOUT1 + (size_t)D * D * 2;
constexpr size_t WS_P = WS_XN + (size_t)M * D * 2;
constexpr size_t WS_LTOK = WS_P + (size_t)100 * 1024 * 1024;
constexpr size_t WS_LGATE = WS_LTOK + (size_t)32 * M * 4;
constexpr size_t WS_GATES = WS_P + (size_t)M * 4096 * 2;
constexpr size_t WS_WR = WS_GATES + (size_t)M * 16 * 4;
constexpr size_t WS_WRB = WS_WR + (size_t)(2 * 40 + 16) * 1024 * 4;
constexpr size_t WS_RWW = WS_WRB + (size_t)(2 * 2 * 48 + 2 * 16) * 1024 * 2;
constexpr size_t WS_ARENA = WS_RWW + (size_t)8 * 256 * 64 * 2;
constexpr size_t WS_WGU = WS_ARENA;
constexpr size_t WS_WD = WS_WGU + (size_t)2 * 32 * 512 * 1024 * 2;
constexpr size_t WS_CHK_RW = WS_ARENA;
constexpr size_t CHK_RW_ITEM = 32768;
constexpr size_t WS_CHK_HG = WS_CHK_RW + (size_t)2048 * CHK_RW_ITEM;
constexpr size_t CHK_HG_ITEM = 24576 + 256;
constexpr size_t WS_END = WS_CHK_HG + (size_t)2048 * CHK_HG_ITEM;
static_assert(WS_END >= WS_WD + (size_t)2 * 32 * 1024 * 256 * 2, "arena");
static_assert(WS_END <= 310000000, "workspace budget");
static_assert(WS_LGATE + (size_t)32 * M * 4 <= WS_P + (size_t)M * 4096 * 2, "lists inside P");
constexpr size_t P_HID = 0;
constexpr size_t P_Y = (size_t)32 * 1024 * 1024;
constexpr size_t H16_OFF = (size_t)M * D * 2;
constexpr int CTL_CNT = 0;
constexpr int CTL_BAR = 1024;
constexpr int CTL_MOE = 16384;
constexpr int CTL_READY = 8192;

struct Params {
    const float* x; const float* norm_mix; const float* norm_ffn; const float* norm_final;
    const float* ev_w_in; const float* ev_mu; const float* rw_w0; const float* rw_w2; const float* rw_a0; const float* rw_a2; const float* rw_g2;
    const float* rw_k_k; const float* rw_k_a; const float* rw_r_k; const float* rw_ln_w; const float* rw_ln_b; const float* hg_lb; const float* hg_norm;
    const float* ev_w_out; const float* od_w_in; const float* gd_conv; const float* gd_a_log; const float* gd_dt_bias; const float* gd_norm;
    const float* ml_i_bias; const float* ml_f_bias; const float* ml_norm; const float* od_w_out;
    const float* moe_w_group; const float* moe_b_group; const float* moe_w_router; const float* moe_b_router;
    const float* moe_w_gate; const float* moe_w_up; const float* moe_w_down;
    float* out; unsigned char* ws;
    int ph_lo, ph_hi;
};

__device__ __forceinline__ float bf2f(unsigned short u) { return __uint_as_float(((unsigned)u) << 16); }
__device__ __forceinline__ unsigned short f2bf(float f) { const __bf16 h = (__bf16)f; return __builtin_bit_cast(unsigned short, h); }
typedef __bf16 bf16x2_t __attribute__((ext_vector_type(2)));
typedef float f32x2_t __attribute__((ext_vector_type(2)));
__device__ __forceinline__ unsigned pack2(float a, float b) { f32x2_t f; f.x = a; f.y = b; const bf16x2_t h = __builtin_convertvector(f, bf16x2_t); return __builtin_bit_cast(unsigned, h); }
__device__ __forceinline__ float lo16(unsigned u) { return __uint_as_float(u << 16); }
__device__ __forceinline__ float hi16(unsigned u) { return __uint_as_float(u & 0xffff0000u); }
__device__ __forceinline__ float sigmoidf_(float x) { return __builtin_amdgcn_rcpf(1.0f + __expf(-x)); }
__device__ __forceinline__ float siluf_(float x) { return x * __builtin_amdgcn_rcpf(1.0f + __expf(-x)); }
__device__ __forceinline__ float softplusf_(float x) { return x > 20.f ? x : log1pf(__expf(x)); }

template <int CTRL> __device__ __forceinline__ float dppf(float x) {
    return __int_as_float(__builtin_amdgcn_update_dpp(0, __float_as_int(x), CTRL, 0xF, 0xF, false));
}
__device__ __forceinline__ float red16(float x) {
    x += dppf<0xB1>(x);
    x += dppf<0x4E>(x);
    x += dppf<0x141>(x);
    x += dppf<0x140>(x);
    return x;
}
__device__ __forceinline__ float red64(float x) {
    x = red16(x);
    x += __shfl_xor(x, 16);
    x += __shfl_xor(x, 32);
    return x;
}

__device__ __forceinline__ void conv_tile(float* tile, const float* s0, const float* s1, size_t ld, bf16_t* d, size_t ldd, unsigned* ready = nullptr, bf16_t* d1 = nullptr) {
    const int tid = threadIdx.x;
#pragma unroll
    for (int i = 0; i < 2; ++i) {
        const int k = (tid >> 4) + 32 * i, nn = (tid & 15) * 4;
        const float* s = nn < 32 ? s0 + (size_t)k * ld + nn : s1 + (size_t)k * ld + (nn - 32);
        const float4 v = *(const float4*)s;
        float* t = tile + k * 65 + nn;
        t[0] = v.x; t[1] = v.y; t[2] = v.z; t[3] = v.w;
    }
    __syncthreads();
    const int n = tid >> 3, kc = (tid & 7) * 8;
    float f0 = tile[(kc + 0) * 65 + n], f1 = tile[(kc + 1) * 65 + n], f2 = tile[(kc + 2) * 65 + n], f3 = tile[(kc + 3) * 65 + n];
    float f4 = tile[(kc + 4) * 65 + n], f5 = tile[(kc + 5) * 65 + n], f6 = tile[(kc + 6) * 65 + n], f7 = tile[(kc + 7) * 65 + n];
    u32x4 o; o.x = pack2(f0, f1); o.y = pack2(f2, f3); o.z = pack2(f4, f5); o.w = pack2(f6, f7);
    if (ready) {
        unsigned long long* dp = (unsigned long long*)(d + (size_t)n * ldd + kc);
        __hip_atomic_store(dp, ((unsigned long long)o.y << 32) | o.x, __ATOMIC_RELAXED, __HIP_MEMORY_SCOPE_AGENT);
        __hip_atomic_store(dp + 1, ((unsigned long long)o.w << 32) | o.z, __ATOMIC_RELAXED, __HIP_MEMORY_SCOPE_AGENT);
        asm volatile("s_waitcnt vmcnt(0)" ::: "memory");
        __syncthreads();
        if (tid == 0) __hip_atomic_fetch_add(ready, 1u, __ATOMIC_RELAXED, __HIP_MEMORY_SCOPE_AGENT);
    } else {
        bf16_t* dd = (d1 && n >= 32) ? d1 + (size_t)(n - 32) * ldd : d + (size_t)n * ldd;
        *(u32x4*)(dd + kc) = o;
        __syncthreads();
    }
}

template <int PART>
__device__ __forceinline__ void phase_convert(const Params& p, char* lds) {
    float* tile = (float*)lds;
    unsigned char* ws = p.ws;
    const int total = PART == 0 ? (960 + 256 + 1024 + 256) : (4096 + 2048);
    for (int g0 = blockIdx.x; g0 < total; g0 += gridDim.x) {
        int g = g0;
        if (PART == 0) {
            if (g < 960) { const int kt = g & 15, nt = g >> 4;
                const float* s0 = p.ev_w_in + (size_t)(kt * 64) * EVEN_IN + nt * 64;
                conv_tile(tile, s0, s0 + 32, EVEN_IN, (bf16_t*)(ws + WS_WIN0) + (size_t)(nt * 64) * D + kt * 64, D, (unsigned*)(ws + WS_CTL) + CTL_READY + 4096 + 64 * (nt >> 2)); continue; }
            g -= 960;
            if (g < 256) { const int kt = g & 15, nt = g >> 4;
                const float* s0 = p.ev_w_out + (size_t)(kt * 64) * D + nt * 64;
                conv_tile(tile, s0, s0 + 32, D, (bf16_t*)(ws + WS_WOUT0) + (size_t)(nt * 64) * D + kt * 64, D); continue; }
            g -= 256;
            if (g < 1024) { const int kt = g & 15, nt = g >> 4;
                const float* s0 = p.od_w_in + (size_t)(kt * 64) * ODD_SRC + nt * 64 + (nt >= 32 ? 8 : 0);
                conv_tile(tile, s0, s0 + 32, ODD_SRC, (bf16_t*)(ws + WS_WIN1) + (size_t)(nt * 64) * D + kt * 64, D); continue; }
            g -= 1024;
            { const int kt = g & 15, nt = g >> 4;
                const float* s0 = p.od_w_out + (size_t)(kt * 64) * D + nt * 64;
                conv_tile(tile, s0, s0 + 32, D, (bf16_t*)(ws + WS_WOUT1) + (size_t)(nt * 64) * D + kt * 64, D); }
        } else {
            if (g < 4096) { const int le = (g >> 7) + (PART == 2 ? 32 : 0), r = g & 127, kt = r & 15, s = r >> 4;
                const size_t so = (size_t)le * 1024 * 256 + (size_t)(kt * 64) * 256 + s * 32;
                bf16_t* dg = (bf16_t*)(ws + WS_WGU) + (size_t)le * 512 * 1024 + (size_t)((s >> 2) * 256 + (s & 3) * 32) * 1024 + kt * 64;
                conv_tile(tile, p.moe_w_gate + so, p.moe_w_up + so, 256, dg, 1024, nullptr, dg + (size_t)128 * 1024); continue; }
            g -= 4096;
            { const int le = (g >> 6) + (PART == 2 ? 32 : 0), r = g & 63, kt = r & 3, nt = r >> 2;
                const float* s0 = p.moe_w_down + (size_t)le * 256 * 1024 + (size_t)(kt * 64) * 1024 + nt * 64;
                conv_tile(tile, s0, s0 + 32, 1024, (bf16_t*)(ws + WS_WD) + (size_t)le * 1024 * 256 + (size_t)(nt * 64) * 256 + kt * 64, 256); }
        }
    }
}


__device__ __forceinline__ void phase_prep_router(const Params& p) {
    float* WR = (float*)(p.ws + WS_WR);
    bf16_t* RWW = (bf16_t*)(p.ws + WS_RWW);
    for (int i = blockIdx.x * NT + threadIdx.x; i < 8 * 256 * 64; i += gridDim.x * NT) {
        const int hh = i >> 14, r = (i >> 6) & 255, cc = i & 63;
        const float w = r < 64 ? p.rw_w2[r * 512 + hh * 64 + cc] : r < 128 ? p.rw_a2[(r - 64) * 512 + hh * 64 + cc] : p.rw_g2[(r - 128) * 512 + hh * 64 + cc];
        RWW[i] = f2bf(w);
    }
    for (int i = blockIdx.x * NT + threadIdx.x; i < 96 * 1024; i += gridDim.x * NT) {
        const int o = i >> 10, d = i & 1023;
        float w = 0.f;
        if (o < 80) { const int l = o / 40, oo = o % 40;
            if (oo < 4) w = p.moe_w_group[(size_t)l * D * 4 + d * 4 + oo]; else if (oo < 36) w = p.moe_w_router[(size_t)l * D * 32 + d * 32 + (oo - 4)];
        } else { const int oo = o - 80; w = p.od_w_in[(size_t)d * ODD_SRC + (oo < 8 ? 2048 + oo : 4104 + (oo - 8))]; }
        WR[i] = w;
        bf16_t* WRB = (bf16_t*)(p.ws + WS_WRB);
        const unsigned short hi = f2bf(w), lo = f2bf(w - bf2f(hi));
        if (o < 80) { const int l = o / 40, oo = o % 40; WRB[((size_t)(l * 2 + 0) * 48 + oo) * 1024 + d] = hi; WRB[((size_t)(l * 2 + 1) * 48 + oo) * 1024 + d] = lo; }
        else { const int oo = o - 80; WRB[(size_t)192 * 1024 + (size_t)oo * 1024 + d] = hi; WRB[(size_t)192 * 1024 + (size_t)(16 + oo) * 1024 + d] = lo; }
    }
    for (int i = blockIdx.x * NT + threadIdx.x; i < 4 * 8 * 1024; i += gridDim.x * NT) {
        const int blk = i >> 13, r = 40 + ((i >> 10) & 7), d = i & 1023; ((bf16_t*)(p.ws + WS_WRB))[((size_t)blk * 48 + r) * 1024 + d] = 0; }
}

template <int MODE>
__device__ __forceinline__ void phase_rows(const Params& p, char* lds, int layer) {
    const int tid = threadIdx.x, lane = tid & 63, wave = tid >> 6;
    unsigned char* ws = p.ws;
    const float* src = p.x;
    bf16_t* H16 = (bf16_t*)((char*)p.out + H16_OFF);
    const float* gain = (MODE == 0) ? p.norm_mix : (MODE == 1) ? p.norm_ffn + layer * D : (MODE == 2) ? p.norm_mix + D : p.norm_final;
    bf16_t* XN = (bf16_t*)(ws + WS_XN);
    const bf16_t* Y0 = (const bf16_t*)(ws + WS_P + P_Y);
    const bf16_t* Y1 = Y0 + (size_t)M * D;
    float* rstd_s = (float*)lds;
    constexpr int LOS = 1032;
    bf16_t* LO = (bf16_t*)(lds + 1024);
    float* lg = (float*)(lds + 1024 + 64 * LOS * 2);
    constexpr int NO = (MODE == 1) ? 5 : 2;
    constexpr int NOUT = (MODE == 1) ? 36 : 16;
    for (int gi = blockIdx.x; gi < M / 64; gi += gridDim.x) {
        const int grp = (gridDim.x == 256) ? ((gi & 7) * 32 + (gi >> 3)) : gi;
        const int t0 = grp * 64;
#pragma unroll 1
        for (int q4 = 0; q4 < 2; ++q4) {
            float4 v[4][4];
#pragma unroll
            for (int j = 0; j < 4; ++j) { const int tok = t0 + wave * 8 + q4 * 4 + j;
#pragma unroll
                for (int i = 0; i < 4; ++i) {
                    if (MODE == 0) v[j][i] = *(const float4*)(src + (size_t)tok * D + i * 256 + lane * 4);
                    else { const u32x2 h = *(const u32x2*)(H16 + (size_t)tok * D + i * 256 + lane * 4); v[j][i].x = lo16(h.x); v[j][i].y = hi16(h.x); v[j][i].z = lo16(h.y); v[j][i].w = hi16(h.y); } } }
            if (MODE == 2 || MODE == 3) {
#pragma unroll
                for (int j = 0; j < 4; ++j) { const int tok = t0 + wave * 8 + q4 * 4 + j;
                    u32x2 a[4], b[4];
#pragma unroll
                    for (int i = 0; i < 4; ++i) { a[i] = *(const u32x2*)(Y0 + (size_t)tok * D + i * 256 + lane * 4); b[i] = *(const u32x2*)(Y1 + (size_t)tok * D + i * 256 + lane * 4); }
#pragma unroll
                    for (int i = 0; i < 4; ++i) { v[j][i].x += lo16(a[i].x) + lo16(b[i].x); v[j][i].y += hi16(a[i].x) + hi16(b[i].x); v[j][i].z += lo16(a[i].y) + lo16(b[i].y); v[j][i].w += hi16(a[i].y) + hi16(b[i].y); }
                }
            }
            float4 g4[4];
#pragma unroll
            for (int i = 0; i < 4; ++i) g4[i] = *(const float4*)(gain + i * 256 + lane * 4);
#pragma unroll
            for (int j = 0; j < 4; ++j) {
                const int tl = wave * 8 + q4 * 4 + j, tok = t0 + tl;
                float ss = 0.f;
#pragma unroll
                for (int i = 0; i < 4; ++i) ss += v[j][i].x * v[j][i].x + v[j][i].y * v[j][i].y + v[j][i].z * v[j][i].z + v[j][i].w * v[j][i].w;
                ss = red64(ss);
                const float rstd = rsqrtf(ss * (1.0f / D) + 1e-6f);
                if (lane == 0) rstd_s[tl] = rstd;
#pragma unroll
                for (int i = 0; i < 4; ++i) {
                    if (MODE == 2) { u32x2 hw; hw.x = pack2(v[j][i].x, v[j][i].y); hw.y = pack2(v[j][i].z, v[j][i].w); *(u32x2*)(H16 + (size_t)tok * D + i * 256 + lane * 4) = hw; }
                    const float o0 = v[j][i].x * rstd * g4[i].x, o1 = v[j][i].y * rstd * g4[i].y, o2 = v[j][i].z * rstd * g4[i].z, o3 = v[j][i].w * rstd * g4[i].w;
                    if (MODE == 3) { float4 o; o.x = o0; o.y = o1; o.z = o2; o.w = o3; *(float4*)(p.out + (size_t)tok * D + i * 256 + lane * 4) = o; }
                    else { u32x2 o; o.x = pack2(o0, o1); o.y = pack2(o2, o3);
                        if (MODE == 1 || MODE == 2) { u32x2 l2; l2.x = pack2(o0 - lo16(o.x), o1 - hi16(o.x)); l2.y = pack2(o2 - lo16(o.y), o3 - hi16(o.y)); *(u32x2*)(LO + tl * LOS + i * 256 + lane * 4) = l2; }
                        if (MODE == 0) __hip_atomic_store((unsigned long long*)(XN + (size_t)tok * D + i * 256 + lane * 4), ((unsigned long long)o.y << 32) | o.x, __ATOMIC_RELAXED, __HIP_MEMORY_SCOPE_AGENT);
                        else *(u32x2*)(XN + (size_t)tok * D + i * 256 + lane * 4) = o; }
                }
            }
        }
        if (MODE == 0) {
            asm volatile("s_waitcnt vmcnt(0)" ::: "memory");
            __syncthreads();
            if (tid == 0) __hip_atomic_fetch_add((unsigned*)(ws + WS_CTL) + CTL_READY + 64 * (grp >> 2), 1u, __ATOMIC_RELAXED, __HIP_MEMORY_SCOPE_AGENT);
        }
        if (MODE == 1 || MODE == 2) {
            const int btok = tid & 63, og = tid >> 6;
            for (int i = tid; i < 64 * 48; i += NT) lg[i] = 0.f;
            asm volatile("s_waitcnt vmcnt(0)" ::: "memory");
            __syncthreads();
            {
                const bf16_t* Whi = (const bf16_t*)(ws + WS_WRB) + (MODE == 1 ? (size_t)(layer * 2) * 48 * 1024 : (size_t)192 * 1024);
                const bf16_t* Wlo = Whi + (MODE == 1 ? (size_t)48 * 1024 : (size_t)16 * 1024);
                constexpr int NTN = (MODE == 1) ? 3 : 1, NJOB = 4 * NTN * 2;
                const int lane16 = lane & 15, g4 = lane >> 4;
                for (int job = wave; job < NJOB; job += 8) {
                    const int kh = job & 1, tq = job >> 1, ti = tq / NTN, nj = tq - ti * NTN;
                    const bf16_t* ah = XN + (size_t)(t0 + ti * 16 + lane16) * D + kh * 512 + 8 * g4;
                    const bf16_t* al = LO + (ti * 16 + lane16) * LOS + kh * 512 + 8 * g4;
                    const bf16_t* bh = Whi + (size_t)(nj * 16 + lane16) * 1024 + kh * 512 + 8 * g4;
                    const bf16_t* bl = Wlo + (size_t)(nj * 16 + lane16) * 1024 + kh * 512 + 8 * g4;
                    f32x4v acc; acc[0] = 0.f; acc[1] = 0.f; acc[2] = 0.f; acc[3] = 0.f;
#pragma unroll 4
                    for (int k0 = 0; k0 < 512; k0 += 32) {
                        const bf16x8 fah = *(const bf16x8*)(ah + k0), fal = *(const bf16x8*)(al + k0), fbh = *(const bf16x8*)(bh + k0), fbl = *(const bf16x8*)(bl + k0);
                        acc = MFMA16(fah, fbh, acc); acc = MFMA16(fah, fbl, acc); acc = MFMA16(fal, fbh, acc);
                    }
#pragma unroll
                    for (int r = 0; r < 4; ++r) atomicAdd(&lg[(ti * 16 + 4 * g4 + r) * 48 + nj * 16 + lane16], acc[r]);
                }
            }
            __syncthreads();
            float acc[NO];
#pragma unroll
            for (int o = 0; o < NO; ++o) acc[o] = lg[btok * 48 + og * NO + o];
            __syncthreads();
            if (MODE == 2) {
                float* G = (float*)(ws + WS_GATES);
#pragma unroll
                for (int o = 0; o < NO; ++o) G[(size_t)(t0 + btok) * 16 + og * NO + o] = acc[o];
            } else {
#pragma unroll
                for (int o = 0; o < NO; ++o) { const int oo = og * NO + o;
                    if (oo < NOUT) lg[btok * 48 + oo] = acc[o] + (oo < 4 ? p.moe_b_group[layer * 4 + oo] : p.moe_b_router[layer * 32 + oo - 4]); }
                __syncthreads();
                if (tid < 64) {
                    const float* l = lg + tid * 48;
                    int gi = 0; float gm = l[0];
#pragma unroll
                    for (int j = 1; j < 4; ++j) if (l[j] > gm) { gm = l[j]; gi = j; }
                    float se = 0.f;
#pragma unroll
                    for (int j = 0; j < 4; ++j) se += __expf(l[j] - gm);
                    const float ptop = 1.0f / se;
                    const float* f = l + 4 + gi * 8;
                    int i1 = 0; float v1 = f[0];
#pragma unroll
                    for (int j = 1; j < 8; ++j) if (f[j] > v1) { v1 = f[j]; i1 = j; }
                    int i2 = -1; float v2 = -3.0e38f;
#pragma unroll
                    for (int j = 0; j < 8; ++j) if (j != i1 && f[j] > v2) { v2 = f[j]; i2 = j; }
                    if (i2 < 0) { i2 = (i1 + 1) & 7; v2 = v1; }
                    const float w1 = 1.0f / (1.0f + __expf(v2 - v1)), w2 = 1.0f - w1;
                    int* cnt = (int*)(ws + WS_CTL) + CTL_CNT + layer * 32;
                    int* ltok = (int*)(ws + WS_LTOK); float* lgate = (float*)(ws + WS_LGATE);
                    const int tok = t0 + tid;
                    const int e1 = gi * 8 + i1, e2 = gi * 8 + i2;
                    const int p1 = atomicAdd(cnt + e1, 1); ltok[(size_t)e1 * M + p1] = tok * 2; lgate[(size_t)e1 * M + p1] = ptop * w1;
                    const int p2 = atomicAdd(cnt + e2, 1); ltok[(size_t)e2 * M + p2] = tok * 2 + 1; lgate[(size_t)e2 * M + p2] = ptop * w2;
                }
            }
        }
        __syncthreads();
    }
}

namespace pg8 {
#define PG8_LAS __attribute__((address_space(3)))
typedef float f32x4 __attribute__((ext_vector_type(4)));
constexpr int BM = 256, BK = 64, HALF = 128, HTB = HALF * BK * 2  , STAGE_BYTES = 8 * HTB, NXCD = 8, WGM = 8;
__host__ __device__ __forceinline__ int lds_byte(int r, int c) { const int st = (r >> 4) * 2 + (c >> 5), rr = r & 15, cc = c & 31, ob = rr * 64 + cc * 2; return st * 1024 + (ob ^ (((ob >> 9) & 1) << 5)); }
__host__ __device__ __forceinline__ void stage_rc(int b, int& R, int& C) { const int st = b / 1024, sb = b % 1024, swz = sb ^ (((sb >> 9) & 1) << 5); R = (st >> 1) * 16 + swz / 64; C = (st & 1) * 32 + (swz % 64) / 2; }
__host__ __device__ __forceinline__ int perm32(int rho) { const int n = rho >> 4, i = rho & 15; return 8 * (i >> 2) + 4 * n + (i & 3); }

struct Unit { int pm, pn; };
struct Gemm { const bf16_t* A; const bf16_t* Bt; int M, N, K; };
struct StaticOrder {
    int nM, nN, nwg, G, c;
    __device__ void init(int M_, int N_, int G_, int c_) { nM = M_ / BM; nN = N_ / BM; nwg = nM * nN; G = G_; c = c_; }
    __device__ bool next(int i, Unit& u) const {
        const long L = (long)i * G + c; if (L >= nwg) return false;
        int wgid = (int)L; { const int q = nwg / NXCD, r = nwg % NXCD, xcd = wgid % NXCD, off = wgid / NXCD; wgid = (xcd < r ? xcd * (q + 1) : r * (q + 1) + (xcd - r) * q) + off; }
        const int nig = WGM * nN, gid = wgid / nig, fm = gid * WGM, gsz = (nM - fm) < WGM ? (nM - fm) : WGM;
        u.pm = fm + ((wgid % nig) % gsz); u.pn = (wgid % nig) / gsz; return true;
    }
    __device__ __forceinline__ void a_ready(const Unit&) const {}
    __device__ __forceinline__ void done(const Unit&) const {}
};


struct CountedOrder : StaticOrder {
    unsigned* ready; unsigned need; unsigned* readyb; unsigned needb;
    __device__ __forceinline__ void a_ready(const Unit& u) const {
        if (threadIdx.x < 64) {
            unsigned polls = 0;
            while ((unsigned)__builtin_amdgcn_readfirstlane(__hip_atomic_load(ready + 64 * u.pm, __ATOMIC_RELAXED, __HIP_MEMORY_SCOPE_AGENT)) < need) {
                if (++polls > (1u << 22)) break;
                __builtin_amdgcn_s_sleep(2); }
            if (readyb) { polls = 0;
                while ((unsigned)__builtin_amdgcn_readfirstlane(__hip_atomic_load(readyb + 64 * u.pn, __ATOMIC_RELAXED, __HIP_MEMORY_SCOPE_AGENT)) < needb) {
                    if (++polls > (1u << 22)) break;
                    __builtin_amdgcn_s_sleep(2); } }
            __builtin_amdgcn_fence(__ATOMIC_ACQUIRE, "agent");
            asm volatile("s_waitcnt vmcnt(0)" ::: "memory");
        }
        asm volatile("" ::: "memory"); __builtin_amdgcn_s_barrier(); asm volatile("" ::: "memory");
    }
};

struct EpiResid16 {
    static constexpr bool PERM = true, AFTER_DRAIN = false;
    const float* X; bf16_t* H; int ldc;
    __device__ __forceinline__ void operator()(const f32x4 (&acc)[2][2][4][2], const Unit& u, int wr, int wc, int fr, int fq) const {
        const int row0 = u.pm * BM + wr * 64 + fr, col0 = u.pn * BM + wc * 32 + 8 * fq;
#pragma unroll
        for (int ai = 0; ai < 2; ++ai)
#pragma unroll
            for (int m = 0; m < 4; ++m) { const size_t ro = (size_t)(row0 + ai * HALF + m * 16) * ldc + col0;
#pragma unroll
                for (int bj = 0; bj < 2; ++bj) { f32x4 v0 = acc[ai][bj][m][0], v1 = acc[ai][bj][m][1];
                    if (X) { v0 += *(const f32x4*)(X + ro + bj * HALF); v1 += *(const f32x4*)(X + ro + bj * HALF + 4); }
                    else { const u32x4 r = *(const u32x4*)(H + ro + bj * HALF);
                        v0[0] += lo16(r.x); v0[1] += hi16(r.x); v0[2] += lo16(r.y); v0[3] += hi16(r.y); v1[0] += lo16(r.z); v1[1] += hi16(r.z); v1[2] += lo16(r.w); v1[3] += hi16(r.w); }
                    u32x4 w; w.x = pack2(v0[0], v0[1]); w.y = pack2(v0[2], v0[3]); w.z = pack2(v1[0], v1[1]); w.w = pack2(v1[2], v1[3]);
                    *(u32x4*)(H + ro + bj * HALF) = w; } }
    }
};
struct EpiStore16 {
    static constexpr bool PERM = true, AFTER_DRAIN = false;
    bf16_t* O; int ldc;
    __device__ __forceinline__ void operator()(const f32x4 (&acc)[2][2][4][2], const Unit& u, int wr, int wc, int fr, int fq) const {
        const int row0 = u.pm * BM + wr * 64 + fr, col0 = u.pn * BM + wc * 32 + 8 * fq;
#pragma unroll
        for (int ai = 0; ai < 2; ++ai)
#pragma unroll
            for (int m = 0; m < 4; ++m) { bf16_t* rowp = O + (size_t)(row0 + ai * HALF + m * 16) * ldc + col0;
#pragma unroll
                for (int bj = 0; bj < 2; ++bj) { const f32x4 v0 = acc[ai][bj][m][0], v1 = acc[ai][bj][m][1];
                    u32x4 w; w.x = pack2(v0[0], v0[1]); w.y = pack2(v0[2], v0[3]); w.z = pack2(v1[0], v1[1]); w.w = pack2(v1[2], v1[3]);
                    *(u32x4*)(rowp + bj * HALF) = w; } }
    }
};

template <class Epi, class Sched, bool STAMP = false>
__device__ __forceinline__ void gemm_phase(PG8_LAS unsigned char* lds, const Gemm g, const Sched& S, const Epi& E, unsigned long long* stamps) {
    const int tid = threadIdx.x, wid = __builtin_amdgcn_readfirstlane(tid >> 6), lane = tid & 63, wr = wid >> 2, wc = wid & 3, fr = lane & 15, fq = lane >> 4;
    const int K = g.K, nt = K / BK;
    int ts_lo = 0, ts_hi = 0, nts = 0; const unsigned long long rt_entry = STAMP ? 0ull : 0ull;
#define PG8_STAMP() do { if (STAMP && wid == 0 && nts < 64) { const unsigned long long _c = (unsigned long long)clock64(); \
        ts_lo = (lane == nts) ? (int)(unsigned)_c : ts_lo; ts_hi = (lane == nts) ? (int)(unsigned)(_c >> 32) : ts_hi; ++nts; } } while (0)
    PG8_STAMP();
    unsigned voffA[2], voffB[2];
#pragma unroll
    for (int i = 0; i < 2; ++i) { int R, C; stage_rc(tid * 16 + i * 8192, R, C); const int Rb = Epi::PERM ? ((R & ~31) + perm32(R & 31)) : R;
        voffA[i] = (unsigned)(R * K + C) * 2u; voffB[i] = (unsigned)(Rb * K + C) * 2u; }
    const size_t kstep = (size_t)(BK * 2);
    const size_t hstep = (size_t)HALF * K * 2;
    const size_t tstep = 2 * hstep;
    const unsigned ldsw = (unsigned)wid * 1024u;
    const int aoff = lds_byte(wr * 64 + fr, fq * 8), boff = lds_byte(wc * 32 + fr, fq * 8);
#define PG8_SA(b, h) (((b) * 2 + (h)) * HTB)
#define PG8_SB(b, h) ((4 + (b) * 2 + (h)) * HTB)
#define PG8_STAGE(bufoff, gbase, voff) do { _Pragma("unroll") for (int _i = 0; _i < 2; ++_i) \
        __builtin_amdgcn_global_load_lds((const unsigned*)((const char*)(gbase) + (voff)[_i]), (PG8_LAS unsigned*)(lds + (bufoff) + ldsw + _i * 8192), 16, 0, 0); } while (0)
#define PG8_LDA(dst, b, h) do { _Pragma("unroll") for (int m = 0; m < 4; ++m) _Pragma("unroll") for (int k = 0; k < 2; ++k) dst[m][k] = *(const PG8_LAS bf16x8*)(lds + PG8_SA(b, h) + aoff + m * 2048 + k * 1024); } while (0)
#define PG8_LDB(dst, b, h) do { _Pragma("unroll") for (int n = 0; n < 2; ++n) _Pragma("unroll") for (int k = 0; k < 2; ++k) dst[n][k] = *(const PG8_LAS bf16x8*)(lds + PG8_SB(b, h) + boff + n * 2048 + k * 1024); } while (0)
#define PG8_MMA(ai, bj, At, Bt) do { __builtin_amdgcn_s_setprio(1); _Pragma("unroll") for (int m = 0; m < 4; ++m) _Pragma("unroll") for (int n = 0; n < 2; ++n) _Pragma("unroll") for (int k = 0; k < 2; ++k) \
        acc[ai][bj][m][n] = __builtin_amdgcn_mfma_f32_16x16x32_bf16(Bt[n][k], At[m][k], acc[ai][bj][m][n], 0, 0, 0); __builtin_amdgcn_s_setprio(0); } while (0)
#define PG8_WAIT_V(n) asm volatile("s_waitcnt vmcnt(" #n ")" ::: "memory")
#define PG8_WAIT_L(n) asm volatile("s_waitcnt lgkmcnt(" #n ")" ::: "memory")
#define PG8_BAR __builtin_amdgcn_s_barrier()
#define PG8_SCHED __builtin_amdgcn_sched_barrier(0)
    Unit cur, nxt; int ui = 0;
    if (!S.next(0, cur)) return;
    f32x4 acc[2][2][4][2];
#pragma unroll
    for (int a = 0; a < 2; ++a)
#pragma unroll
        for (int b = 0; b < 2; ++b)
#pragma unroll
            for (int m = 0; m < 4; ++m)
#pragma unroll
                for (int n = 0; n < 2; ++n) acc[a][b][m][n] = (f32x4){0.f, 0.f, 0.f, 0.f};
    bf16x8 At[4][2], B0[2][2], B1[2][2];
    const char* cA = (const char*)g.A + (size_t)cur.pm * tstep; const char* cB = (const char*)g.Bt + (size_t)cur.pn * tstep;
    S.a_ready(cur);
    PG8_STAGE(PG8_SB(0, 0), cB, voffB); PG8_STAGE(PG8_SA(0, 0), cA, voffA); PG8_STAGE(PG8_SB(0, 1), cB + hstep, voffB); PG8_STAGE(PG8_SA(0, 1), cA + hstep, voffA);
    if (wr == 1) PG8_BAR;
    PG8_WAIT_V(4); PG8_BAR;
    PG8_STAGE(PG8_SB(1, 0), cB + kstep, voffB); PG8_STAGE(PG8_SA(1, 0), cA + kstep, voffA); PG8_STAGE(PG8_SB(1, 1), cB + hstep + kstep, voffB);
    PG8_WAIT_V(6); PG8_BAR;
    PG8_STAMP();
    for (;;) {
        const bool has_next = S.next(ui + 1, nxt);
        const char* nA = has_next ? (const char*)g.A + (size_t)nxt.pm * tstep : cA; const char* nB = has_next ? (const char*)g.Bt + (size_t)nxt.pn * tstep : cB;
        for (int t = 0; t < nt; t += 2) {
            const bool last = (t == nt - 2);
            const char* a1 = cA + (size_t)(t + 1) * kstep;
            const char* a2 = last ? nA : cA + (size_t)(t + 2) * kstep; const char* b2 = last ? nB : cB + (size_t)(t + 2) * kstep;
            const char* a3 = a2 + kstep; const char* b3 = b2 + kstep;
            if (last && has_next) S.a_ready(nxt);
            PG8_LDB(B0, 0, 0); PG8_SCHED; PG8_LDA(At, 0, 0); PG8_STAGE(PG8_SA(1, 1), a1 + hstep, voffA);
            PG8_WAIT_L(8); PG8_BAR; PG8_WAIT_L(0); PG8_MMA(0, 0, At, B0); PG8_BAR; PG8_SCHED;
            PG8_LDB(B1, 0, 1); PG8_STAGE(PG8_SB(0, 0), b2, voffB);
            PG8_BAR; PG8_WAIT_L(0); PG8_MMA(0, 1, At, B1); PG8_BAR;
            PG8_LDA(At, 0, 1); PG8_STAGE(PG8_SA(0, 0), a2, voffA);
            PG8_BAR; PG8_WAIT_L(0); PG8_MMA(1, 0, At, B0); PG8_BAR; PG8_SCHED;
            PG8_STAGE(PG8_SB(0, 1), b2 + hstep, voffB);
            PG8_WAIT_V(6); PG8_BAR; PG8_MMA(1, 1, At, B1); PG8_BAR;
            PG8_LDB(B0, 1, 0); PG8_SCHED; PG8_LDA(At, 1, 0); PG8_STAGE(PG8_SA(0, 1), a2 + hstep, voffA);
            PG8_WAIT_L(8); PG8_BAR; PG8_WAIT_L(0); PG8_MMA(0, 0, At, B0); PG8_BAR; PG8_SCHED;
            PG8_LDB(B1, 1, 1); PG8_STAGE(PG8_SB(1, 0), b3, voffB);
            PG8_BAR; PG8_WAIT_L(0); PG8_MMA(0, 1, At, B1); PG8_BAR;
            PG8_LDA(At, 1, 1); PG8_STAGE(PG8_SA(1, 0), a3, voffA);
            PG8_BAR; PG8_WAIT_L(0); PG8_MMA(1, 0, At, B0); PG8_BAR; PG8_SCHED;
            PG8_STAGE(PG8_SB(1, 1), b3 + hstep, voffB);
            PG8_WAIT_V(6); PG8_BAR; PG8_MMA(1, 1, At, B1); PG8_BAR;
        }
        PG8_STAMP();
        if constexpr (!Epi::AFTER_DRAIN) { E(acc, cur, wr, wc, fr, fq); S.done(cur); }
        PG8_STAMP();
        if (!has_next) break;
#pragma unroll
        for (int a = 0; a < 2; ++a)
#pragma unroll
            for (int b = 0; b < 2; ++b)
#pragma unroll
                for (int m = 0; m < 4; ++m)
#pragma unroll
                    for (int n = 0; n < 2; ++n) acc[a][b][m][n] = (f32x4){0.f, 0.f, 0.f, 0.f};
        cur = nxt; cA = nA; cB = nB; ++ui;
    }
    PG8_WAIT_V(0);
    if (wr == 0) PG8_BAR;
    PG8_BAR;
    if constexpr (Epi::AFTER_DRAIN) { E.fused(acc, cur, wr, wc, fr, fq, lds, wid, lane); S.done(cur); }
    PG8_STAMP();
    if (STAMP && wid == 0) { stamps[lane] = lane < nts ? (((unsigned long long)(unsigned)ts_hi << 32) | (unsigned)ts_lo) : 0ull;
        if (lane == 62) stamps[62] = rt_entry; if (lane == 63) stamps[63] = 0ull; }
#undef PG8_STAMP
#undef PG8_SA
#undef PG8_SB
#undef PG8_STAGE
#undef PG8_LDA
#undef PG8_LDB
#undef PG8_MMA
#undef PG8_WAIT_V
#undef PG8_WAIT_L
#undef PG8_BAR
#undef PG8_SCHED
}
template <class Epi, class Sched, int K>
__device__ __forceinline__ void gemm_phase_g(PG8_LAS unsigned char* lds, const Sched& S, const Epi& E) {
    constexpr bool STAMP = false; unsigned long long* stamps = nullptr;
    const int tid = threadIdx.x, wid = __builtin_amdgcn_readfirstlane(tid >> 6), lane = tid & 63, wr = wid >> 2, wc = wid & 3, fr = lane & 15, fq = lane >> 4;
    constexpr int nt = K / BK;
    int ts_lo = 0, ts_hi = 0, nts = 0; const unsigned long long rt_entry = STAMP ? 0ull : 0ull;
#define PG8_STAMP() do { if (STAMP && wid == 0 && nts < 64) { const unsigned long long _c = (unsigned long long)clock64(); \
        ts_lo = (lane == nts) ? (int)(unsigned)_c : ts_lo; ts_hi = (lane == nts) ? (int)(unsigned)(_c >> 32) : ts_hi; ++nts; } } while (0)
    PG8_STAMP();
    unsigned voffB[2], cu0[2], cu1[2];
    PG8_LAS unsigned* const nxs = (PG8_LAS unsigned*)(lds + 131072) + tid * 4;
#pragma unroll
    for (int i = 0; i < 2; ++i) { int R, C; stage_rc(tid * 16 + i * 8192, R, C); const int Rb = Epi::PERM ? ((R & ~31) + perm32(R & 31)) : R;
        voffB[i] = (unsigned)(Rb * K + C) * 2u; }
    const size_t kstep = (size_t)(BK * 2);
    const size_t hstep = (size_t)HALF * K * 2;
    const size_t tstep = 2 * hstep;
    const unsigned ldsw = (unsigned)wid * 1024u;
    const int aoff = lds_byte(wr * 64 + fr, fq * 8), boff = lds_byte(wc * 32 + fr, fq * 8);
#define PG8_SA(b, h) (((b) * 2 + (h)) * HTB)
#define PG8_SB(b, h) ((4 + (b) * 2 + (h)) * HTB)
#define PG8_STAGE(bufoff, gbase, voff) do { _Pragma("unroll") for (int _i = 0; _i < 2; ++_i) \
        __builtin_amdgcn_global_load_lds((const unsigned*)((const char*)(gbase) + (voff)[_i]), (PG8_LAS unsigned*)(lds + (bufoff) + ldsw + _i * 8192), 16, 0, 0); } while (0)
#define PG8_LDA(dst, b, h) do { _Pragma("unroll") for (int m = 0; m < 4; ++m) _Pragma("unroll") for (int k = 0; k < 2; ++k) dst[m][k] = *(const PG8_LAS bf16x8*)(lds + PG8_SA(b, h) + aoff + m * 2048 + k * 1024); } while (0)
#define PG8_LDB(dst, b, h) do { _Pragma("unroll") for (int n = 0; n < 2; ++n) _Pragma("unroll") for (int k = 0; k < 2; ++k) dst[n][k] = *(const PG8_LAS bf16x8*)(lds + PG8_SB(b, h) + boff + n * 2048 + k * 1024); } while (0)
#define PG8_MMA(ai, bj, At, Bt) do { __builtin_amdgcn_s_setprio(1); _Pragma("unroll") for (int m = 0; m < 4; ++m) _Pragma("unroll") for (int n = 0; n < 2; ++n) _Pragma("unroll") for (int k = 0; k < 2; ++k) \
        acc[ai][bj][m][n] = __builtin_amdgcn_mfma_f32_16x16x32_bf16(Bt[n][k], At[m][k], acc[ai][bj][m][n], 0, 0, 0); __builtin_amdgcn_s_setprio(0); } while (0)
#define PG8_WAIT_V(n) asm volatile("s_waitcnt vmcnt(" #n ")" ::: "memory")
#define PG8_WAIT_L(n) asm volatile("s_waitcnt lgkmcnt(" #n ")" ::: "memory")
#define PG8_BAR __builtin_amdgcn_s_barrier()
#define PG8_SCHED __builtin_amdgcn_sched_barrier(0)
    typename Sched::UnitT cur, nxt; int ui = 0;
    if (!S.next(0, cur)) return;
    f32x4 acc[2][2][4][2];
#pragma unroll
    for (int a = 0; a < 2; ++a)
#pragma unroll
        for (int b = 0; b < 2; ++b)
#pragma unroll
            for (int m = 0; m < 4; ++m)
#pragma unroll
                for (int n = 0; n < 2; ++n) acc[a][b][m][n] = (f32x4){0.f, 0.f, 0.f, 0.f};
    bf16x8 At[4][2], B0[2][2], B1[2][2];
    const char* const Ab = S.a_base(); const char* cB = S.b_base(cur);
#pragma unroll
    for (int i = 0; i < 2; ++i) { int R, C; stage_rc(tid * 16 + i * 8192, R, C); cu0[i] = S.row_off(cur, R) + C * 2; cu1[i] = S.row_off(cur, R + HALF) + C * 2; }
    S.a_ready(cur);
    PG8_STAGE(PG8_SB(0, 0), cB, voffB); PG8_STAGE(PG8_SA(0, 0), Ab, cu0); PG8_STAGE(PG8_SB(0, 1), cB + hstep, voffB); PG8_STAGE(PG8_SA(0, 1), Ab, cu1);
    if (wr == 1) PG8_BAR;
    PG8_WAIT_V(4); PG8_BAR;
    PG8_STAGE(PG8_SB(1, 0), cB + kstep, voffB); PG8_STAGE(PG8_SA(1, 0), Ab + kstep, cu0); PG8_STAGE(PG8_SB(1, 1), cB + hstep + kstep, voffB);
    PG8_WAIT_V(6); PG8_BAR;
    PG8_STAMP();
    for (;;) {
        const bool has_next = S.next(ui + 1, nxt);
        const char* nB = has_next ? S.b_base(nxt) : cB;
#pragma unroll
        for (int i = 0; i < 2; ++i) { int R, C; stage_rc(tid * 16 + i * 8192, R, C);
            nxs[i] = has_next ? S.row_off(nxt, R) + C * 2 : cu0[i]; nxs[2 + i] = has_next ? S.row_off(nxt, R + HALF) + C * 2 : cu1[i]; }
#pragma unroll 1
        for (int t = 0; t < nt; t += 2) {
            const bool last = (t == nt - 2);
            const char* a1 = Ab + (size_t)(t + 1) * kstep;
            const char* a2 = last ? Ab : Ab + (size_t)(t + 2) * kstep; const char* b2 = last ? nB : cB + (size_t)(t + 2) * kstep;
            unsigned o0[2], o1[2];
#pragma unroll
            for (int i = 0; i < 2; ++i) { o0[i] = cu0[i]; o1[i] = cu1[i]; }
            if (last) {
#pragma unroll
                for (int i = 0; i < 2; ++i) { o0[i] = nxs[i]; o1[i] = nxs[2 + i]; } }
            const char* a3 = a2 + kstep; const char* b3 = b2 + kstep;
            if (last && has_next) S.a_ready(nxt);
            PG8_LDB(B0, 0, 0); PG8_SCHED; PG8_LDA(At, 0, 0); PG8_STAGE(PG8_SA(1, 1), a1, cu1);
            PG8_WAIT_L(8); PG8_BAR; PG8_WAIT_L(0); PG8_MMA(0, 0, At, B0); PG8_BAR; PG8_SCHED;
            PG8_LDB(B1, 0, 1); PG8_STAGE(PG8_SB(0, 0), b2, voffB);
            PG8_BAR; PG8_WAIT_L(0); PG8_MMA(0, 1, At, B1); PG8_BAR;
            PG8_LDA(At, 0, 1); PG8_STAGE(PG8_SA(0, 0), a2, o0);
            PG8_BAR; PG8_WAIT_L(0); PG8_MMA(1, 0, At, B0); PG8_BAR; PG8_SCHED;
            PG8_STAGE(PG8_SB(0, 1), b2 + hstep, voffB);
            PG8_WAIT_V(6); PG8_BAR; PG8_MMA(1, 1, At, B1); PG8_BAR;
            PG8_LDB(B0, 1, 0); PG8_SCHED; PG8_LDA(At, 1, 0); PG8_STAGE(PG8_SA(0, 1), a2, o1);
            PG8_WAIT_L(8); PG8_BAR; PG8_WAIT_L(0); PG8_MMA(0, 0, At, B0); PG8_BAR; PG8_SCHED;
            PG8_LDB(B1, 1, 1); PG8_STAGE(PG8_SB(1, 0), b3, voffB);
            PG8_BAR; PG8_WAIT_L(0); PG8_MMA(0, 1, At, B1); PG8_BAR;
            PG8_LDA(At, 1, 1); PG8_STAGE(PG8_SA(1, 0), a3, o0);
            PG8_BAR; PG8_WAIT_L(0); PG8_MMA(1, 0, At, B0); PG8_BAR; PG8_SCHED;
            PG8_STAGE(PG8_SB(1, 1), b3 + hstep, voffB);
            PG8_WAIT_V(6); PG8_BAR; PG8_MMA(1, 1, At, B1); PG8_BAR;
        }
        PG8_STAMP();
        if constexpr (!Epi::AFTER_DRAIN) { E(acc, cur, wr, wc, fr, fq); S.done(cur); }
        PG8_STAMP();
        if (!has_next) break;
#pragma unroll
        for (int a = 0; a < 2; ++a)
#pragma unroll
            for (int b = 0; b < 2; ++b)
#pragma unroll
                for (int m = 0; m < 4; ++m)
#pragma unroll
                    for (int n = 0; n < 2; ++n) acc[a][b][m][n] = (f32x4){0.f, 0.f, 0.f, 0.f};
        cur = nxt; cB = nB; ++ui;
#pragma unroll
        for (int i = 0; i < 2; ++i) { cu0[i] = nxs[i]; cu1[i] = nxs[2 + i]; }
    }
    PG8_WAIT_V(0);
    if (wr == 0) PG8_BAR;
    PG8_BAR;
    if constexpr (Epi::AFTER_DRAIN) { E.fused(acc, cur, wr, wc, fr, fq, lds, wid, lane); S.done(cur); }
    PG8_STAMP();
    if (STAMP && wid == 0) { stamps[lane] = lane < nts ? (((unsigned long long)(unsigned)ts_hi << 32) | (unsigned)ts_lo) : 0ull;
        if (lane == 62) stamps[62] = rt_entry; if (lane == 63) stamps[63] = 0ull; }
#undef PG8_STAMP
#undef PG8_SA
#undef PG8_SB
#undef PG8_STAGE
#undef PG8_LDA
#undef PG8_LDB
#undef PG8_MMA
#undef PG8_WAIT_V
#undef PG8_WAIT_L
#undef PG8_BAR
#undef PG8_SCHED
}


}

template <int WHICH>
__device__ __forceinline__ void phase_dense_gemm(const Params& p, char* lds) {
    unsigned char* ws = p.ws;
    constexpr int N = (WHICH == 0) ? EVEN_IN : (WHICH == 2) ? ODD_IN : D;
    pg8::Gemm g{(const bf16_t*)(ws + WS_XN), (const bf16_t*)(ws + (WHICH == 0 ? WS_WIN0 : WHICH == 1 ? WS_WOUT0 : WHICH == 2 ? WS_WIN1 : WS_WOUT1)), M, N, D};
    pg8::StaticOrder S; S.init(M, N, (int)gridDim.x, (int)blockIdx.x);
    if (WHICH == 0) { pg8::CountedOrder SC; SC.init(M, N, (int)gridDim.x, (int)blockIdx.x); SC.ready = (unsigned*)(ws + WS_CTL) + CTL_READY; SC.need = 4u; SC.readyb = (unsigned*)(ws + WS_CTL) + CTL_READY + 4096; SC.needb = 64u;
        pg8::EpiStore16 E{(bf16_t*)(ws + WS_P), N}; pg8::gemm_phase<pg8::EpiStore16, pg8::CountedOrder, false>((PG8_LAS unsigned char*)lds, g, SC, E, nullptr); }
    else if (WHICH == 2) { pg8::EpiStore16 E{(bf16_t*)(ws + WS_P), N}; pg8::gemm_phase<pg8::EpiStore16, pg8::StaticOrder, false>((PG8_LAS unsigned char*)lds, g, S, E, nullptr); }
    else { pg8::EpiResid16 E{WHICH == 1 ? p.x : nullptr, (bf16_t*)((char*)p.out + H16_OFF), D}; pg8::gemm_phase<pg8::EpiResid16, pg8::StaticOrder, false>((PG8_LAS unsigned char*)lds, g, S, E, nullptr); }
    __syncthreads();
}

struct MUnit { int e, mt, pn, cnt, slot0, mtg; };
struct MoeSchedBase {
    const int* sh;
    int nbx, lb, layer; unsigned char* ws;
    int xe0, xp1, xp2, xp3, xp4;
    __device__ __forceinline__ void decode(int lmt, MUnit& u) const {
        const int k = (lmt >= xp1) + (lmt >= xp2) + (lmt >= xp3), e = xe0 + 8 * k, pk = k == 0 ? 0 : k == 1 ? xp1 : k == 2 ? xp2 : xp3;
        u.e = e; u.mt = lmt - pk; u.cnt = sh[128 + e]; u.slot0 = sh[64 + e]; u.mtg = sh[e] + u.mt;
    }
    __device__ __forceinline__ unsigned* counter(int mtg) const { return (unsigned*)(ws + WS_CTL) + CTL_MOE + (layer * 160 + mtg) * 64; }
};
struct GuSched : MoeSchedBase {
    typedef MUnit UnitT;
    __device__ __forceinline__ bool next(int i, MUnit& u) const { const int ug = i * nbx + lb; if (ug >= 2 * xp4) return false; decode(ug >> 1, u); u.pn = ug & 1; return true; }
    __device__ __forceinline__ const char* a_base() const { return (const char*)(ws + WS_XN); }
    __device__ __forceinline__ unsigned row_off(const MUnit& u, int R) const { int ml = u.mt * 256 + R; ml = ml < u.cnt ? ml : u.cnt - 1;
        return (unsigned)(((const int*)(ws + WS_LTOK))[(size_t)u.e * M + ml] >> 1) * 2048u; }
    __device__ __forceinline__ const char* b_base(const MUnit& u) const { return (const char*)(ws + WS_WGU) + ((size_t)((layer * 32 + u.e) * 2 + u.pn) * 256) * 2048; }
    __device__ __forceinline__ void a_ready(const MUnit&) const {}
    __device__ __forceinline__ void done(const MUnit& u) const {
        asm volatile("s_waitcnt vmcnt(0)" ::: "memory");
        if ((threadIdx.x & 63) == 0) __hip_atomic_fetch_add(counter(u.mtg), 1u, __ATOMIC_RELAXED, __HIP_MEMORY_SCOPE_AGENT);
    }
};
struct DnSched : MoeSchedBase {
    typedef MUnit UnitT;
    int x, nb1;
    __device__ __forceinline__ bool next(int i, MUnit& u) const { if (lb < x) return false; const int ud = i * nb1 + (lb - x); if (ud >= 4 * xp4) return false; decode(ud >> 2, u); u.pn = ud & 3; return true; }
    __device__ __forceinline__ const char* a_base() const { return (const char*)(ws + WS_P + P_HID); }
    __device__ __forceinline__ unsigned row_off(const MUnit& u, int R) const { return (unsigned)(u.slot0 + u.mt * 256 + R) * 512u; }
    __device__ __forceinline__ const char* b_base(const MUnit& u) const { return (const char*)(ws + WS_WD) + ((size_t)(layer * 32 + u.e) * 1024 + u.pn * 256) * 512; }
    __device__ __forceinline__ void a_ready(const MUnit& u) const {
        if (threadIdx.x < 64) {
            unsigned polls = 0; unsigned* c = counter(u.mtg);
            while ((unsigned)__builtin_amdgcn_readfirstlane(__hip_atomic_load(c, __ATOMIC_RELAXED, __HIP_MEMORY_SCOPE_AGENT)) < 16u) { if (++polls > (1u << 22)) break; __builtin_amdgcn_s_sleep(2); }
            __builtin_amdgcn_fence(__ATOMIC_ACQUIRE, "agent");
            asm volatile("s_waitcnt vmcnt(0)" ::: "memory");
        }
        asm volatile("" ::: "memory"); __builtin_amdgcn_s_barrier(); asm volatile("" ::: "memory");
    }
    __device__ __forceinline__ void done(const MUnit&) const {}
};
struct EpiGU {
    static constexpr bool PERM = true, AFTER_DRAIN = false;
    unsigned char* ws;
    __device__ __forceinline__ void operator()(const pg8::f32x4 (&acc)[2][2][4][2], const MUnit& u, int wr, int wc, int fr, int fq) const {
        bf16_t* HID = (bf16_t*)(ws + WS_P + P_HID); const float* lgate = (const float*)(ws + WS_LGATE) + (size_t)u.e * M;
#pragma unroll
        for (int ai = 0; ai < 2; ++ai)
#pragma unroll
            for (int m = 0; m < 4; ++m) { const int ml = u.mt * 256 + ai * 128 + wr * 64 + m * 16 + fr;
                if (ml < u.cnt) { const float gt = lgate[ml]; float h[8];
#pragma unroll
                    for (int n = 0; n < 2; ++n)
#pragma unroll
                        for (int e = 0; e < 4; ++e) h[n * 4 + e] = siluf_(acc[ai][0][m][n][e]) * acc[ai][1][m][n][e] * gt;
                    unsigned long long* dp = (unsigned long long*)(HID + (size_t)(u.slot0 + ml) * 256 + u.pn * 128 + wc * 32 + 8 * fq);
                    __hip_atomic_store(dp, ((unsigned long long)pack2(h[2], h[3]) << 32) | pack2(h[0], h[1]), __ATOMIC_RELAXED, __HIP_MEMORY_SCOPE_AGENT);
                    __hip_atomic_store(dp + 1, ((unsigned long long)pack2(h[6], h[7]) << 32) | pack2(h[4], h[5]), __ATOMIC_RELAXED, __HIP_MEMORY_SCOPE_AGENT); } }
    }
};
struct EpiDn {
    static constexpr bool PERM = true, AFTER_DRAIN = false;
    unsigned char* ws;
    __device__ __forceinline__ void operator()(const pg8::f32x4 (&acc)[2][2][4][2], const MUnit& u, int wr, int wc, int fr, int fq) const {
        bf16_t* Y = (bf16_t*)(ws + WS_P + P_Y); const int* ltok = (const int*)(ws + WS_LTOK) + (size_t)u.e * M;
#pragma unroll
        for (int ai = 0; ai < 2; ++ai)
#pragma unroll
            for (int m = 0; m < 4; ++m) { const int ml = u.mt * 256 + ai * 128 + wr * 64 + m * 16 + fr;
                if (ml < u.cnt) { const int tk = ltok[ml]; bf16_t* rowp = Y + ((size_t)(tk & 1) * M + (tk >> 1)) * D + u.pn * 256 + wc * 32 + 8 * fq;
#pragma unroll
                    for (int bj = 0; bj < 2; ++bj) { const pg8::f32x4 v0 = acc[ai][bj][m][0], v1 = acc[ai][bj][m][1];
                        u32x4 w; w.x = pack2(v0[0], v0[1]); w.y = pack2(v0[2], v0[3]); w.z = pack2(v1[0], v1[1]); w.w = pack2(v1[2], v1[3]);
                        *(u32x4*)(rowp + bj * 128) = w; } } }
    }
};
__device__ __forceinline__ void phase_moe_merged(const Params& p, char* lds, int layer) {
    unsigned char* ws = p.ws;
    int* sh = (int*)(lds + 147456);
    const int* cntg = (const int*)(ws + WS_CTL) + CTL_CNT + layer * 32;
    if (threadIdx.x == 0) { int tp = 0, sp = 0;
        for (int e = 0; e < 32; ++e) { const int c = cntg[e]; sh[e] = tp; sh[64 + e] = sp; sh[128 + e] = c; tp += (c + 255) >> 8; sp += c; }
        sh[32] = tp; }
    __syncthreads();
    const int G = (int)gridDim.x, b = (int)blockIdx.x;
    GuSched SG; DnSched SD;
    {
        const int grp = b & 7, nbx = (G - grp + 7) >> 3, lb = b >> 3;
        const int m0 = sh[grp + 1] - sh[grp], m1 = sh[grp + 9] - sh[grp + 8], m2 = sh[grp + 17] - sh[grp + 16], m3 = sh[grp + 25] - sh[grp + 24];
        SG.sh = sh; SG.nbx = nbx; SG.lb = lb; SG.layer = layer; SG.ws = ws; SG.xe0 = grp; SG.xp1 = m0; SG.xp2 = m0 + m1; SG.xp3 = m0 + m1 + m2; SG.xp4 = m0 + m1 + m2 + m3;
        SD.sh = sh; SD.nbx = nbx; SD.lb = lb; SD.layer = layer; SD.ws = ws; SD.xe0 = grp; SD.xp1 = SG.xp1; SD.xp2 = SG.xp2; SD.xp3 = SG.xp3; SD.xp4 = SG.xp4;
        const int ngu = 2 * SG.xp4;
        SD.x = (ngu > nbx && ngu < 2 * nbx) ? ngu - nbx : 0; SD.nb1 = nbx - SD.x;
    }
    EpiGU EG{ws}; EpiDn ED{ws};
    pg8::gemm_phase_g<EpiGU, GuSched, 1024>((PG8_LAS unsigned char*)lds, SG, EG);
    pg8::gemm_phase_g<EpiDn, DnSched, 256>((PG8_LAS unsigned char*)lds, SD, ED);
    __syncthreads();
}

__device__ __forceinline__ void phase_post0(const Params& p) {
    const int tid = threadIdx.x, lane = tid & 63, wave = tid >> 6;
    unsigned char* ws = p.ws;
    bf16_t* O16 = (bf16_t*)(ws + WS_XN);
    const bf16_t* P = (const bf16_t*)(ws + WS_P);
    const bf16_t* AUX = (const bf16_t*)p.out;
    const int c0 = lane * 16;
    for (int ti_ = blockIdx.x * 8 + wave; ti_ < M; ti_ += gridDim.x * 8) {
        const int tok = (gridDim.x == 256) ? (((ti_ >> 3) & 7) * 2048 + ((ti_ >> 6) & 31) * 64 + (ti_ >> 11) * 8 + (ti_ & 7)) : ti_;
        const u32x4 r0 = *(const u32x4*)(O16 + (size_t)tok * D + c0), r1 = *(const u32x4*)(O16 + (size_t)tok * D + c0 + 8);
        float y[16];
        y[0] = lo16(r0.x); y[1] = hi16(r0.x); y[2] = lo16(r0.y); y[3] = hi16(r0.y); y[4] = lo16(r0.z); y[5] = hi16(r0.z); y[6] = lo16(r0.w); y[7] = hi16(r0.w);
        y[8] = lo16(r1.x); y[9] = hi16(r1.x); y[10] = lo16(r1.y); y[11] = hi16(r1.y); y[12] = lo16(r1.z); y[13] = hi16(r1.z); y[14] = lo16(r1.w); y[15] = hi16(r1.w);
        float o[16];
        if (lane < 32) {
            float s = 0.f;
#pragma unroll
            for (int j = 0; j < 16; ++j) s += y[j];
            s += dppf<0xB1>(s); s += dppf<0x4E>(s);
            const float mean = s * (1.0f / 64.0f);
            float q = 0.f;
#pragma unroll
            for (int j = 0; j < 16; ++j) { const float d = y[j] - mean; q += d * d; }
            q += dppf<0xB1>(q); q += dppf<0x4E>(q);
            const float rstd = rsqrtf(q * (1.0f / 64.0f) + 64e-5f);
#pragma unroll
            for (int j4 = 0; j4 < 4; ++j4) {
                const float4 lw = *(const float4*)(p.rw_ln_w + c0 + j4 * 4), lb = *(const float4*)(p.rw_ln_b + c0 + j4 * 4);
                const u32x2 bq = *(const u32x2*)(AUX + (size_t)tok * D + c0 + j4 * 4), gq = *(const u32x2*)(AUX + (size_t)tok * D + 512 + c0 + j4 * 4);
                float4 bv, gv; bv.x = lo16(bq.x); bv.y = hi16(bq.x); bv.z = lo16(bq.y); bv.w = hi16(bq.y); gv.x = lo16(gq.x); gv.y = hi16(gq.x); gv.z = lo16(gq.y); gv.w = hi16(gq.y);
                o[j4 * 4 + 0] = ((y[j4 * 4 + 0] - mean) * rstd * lw.x + lb.x + bv.x) * gv.x;
                o[j4 * 4 + 1] = ((y[j4 * 4 + 1] - mean) * rstd * lw.y + lb.y + bv.y) * gv.y;
                o[j4 * 4 + 2] = ((y[j4 * 4 + 2] - mean) * rstd * lw.z + lb.z + bv.z) * gv.z;
                o[j4 * 4 + 3] = ((y[j4 * 4 + 3] - mean) * rstd * lw.w + lb.w + bv.w) * gv.w;
            }
        } else {
            float q = 0.f;
#pragma unroll
            for (int j = 0; j < 16; ++j) q += y[j] * y[j];
            q += dppf<0xB1>(q); q += dppf<0x4E>(q);
            const float rstd = rsqrtf(q * (1.0f / 64.0f) + 1e-6f);
            const int cc = c0 - 512;
            const u32x4 g0 = *(const u32x4*)(P + (size_t)tok * EVEN_IN + 1792 + 1536 + cc), g1 = *(const u32x4*)(P + (size_t)tok * EVEN_IN + 1792 + 1536 + cc + 8);
            float gt[16];
            gt[0] = lo16(g0.x); gt[1] = hi16(g0.x); gt[2] = lo16(g0.y); gt[3] = hi16(g0.y); gt[4] = lo16(g0.z); gt[5] = hi16(g0.z); gt[6] = lo16(g0.w); gt[7] = hi16(g0.w);
            gt[8] = lo16(g1.x); gt[9] = hi16(g1.x); gt[10] = lo16(g1.y); gt[11] = hi16(g1.y); gt[12] = lo16(g1.z); gt[13] = hi16(g1.z); gt[14] = lo16(g1.w); gt[15] = hi16(g1.w);
#pragma unroll
            for (int j = 0; j < 16; ++j) o[j] = y[j] * rstd * p.hg_norm[(cc + j) & 63] * siluf_(gt[j]);
        }
        u32x4 w0, w1;
        w0.x = pack2(o[0], o[1]); w0.y = pack2(o[2], o[3]); w0.z = pack2(o[4], o[5]); w0.w = pack2(o[6], o[7]);
        w1.x = pack2(o[8], o[9]); w1.y = pack2(o[10], o[11]); w1.z = pack2(o[12], o[13]); w1.w = pack2(o[14], o[15]);
        *(u32x4*)(O16 + (size_t)tok * D + c0) = w0; *(u32x4*)(O16 + (size_t)tok * D + c0 + 8) = w1;
    }
}


__device__ __forceinline__ bf16x8 frag_rm(const bf16_t* base, int ld, int lane) { return *(const bf16x8*)(base + (lane & 15) * ld + 8 * (lane >> 4)); }
__device__ __forceinline__ bf16x8 frag_tr(const bf16_t* base, int ld, int lane) {
    const int g = lane >> 4, i = lane & 15;
    const bf16_t* a0 = base + (8 * g + (i >> 2)) * ld + 4 * (i & 3);
    const s16x4 lo = __builtin_amdgcn_ds_read_tr16_b64_v4i16((LAS s16x4*)a0);
    const s16x4 hi = __builtin_amdgcn_ds_read_tr16_b64_v4i16((LAS s16x4*)(a0 + 4 * ld));
    bf16x8 r; r[0] = lo[0]; r[1] = lo[1]; r[2] = lo[2]; r[3] = lo[3]; r[4] = hi[0]; r[5] = hi[1]; r[6] = hi[2]; r[7] = hi[3];
    return r;
}
__device__ __forceinline__ float red8(float x) { x += dppf<0xB1>(x); x += dppf<0x4E>(x); x += dppf<0x141>(x); return x; }


__device__ __forceinline__ void tri_inverse_wave(const float* Nf, const bf16_t* Nb, bf16_t* Tb, bf16_t* Wb, int lane) {
    const int g = lane >> 4, li = lane & 15;
    {
        float Tc[16];
        const float* Nrow = Nf + (16 * g) * 68 + 16 * g;
#pragma unroll
        for (int i = 0; i < 16; ++i) {
            float acc = (i == li) ? 1.f : 0.f;
#pragma unroll
            for (int j = 0; j < i; ++j) acc -= Nrow[i * 68 + j] * Tc[j];
            Tc[i] = acc;
        }
#pragma unroll
        for (int i = 0; i < 16; ++i) Tb[(16 * g + i) * 72 + 16 * g + li] = f2bf(Tc[i]);
    }
    asm volatile("s_waitcnt lgkmcnt(0)" ::: "memory");
#pragma unroll
    for (int dl = 1; dl < 4; ++dl) {
#pragma unroll
        for (int j = 0; j + dl < 4; ++j) {
            const int i = j + dl;
            f32x4v w; w[0] = 0.f; w[1] = 0.f; w[2] = 0.f; w[3] = 0.f;
#pragma unroll
            for (int k0 = 0; k0 < 16 * dl; k0 += 32) {
                bf16x8 a = frag_rm(Nb + (16 * i) * 72 + 16 * j + k0, 72, lane);
                const bf16x8 b = frag_tr(Tb + (16 * j + k0) * 72 + 16 * j, 72, lane);
                if (k0 + 8 * g >= 16 * dl) { a[0] = 0; a[1] = 0; a[2] = 0; a[3] = 0; a[4] = 0; a[5] = 0; a[6] = 0; a[7] = 0; }
                w = MFMA16(a, b, w);
            }
#pragma unroll
            for (int r = 0; r < 4; ++r) Wb[(4 * g + r) * 24 + li] = f2bf(w[r]);
            asm volatile("s_waitcnt lgkmcnt(0)" ::: "memory");
            bf16x8 a = frag_rm(Tb + (16 * i) * 72 + 16 * i, 72, lane);
            if (g >= 2) { a[0] = 0; a[1] = 0; a[2] = 0; a[3] = 0; a[4] = 0; a[5] = 0; a[6] = 0; a[7] = 0; }
            const bf16x8 b = frag_tr(Wb, 24, lane);
            f32x4v t; t[0] = 0.f; t[1] = 0.f; t[2] = 0.f; t[3] = 0.f;
            t = MFMA16(a, b, t);
#pragma unroll
            for (int r = 0; r < 4; ++r) Tb[(16 * i + 4 * g + r) * 72 + 16 * j + li] = f2bf(-t[r]);
            asm volatile("s_waitcnt lgkmcnt(0)" ::: "memory");
        }
    }
}


__device__ __forceinline__ void hg_pre_item(const Params& p, char* lds, int id) {
    const int tid = threadIdx.x, lane = tid & 63, wave = tid >> 6, g = lane >> 4, li = lane & 15;
    const int bb = id >> 8, hh = (id >> 5) & 7, c = id & 31;
    unsigned char* ws = p.ws;
    const bf16_t* P = (const bf16_t*)(ws + WS_P);
    unsigned char* item = ws + WS_CHK_HG + (size_t)id * CHK_HG_ITEM;
    float* LG = (float*)lds;
    bf16_t* QV = (bf16_t*)(lds + 17408);
    bf16_t* KV = (bf16_t*)(lds + 26624);
    bf16_t* QT = (bf16_t*)(lds + 35840);
    bf16_t* KT = (bf16_t*)(lds + 45056);
    bf16_t* AyS = (bf16_t*)(lds + 81920);
    const int t = tid >> 3, part = tid & 7, d0 = part * 8;
    const size_t tok = (size_t)bb * SEQ + c * 64 + t;
    {
        const u32x4 q8 = *(const u32x4*)(P + tok * EVEN_IN + 1792 + hh * 64 + d0);
        const u32x4 f8 = *(const u32x4*)(P + tok * EVEN_IN + 1792 + 512 + hh * 64 + d0);
        float qv[8], fv[8];
        qv[0] = lo16(q8.x); qv[1] = hi16(q8.x); qv[2] = lo16(q8.y); qv[3] = hi16(q8.y); qv[4] = lo16(q8.z); qv[5] = hi16(q8.z); qv[6] = lo16(q8.w); qv[7] = hi16(q8.w);
        fv[0] = lo16(f8.x); fv[1] = hi16(f8.x); fv[2] = lo16(f8.y); fv[3] = hi16(f8.y); fv[4] = lo16(f8.z); fv[5] = hi16(f8.z); fv[6] = lo16(f8.w); fv[7] = hi16(f8.w);
        float kq[8];
#pragma unroll
        for (int e = 0; e < 8; ++e) {
            const float lbv = ((const float*)(lds + 131072))[320 + d0 + e];
            const float fg = lbv + (1.f - lbv) * sigmoidf_(fv[e]);
            LG[t * 68 + d0 + e] = __logf(fg);
            qv[e] = siluf_(qv[e]); kq[e] = 1.f - fg;
        }
        u32x4 o; o.x = pack2(qv[0], qv[1]); o.y = pack2(qv[2], qv[3]); o.z = pack2(qv[4], qv[5]); o.w = pack2(qv[6], qv[7]);
        *(u32x4*)(QV + t * 72 + d0) = o;
        o.x = pack2(kq[0], kq[1]); o.y = pack2(kq[2], kq[3]); o.z = pack2(kq[4], kq[5]); o.w = pack2(kq[6], kq[7]);
        *(u32x4*)(KV + t * 72 + d0) = o;
    }
    __syncthreads();
    if (tid < 64) { float run = 0.f;
#pragma unroll 8
        for (int s = 0; s < 64; ++s) { run += LG[s * 68 + tid]; LG[s * 68 + tid] = run; } }
    __syncthreads();
    {
        const int blk = t >> 4;
        const u32x4 q8 = *(const u32x4*)(QV + t * 72 + d0), k8 = *(const u32x4*)(KV + t * 72 + d0);
        float qv[8], kv[8];
        qv[0] = lo16(q8.x); qv[1] = hi16(q8.x); qv[2] = lo16(q8.y); qv[3] = hi16(q8.y); qv[4] = lo16(q8.z); qv[5] = hi16(q8.z); qv[6] = lo16(q8.w); qv[7] = hi16(q8.w);
        kv[0] = lo16(k8.x); kv[1] = hi16(k8.x); kv[2] = lo16(k8.y); kv[3] = hi16(k8.y); kv[4] = lo16(k8.z); kv[5] = hi16(k8.z); kv[6] = lo16(k8.w); kv[7] = hi16(k8.w);
        float lc[8], rp[8], kc[8], qt[8];
#pragma unroll
        for (int e = 0; e < 8; ++e) {
            lc[e] = LG[t * 68 + d0 + e];
            const float lcl = LG[63 * 68 + d0 + e];
            const float ref = blk ? LG[(16 * blk - 1) * 68 + d0 + e] : 0.f;
            rp[e] = qv[e] * __expf(lc[e]); kc[e] = kv[e] * __expf(lcl - lc[e]); qt[e] = qv[e] * __expf(lc[e] - ref);
            if (t == 0) ((float*)(item + 24576))[d0 + e] = __expf(lcl);
        }
        u32x4 o; o.x = pack2(rp[0], rp[1]); o.y = pack2(rp[2], rp[3]); o.z = pack2(rp[4], rp[5]); o.w = pack2(rp[6], rp[7]);
        *(u32x4*)(item + t * 128 + part * 16) = o;
        o.x = pack2(kc[0], kc[1]); o.y = pack2(kc[2], kc[3]); o.z = pack2(kc[4], kc[5]); o.w = pack2(kc[6], kc[7]);
        *(u32x4*)(item + 16384 + t * 128 + part * 16) = o;
        o.x = pack2(qt[0], qt[1]); o.y = pack2(qt[2], qt[3]); o.z = pack2(qt[4], qt[5]); o.w = pack2(qt[6], qt[7]);
        *(u32x4*)(QT + t * 72 + d0) = o;
#pragma unroll
        for (int ib = 0; ib < 4; ++ib) {
            if (ib >= blk) {
                float kt[8];
#pragma unroll
                for (int e = 0; e < 8; ++e) { const float ref = ib ? LG[(16 * ib - 1) * 68 + d0 + e] : 0.f; kt[e] = kv[e] * __expf(fminf(ref - lc[e], 80.f)); }
                o.x = pack2(kt[0], kt[1]); o.y = pack2(kt[2], kt[3]); o.z = pack2(kt[4], kt[5]); o.w = pack2(kt[6], kt[7]);
                *(u32x4*)(KT + (ib * 64 + t) * 72 + d0) = o;
            }
        }
    }
    __syncthreads();
    {
        const int ti = wave >> 1;
#pragma unroll
        for (int jj = 0; jj < 2; ++jj) {
            const int tj = (wave & 1) * 2 + jj, s = tj * 16 + li;
            f32x4v acc; acc[0] = 0.f; acc[1] = 0.f; acc[2] = 0.f; acc[3] = 0.f;
            if (tj <= ti) {
#pragma unroll
                for (int k0 = 0; k0 < 64; k0 += 32) acc = MFMA16(frag_rm(QT + ti * 16 * 72 + k0, 72, lane), frag_rm(KT + (ti * 64 + tj * 16) * 72 + k0, 72, lane), acc);
#pragma unroll
                for (int r = 0; r < 4; ++r) if (s > ti * 16 + 4 * g + r) acc[r] = 0.f;
            }
#pragma unroll
            for (int r = 0; r < 4; ++r) AyS[(ti * 16 + 4 * g + r) * 72 + s] = f2bf(acc[r]);
        }
    }
    __syncthreads();
    *(u32x4*)(item + 8192 + t * 128 + part * 16) = *(const u32x4*)(AyS + t * 72 + d0);
    __syncthreads();
}


__device__ __forceinline__ void rw_pre_load(const Params& p, int id, u32x4 (&rw)[9]) {
    const int tid = threadIdx.x;
    if (tid < 448) {
        const int bb = id >> 8, hh = (id >> 5) & 7, c = id & 31;
        const int q = tid % 56, tg = tid / 56;
        int pcol;
        if (q < 24) pcol = (q >> 3) * 512 + hh * 64 + (q & 7) * 8; else if (q < 32) pcol = 1536 + (q - 24) * 8; else if (q < 40) pcol = 1600 + (q - 32) * 8; else pcol = 1664 + (q - 40) * 8;
        const bf16_t* src_ = (const bf16_t*)(p.ws + WS_P) + ((size_t)bb * SEQ + c * 64 + tg * 8) * EVEN_IN + pcol;
        rw[0].x = 0u; rw[0].y = 0u; rw[0].z = 0u; rw[0].w = 0u;
        if (c * 64 + tg * 8 > 0) rw[0] = *(const u32x4*)(src_ - EVEN_IN);
#pragma unroll
        for (int i = 0; i < 8; ++i) rw[i + 1] = *(const u32x4*)(src_ + (size_t)i * EVEN_IN);
    }
}

__device__ __forceinline__ float tanhf_(float x) { return 1.0f - 2.0f * __builtin_amdgcn_rcpf(1.0f + __expf(2.0f * x)); }
__device__ __forceinline__ void unpack8(const u32x4& v, float* f) { f[0] = lo16(v.x); f[1] = hi16(v.x); f[2] = lo16(v.y); f[3] = hi16(v.y); f[4] = lo16(v.z); f[5] = hi16(v.z); f[6] = lo16(v.w); f[7] = hi16(v.w); }
__device__ __forceinline__ u32x4 pack8(const float* f) { u32x4 o; o.x = pack2(f[0], f[1]); o.y = pack2(f[2], f[3]); o.z = pack2(f[4], f[5]); o.w = pack2(f[6], f[7]); return o; }

__device__ __forceinline__ void rw_pre_item(const Params& p, char* lds0, int id, u32x4 (&rw)[9], int next_id) {
    const int tid = threadIdx.x, lane = tid & 63, wave = tid >> 6, g = lane >> 4, li = lane & 15;
    const int bb = id >> 8, hh = (id >> 5) & 7, c = id & 31;
    int lz = 0; asm volatile("" : "+s"(lz));
    char* lds = lds0 + lz;
    unsigned char* ws = p.ws;
    const bf16_t* P = (const bf16_t*)(ws + WS_P);
    unsigned char* item = ws + WS_CHK_RW + (size_t)id * CHK_RW_ITEM;
    bf16_t* AUX = (bf16_t*)p.out;
    bf16_t* w2h = (bf16_t*)(lds + 0);
    bf16_t* a2h = (bf16_t*)(lds + 9216);
    bf16_t* g2h = (bf16_t*)(lds + 18432);
    bf16_t* TW = (bf16_t*)(lds + 36864);
    bf16_t* AL = (bf16_t*)(lds + 46080);
    bf16_t* SG = (bf16_t*)(lds + 55296);
    bf16_t* Rt = (bf16_t*)(lds + 0);
    bf16_t* At = (bf16_t*)(lds + 9216);
    bf16_t* Kh = (bf16_t*)(lds + 18432);
    bf16_t* Bh = (bf16_t*)(lds + 27648);
    bf16_t* Kt = (bf16_t*)(lds + 36864);
    bf16_t* Bt = (bf16_t*)(lds + 46080);
    bf16_t* Ap = (bf16_t*)(lds + 36864);
    bf16_t* Wv = (bf16_t*)(lds + 46080);
    bf16_t* Tb = (bf16_t*)(lds + 55296);
    bf16_t* Wb = (bf16_t*)(lds + 64512);
    float* GLs = (float*)(lds + 66048);
    float* TT = (float*)(lds + 132608);
    bf16_t* RS = (bf16_t*)(lds + 72704);
    bf16_t* KS = (bf16_t*)(lds + 81920);
    bf16_t* VS = (bf16_t*)(lds + 91136);
    float* LD = (float*)(lds + 100352);
    bf16_t* AG = (bf16_t*)(lds + 117760);
    bf16_t* Ark = (bf16_t*)(lds + 72704);
    bf16_t* Arb = (bf16_t*)(lds + 81920);
    bf16_t* Aak = (bf16_t*)(lds + 91136);
    bf16_t* Nb = (bf16_t*)(lds + 100352);
    float* Nf = (float*)(lds + 109568);
    bf16_t* OutA = Aak; bf16_t* OutB = Nb; bf16_t* OutC = Tb; bf16_t* OutD = (bf16_t*)Nf;
    const size_t tok0 = (size_t)bb * SEQ + c * 64;
    {
        const bf16_t* RWW = (const bf16_t*)(ws + WS_RWW) + (size_t)hh * 256 * 64;
#pragma unroll
        for (int i = 0; i < 4; ++i) { const int idx = tid + NT * i, r = idx >> 3, c8 = idx & 7; *(u32x4*)(w2h + r * 72 + c8 * 8) = *(const u32x4*)(RWW + r * 64 + c8 * 8); }
    }
    if (tid < 448) {
        const int q = tid % 56, tg = tid / 56;
        int pcol, role, lc;
        if (q < 24) { role = q >> 3; lc = (q & 7) * 8; pcol = role * 512 + hh * 64 + lc; }
        else if (q < 32) { role = 3; lc = (q - 24) * 8; pcol = 1536 + lc; }
        else if (q < 40) { role = 4; lc = (q - 32) * 8; pcol = 1600 + lc; }
        else { role = 5; lc = (q - 40) * 8; pcol = 1664 + lc; }
        const float4 m0 = *(const float4*)(p.ev_mu + pcol), m1 = *(const float4*)(p.ev_mu + pcol + 4);
        float y[8]; unpack8(rw[0], y);
        bf16_t* dst = (role == 0 ? RS : role == 1 ? KS : role == 2 ? VS : role == 3 ? TW : role == 4 ? AL : SG) + lc;
        const int dstride = role == 5 ? 136 : 72;
#pragma unroll
        for (int i = 0; i < 8; ++i) {
            float x[8], s[8]; unpack8(rw[i + 1], x);
            s[0] = x[0] + m0.x * (y[0] - x[0]); s[1] = x[1] + m0.y * (y[1] - x[1]); s[2] = x[2] + m0.z * (y[2] - x[2]); s[3] = x[3] + m0.w * (y[3] - x[3]);
            s[4] = x[4] + m1.x * (y[4] - x[4]); s[5] = x[5] + m1.y * (y[5] - x[5]); s[6] = x[6] + m1.z * (y[6] - x[6]); s[7] = x[7] + m1.w * (y[7] - x[7]);
#pragma unroll
            for (int e = 0; e < 8; ++e) y[e] = x[e];
            if (role == 3) {
#pragma unroll
                for (int e = 0; e < 8; ++e) s[e] = tanhf_(s[e]);
            } else if (role == 5) {
#pragma unroll
                for (int e = 0; e < 8; ++e) s[e] = sigmoidf_(s[e]);
            }
            *(u32x4*)(dst + (tg * 8 + i) * dstride) = pack8(s);
        }
    }
    if (next_id >= 0) rw_pre_load(p, next_id, rw);
    __syncthreads();
#pragma unroll 1
    for (int q = 0; q < 2; ++q) {
        const int T = wave * 2 + q, ti = T >> 2, cj = T & 3;
        f32x4v aw, aa, ag; aw[0] = 0.f; aw[1] = 0.f; aw[2] = 0.f; aw[3] = 0.f; aa = aw; ag = aw;
#pragma unroll
        for (int k0 = 0; k0 < 64; k0 += 32) {
            aw = MFMA16(frag_rm(TW + ti * 16 * 72 + k0, 72, lane), frag_tr(w2h + k0 * 72 + cj * 16, 72, lane), aw);
            aa = MFMA16(frag_rm(AL + ti * 16 * 72 + k0, 72, lane), frag_tr(a2h + k0 * 72 + cj * 16, 72, lane), aa);
        }
#pragma unroll
        for (int k0 = 0; k0 < 128; k0 += 32) ag = MFMA16(frag_rm(SG + ti * 16 * 136 + k0, 136, lane), frag_tr(g2h + k0 * 72 + cj * 16, 72, lane), ag);
        const int cc = cj * 16 + li;
        const float* PRM = (const float*)(lds0 + 131072);
        const float w0 = PRM[cc], a0 = PRM[64 + cc];
        float ldv[4];
#pragma unroll
        for (int r = 0; r < 4; ++r) {
            const int t = ti * 16 + 4 * g + r;
            ldv[r] = -0.6065306597126334f * sigmoidf_(aw[r] + w0);
            AG[t * 72 + cc] = f2bf(sigmoidf_(aa[r] + a0));
            AUX[(tok0 + t) * D + 512 + hh * 64 + cc] = f2bf(ag[r]);
        }
        ldv[1] += ldv[0]; ldv[2] += ldv[1]; ldv[3] += ldv[2];
        const float s16 = __shfl_up(ldv[3], 16), s32 = __shfl_up(ldv[3], 32), s48 = __shfl_up(ldv[3], 48);
        const float off = (g >= 1 ? s16 : 0.f) + (g >= 2 ? s32 : 0.f) + (g >= 3 ? s48 : 0.f);
#pragma unroll
        for (int r = 0; r < 4; ++r) LD[(ti * 16 + 4 * g + r) * 68 + cc] = ldv[r] + off;
        if (g == 3) TT[ti * 64 + cc] = ldv[3] + off;
    }
    __syncthreads();
    {
        const int t = tid >> 3, part = tid & 7, c0 = part * 8;
        float rs[8], ks[8], vs[8], ag[8];
        unpack8(*(const u32x4*)(RS + t * 72 + c0), rs); unpack8(*(const u32x4*)(KS + t * 72 + c0), ks); unpack8(*(const u32x4*)(VS + t * 72 + c0), vs); unpack8(*(const u32x4*)(AG + t * 72 + c0), ag);
        const float* PRM2 = (const float*)(lds0 + 131072);
        float kk[8], k2[8], bv[8], ss = 0.f, bon = 0.f;
#pragma unroll
        for (int e = 0; e < 8; ++e) {
            kk[e] = ks[e] * PRM2[128 + c0 + e]; ss += kk[e] * kk[e];
            k2[e] = ks[e] * (1.f + (ag[e] - 1.f) * PRM2[192 + c0 + e]);
            bon += rs[e] * k2[e] * PRM2[256 + c0 + e];
        }
        ss = red8(ss); bon = red8(bon);
        const float nrm = rsqrtf(ss + 1e-6f);
        float o1[8], o2[8], o3[8], o4[8], o5[8], o6[8];
#pragma unroll
        for (int e = 0; e < 8; ++e) {
            kk[e] *= nrm; bv[e] = kk[e] * ag[e];
            const int tiq = t >> 4; const float t0_ = TT[c0 + e], t1_ = TT[64 + c0 + e], t2_ = TT[128 + c0 + e];
            const float toff = (tiq >= 1 ? t0_ : 0.f) + (tiq >= 2 ? t1_ : 0.f) + (tiq >= 3 ? t2_ : 0.f);
            const float poff = ((t & 15) == 0 && t > 0) ? toff - (tiq == 1 ? t0_ : tiq == 2 ? t1_ : t2_) : toff;
            const float lc = LD[t * 68 + c0 + e] + toff, lcp = t ? LD[(t - 1) * 68 + c0 + e] + poff : 0.f, lcl = LD[63 * 68 + c0 + e] + t0_ + t1_ + t2_;
            const float eg = __expf(lc), egp = __expf(lcp), ei = __expf(-lc), eh = __expf(lcl - lc);
            o1[e] = rs[e] * eg; o2[e] = -kk[e] * egp; o3[e] = k2[e] * ei; o4[e] = bv[e] * ei; o5[e] = k2[e] * eh; o6[e] = bv[e] * eh;
            if (t == 0) GLs[c0 + e] = __expf(lcl);
            vs[e] *= bon;
        }
        *(u32x4*)(AUX + (tok0 + t) * D + hh * 64 + c0) = pack8(vs);
        *(u32x4*)(Rt + t * 72 + c0) = pack8(o1); *(u32x4*)(At + t * 72 + c0) = pack8(o2); *(u32x4*)(Kt + t * 72 + c0) = pack8(o3);
        *(u32x4*)(Bt + t * 72 + c0) = pack8(o4); *(u32x4*)(Kh + t * 72 + c0) = pack8(o5); *(u32x4*)(Bh + t * 72 + c0) = pack8(o6);
        for (int i = tid; i < 64 * 72 / 2; i += NT) ((unsigned*)Tb)[i] = 0u;
        for (int i = tid; i < 32 * 24 / 2; i += NT) ((unsigned*)Wb)[i] = 0u;
    }
    __syncthreads();
    {
        const int ti = wave >> 1;
#pragma unroll 1
        for (int jj = 0; jj < 2; ++jj) {
            const int tj = (wave & 1) * 2 + jj, s = tj * 16 + li;
            f32x4v ab; ab[0] = 0.f; ab[1] = 0.f; ab[2] = 0.f; ab[3] = 0.f;
            if (tj <= ti) {
#pragma unroll
                for (int k0 = 0; k0 < 64; k0 += 32) ab = MFMA16(frag_rm(At + ti * 16 * 72 + k0, 72, lane), frag_rm(Bt + tj * 16 * 72 + k0, 72, lane), ab);
#pragma unroll
                for (int r = 0; r < 4; ++r) if (s >= ti * 16 + 4 * g + r) ab[r] = 0.f;
            }
#pragma unroll
            for (int r = 0; r < 4; ++r) { const int t = ti * 16 + 4 * g + r; Nb[t * 72 + s] = f2bf(-ab[r]); Nf[t * 68 + s] = -ab[r]; }
        }
    }
    __syncthreads();
    if (wave == 0) tri_inverse_wave(Nf, Nb, Tb, Wb, lane);
    else {
#pragma unroll 1
        for (int pos = wave - 1; pos < 16; pos += 7) {
            const int ti = pos >> 2, tj = pos & 3, s = tj * 16 + li;
            f32x4v rk, rb, ak; rk[0] = 0.f; rk[1] = 0.f; rk[2] = 0.f; rk[3] = 0.f; rb = rk; ak = rk;
            if (tj <= ti) {
#pragma unroll
                for (int k0 = 0; k0 < 64; k0 += 32) {
                    const bf16x8 fr = frag_rm(Rt + ti * 16 * 72 + k0, 72, lane), fa = frag_rm(At + ti * 16 * 72 + k0, 72, lane);
                    const bf16x8 fk = frag_rm(Kt + tj * 16 * 72 + k0, 72, lane), fb = frag_rm(Bt + tj * 16 * 72 + k0, 72, lane);
                    rk = MFMA16(fr, fk, rk); rb = MFMA16(fr, fb, rb); ak = MFMA16(fa, fk, ak);
                }
#pragma unroll
                for (int r = 0; r < 4; ++r) { const int t = ti * 16 + 4 * g + r;
                    if (s > t) { rk[r] = 0.f; rb[r] = 0.f; } if (s >= t) ak[r] = 0.f; }
            }
#pragma unroll
            for (int r = 0; r < 4; ++r) { const int t = ti * 16 + 4 * g + r; Ark[t * 72 + s] = f2bf(rk[r]); Arb[t * 72 + s] = f2bf(rb[r]); Aak[t * 72 + s] = f2bf(ak[r]); }
        }
    }
    __syncthreads();
#pragma unroll 1
    for (int q = 0; q < 2; ++q) {
        const int T = wave * 2 + q, ti = T >> 2, nj = T & 3;
        f32x4v x1, x2; x1[0] = 0.f; x1[1] = 0.f; x1[2] = 0.f; x1[3] = 0.f; x2 = x1;
#pragma unroll
        for (int k0 = 0; k0 < 64; k0 += 32) {
            const bf16x8 ft = frag_rm(Tb + ti * 16 * 72 + k0, 72, lane);
            x1 = MFMA16(ft, frag_tr(At + k0 * 72 + nj * 16, 72, lane), x1);
            x2 = MFMA16(ft, frag_tr(Aak + k0 * 72 + nj * 16, 72, lane), x2);
        }
#pragma unroll
        for (int r = 0; r < 4; ++r) { const int t = ti * 16 + 4 * g + r; Ap[t * 72 + nj * 16 + li] = f2bf(x1[r]); Wv[t * 72 + nj * 16 + li] = f2bf(x2[r]); }
    }
    __syncthreads();
#pragma unroll 1
    for (int q = 0; q < 2; ++q) {
        const int T = wave * 2 + q, ti = T >> 2, nj = T & 3;
        f32x4v x1, x2; x1[0] = 0.f; x1[1] = 0.f; x1[2] = 0.f; x1[3] = 0.f; x2 = x1;
#pragma unroll
        for (int k0 = 0; k0 < 64; k0 += 32) {
            const bf16x8 fb = frag_rm(Arb + ti * 16 * 72 + k0, 72, lane);
            x1 = MFMA16(fb, frag_tr(Ap + k0 * 72 + nj * 16, 72, lane), x1);
            x2 = MFMA16(fb, frag_tr(Wv + k0 * 72 + nj * 16, 72, lane), x2);
        }
#pragma unroll
        for (int r = 0; r < 4; ++r) { const int t = ti * 16 + 4 * g + r, n = nj * 16 + li;
            OutA[t * 72 + n] = f2bf(x1[r] + bf2f(Rt[t * 72 + n])); OutB[t * 72 + n] = f2bf(x2[r] + bf2f(Ark[t * 72 + n])); }
    }
#pragma unroll 1
    for (int q = 0; q < 2; ++q) {
        const int T = wave * 2 + q, mi = T >> 2, nj = T & 3;
        f32x4v x1, x2; x1[0] = 0.f; x1[1] = 0.f; x1[2] = 0.f; x1[3] = 0.f; x2 = x1;
#pragma unroll
        for (int k0 = 0; k0 < 64; k0 += 32) {
            const bf16x8 fb = frag_tr(Bh + k0 * 72 + nj * 16, 72, lane);
            x1 = MFMA16(frag_tr(Ap + k0 * 72 + mi * 16, 72, lane), fb, x1);
            x2 = MFMA16(frag_tr(Wv + k0 * 72 + mi * 16, 72, lane), fb, x2);
        }
#pragma unroll
        for (int r = 0; r < 4; ++r) { const int m = mi * 16 + 4 * g + r, n = nj * 16 + li;
            OutC[m * 72 + n] = f2bf(x1[r] + (m == n ? GLs[n] : 0.f)); OutD[m * 72 + n] = f2bf(x2[r] + bf2f(Kh[m * 72 + n])); }
    }
    __syncthreads();
    {
        const int t = tid >> 3, part = tid & 7;
        *(u32x4*)(item + t * 128 + part * 16) = *(const u32x4*)(OutA + t * 72 + part * 8);
        *(u32x4*)(item + 8192 + t * 128 + part * 16) = *(const u32x4*)(OutB + t * 72 + part * 8);
        *(u32x4*)(item + 16384 + t * 128 + part * 16) = *(const u32x4*)(OutC + t * 72 + part * 8);
        *(u32x4*)(item + 24576 + t * 128 + part * 16) = *(const u32x4*)(OutD + t * 72 + part * 8);
    }
    __syncthreads();
}

__device__ __forceinline__ void phase_pre0(const Params& p, char* lds) {
    u32x4 rw[9];
    if ((int)blockIdx.x < 2048) rw_pre_load(p, blockIdx.x, rw);
    int tab_hh = -1;
    for (int i = blockIdx.x; i < 4096; i += gridDim.x) {
        const int hh_i = (i >> 5) & 7;
        if (hh_i != tab_hh) {
            __syncthreads();
            float* PRM = (float*)(lds + 131072);
            if (threadIdx.x < 64) { const int ch = hh_i * 64 + threadIdx.x;
                PRM[threadIdx.x] = p.rw_w0[ch]; PRM[64 + threadIdx.x] = p.rw_a0[ch]; PRM[128 + threadIdx.x] = p.rw_k_k[ch]; PRM[192 + threadIdx.x] = p.rw_k_a[ch]; PRM[256 + threadIdx.x] = p.rw_r_k[ch];
                PRM[320 + threadIdx.x] = sigmoidf_(p.hg_lb[ch] - p.hg_lb[512 + ch]); }
            __syncthreads();
            tab_hh = hh_i;
        }
        if (i < 2048) rw_pre_item(p, lds, i, rw, (i + (int)gridDim.x < 2048) ? i + (int)gridDim.x : -1);
        else hg_pre_item(p, lds, i - 2048);
    }
}

template <bool RW>
__device__ __forceinline__ void seq64_unit(const Params& p, char* lds, int bb, int hh, int cg) {
    const int tid = threadIdx.x, lane = tid & 63, wave = tid >> 6, g = lane >> 4, li = lane & 15;
    unsigned char* ws = p.ws;
    const bf16_t* P = (const bf16_t*)(ws + WS_P);
    bf16_t* O16 = (bf16_t*)(ws + WS_XN);
    constexpr size_t ITEM = RW ? CHK_RW_ITEM : CHK_HG_ITEM;
    const unsigned char* chk = ws + (RW ? WS_CHK_RW : WS_CHK_HG) + (size_t)((bb * 8 + hh) * 32) * ITEM;
    constexpr int STG = 41984 + 512;
    bf16_t* St = (bf16_t*)(lds + 2 * STG);
    const int vcol = RW ? 1024 + hh * 64 + cg * 32 : 1792 + 1024 + hh * 64 + cg * 32;
    const int ocol = RW ? hh * 64 + cg * 32 : 512 + hh * 64 + cg * 32;
    const int mrow = tid >> 3, mc8 = tid & 7;
    const int vt = tid >> 2, vc = tid & 3;
    float mu[8];
#pragma unroll
    for (int e = 0; e < 8; ++e) mu[e] = RW ? p.ev_mu[vcol + vc * 8 + e] : 0.f;
    u32x4 rm0, rm1, rm2, rm3, rv, rvp; float rgl = 0.f;
    rm3 = u32x4{0u, 0u, 0u, 0u}; rvp = rm3; rv = rm3;
#define SEQ_LOAD(c) do { const unsigned char* it = chk + (size_t)(c) * ITEM; \
        rm0 = *(const u32x4*)(it + mrow * 128 + mc8 * 16); rm1 = *(const u32x4*)(it + 8192 + mrow * 128 + mc8 * 16); rm2 = *(const u32x4*)(it + 16384 + mrow * 128 + mc8 * 16); \
        if (RW) rm3 = *(const u32x4*)(it + 24576 + mrow * 128 + mc8 * 16); else if (tid < 64) rgl = ((const float*)(it + 24576))[tid]; \
        if (tid < 256) { const size_t tk = (size_t)bb * SEQ + (c) * 64 + vt; rv = *(const u32x4*)(P + tk * EVEN_IN + vcol + vc * 8); \
            if (RW) { if ((c) * 64 + vt > 0) rvp = *(const u32x4*)(P + (tk - 1) * EVEN_IN + vcol + vc * 8); else rvp = u32x4{0u, 0u, 0u, 0u}; } } } while (0)
#define SEQ_STAGE(sb) do { char* sg_ = lds + (sb) * STG; \
        *(u32x4*)(sg_ + mrow * 144 + mc8 * 16) = rm0; *(u32x4*)(sg_ + 9216 + mrow * 144 + mc8 * 16) = rm1; \
        if (RW) { *(u32x4*)(sg_ + 18432 + mrow * 144 + mc8 * 16) = rm2; *(u32x4*)(sg_ + 27648 + mrow * 144 + mc8 * 16) = rm3; } \
        else { *(u32x4*)(sg_ + 27648 + mrow * 144 + mc8 * 16) = rm2; if (tid < 64) ((float*)(sg_ + 41984))[tid] = rgl; } \
        if (tid < 256) { u32x4 o_ = rv; \
            if (RW) { float a_[8], b_[8]; a_[0] = lo16(rv.x); a_[1] = hi16(rv.x); a_[2] = lo16(rv.y); a_[3] = hi16(rv.y); a_[4] = lo16(rv.z); a_[5] = hi16(rv.z); a_[6] = lo16(rv.w); a_[7] = hi16(rv.w); \
                b_[0] = lo16(rvp.x); b_[1] = hi16(rvp.x); b_[2] = lo16(rvp.y); b_[3] = hi16(rvp.y); b_[4] = lo16(rvp.z); b_[5] = hi16(rvp.z); b_[6] = lo16(rvp.w); b_[7] = hi16(rvp.w); \
                _Pragma("unroll") for (int e_ = 0; e_ < 8; ++e_) a_[e_] = a_[e_] + mu[e_] * (b_[e_] - a_[e_]); \
                o_.x = pack2(a_[0], a_[1]); o_.y = pack2(a_[2], a_[3]); o_.z = pack2(a_[4], a_[5]); o_.w = pack2(a_[6], a_[7]); } \
            *(u32x4*)(sg_ + 36864 + vt * 80 + vc * 16) = o_; } } while (0)
    SEQ_LOAD(0);
    for (int i = tid; i < 2 * 32 * 72 / 2; i += NT) ((unsigned*)St)[i] = 0u;
    SEQ_STAGE(0);
    SEQ_LOAD(1);
    f32x4v sacc; sacc[0] = 0.f; sacc[1] = 0.f; sacc[2] = 0.f; sacc[3] = 0.f;
    __syncthreads();
    for (int c = 0; c < 32; ++c) {
        const int cur = c & 1;
        if (c + 1 < 32) SEQ_STAGE(cur ^ 1);
        if (c + 2 < 32) SEQ_LOAD(c + 2);
        const char* sg = lds + cur * STG;
        const bf16_t* Rp = (const bf16_t*)sg; const bf16_t* Ay = (const bf16_t*)(sg + 9216); const bf16_t* Gc = (const bf16_t*)(sg + 18432); const bf16_t* Kc = (const bf16_t*)(sg + 27648);
        const bf16_t* Vs = (const bf16_t*)(sg + 36864); const float* gL = (const float*)(sg + 41984);
        const bf16_t* Sc = St + cur * 32 * 72; bf16_t* Sn = St + (cur ^ 1) * 32 * 72;
        {
            const int ti = wave >> 1, vj = wave & 1;
            f32x4v acc; acc[0] = 0.f; acc[1] = 0.f; acc[2] = 0.f; acc[3] = 0.f;
#pragma unroll
            for (int k0 = 0; k0 < 64; k0 += 32) acc = MFMA16(frag_rm(Rp + ti * 16 * 72 + k0, 72, lane), frag_rm(Sc + vj * 16 * 72 + k0, 72, lane), acc);
#pragma unroll
            for (int k0 = 0; k0 < 64; k0 += 32) acc = MFMA16(frag_rm(Ay + ti * 16 * 72 + k0, 72, lane), frag_tr(Vs + k0 * 40 + vj * 16, 40, lane), acc);
#pragma unroll
            for (int r = 0; r < 4; ++r) O16[((size_t)bb * SEQ + c * 64 + ti * 16 + 4 * g + r) * D + ocol + vj * 16 + li] = f2bf(acc[r]);
        }
        {
            const int vi = wave >> 2, kj = wave & 3;
            f32x4v t4; t4[0] = 0.f; t4[1] = 0.f; t4[2] = 0.f; t4[3] = 0.f;
#pragma unroll
            for (int k0 = 0; k0 < 64; k0 += 32) t4 = MFMA16(frag_tr(Vs + k0 * 40 + vi * 16, 40, lane), frag_tr(Kc + k0 * 72 + kj * 16, 72, lane), t4);
            if (RW) {
#pragma unroll
                for (int k0 = 0; k0 < 64; k0 += 32) t4 = MFMA16(frag_rm(Sc + vi * 16 * 72 + k0, 72, lane), frag_tr(Gc + k0 * 72 + kj * 16, 72, lane), t4);
                sacc = t4;
            } else { const float gl = gL[kj * 16 + li];
#pragma unroll
                for (int r = 0; r < 4; ++r) sacc[r] = sacc[r] * gl + t4[r]; }
#pragma unroll
            for (int r = 0; r < 4; ++r) Sn[(vi * 16 + 4 * g + r) * 72 + kj * 16 + li] = f2bf(sacc[r]);
        }
        __syncthreads();
    }
#undef SEQ_LOAD
#undef SEQ_STAGE
}

__device__ __forceinline__ void phase_mix0(const Params& p, char* lds) {
    for (int u = blockIdx.x; u < 256; u += gridDim.x) {
        const int v = u & 127, x = v & 7, j = v >> 3, pair = x * 8 + (j >> 1), bb = pair >> 3, hh = pair & 7, cg = j & 1;
        if (u < 128) seq64_unit<true>(p, lds, bb, hh, cg); else seq64_unit<false>(p, lds, bb, hh, cg);
        __syncthreads();
    }
}


constexpr size_t CHK_GD_ITEM = 90112;
constexpr size_t WS_CHK_GD = WS_ARENA;
static_assert(WS_CHK_GD + (size_t)1024 * CHK_GD_ITEM <= WS_END, "gdn chunk matrices fit the arena");

__device__ __forceinline__ void gdn_pre_item(const Params& p, char* lds0, int id) {
    const int tid = threadIdx.x, lane = tid & 63, wave = tid >> 6, g = lane >> 4, li = lane & 15;
    const int bb = id >> 7, hh = (id >> 5) & 3, c = id & 31;
    int lz = 0; asm volatile("" : "+s"(lz));
    char* lds = lds0 + lz;
    unsigned char* ws = p.ws;
    const bf16_t* P = (const bf16_t*)(ws + WS_P);
    const float* GT = (const float*)(ws + WS_GATES);
    unsigned char* item = ws + WS_CHK_GD + (size_t)id * CHK_GD_ITEM;
    constexpr int LQ = 136, LS = 72, LRQ = 264, LRV = 136;
    bf16_t* Qs = (bf16_t*)(lds + 0);
    bf16_t* Ks = (bf16_t*)(lds + 17408);
    bf16_t* RAWqk = (bf16_t*)(lds + 34816);
    bf16_t* Kt = (bf16_t*)(lds + 34816);
    bf16_t* Kte = (bf16_t*)(lds + 52224);
    bf16_t* RAWv = (bf16_t*)(lds + 70208);
    bf16_t* A1b = (bf16_t*)(lds + 70208);
    bf16_t* A2b = (bf16_t*)(lds + 79424);
    bf16_t* Tb = (bf16_t*)(lds + 88640);
    bf16_t* Tg = (bf16_t*)(lds + 97856);
    bf16_t* Wv = (bf16_t*)(lds + 107072);
    bf16_t* Wve = (bf16_t*)(lds + 116288);
    float* A2f = (float*)(lds + 125504);
    bf16_t* Wb = (bf16_t*)(lds + 142912);
    float* gam = (float*)(lds + 144448); float* be = gam + 64; float* egam = be + 64; float* edl = egam + 64; float* misc = edl + 64;
    const size_t tok0 = (size_t)bb * SEQ + c * 64;
    for (int i = tid; i < 67 * 32; i += NT) { const int row = i >> 5, ch = i & 31; const int t = row - 3;
        u32x4 v; v.x = 0u; v.y = 0u; v.z = 0u; v.w = 0u;
        if (c * 64 + t >= 0) v = *(const u32x4*)(P + (tok0 + t) * ODD_IN + (ch < 16 ? hh * 128 + ch * 8 : 512 + hh * 128 + (ch - 16) * 8));
        *(u32x4*)(RAWqk + row * LRQ + ch * 8) = v; }
    for (int i = tid; i < 67 * 16; i += NT) { const int row = i >> 4, ch = i & 15; const int t = row - 3;
        u32x4 v; v.x = 0u; v.y = 0u; v.z = 0u; v.w = 0u;
        if (c * 64 + t >= 0) v = *(const u32x4*)(P + (tok0 + t) * ODD_IN + 1024 + hh * 128 + ch * 8);
        *(u32x4*)(RAWv + row * LRV + ch * 8) = v; }
    if (wave == 0) {
        const float negA = -__expf(p.gd_a_log[hh]), dtb = p.gd_dt_bias[hh];
        const float bev = sigmoidf_(GT[(tok0 + lane) * 16 + hh]);
        const float gg = negA * softplusf_(GT[(tok0 + lane) * 16 + 4 + hh] + dtb);
        float gc = gg;
#pragma unroll
        for (int off = 1; off < 64; off <<= 1) { const float y = __shfl_up(gc, off); if (lane >= off) gc += y; }
        const float gl = __shfl(gc, 63);
        gam[lane] = gc; be[lane] = bev; egam[lane] = __expf(gc); edl[lane] = __expf(gl - gc);
        if (lane == 0) misc[0] = __expf(gl);
    }
    __syncthreads();
    {
        const int lt = tid >> 4, lc = tid & 15;
        const float* CWT = (const float*)(lds0 + 145664);
#pragma unroll 1
        for (int grp = 0; grp < 3; ++grp) {
            float4 wA[4], wB[4];
#pragma unroll
            for (int r = 0; r < 4; ++r) { wA[r] = *(const float4*)(CWT + r * 384 + grp * 128 + lc * 8); wB[r] = *(const float4*)(CWT + r * 384 + grp * 128 + lc * 8 + 4); }
#pragma unroll 1
            for (int tt = 0; tt < 2; ++tt) {
                const int t = lt + 32 * tt;
                float y[8];
#pragma unroll
                for (int e = 0; e < 8; ++e) y[e] = 0.f;
#pragma unroll
                for (int r = 0; r < 4; ++r) {
                    const bf16_t* rp = grp < 2 ? RAWqk + (t + r) * LRQ + grp * 128 + lc * 8 : RAWv + (t + r) * LRV + lc * 8;
                    float x[8]; unpack8(*(const u32x4*)rp, x);
                    y[0] += wA[r].x * x[0]; y[1] += wA[r].y * x[1]; y[2] += wA[r].z * x[2]; y[3] += wA[r].w * x[3];
                    y[4] += wB[r].x * x[4]; y[5] += wB[r].y * x[5]; y[6] += wB[r].z * x[6]; y[7] += wB[r].w * x[7];
                }
                float ss = 0.f;
#pragma unroll
                for (int e = 0; e < 8; ++e) { y[e] = siluf_(y[e]); ss += y[e] * y[e]; }
                if (grp < 2) { ss = red16(ss); const float nrm = rsqrtf(ss + 1e-6f) * (grp == 0 ? 0.08838834764831845f : 1.f);
#pragma unroll
                    for (int e = 0; e < 8; ++e) y[e] *= nrm;
                    *(u32x4*)((grp == 0 ? Qs : Ks) + t * LQ + lc * 8) = pack8(y);
                } else *(u32x4*)(item + 73728 + t * 256 + lc * 16) = pack8(y);
            }
        }
    }
    __syncthreads();
    {
        for (int i = tid; i < 64 * LS / 2; i += NT) ((unsigned*)Tb)[i] = 0u;
        for (int i = tid; i < 32 * 24 / 2; i += NT) ((unsigned*)Wb)[i] = 0u;
        const int ti = wave >> 1;
#pragma unroll 1
        for (int jj = 0; jj < 2; ++jj) {
            const int tj = (wave & 1) * 2 + jj, s = tj * 16 + li;
            f32x4v aq, ak; aq[0] = 0.f; aq[1] = 0.f; aq[2] = 0.f; aq[3] = 0.f; ak = aq;
            if (tj <= ti) {
#pragma unroll
                for (int k0 = 0; k0 < 128; k0 += 32) {
                    const bf16x8 kb = frag_rm(Ks + tj * 16 * LQ + k0, LQ, lane);
                    aq = MFMA16(frag_rm(Qs + ti * 16 * LQ + k0, LQ, lane), kb, aq);
                    ak = MFMA16(frag_rm(Ks + ti * 16 * LQ + k0, LQ, lane), kb, ak);
                }
                const float gs = gam[s];
#pragma unroll
                for (int r = 0; r < 4; ++r) { const int t = ti * 16 + 4 * g + r; const float dcy = __expf(fminf(gam[t] - gs, 0.f));
                    aq[r] = (s <= t) ? aq[r] * dcy : 0.f; ak[r] = (s < t) ? ak[r] * be[t] * dcy : 0.f; }
            }
#pragma unroll
            for (int r = 0; r < 4; ++r) { const int t = ti * 16 + 4 * g + r; A1b[t * LS + s] = f2bf(aq[r]); A2b[t * LS + s] = f2bf(ak[r]); A2f[t * 68 + s] = ak[r]; }
        }
    }
    __syncthreads();
    if (wave == 0) tri_inverse_wave(A2f, A2b, Tb, Wb, lane);
    __syncthreads();
    {
        const int t = tid >> 3, s0 = (tid & 7) * 8;
        float tv[8], a[8], b[8], cc[8]; unpack8(*(const u32x4*)(Tb + t * LS + s0), tv);
        const float ed = edl[t];
#pragma unroll
        for (int e = 0; e < 8; ++e) { const float bs = be[s0 + e]; b[e] = tv[e] * bs; a[e] = b[e] * egam[s0 + e]; cc[e] = b[e] * ed; }
        *(u32x4*)(Tg + t * LS + s0) = pack8(a); *(u32x4*)(Wv + t * LS + s0) = pack8(b); *(u32x4*)(Wve + t * LS + s0) = pack8(cc);
    }
    __syncthreads();
#pragma unroll 1
    for (int q = 0; q < 4; ++q) {
        const int T = wave * 4 + q, ti = T >> 3, nj = T & 7;
        f32x4v x; x[0] = 0.f; x[1] = 0.f; x[2] = 0.f; x[3] = 0.f;
#pragma unroll
        for (int k0 = 0; k0 < 64; k0 += 32) x = MFMA16(frag_rm(Tg + ti * 16 * LS + k0, LS, lane), frag_tr(Ks + k0 * LQ + nj * 16, LQ, lane), x);
#pragma unroll
        for (int r = 0; r < 4; ++r) { const int t = ti * 16 + 4 * g + r; Kt[t * LQ + nj * 16 + li] = f2bf(x[r]); Kte[t * LQ + nj * 16 + li] = f2bf(x[r] * edl[t]); }
    }
    __syncthreads();
#pragma unroll 1
    for (int q = 0; q < 4; ++q) {
        const int T = wave * 4 + q, ti = T >> 3, nj = T & 7;
        f32x4v x; x[0] = 0.f; x[1] = 0.f; x[2] = 0.f; x[3] = 0.f;
#pragma unroll
        for (int k0 = 0; k0 < 64; k0 += 32) x = MFMA16(frag_rm(A1b + ti * 16 * LS + k0, LS, lane), frag_tr(Kt + k0 * LQ + nj * 16, LQ, lane), x);
#pragma unroll
        for (int r = 0; r < 4; ++r) { const int t = ti * 16 + 4 * g + r; bf16_t* qp = Qs + t * LQ + nj * 16 + li; *qp = f2bf(egam[t] * bf2f(*qp) - x[r]); }
    }
#pragma unroll 1
    for (int q = 0; q < 2; ++q) {
        const int T = wave * 2 + q, ti = T >> 2, nj = T & 3;
        f32x4v x; x[0] = 0.f; x[1] = 0.f; x[2] = 0.f; x[3] = 0.f;
#pragma unroll
        for (int k0 = 0; k0 < 64; k0 += 32) x = MFMA16(frag_rm(A1b + ti * 16 * LS + k0, LS, lane), frag_tr(Wv + k0 * LS + nj * 16, LS, lane), x);
#pragma unroll
        for (int r = 0; r < 4; ++r) { const int t = ti * 16 + 4 * g + r; ((bf16_t*)(item + 16384))[t * 64 + nj * 16 + li] = f2bf(x[r]); }
    }
    __syncthreads();
    {
        const int t = tid >> 3, part = tid & 7;
        *(u32x4*)(item + t * 256 + part * 32) = *(const u32x4*)(Qs + t * LQ + part * 16);
        *(u32x4*)(item + t * 256 + part * 32 + 16) = *(const u32x4*)(Qs + t * LQ + part * 16 + 8);
    }
    {
        const float gl = misc[0];
#pragma unroll 1
        for (int q = 0; q < 8; ++q) {
            const int T = wave * 8 + q, mi = T >> 3, nj = T & 7;
            f32x4v x; x[0] = 0.f; x[1] = 0.f; x[2] = 0.f; x[3] = 0.f;
#pragma unroll
            for (int k0 = 0; k0 < 64; k0 += 32) x = MFMA16(frag_tr(Kte + k0 * LQ + mi * 16, LQ, lane), frag_tr(Ks + k0 * LQ + nj * 16, LQ, lane), x);
#pragma unroll
            for (int r = 0; r < 4; ++r) { const int m = mi * 16 + 4 * g + r, n = nj * 16 + li; ((bf16_t*)(item + 24576))[m * 128 + n] = f2bf((m == n ? gl : 0.f) - x[r]); }
        }
#pragma unroll 1
        for (int q = 0; q < 4; ++q) {
            const int T = wave * 4 + q, mi = T >> 3, nj = T & 7;
            f32x4v x; x[0] = 0.f; x[1] = 0.f; x[2] = 0.f; x[3] = 0.f;
#pragma unroll
            for (int k0 = 0; k0 < 64; k0 += 32) x = MFMA16(frag_tr(Wve + k0 * LS + mi * 16, LS, lane), frag_tr(Ks + k0 * LQ + nj * 16, LQ, lane), x);
#pragma unroll
            for (int r = 0; r < 4; ++r) { const int m = mi * 16 + 4 * g + r, n = nj * 16 + li; ((bf16_t*)(item + 57344))[m * 128 + n] = f2bf(x[r]); }
        }
    }
    __syncthreads();
}

__device__ __forceinline__ void gdn_seq_unit(const Params& p, char* lds, int bb, int hh, int cg) {
    const int tid = threadIdx.x, lane = tid & 63, wave = tid >> 6, g = lane >> 4, li = lane & 15;
    unsigned char* ws = p.ws;
    bf16_t* O16 = (bf16_t*)(ws + WS_XN);
    const unsigned char* chk = ws + WS_CHK_GD + (size_t)((bb * 4 + hh) * 32) * CHK_GD_ITEM;
    constexpr int LQ = 136, LS = 72, LV = 40;
    bf16_t* Rp = (bf16_t*)(lds + 0);
    bf16_t* Ay = (bf16_t*)(lds + 17408);
    bf16_t* Gc = (bf16_t*)(lds + 26624);
    bf16_t* Kc = (bf16_t*)(lds + 61440);
    bf16_t* Vs = (bf16_t*)(lds + 78848);
    bf16_t* St = (bf16_t*)(lds + 83968);
    const int r8 = tid >> 3, c8 = tid & 7;
    const int r16 = tid >> 4, c16 = tid & 15, vt = tid >> 2, vc = tid & 3;
    u32x4 q0, q1, ao, g0, g1, g2, g3, k0r, k1r, rv;
    rv.x = 0u; rv.y = 0u; rv.z = 0u; rv.w = 0u;
#define GSEQ_LOAD(c) do { const unsigned char* it = chk + (size_t)(c) * CHK_GD_ITEM; \
        q0 = *(const u32x4*)(it + r16 * 256 + c16 * 16); q1 = *(const u32x4*)(it + (r16 + 32) * 256 + c16 * 16); \
        ao = *(const u32x4*)(it + 16384 + r8 * 128 + c8 * 16); \
        g0 = *(const u32x4*)(it + 24576 + r16 * 256 + c16 * 16); g1 = *(const u32x4*)(it + 24576 + (r16 + 32) * 256 + c16 * 16); \
        g2 = *(const u32x4*)(it + 24576 + (r16 + 64) * 256 + c16 * 16); g3 = *(const u32x4*)(it + 24576 + (r16 + 96) * 256 + c16 * 16); \
        k0r = *(const u32x4*)(it + 57344 + r16 * 256 + c16 * 16); k1r = *(const u32x4*)(it + 57344 + (r16 + 32) * 256 + c16 * 16); \
        if (tid < 256) rv = *(const u32x4*)(it + 73728 + vt * 256 + cg * 64 + vc * 16); } while (0)
#define GSEQ_STAGE() do { \
        *(u32x4*)(Rp + r16 * LQ + c16 * 8) = q0; *(u32x4*)(Rp + (r16 + 32) * LQ + c16 * 8) = q1; *(u32x4*)(Ay + r8 * LS + c8 * 8) = ao; \
        *(u32x4*)(Gc + r16 * LQ + c16 * 8) = g0; *(u32x4*)(Gc + (r16 + 32) * LQ + c16 * 8) = g1; *(u32x4*)(Gc + (r16 + 64) * LQ + c16 * 8) = g2; *(u32x4*)(Gc + (r16 + 96) * LQ + c16 * 8) = g3; \
        *(u32x4*)(Kc + r16 * LQ + c16 * 8) = k0r; *(u32x4*)(Kc + (r16 + 32) * LQ + c16 * 8) = k1r; \
        if (tid < 256) *(u32x4*)(Vs + vt * LV + vc * 8) = rv; } while (0)
    GSEQ_LOAD(0);
    for (int i = tid; i < 2 * 32 * LQ / 2; i += NT) ((unsigned*)St)[i] = 0u;
    for (int c = 0; c < 32; ++c) {
        const int cur = c & 1;
        GSEQ_STAGE();
        __syncthreads();
        if (c + 1 < 32) GSEQ_LOAD(c + 1);
        const bf16_t* Sc = St + cur * 32 * LQ; bf16_t* Sn = St + (cur ^ 1) * 32 * LQ;
        {
            const int ti = wave >> 1, vj = wave & 1;
            f32x4v acc; acc[0] = 0.f; acc[1] = 0.f; acc[2] = 0.f; acc[3] = 0.f;
#pragma unroll
            for (int k0 = 0; k0 < 128; k0 += 32) acc = MFMA16(frag_rm(Rp + ti * 16 * LQ + k0, LQ, lane), frag_rm(Sc + vj * 16 * LQ + k0, LQ, lane), acc);
#pragma unroll
            for (int k0 = 0; k0 < 64; k0 += 32) acc = MFMA16(frag_rm(Ay + ti * 16 * LS + k0, LS, lane), frag_tr(Vs + k0 * LV + vj * 16, LV, lane), acc);
#pragma unroll
            for (int r = 0; r < 4; ++r) O16[((size_t)bb * SEQ + c * 64 + ti * 16 + 4 * g + r) * D + hh * 128 + cg * 32 + vj * 16 + li] = f2bf(acc[r]);
        }
#pragma unroll
        for (int vi = 0; vi < 2; ++vi) {
            f32x4v t4; t4[0] = 0.f; t4[1] = 0.f; t4[2] = 0.f; t4[3] = 0.f;
#pragma unroll
            for (int k0 = 0; k0 < 64; k0 += 32) t4 = MFMA16(frag_tr(Vs + k0 * LV + vi * 16, LV, lane), frag_tr(Kc + k0 * LQ + wave * 16, LQ, lane), t4);
#pragma unroll
            for (int k0 = 0; k0 < 128; k0 += 32) t4 = MFMA16(frag_rm(Sc + vi * 16 * LQ + k0, LQ, lane), frag_tr(Gc + k0 * LQ + wave * 16, LQ, lane), t4);
#pragma unroll
            for (int r = 0; r < 4; ++r) Sn[(vi * 16 + 4 * g + r) * LQ + wave * 16 + li] = f2bf(t4[r]);
        }
        __syncthreads();
    }
#undef GSEQ_LOAD
#undef GSEQ_STAGE
}


constexpr size_t CHK_ML_ITEM = 9472;
constexpr size_t WS_CHK_ML = WS_CHK_GD + (size_t)1024 * CHK_GD_ITEM;
static_assert(WS_CHK_ML + (size_t)1024 * CHK_ML_ITEM <= WS_END, "mlstm chunk data fits the arena");

__device__ __forceinline__ void mlstm_pre_item(const Params& p, char* lds, int id) {
    const int tid = threadIdx.x, lane = tid & 63, wave = tid >> 6, g = lane >> 4, li = lane & 15;
    const int bb = id >> 7, hh = (id >> 5) & 3, c = id & 31;
    unsigned char* ws = p.ws;
    const bf16_t* P = (const bf16_t*)(ws + WS_P);
    const float* GT = (const float*)(ws + WS_GATES);
    unsigned char* item = ws + WS_CHK_ML + (size_t)id * CHK_ML_ITEM;
    constexpr int LQ = 136, LS = 72;
    bf16_t* Qs = (bf16_t*)lds;
    bf16_t* Ks = Qs + 64 * LQ;
    bf16_t* SC = Ks + 64 * LQ;
    float* fl = (float*)(SC + 64 * LS);
    float* zs = fl; float* Mt = fl + 64; float* rsum = fl + 128; float* summ = fl + 192;
    const float scale = 0.08838834764831845f;
    const float ib = p.ml_i_bias[hh], fb = p.ml_f_bias[hh];
    const size_t tokb = (size_t)bb * SEQ;
    {
        const int qt0 = tid >> 4, qc = tid & 15;
        const bf16_t* qsrc = P + (tokb + c * 64 + qt0) * ODD_IN + 2048 + hh * 128 + qc * 8;
        *(u32x4*)(Qs + qt0 * LQ + qc * 8) = *(const u32x4*)qsrc; *(u32x4*)(Qs + (qt0 + 32) * LQ + qc * 8) = *(const u32x4*)(qsrc + (size_t)32 * ODD_IN);
        *(u32x4*)(Ks + qt0 * LQ + qc * 8) = *(const u32x4*)(qsrc + 512); *(u32x4*)(Ks + (qt0 + 32) * LQ + qc * 8) = *(const u32x4*)(qsrc + 512 + (size_t)32 * ODD_IN);
    }
    for (int cp = wave; cp < c; cp += 8) {
        const size_t tok = tokb + cp * 64 + lane;
        const float lf = -softplusf_(-(GT[tok * 16 + 12 + hh] + fb)), ig = GT[tok * 16 + 8 + hh] + ib;
        float bc = lf;
#pragma unroll
        for (int off = 1; off < 64; off <<= 1) { const float y = __shfl_up(bc, off); if (lane >= off) bc += y; }
        float z = ig - bc;
#pragma unroll
        for (int off = 32; off >= 1; off >>= 1) z = fmaxf(z, __shfl_xor(z, off));
        if (lane == 63) { summ[cp * 2] = bc; summ[cp * 2 + 1] = z; }
    }
    __syncthreads();
    if (wave == 0) {
        float m = 0.f;
        for (int cp = 0; cp < c; ++cp) m = summ[cp * 2] + fmaxf(m, summ[cp * 2 + 1]);
        const size_t tok = tokb + c * 64 + lane;
        const float lf = -softplusf_(-(GT[tok * 16 + 12 + hh] + fb)), ig = GT[tok * 16 + 8 + hh] + ib;
        float bc = lf;
#pragma unroll
        for (int off = 1; off < 64; off <<= 1) { const float y = __shfl_up(bc, off); if (lane >= off) bc += y; }
        const float z = ig - bc;
        float cz = z;
#pragma unroll
        for (int off = 1; off < 64; off <<= 1) { const float y = __shfl_up(cz, off); if (lane >= off) cz = fmaxf(cz, y); }
        const float Mtv = fmaxf(m, cz);
        const float Ml = __shfl(Mtv, 63);
        zs[lane] = z; Mt[lane] = Mtv; rsum[lane] = 0.f;
        float* sc_f = (float*)(item + 8192);
        sc_f[lane] = __expf(m - Mtv); sc_f[64 + lane] = __expf(-(bc + Mtv)); sc_f[128 + lane] = __expf(z - Ml) * scale;
        if (lane == 0) sc_f[256] = __expf(m - Ml);
    }
    __syncthreads();
    {
        const int ti = wave >> 1;
        float rs0 = 0.f, rs1 = 0.f, rs2 = 0.f, rs3 = 0.f;
#pragma unroll 1
        for (int jj = 0; jj < 2; ++jj) {
            const int tj = (wave & 1) * 2 + jj, s = tj * 16 + li;
            f32x4v acc; acc[0] = 0.f; acc[1] = 0.f; acc[2] = 0.f; acc[3] = 0.f;
            if (tj <= ti) {
#pragma unroll
                for (int k0 = 0; k0 < 128; k0 += 32) acc = MFMA16(frag_rm(Qs + ti * 16 * LQ + k0, LQ, lane), frag_rm(Ks + tj * 16 * LQ + k0, LQ, lane), acc);
                const float zv = zs[s];
#pragma unroll
                for (int r = 0; r < 4; ++r) { const int t = ti * 16 + 4 * g + r; acc[r] = (s <= t) ? acc[r] * scale * __expf(zv - Mt[t]) : 0.f; }
                rs0 += acc[0]; rs1 += acc[1]; rs2 += acc[2]; rs3 += acc[3];
            }
#pragma unroll
            for (int r = 0; r < 4; ++r) SC[(ti * 16 + 4 * g + r) * LS + s] = f2bf(acc[r]);
        }
        rs0 = red16(rs0); rs1 = red16(rs1); rs2 = red16(rs2); rs3 = red16(rs3);
        if (li == 0) { atomicAdd(&rsum[ti * 16 + 4 * g + 0], rs0); atomicAdd(&rsum[ti * 16 + 4 * g + 1], rs1); atomicAdd(&rsum[ti * 16 + 4 * g + 2], rs2); atomicAdd(&rsum[ti * 16 + 4 * g + 3], rs3); }
    }
    __syncthreads();
    { const int t = tid >> 3, part = tid & 7; *(u32x4*)(item + t * 128 + part * 16) = *(const u32x4*)(SC + t * LS + part * 8); }
    if (tid < 64) ((float*)(item + 8192))[192 + tid] = rsum[tid];
    __syncthreads();
}

__device__ __forceinline__ void mlstm_seq_unit(const Params& p, char* lds, int bb, int hh, int cg) {
    const int tid = threadIdx.x, lane = tid & 63, wave = tid >> 6, g = lane >> 4, li = lane & 15;
    unsigned char* ws = p.ws;
    const bf16_t* P = (const bf16_t*)(ws + WS_P);
    bf16_t* O16 = (bf16_t*)(ws + WS_XN);
    const unsigned char* chk = ws + WS_CHK_ML + (size_t)((bb * 4 + hh) * 32) * CHK_ML_ITEM;
    constexpr int LQ = 136, LV = 40, LS = 72;
    constexpr int STG = 55552;
    bf16_t* Ct = (bf16_t*)(lds + 2 * STG);
    float* nvec = (float*)(lds + 2 * STG + 2 * 32 * LQ * 2);
    for (int i = tid; i < 2 * 32 * LQ / 2; i += NT) ((unsigned*)Ct)[i] = 0u;
    if (tid < 256) nvec[tid] = 0.f;
    f32x4v cacc[2];
#pragma unroll
    for (int v = 0; v < 2; ++v) { cacc[v][0] = 0.f; cacc[v][1] = 0.f; cacc[v][2] = 0.f; cacc[v][3] = 0.f; }
    const int qt0 = tid >> 4, qc = tid & 15, vt = tid >> 2, vc = tid & 3, st = tid >> 3, sp = tid & 7;
    const bf16_t* qsrc = P + ((size_t)bb * SEQ + qt0) * ODD_IN + 2048 + hh * 128 + qc * 8;
    const bf16_t* ksrc = qsrc + 512;
    const bf16_t* vsrc = P + ((size_t)bb * SEQ + vt) * ODD_IN + 3072 + hh * 128 + cg * 32 + vc * 8;
    u32x4 rq0, rq1, rk0, rk1, rv, rs; float s_iw = 0.f, s_emt = 0.f, s_wsc = 0.f, s_rs = 0.f, s_dec = 0.f, v_wsc = 0.f;
    rv.x = 0u; rv.y = 0u; rv.z = 0u; rv.w = 0u;
#define MSEQ_LOAD(c) do { const size_t adv = (size_t)((c) * 64) * ODD_IN; const unsigned char* it = chk + (size_t)(c) * CHK_ML_ITEM; const float* sf = (const float*)(it + 8192); \
        rq0 = *(const u32x4*)(qsrc + adv); rq1 = *(const u32x4*)(qsrc + adv + (size_t)32 * ODD_IN); rk0 = *(const u32x4*)(ksrc + adv); rk1 = *(const u32x4*)(ksrc + adv + (size_t)32 * ODD_IN); \
        rs = *(const u32x4*)(it + st * 128 + sp * 16); \
        if (tid < 256) { rv = *(const u32x4*)(vsrc + adv); v_wsc = sf[128 + vt]; } \
        if (tid < 64) { s_iw = sf[tid]; s_emt = sf[64 + tid]; s_wsc = sf[128 + tid]; s_rs = sf[192 + tid]; s_dec = sf[256]; } } while (0)
#define MSEQ_STAGE(sb) do { char* sg_ = lds + (sb) * STG; bf16_t* Qs_ = (bf16_t*)sg_; bf16_t* Ks_ = Qs_ + 64 * LQ; bf16_t* Vs_ = Ks_ + 64 * LQ; bf16_t* VWs_ = Vs_ + 64 * LV; bf16_t* SC_ = VWs_ + 64 * LV; float* fl_ = (float*)(SC_ + 64 * LS); \
        *(u32x4*)(Qs_ + qt0 * LQ + qc * 8) = rq0; *(u32x4*)(Qs_ + (qt0 + 32) * LQ + qc * 8) = rq1; \
        *(u32x4*)(Ks_ + qt0 * LQ + qc * 8) = rk0; *(u32x4*)(Ks_ + (qt0 + 32) * LQ + qc * 8) = rk1; \
        *(u32x4*)(SC_ + st * LS + sp * 8) = rs; \
        if (tid < 256) { *(u32x4*)(Vs_ + vt * LV + vc * 8) = rv; float x_[8]; unpack8(rv, x_); \
            _Pragma("unroll") for (int e_ = 0; e_ < 8; ++e_) x_[e_] *= v_wsc; \
            *(u32x4*)(VWs_ + vt * LV + vc * 8) = pack8(x_); } \
        if (tid < 64) { fl_[tid] = s_iw; fl_[64 + tid] = s_emt; fl_[128 + tid] = s_wsc; fl_[192 + tid] = s_rs; if (tid == 0) fl_[256] = s_dec; } } while (0)
    MSEQ_LOAD(0);
    MSEQ_STAGE(0);
    MSEQ_LOAD(1);
    __syncthreads();
    for (int c = 0; c < 32; ++c) {
        const int cur = c & 1, nxt = cur ^ 1;
        if (c + 1 < 32) MSEQ_STAGE(nxt);
        if (c + 2 < 32) MSEQ_LOAD(c + 2);
        const char* sg = lds + cur * STG;
        const bf16_t* Qs = (const bf16_t*)sg; const bf16_t* Ks = Qs + 64 * LQ; const bf16_t* Vs = Ks + 64 * LQ; const bf16_t* VWs = Vs + 64 * LV; const bf16_t* SC = VWs + 64 * LV;
        const float* iw = (const float*)(SC + 64 * LS); const float* emt = iw + 64; const float* wsc = emt + 64; const float* rsum = wsc + 64; const float* misc = rsum + 64;
        const float* ncur = nvec + cur * 128; float* nnxt = nvec + nxt * 128;
        {
            const int ti = wave >> 1, vj = wave & 1;
            f32x4v acc; acc[0] = 0.f; acc[1] = 0.f; acc[2] = 0.f; acc[3] = 0.f;
            const bf16_t* Cc = Ct + cur * 32 * LQ;
#pragma unroll
            for (int k0 = 0; k0 < 128; k0 += 32) acc = MFMA16(frag_rm(Qs + ti * 16 * LQ + k0, LQ, lane), frag_rm(Cc + vj * 16 * LQ + k0, LQ, lane), acc);
#pragma unroll
            for (int r = 0; r < 4; ++r) acc[r] *= iw[ti * 16 + 4 * g + r];
#pragma unroll
            for (int k0 = 0; k0 < 64; k0 += 32) acc = MFMA16(frag_rm(SC + ti * 16 * LS + k0, LS, lane), frag_tr(Vs + k0 * LV + vj * 16, LV, lane), acc);
            float qn = 0.f;
#pragma unroll
            for (int j8 = 0; j8 < 4; ++j8) { float x[8]; unpack8(*(const u32x4*)(Qs + (ti * 16 + li) * LQ + g * 32 + j8 * 8), x);
                const float4 n0 = *(const float4*)(ncur + g * 32 + j8 * 8), n1 = *(const float4*)(ncur + g * 32 + j8 * 8 + 4);
                qn += x[0] * n0.x + x[1] * n0.y + x[2] * n0.z + x[3] * n0.w + x[4] * n1.x + x[5] * n1.y + x[6] * n1.z + x[7] * n1.w; }
            qn += __shfl_xor(qn, 16); qn += __shfl_xor(qn, 32);
#pragma unroll
            for (int r = 0; r < 4; ++r) {
                const int t = ti * 16 + 4 * g + r;
                const float qr = __shfl(qn, 4 * g + r);
                const float den = iw[t] * qr + rsum[t];
                O16[((size_t)bb * SEQ + c * 64 + t) * D + 512 + hh * 128 + cg * 32 + vj * 16 + li] = f2bf(acc[r] / fmaxf(fabsf(den), emt[t]));
            }
        }
        {
            const float dec = misc[0];
            bf16_t* Cn = Ct + nxt * 32 * LQ;
#pragma unroll
            for (int vi = 0; vi < 2; ++vi) {
                f32x4v t4; t4[0] = 0.f; t4[1] = 0.f; t4[2] = 0.f; t4[3] = 0.f;
#pragma unroll
                for (int k0 = 0; k0 < 64; k0 += 32) t4 = MFMA16(frag_tr(Ks + k0 * LQ + wave * 16, LQ, lane), frag_tr(VWs + k0 * LV + vi * 16, LV, lane), t4);
                cacc[vi][0] = dec * cacc[vi][0] + t4[0]; cacc[vi][1] = dec * cacc[vi][1] + t4[1]; cacc[vi][2] = dec * cacc[vi][2] + t4[2]; cacc[vi][3] = dec * cacc[vi][3] + t4[3];
                u32x2 o; o.x = pack2(cacc[vi][0], cacc[vi][1]); o.y = pack2(cacc[vi][2], cacc[vi][3]);
                *(u32x2*)(Cn + (vi * 16 + li) * LQ + wave * 16 + 4 * g) = o;
            }
            if (tid < 128) {
                float a = dec * ncur[tid];
#pragma unroll 8
                for (int s = 0; s < 64; ++s) a += wsc[s] * bf2f(Ks[s * LQ + tid]);
                nnxt[tid] = a;
            }
        }
        __syncthreads();
    }
#undef MSEQ_LOAD
#undef MSEQ_STAGE
}

__device__ __forceinline__ void phase_pre1(const Params& p, char* lds) {
    int tab_hh = -1;
    for (int i = blockIdx.x; i < 2048; i += gridDim.x) {
        if (i < 1024) {
            const int hh_i = (i >> 5) & 3;
            if (hh_i != tab_hh) {
                __syncthreads();
                float* CWT = (float*)(lds + 145664);
                for (int j = threadIdx.x; j < 4 * 384; j += NT) { const int r = j / 384, cc = j % 384; CWT[j] = p.gd_conv[r * 1536 + (cc >> 7) * 512 + hh_i * 128 + (cc & 127)]; }
                __syncthreads();
                tab_hh = hh_i;
            }
            gdn_pre_item(p, lds, i);
        } else mlstm_pre_item(p, lds, i - 1024);
    }
}

__device__ __forceinline__ void phase_mix1(const Params& p, char* lds) {
    for (int u = blockIdx.x; u < 256; u += gridDim.x) {
        const int v = u & 127, x = v & 7, j = v >> 3, pair = x * 4 + (j >> 2), bb = pair >> 2, hh = pair & 3, cg = j & 3;
        if (u < 128) gdn_seq_unit(p, lds, bb, hh, cg);
        else mlstm_seq_unit(p, lds, bb, hh, cg);
        __syncthreads();
    }
}

__device__ __forceinline__ void phase_post1(const Params& p) {
    const int tid = threadIdx.x, lane = tid & 63, wave = tid >> 6;
    unsigned char* ws = p.ws;
    bf16_t* O16 = (bf16_t*)(ws + WS_XN);
    const bf16_t* P = (const bf16_t*)(ws + WS_P);
    const int c0 = lane * 16;
    for (int ti_ = blockIdx.x * 8 + wave; ti_ < M; ti_ += gridDim.x * 8) {
        const int tok = (gridDim.x == 256) ? (((ti_ >> 3) & 7) * 2048 + ((ti_ >> 6) & 31) * 64 + (ti_ >> 11) * 8 + (ti_ & 7)) : ti_;
        const u32x4 r0 = *(const u32x4*)(O16 + (size_t)tok * D + c0), r1 = *(const u32x4*)(O16 + (size_t)tok * D + c0 + 8);
        float y[16];
        y[0] = lo16(r0.x); y[1] = hi16(r0.x); y[2] = lo16(r0.y); y[3] = hi16(r0.y); y[4] = lo16(r0.z); y[5] = hi16(r0.z); y[6] = lo16(r0.w); y[7] = hi16(r0.w);
        y[8] = lo16(r1.x); y[9] = hi16(r1.x); y[10] = lo16(r1.y); y[11] = hi16(r1.y); y[12] = lo16(r1.z); y[13] = hi16(r1.z); y[14] = lo16(r1.w); y[15] = hi16(r1.w);
        float q = 0.f;
#pragma unroll
        for (int j = 0; j < 16; ++j) q += y[j] * y[j];
        q += dppf<0xB1>(q); q += dppf<0x4E>(q); q += dppf<0x141>(q);
        const float rstd = rsqrtf(q * (1.0f / 128.0f) + 1e-6f);
        const int gcol = lane < 32 ? 1536 + c0 : 3584 + (c0 - 512);
        const u32x4 g0 = *(const u32x4*)(P + (size_t)tok * ODD_IN + gcol), g1 = *(const u32x4*)(P + (size_t)tok * ODD_IN + gcol + 8);
        float gt[16];
        gt[0] = lo16(g0.x); gt[1] = hi16(g0.x); gt[2] = lo16(g0.y); gt[3] = hi16(g0.y); gt[4] = lo16(g0.z); gt[5] = hi16(g0.z); gt[6] = lo16(g0.w); gt[7] = hi16(g0.w);
        gt[8] = lo16(g1.x); gt[9] = hi16(g1.x); gt[10] = lo16(g1.y); gt[11] = hi16(g1.y); gt[12] = lo16(g1.z); gt[13] = hi16(g1.z); gt[14] = lo16(g1.w); gt[15] = hi16(g1.w);
        float o[16];
        if (lane < 32) {
#pragma unroll
            for (int j = 0; j < 16; ++j) o[j] = y[j] * rstd * p.gd_norm[(c0 + j) & 127] * siluf_(gt[j]);
        } else {
#pragma unroll
            for (int j = 0; j < 16; ++j) o[j] = y[j] * rstd * p.ml_norm[c0 - 512 + j] * sigmoidf_(gt[j]);
        }
        u32x4 w0, w1;
        w0.x = pack2(o[0], o[1]); w0.y = pack2(o[2], o[3]); w0.z = pack2(o[4], o[5]); w0.w = pack2(o[6], o[7]);
        w1.x = pack2(o[8], o[9]); w1.y = pack2(o[10], o[11]); w1.z = pack2(o[12], o[13]); w1.w = pack2(o[14], o[15]);
        *(u32x4*)(O16 + (size_t)tok * D + c0) = w0; *(u32x4*)(O16 + (size_t)tok * D + c0 + 8) = w1;
    }
}


#define XB_TMO      128
#define XB_XCNT(j)  (256  + 64 * (j))
#define XB_XSUB(j)  (1280 + 64 * (j))
#define XB_XGEN(j)  (2304 + 64 * (j))
#define XB_TOP      3328
#define XB_TOPGEN   3392
#define XCD_BAR_WORDS 3456
#define XB_SPIN_CAP (1u << 22)
__device__ __forceinline__ unsigned xb_ld(unsigned* p)              { return __hip_atomic_load(p, __ATOMIC_RELAXED, __HIP_MEMORY_SCOPE_AGENT); }
__device__ __forceinline__ unsigned xb_add(unsigned* p, unsigned v) { return __hip_atomic_fetch_add(p, v, __ATOMIC_RELAXED, __HIP_MEMORY_SCOPE_AGENT); }
__device__ __forceinline__ unsigned xb_xcc_id() { return (unsigned)__builtin_amdgcn_s_getreg((3 << 11) | 20) & 0xFu; }
#define XB_SPIN(cond, bar) do { unsigned _sp = 0; while (cond) { __builtin_amdgcn_s_sleep(1); \
    if ((++_sp & 255u) == 0u) { if (xb_ld(&(bar)[XB_TMO])) break; if (_sp > XB_SPIN_CAP) { atomicAdd(&(bar)[XB_TMO], 1u); break; } } } } while (0)
struct XcdBarrier { unsigned* bar; unsigned x; volatile LAS unsigned* st; };
__device__ __forceinline__ XcdBarrier xcd_barrier_post(unsigned* bar, volatile LAS unsigned* st) {
    XcdBarrier b; b.bar = bar; b.x = xb_xcc_id(); b.st = st;
    if (threadIdx.x == 0) (void)xb_add(&bar[XB_XCNT(b.x)], 1u);
    return b;
}
__device__ __forceinline__ void xcd_barrier_complete(unsigned* bar, unsigned x, unsigned& nloc, unsigned& nx) {
    const unsigned G = gridDim.x * gridDim.y * gridDim.z;
    unsigned sum, cnt, mine, sp = 0u;
    for (;;) {
        sum = 0u; cnt = 0u; mine = 0u;
#pragma unroll
        for (unsigned j = 0; j < 16; ++j) { const unsigned c = xb_ld(&bar[XB_XCNT(j)]); sum += c; cnt += (c > 0u) ? 1u : 0u; mine = (j == x) ? c : mine; }
        if (sum == G) break;
        __builtin_amdgcn_s_sleep(1);
        if ((++sp & 255u) == 0u) { if (xb_ld(&bar[XB_TMO])) break; if (sp > XB_SPIN_CAP) { atomicAdd(&bar[XB_TMO], 1u); break; } }
    }
    nloc = mine > 0u ? mine : 1u; nx = cnt > 0u ? cnt : 1u;
}
__device__ __forceinline__ void xcd_barrier(const XcdBarrier& b) {
    asm volatile("s_waitcnt vmcnt(0)" ::: "memory");
    __syncthreads();
    if (threadIdx.x == 0) {
        unsigned* bar = b.bar;
        __builtin_amdgcn_s_waitcnt(0);
        unsigned nloc = b.st[0], nx = b.st[1];
        if (nloc == 0u) { xcd_barrier_complete(bar, b.x, nloc, nx); b.st[0] = nloc; b.st[1] = nx; }
        const unsigned old = xb_add(&bar[XB_XSUB(b.x)], 1u);
        const unsigned gen = old / nloc;
        if (old + 1u == (gen + 1u) * nloc) {
            __builtin_amdgcn_fence(__ATOMIC_RELEASE, "agent");
            asm volatile("s_waitcnt vmcnt(0)" ::: "memory");
            const unsigned og = xb_add(&bar[XB_TOP], 1u);
            const unsigned tg = og / nx;
            if (og + 1u == (tg + 1u) * nx) xb_add(&bar[XB_TOPGEN], 1u);
            else XB_SPIN(xb_ld(&bar[XB_TOPGEN]) == tg, bar);
            __builtin_amdgcn_fence(__ATOMIC_ACQUIRE, "agent");
            xb_add(&bar[XB_XGEN(b.x)], 1u);
            asm volatile("s_waitcnt vmcnt(0)" ::: "memory");
        } else {
            XB_SPIN(xb_ld(&bar[XB_XGEN(b.x)]) == gen, bar);
            __builtin_amdgcn_fence(__ATOMIC_ACQUIRE, "agent");
            asm volatile("s_waitcnt vmcnt(0)" ::: "memory");
        }
    }
    __syncthreads();
}

__device__ __forceinline__ void final_row(const Params& p, int tok, int lane, float* dst  ) {
    const bf16_t* H16 = (const bf16_t*)((const char*)p.out + H16_OFF);
    const bf16_t* Y0 = (const bf16_t*)(p.ws + WS_P + P_Y); const bf16_t* Y1 = Y0 + (size_t)M * D;
    float4 v[4];
#pragma unroll
    for (int i = 0; i < 4; ++i) {
        const u32x2 h = *(const u32x2*)(H16 + (size_t)tok * D + i * 256 + lane * 4), a = *(const u32x2*)(Y0 + (size_t)tok * D + i * 256 + lane * 4), b = *(const u32x2*)(Y1 + (size_t)tok * D + i * 256 + lane * 4);
        v[i].x = lo16(h.x) + lo16(a.x) + lo16(b.x); v[i].y = hi16(h.x) + hi16(a.x) + hi16(b.x); v[i].z = lo16(h.y) + lo16(a.y) + lo16(b.y); v[i].w = hi16(h.y) + hi16(a.y) + hi16(b.y);
    }
    float ss = 0.f;
#pragma unroll
    for (int i = 0; i < 4; ++i) ss += v[i].x * v[i].x + v[i].y * v[i].y + v[i].z * v[i].z + v[i].w * v[i].w;
    ss = red64(ss);
    const float rstd = rsqrtf(ss * (1.0f / D) + 1e-6f);
#pragma unroll
    for (int i = 0; i < 4; ++i) { const float4 g4 = *(const float4*)(p.norm_final + i * 256 + lane * 4);
        float4 o; o.x = v[i].x * rstd * g4.x; o.y = v[i].y * rstd * g4.y; o.z = v[i].z * rstd * g4.z; o.w = v[i].w * rstd * g4.w;
        *(float4*)(dst + i * 256 + lane * 4) = o; }
}
__device__ __forceinline__ void phase_final(const Params& p, char* lds, const XcdBarrier& bar) {
    const int tid = threadIdx.x, lane = tid & 63, wave = tid >> 6, G = (int)gridDim.x, b = (int)blockIdx.x;
    float* stage = (float*)lds;
    for (int base = b * 32; base < M / 2; base += G * 32)
#pragma unroll 1
        for (int q = 0; q < 4; ++q) { const int tok = base + wave * 4 + q; final_row(p, tok, lane, p.out + (size_t)tok * D); }
    for (int r0 = 0; r0 < M / 2; r0 += G * 32) {
        const int base = M / 2 + r0 + b * 32;
        if (base < M) {
#pragma unroll 1
            for (int q = 0; q < 4; ++q) { const int tl = wave * 4 + q; final_row(p, base + tl, lane, stage + tl * 1024); }
        }
        xcd_barrier(bar);
        if (base < M) {
            for (int i = tid; i < 32 * 256; i += NT) { const int tl = i >> 8, c4 = i & 255; *(float4*)(p.out + (size_t)(base + tl) * D + c4 * 4) = *(const float4*)(stage + tl * 1024 + c4 * 4); }
        }
        __syncthreads();
    }
}

__global__ void __launch_bounds__(NT) fwd_kernel(Params p) {
    extern __shared__ __attribute__((aligned(16))) char lds[];
    const int lo = p.ph_lo, hi = p.ph_hi;
    volatile LAS unsigned* bst = (volatile LAS unsigned*)(lds + LDS_BYTES - 16);
    if (threadIdx.x < 4) bst[threadIdx.x] = 0u;
    __syncthreads();
    XcdBarrier bar; bar.bar = (unsigned*)(p.ws + WS_CTL) + CTL_BAR; bar.x = 0; bar.st = bst;
    if (hi - lo > 1) bar = xcd_barrier_post((unsigned*)(p.ws + WS_CTL) + CTL_BAR, bst);
    if (hi > 1000) cooperative_groups::this_grid().sync();
#define IN(k) (lo <= (k) && (k) < hi)
#define SEAM(k) do { if (IN(k) && IN((k) + 1)) xcd_barrier(bar); } while (0)
#define RUN(k, ...) do { if (IN(k)) { __VA_ARGS__; if (REP_PHASE == (k)) { xcd_barrier(bar); __VA_ARGS__; } } SEAM(k); } while (0)
    RUN(1, phase_prep_router(p); phase_convert<0>(p, lds); phase_rows<0>(p, lds, 0); phase_dense_gemm<0>(p, lds));
    RUN(2, phase_pre0(p, lds));
    RUN(3, phase_mix0(p, lds));
    RUN(4, phase_post0(p); phase_convert<1>(p, lds));
    RUN(5, phase_dense_gemm<1>(p, lds));
    RUN(6, phase_rows<1>(p, lds, 0));
    RUN(7, phase_moe_merged(p, lds, 0));
    RUN(8, phase_rows<2>(p, lds, 1));
    RUN(9, phase_dense_gemm<2>(p, lds));
    RUN(10, phase_pre1(p, lds));
    RUN(11, phase_mix1(p, lds));
    RUN(12, phase_post1(p); phase_convert<2>(p, lds));
    RUN(13, phase_dense_gemm<3>(p, lds));
    RUN(14, phase_rows<1>(p, lds, 1));
    RUN(15, phase_moe_merged(p, lds, 1));
    RUN(16, phase_final(p, lds, bar));
#undef RUN
#undef IN
#undef SEAM
}

extern "C" void kernel_launch(void* const* d_in, const int* in_sizes, int n_in, void* d_out, int out_size, void* d_ws, size_t ws_size, hipStream_t stream) {
    static int ok = 0, grid = 0;
    if (ok == 0) {
        ok = 1;
        if (n_in != 35 || out_size != M * D || ws_size < WS_END) { fprintf(stderr, "kernel_launch: unexpected sizes n_in=%d out=%d ws=%zu need=%zu\n", n_in, out_size, ws_size, (size_t)WS_END); ok = -1; }
        if (hipFuncSetAttribute((const void*)fwd_kernel, hipFuncAttributeMaxDynamicSharedMemorySize, LDS_BYTES) != hipSuccess) { fprintf(stderr, "kernel_launch: hipFuncSetAttribute failed\n"); ok = -1; }
        int dev = 0, cus = 0, per_cu = 0;
        hipGetDevice(&dev); hipDeviceGetAttribute(&cus, hipDeviceAttributeMultiprocessorCount, dev);
        if (hipOccupancyMaxActiveBlocksPerMultiprocessor(&per_cu, (const void*)fwd_kernel, NT, LDS_BYTES) != hipSuccess || per_cu < 1) { fprintf(stderr, "kernel_launch: occupancy query failed (%d)\n", per_cu); per_cu = 1; }
        (void)hipGetLastError();
        grid = cus * (per_cu > 1 ? 1 : per_cu);
        if (grid > 256) grid = 256;
        if (grid < 1) ok = -1;
    }
    if (ok < 0) return;
    Params p{};
    const float** f = (const float**)&p;
    for (int i = 0; i < 35; ++i) f[i] = (const float*)d_in[i];
    p.out = (float*)d_out; p.ws = (unsigned char*)d_ws;
    (void)hipMemsetAsync((char*)d_ws + WS_CTL, 0, 163840, stream);
#if SINGLE_LAUNCH
    p.ph_lo = 0; p.ph_hi = NPHASE;
    void* args[] = {&p};
    hipError_t e = hipLaunchCooperativeKernel((const void*)fwd_kernel, dim3(grid), dim3(NT), args, LDS_BYTES, stream);
    if (e != hipSuccess) fprintf(stderr, "kernel_launch: cooperative launch failed: %s (grid %d)\n", hipGetErrorString(e), grid);
#else
    for (int ph = 0; ph < NPHASE; ++ph) {
        p.ph_lo = ph; p.ph_hi = ph + 1;
        hipLaunchKernelGGL(fwd_kernel, dim3(grid), dim3(NT), LDS_BYTES, stream, p);
    }
#endif
}
```

```cpp
#include <hip/hip_runtime.h>
#include <hip/hip_cooperative_groups.h>
#include <stdint.h>
#include <stdio.h>

#ifndef POST_NB
#define POST_NB 2
#endif
#ifndef REP_PHASE
#define REP_PHASE -1
#endif
#ifndef REP_UNIT
#define REP_UNIT 0
#endif
#ifndef SINGLE_LAUNCH
#define SINGLE_LAUNCH 1
#endif

typedef unsigned short bf16_t;
typedef short bf16x8 __attribute__((ext_vector_type(8)));
typedef float f32x16 __attribute__((ext_vector_type(16)));
typedef float f32x4 __attribute__((ext_vector_type(4)));
typedef unsigned u32x4 __attribute__((ext_vector_type(4)));
typedef unsigned u32x2 __attribute__((ext_vector_type(2)));

#define NT 512
typedef short s16x4 __attribute__((ext_vector_type(4)));
typedef float f32x4v __attribute__((ext_vector_type(4)));
#define MFMA16(a, b, c) __builtin_amdgcn_mfma_f32_16x16x32_bf16((a), (b), (c), 0, 0, 0)
#define LAS __attribute__((address_space(3)))
constexpr int D = 1024, NBATCH = 8, SEQ = 2048, M = NBATCH * SEQ;
constexpr int EVEN_IN = 3840, ODD_SRC = 4112, ODD_IN = 4096;
constexpr int P1_LD = ODD_IN + 64;
constexpr int NPHASE = 17;
constexpr int LDS_BYTES = 150 * 1024;

constexpr size_t WS_CTL = 0;
constexpr size_t WS_WIN0 = 163840;
constexpr size_t WS_WOUT0 = WS_WIN0 + (size_t)EVEN_IN * D * 2;
constexpr size_t WS_WIN1 = WS_WOUT0 + (size_t)D * D * 2;
constexpr size_t WS_WOUT1 = WS_WIN1 + (size_t)ODD_IN * D * 2;
constexpr size_t WS_XN = WS_WOUT1 + (size_t)D * D * 2;
constexpr size_t WS_P = WS_XN + (size_t)M * D * 2;
constexpr size_t WS_LTOK = WS_P + (size_t)100 * 1024 * 1024;
constexpr size_t WS_LGATE = WS_LTOK + (size_t)32 * M * 4;
constexpr size_t WS_WRB = WS_P + (size_t)M * P1_LD * 2;
constexpr size_t WS_RWW = WS_WRB + (size_t)(2 * 2 * 48 + 2 * 16) * 1024 * 2;
constexpr size_t WS_ARENA = WS_RWW + (size_t)8 * 256 * 64 * 2;
constexpr size_t WS_WGU = WS_ARENA;
constexpr size_t WS_WD = WS_WGU + (size_t)2 * 32 * 512 * 1024 * 2;
constexpr size_t WS_CHK_RW = WS_ARENA;
constexpr size_t CHK_RW_ITEM = 32768;
constexpr size_t WS_CHK_HG = WS_CHK_RW + (size_t)2048 * CHK_RW_ITEM;
constexpr size_t CHK_HG_ITEM = 24576 + 256;
constexpr size_t WS_END = WS_CHK_HG + (size_t)2048 * CHK_HG_ITEM;
static_assert(WS_END >= WS_WD + (size_t)2 * 32 * 1024 * 256 * 2, "arena");
static_assert(WS_END <= 310200000, "workspace budget");
static_assert((size_t)M * 16 * 4 <= (size_t)M * D * 2, "GATES fit the lower half of d_out");
static_assert(WS_LGATE + (size_t)32 * M * 4 <= WS_P + (size_t)M * 4096 * 2, "lists inside P");
constexpr size_t P_HID = 0;
constexpr size_t P_Y = (size_t)32 * 1024 * 1024;
constexpr size_t H16_OFF = (size_t)M * D * 2;
constexpr int CTL_CNT = 36864;
constexpr int CTL_BAR = 1024;
constexpr int CTL_MOE = 16384;
constexpr int CTL_READY = 8192;

struct Params {
    const float* x; const float* norm_mix; const float* norm_ffn; const float* norm_final;
    const float* ev_w_in; const float* ev_mu; const float* rw_w0; const float* rw_w2; const float* rw_a0; const float* rw_a2; const float* rw_g2;
    const float* rw_k_k; const float* rw_k_a; const float* rw_r_k; const float* rw_ln_w; const float* rw_ln_b; const float* hg_lb; const float* hg_norm;
    const float* ev_w_out; const float* od_w_in; const float* gd_conv; const float* gd_a_log; const float* gd_dt_bias; const float* gd_norm;
    const float* ml_i_bias; const float* ml_f_bias; const float* ml_norm; const float* od_w_out;
    const float* moe_w_group; const float* moe_b_group; const float* moe_w_router; const float* moe_b_router;
    const float* moe_w_gate; const float* moe_w_up; const float* moe_w_down;
    float* out; unsigned char* ws;
    int ph_lo, ph_hi;
};

__device__ __forceinline__ float bf2f(unsigned short u) { return __uint_as_float(((unsigned)u) << 16); }
__device__ __forceinline__ unsigned short f2bf(float f) { const __bf16 h = (__bf16)f; return __builtin_bit_cast(unsigned short, h); }
typedef __bf16 bf16x2_t __attribute__((ext_vector_type(2)));
typedef float f32x2_t __attribute__((ext_vector_type(2)));
__device__ __forceinline__ unsigned pack2(float a, float b) { f32x2_t f; f.x = a; f.y = b; const bf16x2_t h = __builtin_convertvector(f, bf16x2_t); return __builtin_bit_cast(unsigned, h); }
__device__ __forceinline__ float lo16(unsigned u) { return __uint_as_float(u << 16); }
__device__ __forceinline__ float hi16(unsigned u) { return __uint_as_float(u & 0xffff0000u); }
__device__ __forceinline__ float sigmoidf_(float x) { return __builtin_amdgcn_rcpf(1.0f + __expf(-x)); }
__device__ __forceinline__ float siluf_(float x) { return x * __builtin_amdgcn_rcpf(1.0f + __expf(-x)); }
__device__ __forceinline__ float softplusf_(float x) { return x > 20.f ? x : log1pf(__expf(x)); }

template <int CTRL> __device__ __forceinline__ float dppf(float x) {
    return __int_as_float(__builtin_amdgcn_update_dpp(0, __float_as_int(x), CTRL, 0xF, 0xF, false));
}
__device__ __forceinline__ float red16(float x) {
    x += dppf<0xB1>(x);
    x += dppf<0x4E>(x);
    x += dppf<0x141>(x);
    x += dppf<0x140>(x);
    return x;
}
__device__ __forceinline__ float red64(float x) {
    x = red16(x);
    x += __shfl_xor(x, 16);
    x += __shfl_xor(x, 32);
    return x;
}

__device__ __forceinline__ void conv_tile(float* tile, const float* s0, const float* s1, size_t ld, bf16_t* d, size_t ldd, unsigned* ready = nullptr, bf16_t* d1 = nullptr) {
    const int tid = threadIdx.x;
#pragma unroll
    for (int i = 0; i < 2; ++i) {
        const int k = (tid >> 4) + 32 * i, nn = (tid & 15) * 4;
        const float* s = nn < 32 ? s0 + (size_t)k * ld + nn : s1 + (size_t)k * ld + (nn - 32);
        const float4 v = *(const float4*)s;
        float* t = tile + k * 65 + nn;
        t[0] = v.x; t[1] = v.y; t[2] = v.z; t[3] = v.w;
    }
    __syncthreads();
    const int n = tid >> 3, kc = (tid & 7) * 8;
    float f0 = tile[(kc + 0) * 65 + n], f1 = tile[(kc + 1) * 65 + n], f2 = tile[(kc + 2) * 65 + n], f3 = tile[(kc + 3) * 65 + n];
    float f4 = tile[(kc + 4) * 65 + n], f5 = tile[(kc + 5) * 65 + n], f6 = tile[(kc + 6) * 65 + n], f7 = tile[(kc + 7) * 65 + n];
    u32x4 o; o.x = pack2(f0, f1); o.y = pack2(f2, f3); o.z = pack2(f4, f5); o.w = pack2(f6, f7);
    if (ready) {
        bf16_t* dp = d + (size_t)n * ldd + kc;
        asm volatile("s_nop 1\n\tglobal_store_dwordx4 %0, %1, off sc1\n\ts_nop 0" :: "v"(dp), "v"(o) : "memory");
        asm volatile("s_waitcnt vmcnt(0)" ::: "memory");
        __syncthreads();
        if (tid == 0) __hip_atomic_fetch_add(ready, 1u, __ATOMIC_RELAXED, __HIP_MEMORY_SCOPE_AGENT);
    } else {
        bf16_t* dd = (d1 && n >= 32) ? d1 + (size_t)(n - 32) * ldd : d + (size_t)n * ldd;
        *(u32x4*)(dd + kc) = o;
        __syncthreads();
    }
}

template <int PART>
__device__ __forceinline__ void phase_convert(const Params& p, char* lds) {
    float* tile = (float*)lds;
    unsigned char* ws = p.ws;
    const int total = PART == 0 ? (960 + 256 + 1024 + 256) : (4096 + 2048);
    for (int g0 = blockIdx.x; g0 < total; g0 += gridDim.x) {
        int g = g0;
        if (PART == 0) {
            if (g < 960) { const int kt = g & 15, nt = g >> 4;
                const float* s0 = p.ev_w_in + (size_t)(kt * 64) * EVEN_IN + nt * 64;
                conv_tile(tile, s0, s0 + 32, EVEN_IN, (bf16_t*)(ws + WS_WIN0) + (size_t)(nt * 64) * D + kt * 64, D, (unsigned*)(ws + WS_CTL) + CTL_READY + 4096 + 64 * (nt >> 2)); continue; }
            g -= 960;
            if (g < 256) { const int kt = g & 15, nt = g >> 4;
                const float* s0 = p.ev_w_out + (size_t)(kt * 64) * D + nt * 64;
                conv_tile(tile, s0, s0 + 32, D, (bf16_t*)(ws + WS_WOUT0) + (size_t)(nt * 64) * D + kt * 64, D); continue; }
            g -= 256;
            if (g < 1024) { const int kt = g & 15, nt = g >> 4;
                const float* s0 = p.od_w_in + (size_t)(kt * 64) * ODD_SRC + nt * 64 + (nt >= 32 ? 8 : 0);
                conv_tile(tile, s0, s0 + 32, ODD_SRC, (bf16_t*)(ws + WS_WIN1) + (size_t)(nt * 64) * D + kt * 64, D); continue; }
            g -= 1024;
            { const int kt = g & 15, nt = g >> 4;
                const float* s0 = p.od_w_out + (size_t)(kt * 64) * D + nt * 64;
                conv_tile(tile, s0, s0 + 32, D, (bf16_t*)(ws + WS_WOUT1) + (size_t)(nt * 64) * D + kt * 64, D); }
        } else {
            if (g < 4096) { const int le = (g >> 7) + (PART == 2 ? 32 : 0), r = g & 127, kt = r & 15, s = r >> 4;
                const size_t so = (size_t)le * 1024 * 256 + (size_t)(kt * 64) * 256 + s * 32;
                bf16_t* dg = (bf16_t*)(ws + WS_WGU) + (size_t)le * 512 * 1024 + (size_t)((s >> 2) * 256 + (s & 3) * 32) * 1024 + kt * 64;
                conv_tile(tile, p.moe_w_gate + so, p.moe_w_up + so, 256, dg, 1024, nullptr, dg + (size_t)128 * 1024); continue; }
            g -= 4096;
            { const int le = (g >> 6) + (PART == 2 ? 32 : 0), r = g & 63, kt = r & 3, nt = r >> 2;
                const float* s0 = p.moe_w_down + (size_t)le * 256 * 1024 + (size_t)(kt * 64) * 1024 + nt * 64;
                conv_tile(tile, s0, s0 + 32, 1024, (bf16_t*)(ws + WS_WD) + (size_t)le * 1024 * 256 + (size_t)(nt * 64) * 256 + kt * 64, 256); }
        }
    }
}


__device__ __forceinline__ size_t wrb_idx(int oo, int d) { return ((size_t)(((oo >> 4) * 32 + (d >> 5)) * 64 + ((d >> 3) & 3) * 16 + (oo & 15))) * 8 + (d & 7); }
__device__ __forceinline__ void phase_prep_router(const Params& p) {
    bf16_t* RWW = (bf16_t*)(p.ws + WS_RWW);
    for (int i = blockIdx.x * NT + threadIdx.x; i < 8 * 256 * 64; i += gridDim.x * NT) {
        const int hh = i >> 14, r = (i >> 6) & 255, cc = i & 63;
        const float w = r < 64 ? p.rw_w2[r * 512 + hh * 64 + cc] : r < 128 ? p.rw_a2[(r - 64) * 512 + hh * 64 + cc] : p.rw_g2[(r - 128) * 512 + hh * 64 + cc];
        RWW[i] = f2bf(w);
    }
    for (int i = blockIdx.x * NT + threadIdx.x; i < 96 * 1024; i += gridDim.x * NT) {
        const int o = i >> 10, d = i & 1023;
        float w = 0.f;
        if (o < 80) { const int l = o / 40, oo = o % 40;
            if (oo < 4) w = p.moe_w_group[(size_t)l * D * 4 + d * 4 + oo]; else if (oo < 36) w = p.moe_w_router[(size_t)l * D * 32 + d * 32 + (oo - 4)];
        } else { const int oo = o - 80; w = p.od_w_in[(size_t)d * ODD_SRC + (oo < 8 ? 2048 + oo : 4104 + (oo - 8))]; }
        bf16_t* WRB = (bf16_t*)(p.ws + WS_WRB);
        const unsigned short hi = f2bf(w), lo = f2bf(w - bf2f(hi));
        if (o < 80) { const int l = o / 40, oo = o % 40; WRB[(size_t)(l * 2 + 0) * 48 * 1024 + wrb_idx(oo, d)] = hi; WRB[(size_t)(l * 2 + 1) * 48 * 1024 + wrb_idx(oo, d)] = lo; }
        else { const int oo = o - 80; WRB[(size_t)192 * 1024 + wrb_idx(oo, d)] = hi; WRB[(size_t)(192 + 16) * 1024 + wrb_idx(oo, d)] = lo; }
    }
    for (int i = blockIdx.x * NT + threadIdx.x; i < 4 * 8 * 1024; i += gridDim.x * NT) {
        const int blk = i >> 13, r = 40 + ((i >> 10) & 7), d = i & 1023; ((bf16_t*)(p.ws + WS_WRB))[(size_t)blk * 48 * 1024 + wrb_idx(r, d)] = 0; }
}

template <int MODE>
__device__ __forceinline__ void phase_rows(const Params& p, char* lds, int layer) {
    const int tid = threadIdx.x, lane = tid & 63, wave = tid >> 6;
    unsigned char* ws = p.ws;
    const float* src = p.x;
    bf16_t* H16 = (bf16_t*)((char*)p.out + H16_OFF);
    const float* gain = (MODE == 0) ? p.norm_mix : (MODE == 1) ? p.norm_ffn + layer * D : (MODE == 2) ? p.norm_mix + D : p.norm_final;
    bf16_t* XN = (bf16_t*)(ws + WS_XN);
    const bf16_t* Y0 = (const bf16_t*)(ws + WS_P + P_Y);
    const bf16_t* Y1 = Y0 + (size_t)M * D;
    float* rstd_s = (float*)lds;
    constexpr int LOS = 1032;
    bf16_t* LO = (bf16_t*)(lds + 1024);
    float* lg = (float*)(lds + 1024 + 64 * LOS * 2);
    int* lcnt = (int*)(lds + 1024 + 64 * LOS * 2 + 64 * 48 * 4);
    constexpr int NO = (MODE == 1) ? 5 : 2;
    constexpr int NOUT = (MODE == 1) ? 36 : 16;
    constexpr int NTNC = (MODE == 1) ? 3 : 1;
    for (int gi = blockIdx.x; gi < M / 64; gi += gridDim.x) {
        const int grp = (gridDim.x == 256) ? ((gi & 7) * 32 + (gi >> 3)) : gi;
        const int t0 = grp * 64;
#pragma unroll 1
        for (int q4 = 0; q4 < 2; ++q4) {
            float4 v[4][4];
#pragma unroll
            for (int j = 0; j < 4; ++j) { const int tok = t0 + wave * 8 + q4 * 4 + j;
#pragma unroll
                for (int i = 0; i < 4; ++i) {
                    if (MODE == 0) v[j][i] = *(const float4*)(src + (size_t)tok * D + i * 256 + lane * 4);
                    else { const u32x2 h = *(const u32x2*)(H16 + (size_t)tok * D + i * 256 + lane * 4); v[j][i].x = lo16(h.x); v[j][i].y = hi16(h.x); v[j][i].z = lo16(h.y); v[j][i].w = hi16(h.y); } } }
            if (MODE == 2 || MODE == 3) {
#pragma unroll
                for (int j = 0; j < 4; ++j) { const int tok = t0 + wave * 8 + q4 * 4 + j;
                    u32x2 a[4], b[4];
#pragma unroll
                    for (int i = 0; i < 4; ++i) { a[i] = *(const u32x2*)(Y0 + (size_t)tok * D + i * 256 + lane * 4); b[i] = *(const u32x2*)(Y1 + (size_t)tok * D + i * 256 + lane * 4); }
#pragma unroll
                    for (int i = 0; i < 4; ++i) { v[j][i].x += lo16(a[i].x) + lo16(b[i].x); v[j][i].y += hi16(a[i].x) + hi16(b[i].x); v[j][i].z += lo16(a[i].y) + lo16(b[i].y); v[j][i].w += hi16(a[i].y) + hi16(b[i].y); }
                }
            }
            float4 g4[4];
#pragma unroll
            for (int i = 0; i < 4; ++i) g4[i] = *(const float4*)(gain + i * 256 + lane * 4);
#pragma unroll
            for (int j = 0; j < 4; ++j) {
                const int tl = wave * 8 + q4 * 4 + j, tok = t0 + tl;
                float ss = 0.f;
#pragma unroll
                for (int i = 0; i < 4; ++i) ss += v[j][i].x * v[j][i].x + v[j][i].y * v[j][i].y + v[j][i].z * v[j][i].z + v[j][i].w * v[j][i].w;
                ss = red64(ss);
                const float rstd = rsqrtf(ss * (1.0f / D) + 1e-6f);
                if (lane == 0) rstd_s[tl] = rstd;
#pragma unroll
                for (int i = 0; i < 4; ++i) {
                    if (MODE == 2) { u32x2 hw; hw.x = pack2(v[j][i].x, v[j][i].y); hw.y = pack2(v[j][i].z, v[j][i].w); *(u32x2*)(H16 + (size_t)tok * D + i * 256 + lane * 4) = hw; }
                    const float o0 = v[j][i].x * rstd * g4[i].x, o1 = v[j][i].y * rstd * g4[i].y, o2 = v[j][i].z * rstd * g4[i].z, o3 = v[j][i].w * rstd * g4[i].w;
                    if (MODE == 3) { float4 o; o.x = o0; o.y = o1; o.z = o2; o.w = o3; *(float4*)(p.out + (size_t)tok * D + i * 256 + lane * 4) = o; }
                    else { u32x2 o; o.x = pack2(o0, o1); o.y = pack2(o2, o3);
                        if (MODE == 1 || MODE == 2) { u32x2 l2; l2.x = pack2(o0 - lo16(o.x), o1 - hi16(o.x)); l2.y = pack2(o2 - lo16(o.y), o3 - hi16(o.y)); *(u32x2*)(LO + tl * LOS + i * 256 + lane * 4) = l2; }
                        if (MODE == 0) __hip_atomic_store((unsigned long long*)(XN + (size_t)tok * D + i * 256 + lane * 4), ((unsigned long long)o.y << 32) | o.x, __ATOMIC_RELAXED, __HIP_MEMORY_SCOPE_AGENT);
                        else *(u32x2*)(XN + (size_t)tok * D + i * 256 + lane * 4) = o; }
                }
            }
        }
        if (MODE == 0) {
            asm volatile("s_waitcnt vmcnt(0)" ::: "memory");
            __syncthreads();
            if (tid == 0) __hip_atomic_fetch_add((unsigned*)(ws + WS_CTL) + CTL_READY + 64 * (grp >> 2), 1u, __ATOMIC_RELAXED, __HIP_MEMORY_SCOPE_AGENT);
        }
        if (MODE == 1 || MODE == 2) {
            const int btok = tid & 63, og = tid >> 6;
            if (MODE == 1 && tid < 32) lcnt[tid] = 0;
            asm volatile("s_waitcnt vmcnt(0)" ::: "memory");
            __syncthreads();
            {
                const bf16_t* Whi = (const bf16_t*)(ws + WS_WRB) + (MODE == 1 ? (size_t)(layer * 2) * 48 * 1024 : (size_t)192 * 1024);
                const bf16_t* Wlo = Whi + (MODE == 1 ? (size_t)48 * 1024 : (size_t)16 * 1024);
                constexpr int NTN = (MODE == 1) ? 3 : 1;
                const int lane16 = lane & 15, g4 = lane >> 4;
                {
                    bf16x8 fbh[NTN][4], fbl[NTN][4];
#pragma unroll
                    for (int nj = 0; nj < NTN; ++nj)
#pragma unroll
                        for (int s = 0; s < 4; ++s) { const size_t o = ((size_t)((nj * 32 + wave * 4 + s) * 64 + lane)) * 8; fbh[nj][s] = *(const bf16x8*)(Whi + o); fbl[nj][s] = *(const bf16x8*)(Wlo + o); }
                    f32x4v acc[4][NTN];
#pragma unroll
                    for (int ti = 0; ti < 4; ++ti) {
                        const bf16_t* ah = XN + (size_t)(t0 + ti * 16 + lane16) * D + wave * 128 + 8 * g4;
                        const bf16_t* al = LO + (ti * 16 + lane16) * LOS + wave * 128 + 8 * g4;
                        bf16x8 fah[4], fal[4];
#pragma unroll
                        for (int s = 0; s < 4; ++s) { fah[s] = *(const bf16x8*)(ah + s * 32); fal[s] = *(const bf16x8*)(al + s * 32); }
#pragma unroll
                        for (int nj = 0; nj < NTN; ++nj) { acc[ti][nj][0] = 0.f; acc[ti][nj][1] = 0.f; acc[ti][nj][2] = 0.f; acc[ti][nj][3] = 0.f; }
#pragma unroll
                        for (int s = 0; s < 4; ++s)
#pragma unroll
                            for (int nj = 0; nj < NTN; ++nj) { acc[ti][nj] = MFMA16(fah[s], fbh[nj][s], acc[ti][nj]); acc[ti][nj] = MFMA16(fah[s], fbl[nj][s], acc[ti][nj]); acc[ti][nj] = MFMA16(fal[s], fbh[nj][s], acc[ti][nj]); }
                    }
                    __syncthreads();
                    float* part = (float*)LO + wave * (64 * 48);
#pragma unroll
                    for (int ti = 0; ti < 4; ++ti)
#pragma unroll
                        for (int nj = 0; nj < NTN; ++nj)
#pragma unroll
                            for (int r = 0; r < 4; ++r) part[(ti * 16 + 4 * g4 + r) * 48 + nj * 16 + lane16] = acc[ti][nj][r];
                }
            }
            __syncthreads();
            float acc[NO];
#pragma unroll
            for (int o = 0; o < NO; ++o) { float a = 0.f;
                if (og * NO + o < NTNC * 16) {
#pragma unroll
                    for (int w = 0; w < 8; ++w) a += ((const float*)LO)[w * (64 * 48) + btok * 48 + og * NO + o]; }
                acc[o] = a; }
            __syncthreads();
            if (MODE == 2) {
                float* G = p.out;
#pragma unroll
                for (int o = 0; o < NO; ++o) G[(size_t)(t0 + btok) * 16 + og * NO + o] = acc[o];
            } else {
#pragma unroll
                for (int o = 0; o < NO; ++o) { const int oo = og * NO + o;
                    if (oo < NOUT) lg[btok * 48 + oo] = acc[o] + (oo < 4 ? p.moe_b_group[layer * 4 + oo] : p.moe_b_router[layer * 32 + oo - 4]); }
                __syncthreads();
                if (tid < 64) {
                    const float* l = lg + tid * 48;
                    int gi = 0; float gm = l[0];
#pragma unroll
                    for (int j = 1; j < 4; ++j) if (l[j] > gm) { gm = l[j]; gi = j; }
                    float se = 0.f;
#pragma unroll
                    for (int j = 0; j < 4; ++j) se += __expf(l[j] - gm);
                    const float ptop = 1.0f / se;
                    const float* f = l + 4 + gi * 8;
                    int i1 = 0; float v1 = f[0];
#pragma unroll
                    for (int j = 1; j < 8; ++j) if (f[j] > v1) { v1 = f[j]; i1 = j; }
                    int i2 = -1; float v2 = -3.0e38f;
#pragma unroll
                    for (int j = 0; j < 8; ++j) if (j != i1 && f[j] > v2) { v2 = f[j]; i2 = j; }
                    if (i2 < 0) { i2 = (i1 + 1) & 7; v2 = v1; }
                    const float w1 = 1.0f / (1.0f + __expf(v2 - v1)), w2 = 1.0f - w1;
                    int* cnt = (int*)(ws + WS_CTL) + CTL_CNT + layer * 32 * 64;
                    int* ltok = (int*)(ws + WS_LTOK); float* lgate = (float*)(ws + WS_LGATE);
                    const int tok = t0 + tid;
                    const int e1 = gi * 8 + i1, e2 = gi * 8 + i2;
                    const int r1 = __hip_atomic_fetch_add(&lcnt[e1], 1, __ATOMIC_RELAXED, __HIP_MEMORY_SCOPE_WORKGROUP);
                    const int r2 = __hip_atomic_fetch_add(&lcnt[e2], 1, __ATOMIC_RELAXED, __HIP_MEMORY_SCOPE_WORKGROUP);
                    __builtin_amdgcn_fence(__ATOMIC_RELEASE, "workgroup"); __builtin_amdgcn_wave_barrier(); __builtin_amdgcn_fence(__ATOMIC_ACQUIRE, "workgroup");
                    if (tid < 32) { const int c = lcnt[tid]; lcnt[32 + tid] = c ? atomicAdd(cnt + tid * 64, c) : 0; }
                    __builtin_amdgcn_fence(__ATOMIC_RELEASE, "workgroup"); __builtin_amdgcn_wave_barrier(); __builtin_amdgcn_fence(__ATOMIC_ACQUIRE, "workgroup");
                    const int p1 = lcnt[32 + e1] + r1, p2 = lcnt[32 + e2] + r2;
                    ltok[(size_t)e1 * M + p1] = tok * 2; lgate[(size_t)e1 * M + p1] = ptop * w1;
                    ltok[(size_t)e2 * M + p2] = tok * 2 + 1; lgate[(size_t)e2 * M + p2] = ptop * w2;
                }
            }
        }
        __syncthreads();
    }
}

namespace pg8 {
#define PG8_LAS __attribute__((address_space(3)))
typedef float f32x4 __attribute__((ext_vector_type(4)));
constexpr int BM = 256, BK = 64, HALF = 128, HTB = HALF * BK * 2  , STAGE_BYTES = 8 * HTB, NXCD = 8, WGM = 8;
__host__ __device__ __forceinline__ int lds_byte(int r, int c) { const int st = (r >> 4) * 2 + (c >> 5), rr = r & 15, cc = c & 31, ob = rr * 64 + cc * 2; return st * 1024 + (ob ^ (((ob >> 9) & 1) << 5)); }
__host__ __device__ __forceinline__ void stage_rc(int b, int& R, int& C) { const int st = b / 1024, sb = b % 1024, swz = sb ^ (((sb >> 9) & 1) << 5); R = (st >> 1) * 16 + swz / 64; C = (st & 1) * 32 + (swz % 64) / 2; }
__host__ __device__ __forceinline__ int perm32(int rho) { const int n = rho >> 4, i = rho & 15; return 8 * (i >> 2) + 4 * n + (i & 3); }

struct Unit { int pm, pn; };
struct Gemm { const bf16_t* A; const bf16_t* Bt; int M, N, K; };
struct StaticOrder {
    int nM, nN, nwg, G, c;
    __device__ void init(int M_, int N_, int G_, int c_) { nM = M_ / BM; nN = N_ / BM; nwg = nM * nN; G = G_; c = c_; }
    __device__ bool next(int i, Unit& u) const {
        const long L = (long)i * G + c; if (L >= nwg) return false;
        int wgid = (int)L; { const int q = nwg / NXCD, r = nwg % NXCD, xcd = wgid % NXCD, off = wgid / NXCD; wgid = (xcd < r ? xcd * (q + 1) : r * (q + 1) + (xcd - r) * q) + off; }
        const int nig = WGM * nN, gid = wgid / nig, fm = gid * WGM, gsz = (nM - fm) < WGM ? (nM - fm) : WGM;
        u.pm = fm + ((wgid % nig) % gsz); u.pn = (wgid % nig) / gsz; return true;
    }
    __device__ __forceinline__ void a_ready(const Unit&) const {}
    __device__ __forceinline__ void done(const Unit&) const {}
};


struct CountedOrder : StaticOrder {
    unsigned* ready; unsigned need; unsigned* readyb; unsigned needb;
    __device__ __forceinline__ void a_ready(const Unit& u) const {
        if (threadIdx.x < 64) {
            unsigned polls = 0;
            while ((unsigned)__builtin_amdgcn_readfirstlane(__hip_atomic_load(ready + 64 * u.pm, __ATOMIC_RELAXED, __HIP_MEMORY_SCOPE_AGENT)) < need) {
                if (++polls > (1u << 22)) break;
                __builtin_amdgcn_s_sleep(2); }
            if (readyb) { polls = 0;
                while ((unsigned)__builtin_amdgcn_readfirstlane(__hip_atomic_load(readyb + 64 * u.pn, __ATOMIC_RELAXED, __HIP_MEMORY_SCOPE_AGENT)) < needb) {
                    if (++polls > (1u << 22)) break;
                    __builtin_amdgcn_s_sleep(2); } }
            __builtin_amdgcn_fence(__ATOMIC_ACQUIRE, "agent");
            asm volatile("s_waitcnt vmcnt(0)" ::: "memory");
        }
        asm volatile("" ::: "memory"); __builtin_amdgcn_s_barrier(); asm volatile("" ::: "memory");
    }
};

struct EpiResid16 {
    static constexpr bool PERM = true, AFTER_DRAIN = false;
    const float* X; bf16_t* H; int ldc;
    __device__ __forceinline__ void operator()(const f32x4 (&acc)[2][2][4][2], const Unit& u, int wr, int wc, int fr, int fq) const {
        const int row0 = u.pm * BM + wr * 64 + fr, col0 = u.pn * BM + wc * 32 + 8 * fq;
#pragma unroll
        for (int ai = 0; ai < 2; ++ai)
#pragma unroll
            for (int m = 0; m < 4; ++m) { const size_t ro = (size_t)(row0 + ai * HALF + m * 16) * ldc + col0;
#pragma unroll
                for (int bj = 0; bj < 2; ++bj) { f32x4 v0 = acc[ai][bj][m][0], v1 = acc[ai][bj][m][1];
                    if (X) { v0 += *(const f32x4*)(X + ro + bj * HALF); v1 += *(const f32x4*)(X + ro + bj * HALF + 4); }
                    else { const u32x4 r = *(const u32x4*)(H + ro + bj * HALF);
                        v0[0] += lo16(r.x); v0[1] += hi16(r.x); v0[2] += lo16(r.y); v0[3] += hi16(r.y); v1[0] += lo16(r.z); v1[1] += hi16(r.z); v1[2] += lo16(r.w); v1[3] += hi16(r.w); }
                    u32x4 w; w.x = pack2(v0[0], v0[1]); w.y = pack2(v0[2], v0[3]); w.z = pack2(v1[0], v1[1]); w.w = pack2(v1[2], v1[3]);
                    *(u32x4*)(H + ro + bj * HALF) = w; } }
    }
};
struct EpiStore16 {
    static constexpr bool PERM = true, AFTER_DRAIN = false;
    bf16_t* O; int ldc;
    __device__ __forceinline__ void operator()(const f32x4 (&acc)[2][2][4][2], const Unit& u, int wr, int wc, int fr, int fq) const {
        const int row0 = u.pm * BM + wr * 64 + fr, col0 = u.pn * BM + wc * 32 + 8 * fq;
#pragma unroll
        for (int ai = 0; ai < 2; ++ai)
#pragma unroll
            for (int m = 0; m < 4; ++m) { bf16_t* rowp = O + (size_t)(row0 + ai * HALF + m * 16) * ldc + col0;
#pragma unroll
                for (int bj = 0; bj < 2; ++bj) { const f32x4 v0 = acc[ai][bj][m][0], v1 = acc[ai][bj][m][1];
                    u32x4 w; w.x = pack2(v0[0], v0[1]); w.y = pack2(v0[2], v0[3]); w.z = pack2(v1[0], v1[1]); w.w = pack2(v1[2], v1[3]);
                    __builtin_nontemporal_store(w, (u32x4*)(rowp + bj * HALF)); } }
    }
};

template <class Epi, class Sched, bool STAMP = false>
__device__ __forceinline__ void gemm_phase(PG8_LAS unsigned char* lds, const Gemm g, const Sched& S, const Epi& E, unsigned long long* stamps) {
    const int tid = threadIdx.x, wid = __builtin_amdgcn_readfirstlane(tid >> 6), lane = tid & 63, wr = wid >> 2, wc = wid & 3, fr = lane & 15, fq = lane >> 4;
    const int K = g.K, nt = K / BK;
    int ts_lo = 0, ts_hi = 0, nts = 0; const unsigned long long rt_entry = STAMP ? 0ull : 0ull;
#define PG8_STAMP() do { if (STAMP && wid == 0 && nts < 64) { const unsigned long long _c = (unsigned long long)clock64(); \
        ts_lo = (lane == nts) ? (int)(unsigned)_c : ts_lo; ts_hi = (lane == nts) ? (int)(unsigned)(_c >> 32) : ts_hi; ++nts; } } while (0)
    PG8_STAMP();
    unsigned voffA[2], voffB[2];
#pragma unroll
    for (int i = 0; i < 2; ++i) { int R, C; stage_rc(tid * 16 + i * 8192, R, C); const int Rb = Epi::PERM ? ((R & ~31) + perm32(R & 31)) : R;
        voffA[i] = (unsigned)(R * K + C) * 2u; voffB[i] = (unsigned)(Rb * K + C) * 2u; }
    const size_t kstep = (size_t)(BK * 2);
    const size_t hstep = (size_t)HALF * K * 2;
    const size_t tstep = 2 * hstep;
    const unsigned ldsw = (unsigned)wid * 1024u;
    const int aoff = lds_byte(wr * 64 + fr, fq * 8), boff = lds_byte(wc * 32 + fr, fq * 8);
#define PG8_SA(b, h) (((b) * 2 + (h)) * HTB)
#define PG8_SB(b, h) ((4 + (b) * 2 + (h)) * HTB)
#define PG8_STAGE(bufoff, gbase, voff) do { _Pragma("unroll") for (int _i = 0; _i < 2; ++_i) \
        __builtin_amdgcn_global_load_lds((const unsigned*)((const char*)(gbase) + (voff)[_i]), (PG8_LAS unsigned*)(lds + (bufoff) + ldsw + _i * 8192), 16, 0, 0); } while (0)
#define PG8_LDA(dst, b, h) do { _Pragma("unroll") for (int m = 0; m < 4; ++m) _Pragma("unroll") for (int k = 0; k < 2; ++k) dst[m][k] = *(const PG8_LAS bf16x8*)(lds + PG8_SA(b, h) + aoff + m * 2048 + k * 1024); } while (0)
#define PG8_LDB(dst, b, h) do { _Pragma("unroll") for (int n = 0; n < 2; ++n) _Pragma("unroll") for (int k = 0; k < 2; ++k) dst[n][k] = *(const PG8_LAS bf16x8*)(lds + PG8_SB(b, h) + boff + n * 2048 + k * 1024); } while (0)
#define PG8_MMA(ai, bj, At, Bt) do { __builtin_amdgcn_s_setprio(1); _Pragma("unroll") for (int m = 0; m < 4; ++m) _Pragma("unroll") for (int n = 0; n < 2; ++n) _Pragma("unroll") for (int k = 0; k < 2; ++k) \
        acc[ai][bj][m][n] = __builtin_amdgcn_mfma_f32_16x16x32_bf16(Bt[n][k], At[m][k], acc[ai][bj][m][n], 0, 0, 0); __builtin_amdgcn_s_setprio(0); } while (0)
#define PG8_WAIT_V(n) asm volatile("s_waitcnt vmcnt(" #n ")" ::: "memory")
#define PG8_WAIT_L(n) asm volatile("s_waitcnt lgkmcnt(" #n ")" ::: "memory")
#define PG8_BAR __builtin_amdgcn_s_barrier()
#define PG8_SCHED __builtin_amdgcn_sched_barrier(0)
    Unit cur, nxt; int ui = 0;
    if (!S.next(0, cur)) return;
    f32x4 acc[2][2][4][2];
#pragma unroll
    for (int a = 0; a < 2; ++a)
#pragma unroll
        for (int b = 0; b < 2; ++b)
#pragma unroll
            for (int m = 0; m < 4; ++m)
#pragma unroll
                for (int n = 0; n < 2; ++n) acc[a][b][m][n] = (f32x4){0.f, 0.f, 0.f, 0.f};
    bf16x8 At[4][2], B0[2][2], B1[2][2];
    const char* cA = (const char*)g.A + (size_t)cur.pm * tstep; const char* cB = (const char*)g.Bt + (size_t)cur.pn * tstep;
    S.a_ready(cur);
    PG8_STAGE(PG8_SB(0, 0), cB, voffB); PG8_STAGE(PG8_SA(0, 0), cA, voffA); PG8_STAGE(PG8_SB(0, 1), cB + hstep, voffB); PG8_STAGE(PG8_SA(0, 1), cA + hstep, voffA);
    if (wr == 1) PG8_BAR;
    PG8_WAIT_V(4); PG8_BAR;
    PG8_STAGE(PG8_SB(1, 0), cB + kstep, voffB); PG8_STAGE(PG8_SA(1, 0), cA + kstep, voffA); PG8_STAGE(PG8_SB(1, 1), cB + hstep + kstep, voffB);
    PG8_WAIT_V(6); PG8_BAR;
    PG8_STAMP();
    for (;;) {
        const bool has_next = S.next(ui + 1, nxt);
        const char* nA = has_next ? (const char*)g.A + (size_t)nxt.pm * tstep : cA; const char* nB = has_next ? (const char*)g.Bt + (size_t)nxt.pn * tstep : cB;
        for (int t = 0; t < nt; t += 2) {
            const bool last = (t == nt - 2);
            const char* a1 = cA + (size_t)(t + 1) * kstep;
            const char* a2 = last ? nA : cA + (size_t)(t + 2) * kstep; const char* b2 = last ? nB : cB + (size_t)(t + 2) * kstep;
            const char* a3 = a2 + kstep; const char* b3 = b2 + kstep;
            if (last && has_next) S.a_ready(nxt);
            PG8_LDB(B0, 0, 0); PG8_SCHED; PG8_LDA(At, 0, 0); PG8_STAGE(PG8_SA(1, 1), a1 + hstep, voffA);
            PG8_WAIT_L(8); PG8_BAR; PG8_WAIT_L(0); PG8_MMA(0, 0, At, B0); PG8_BAR; PG8_SCHED;
            PG8_LDB(B1, 0, 1); PG8_STAGE(PG8_SB(0, 0), b2, voffB);
            PG8_BAR; PG8_WAIT_L(0); PG8_MMA(0, 1, At, B1); PG8_BAR;
            PG8_LDA(At, 0, 1); PG8_STAGE(PG8_SA(0, 0), a2, voffA);
            PG8_BAR; PG8_WAIT_L(0); PG8_MMA(1, 0, At, B0); PG8_BAR; PG8_SCHED;
            PG8_STAGE(PG8_SB(0, 1), b2 + hstep, voffB);
            PG8_WAIT_V(6); PG8_BAR; PG8_MMA(1, 1, At, B1); PG8_BAR;
            PG8_LDB(B0, 1, 0); PG8_SCHED; PG8_LDA(At, 1, 0); PG8_STAGE(PG8_SA(0, 1), a2 + hstep, voffA);
            PG8_WAIT_L(8); PG8_BAR; PG8_WAIT_L(0); PG8_MMA(0, 0, At, B0); PG8_BAR; PG8_SCHED;
            PG8_LDB(B1, 1, 1); PG8_STAGE(PG8_SB(1, 0), b3, voffB);
            PG8_BAR; PG8_WAIT_L(0); PG8_MMA(0, 1, At, B1); PG8_BAR;
            PG8_LDA(At, 1, 1); PG8_STAGE(PG8_SA(1, 0), a3, voffA);
            PG8_BAR; PG8_WAIT_L(0); PG8_MMA(1, 0, At, B0); PG8_BAR; PG8_SCHED;
            PG8_STAGE(PG8_SB(1, 1), b3 + hstep, voffB);
            PG8_WAIT_V(6); PG8_BAR; PG8_MMA(1, 1, At, B1); PG8_BAR;
        }
        PG8_STAMP();
        if constexpr (!Epi::AFTER_DRAIN) { E(acc, cur, wr, wc, fr, fq); S.done(cur); }
        PG8_STAMP();
        if (!has_next) break;
#pragma unroll
        for (int a = 0; a < 2; ++a)
#pragma unroll
            for (int b = 0; b < 2; ++b)
#pragma unroll
                for (int m = 0; m < 4; ++m)
#pragma unroll
                    for (int n = 0; n < 2; ++n) acc[a][b][m][n] = (f32x4){0.f, 0.f, 0.f, 0.f};
        cur = nxt; cA = nA; cB = nB; ++ui;
    }
    PG8_WAIT_V(0);
    if (wr == 0) PG8_BAR;
    PG8_BAR;
    if constexpr (Epi::AFTER_DRAIN) { E.fused(acc, cur, wr, wc, fr, fq, lds, wid, lane); S.done(cur); }
    PG8_STAMP();
    if (STAMP && wid == 0) { stamps[lane] = lane < nts ? (((unsigned long long)(unsigned)ts_hi << 32) | (unsigned)ts_lo) : 0ull;
        if (lane == 62) stamps[62] = rt_entry; if (lane == 63) stamps[63] = 0ull; }
#undef PG8_STAMP
#undef PG8_SA
#undef PG8_SB
#undef PG8_STAGE
#undef PG8_LDA
#undef PG8_LDB
#undef PG8_MMA
#undef PG8_WAIT_V
#undef PG8_WAIT_L
#undef PG8_BAR
#undef PG8_SCHED
}
template <class Epi, class Sched, int K>
__device__ __forceinline__ void gemm_phase_g(PG8_LAS unsigned char* lds, const Sched& S, const Epi& E) {
    constexpr bool STAMP = false; unsigned long long* stamps = nullptr;
    const int tid = threadIdx.x, wid = __builtin_amdgcn_readfirstlane(tid >> 6), lane = tid & 63, wr = wid >> 2, wc = wid & 3, fr = lane & 15, fq = lane >> 4;
    constexpr int nt = K / BK;
    int ts_lo = 0, ts_hi = 0, nts = 0; const unsigned long long rt_entry = STAMP ? 0ull : 0ull;
#define PG8_STAMP() do { if (STAMP && wid == 0 && nts < 64) { const unsigned long long _c = (unsigned long long)clock64(); \
        ts_lo = (lane == nts) ? (int)(unsigned)_c : ts_lo; ts_hi = (lane == nts) ? (int)(unsigned)(_c >> 32) : ts_hi; ++nts; } } while (0)
    PG8_STAMP();
    unsigned voffB[2], cu0[2], cu1[2];
    PG8_LAS unsigned* const nxs = (PG8_LAS unsigned*)(lds + 131072) + tid * 4;
#pragma unroll
    for (int i = 0; i < 2; ++i) { int R, C; stage_rc(tid * 16 + i * 8192, R, C); const int Rb = Epi::PERM ? ((R & ~31) + perm32(R & 31)) : R;
        voffB[i] = (unsigned)(Rb * K + C) * 2u; }
    const size_t kstep = (size_t)(BK * 2);
    const size_t hstep = (size_t)HALF * K * 2;
    const size_t tstep = 2 * hstep;
    const unsigned ldsw = (unsigned)wid * 1024u;
    const int aoff = lds_byte(wr * 64 + fr, fq * 8), boff = lds_byte(wc * 32 + fr, fq * 8);
#define PG8_SA(b, h) (((b) * 2 + (h)) * HTB)
#define PG8_SB(b, h) ((4 + (b) * 2 + (h)) * HTB)
#define PG8_STAGE(bufoff, gbase, voff) do { _Pragma("unroll") for (int _i = 0; _i < 2; ++_i) \
        __builtin_amdgcn_global_load_lds((const unsigned*)((const char*)(gbase) + (voff)[_i]), (PG8_LAS unsigned*)(lds + (bufoff) + ldsw + _i * 8192), 16, 0, 0); } while (0)
#define PG8_LDA(dst, b, h) do { _Pragma("unroll") for (int m = 0; m < 4; ++m) _Pragma("unroll") for (int k = 0; k < 2; ++k) dst[m][k] = *(const PG8_LAS bf16x8*)(lds + PG8_SA(b, h) + aoff + m * 2048 + k * 1024); } while (0)
#define PG8_LDB(dst, b, h) do { _Pragma("unroll") for (int n = 0; n < 2; ++n) _Pragma("unroll") for (int k = 0; k < 2; ++k) dst[n][k] = *(const PG8_LAS bf16x8*)(lds + PG8_SB(b, h) + boff + n * 2048 + k * 1024); } while (0)
#define PG8_MMA(ai, bj, At, Bt) do { if ((ai) == 0 ? act0 : act1) { __builtin_amdgcn_s_setprio(1); _Pragma("unroll") for (int m = 0; m < 4; ++m) _Pragma("unroll") for (int n = 0; n < 2; ++n) _Pragma("unroll") for (int k = 0; k < 2; ++k) \
        acc[ai][bj][m][n] = __builtin_amdgcn_mfma_f32_16x16x32_bf16(Bt[n][k], At[m][k], acc[ai][bj][m][n], 0, 0, 0); __builtin_amdgcn_s_setprio(0); } } while (0)
#define PG8_WAIT_V(n) asm volatile("s_waitcnt vmcnt(" #n ")" ::: "memory")
#define PG8_WAIT_L(n) asm volatile("s_waitcnt lgkmcnt(" #n ")" ::: "memory")
#define PG8_BAR __builtin_amdgcn_s_barrier()
#define PG8_SCHED __builtin_amdgcn_sched_barrier(0)
    typename Sched::UnitT cur, nxt; int ui = 0;
    if (!S.next(0, cur)) return;
    bool act0 = wr * 64 < S.vrows(cur), act1 = 128 + wr * 64 < S.vrows(cur);
    f32x4 acc[2][2][4][2];
#pragma unroll
    for (int a = 0; a < 2; ++a)
#pragma unroll
        for (int b = 0; b < 2; ++b)
#pragma unroll
            for (int m = 0; m < 4; ++m)
#pragma unroll
                for (int n = 0; n < 2; ++n) acc[a][b][m][n] = (f32x4){0.f, 0.f, 0.f, 0.f};
    bf16x8 At[4][2], B0[2][2], B1[2][2];
    const char* const Ab = S.a_base(); const char* cB = S.b_base(cur);
#pragma unroll
    for (int i = 0; i < 2; ++i) { int R, C; stage_rc(tid * 16 + i * 8192, R, C); cu0[i] = S.row_off(cur, R) + C * 2; cu1[i] = S.row_off(cur, R + HALF) + C * 2; }
    S.a_ready(cur);
    PG8_STAGE(PG8_SB(0, 0), cB, voffB); PG8_STAGE(PG8_SA(0, 0), Ab, cu0); PG8_STAGE(PG8_SB(0, 1), cB + hstep, voffB); PG8_STAGE(PG8_SA(0, 1), Ab, cu1);
    if (wr == 1) PG8_BAR;
    PG8_WAIT_V(4); PG8_BAR;
    PG8_STAGE(PG8_SB(1, 0), cB + kstep, voffB); PG8_STAGE(PG8_SA(1, 0), Ab + kstep, cu0); PG8_STAGE(PG8_SB(1, 1), cB + hstep + kstep, voffB);
    PG8_WAIT_V(6); PG8_BAR;
    PG8_STAMP();
    for (;;) {
        const bool has_next = S.next(ui + 1, nxt);
        const char* nB = has_next ? S.b_base(nxt) : cB;
#pragma unroll
        for (int i = 0; i < 2; ++i) { int R, C; stage_rc(tid * 16 + i * 8192, R, C);
            nxs[i] = has_next ? S.row_off(nxt, R) + C * 2 : cu0[i]; nxs[2 + i] = has_next ? S.row_off(nxt, R + HALF) + C * 2 : cu1[i]; }
#pragma unroll 1
        for (int t = 0; t < nt; t += 2) {
            const bool last = (t == nt - 2);
            const char* a1 = Ab + (size_t)(t + 1) * kstep;
            const char* a2 = last ? Ab : Ab + (size_t)(t + 2) * kstep; const char* b2 = last ? nB : cB + (size_t)(t + 2) * kstep;
            unsigned o0[2], o1[2];
#pragma unroll
            for (int i = 0; i < 2; ++i) { o0[i] = cu0[i]; o1[i] = cu1[i]; }
            if (last) {
#pragma unroll
                for (int i = 0; i < 2; ++i) { o0[i] = nxs[i]; o1[i] = nxs[2 + i]; } }
            const char* a3 = a2 + kstep; const char* b3 = b2 + kstep;
            if (last && has_next) S.a_ready(nxt);
            PG8_LDB(B0, 0, 0); PG8_SCHED; PG8_LDA(At, 0, 0); PG8_STAGE(PG8_SA(1, 1), a1, cu1);
            PG8_WAIT_L(8); PG8_BAR; PG8_WAIT_L(0); PG8_MMA(0, 0, At, B0); PG8_BAR; PG8_SCHED;
            PG8_LDB(B1, 0, 1); PG8_STAGE(PG8_SB(0, 0), b2, voffB);
            PG8_BAR; PG8_WAIT_L(0); PG8_MMA(0, 1, At, B1); PG8_BAR;
            PG8_LDA(At, 0, 1); PG8_STAGE(PG8_SA(0, 0), a2, o0);
            PG8_BAR; PG8_WAIT_L(0); PG8_MMA(1, 0, At, B0); PG8_BAR; PG8_SCHED;
            PG8_STAGE(PG8_SB(0, 1), b2 + hstep, voffB);
            PG8_WAIT_V(6); PG8_BAR; PG8_MMA(1, 1, At, B1); PG8_BAR;
            PG8_LDB(B0, 1, 0); PG8_SCHED; PG8_LDA(At, 1, 0); PG8_STAGE(PG8_SA(0, 1), a2, o1);
            PG8_WAIT_L(8); PG8_BAR; PG8_WAIT_L(0); PG8_MMA(0, 0, At, B0); PG8_BAR; PG8_SCHED;
            PG8_LDB(B1, 1, 1); PG8_STAGE(PG8_SB(1, 0), b3, voffB);
            PG8_BAR; PG8_WAIT_L(0); PG8_MMA(0, 1, At, B1); PG8_BAR;
            PG8_LDA(At, 1, 1); PG8_STAGE(PG8_SA(1, 0), a3, o0);
            PG8_BAR; PG8_WAIT_L(0); PG8_MMA(1, 0, At, B0); PG8_BAR; PG8_SCHED;
            PG8_STAGE(PG8_SB(1, 1), b3 + hstep, voffB);
            PG8_WAIT_V(6); PG8_BAR; PG8_MMA(1, 1, At, B1); PG8_BAR;
        }
        PG8_STAMP();
        if constexpr (!Epi::AFTER_DRAIN) { E(acc, cur, wr, wc, fr, fq); S.done(cur); }
        PG8_STAMP();
        if (!has_next) break;
#pragma unroll
        for (int a = 0; a < 2; ++a)
#pragma unroll
            for (int b = 0; b < 2; ++b)
#pragma unroll
                for (int m = 0; m < 4; ++m)
#pragma unroll
                    for (int n = 0; n < 2; ++n) acc[a][b][m][n] = (f32x4){0.f, 0.f, 0.f, 0.f};
        cur = nxt; cB = nB; ++ui;
        act0 = wr * 64 < S.vrows(cur); act1 = 128 + wr * 64 < S.vrows(cur);
#pragma unroll
        for (int i = 0; i < 2; ++i) { cu0[i] = nxs[i]; cu1[i] = nxs[2 + i]; }
    }
    PG8_WAIT_V(0);
    if (wr == 0) PG8_BAR;
    PG8_BAR;
    if constexpr (Epi::AFTER_DRAIN) { E.fused(acc, cur, wr, wc, fr, fq, lds, wid, lane); S.done(cur); }
    PG8_STAMP();
    if (STAMP && wid == 0) { stamps[lane] = lane < nts ? (((unsigned long long)(unsigned)ts_hi << 32) | (unsigned)ts_lo) : 0ull;
        if (lane == 62) stamps[62] = rt_entry; if (lane == 63) stamps[63] = 0ull; }
#undef PG8_STAMP
#undef PG8_SA
#undef PG8_SB
#undef PG8_STAGE
#undef PG8_LDA
#undef PG8_LDB
#undef PG8_MMA
#undef PG8_WAIT_V
#undef PG8_WAIT_L
#undef PG8_BAR
#undef PG8_SCHED
}


}

template <int WHICH>
__device__ __forceinline__ void phase_dense_gemm(const Params& p, char* lds) {
    unsigned char* ws = p.ws;
    constexpr int N = (WHICH == 0) ? EVEN_IN : (WHICH == 2) ? ODD_IN : D;
    pg8::Gemm g{(const bf16_t*)(ws + WS_XN), (const bf16_t*)(ws + (WHICH == 0 ? WS_WIN0 : WHICH == 1 ? WS_WOUT0 : WHICH == 2 ? WS_WIN1 : WS_WOUT1)), M, N, D};
    pg8::StaticOrder S; S.init(M, N, (int)gridDim.x, (int)blockIdx.x);
    if (WHICH == 0) { pg8::CountedOrder SC; SC.init(M, N, (int)gridDim.x, (int)blockIdx.x); SC.ready = (unsigned*)(ws + WS_CTL) + CTL_READY; SC.need = 4u; SC.readyb = (unsigned*)(ws + WS_CTL) + CTL_READY + 4096; SC.needb = 64u;
        pg8::EpiStore16 E{(bf16_t*)(ws + WS_P), N}; pg8::gemm_phase<pg8::EpiStore16, pg8::CountedOrder, false>((PG8_LAS unsigned char*)lds, g, SC, E, nullptr); }
    else if (WHICH == 2) { pg8::EpiStore16 E{(bf16_t*)(ws + WS_P), P1_LD}; pg8::gemm_phase<pg8::EpiStore16, pg8::StaticOrder, false>((PG8_LAS unsigned char*)lds, g, S, E, nullptr); }
    else { pg8::EpiResid16 E{WHICH == 1 ? p.x : nullptr, (bf16_t*)((char*)p.out + H16_OFF), D}; pg8::gemm_phase<pg8::EpiResid16, pg8::StaticOrder, false>((PG8_LAS unsigned char*)lds, g, S, E, nullptr); }
    __syncthreads();
}

struct MUnit { int e, mt, pn, cnt, slot0, mtg; };
struct MoeSchedBase {
    const int* sh;
    int nbx, lb, layer; unsigned char* ws;
    int xe0, xe1, xe2, xe3, xp1, xp2, xp3, xp4;
    __device__ __forceinline__ int xe(int k) const { return k == 0 ? xe0 : k == 1 ? xe1 : k == 2 ? xe2 : xe3; }
    int xq4, tord;
    __device__ __forceinline__ void decode(int lmt, MUnit& u) const {
        int k, mt;
        if (lmt < xq4) { k = (lmt >= xp1) + (lmt >= xp2) + (lmt >= xp3); mt = lmt - (k == 0 ? 0 : k == 1 ? xp1 : k == 2 ? xp2 : xp3); }
        else { k = (tord >> (2 * (lmt - xq4))) & 3; mt = sh[xe(k) + 1] - sh[xe(k)] - 1; }
        const int e = xe(k);
        u.e = e; u.mt = mt; u.cnt = sh[128 + e]; u.slot0 = sh[64 + e]; u.mtg = sh[e] + mt;
    }
    __device__ __forceinline__ int vrows(const MUnit& u) const { const int r = u.cnt - u.mt * 256; return r < 256 ? r : 256; }
    __device__ __forceinline__ void setup(int m0, int m1, int m2, int m3) {
        const int f0 = m0 > 0 ? m0 - 1 : 0, f1 = m1 > 0 ? m1 - 1 : 0, f2 = m2 > 0 ? m2 - 1 : 0, f3 = m3 > 0 ? m3 - 1 : 0;
        xp1 = f0; xp2 = f0 + f1; xp3 = f0 + f1 + f2; xq4 = f0 + f1 + f2 + f3; xp4 = m0 + m1 + m2 + m3;
        int r[4]; const int mm[4] = {m0, m1, m2, m3};
#pragma unroll
        for (int k = 0; k < 4; ++k) r[k] = mm[k] > 0 ? sh[128 + xe(k)] - 256 * (mm[k] - 1) : 0;
        tord = 0;
#pragma unroll
        for (int k = 0; k < 4; ++k) { int rank = 0;
#pragma unroll
            for (int j = 0; j < 4; ++j) rank += (j != k) && (r[j] > r[k] || (r[j] == r[k] && j < k));
            tord |= k << (2 * rank); }
    }
    __device__ __forceinline__ unsigned* counter(int mtg) const { return (unsigned*)(ws + WS_CTL) + CTL_MOE + (layer * 160 + mtg) * 64; }
};
struct GuSched : MoeSchedBase {
    typedef MUnit UnitT;
    __device__ __forceinline__ bool next(int i, MUnit& u) const { const int ug = i * nbx + lb; if (ug >= 2 * xp4) return false; decode(ug >> 1, u); u.pn = ug & 1; return true; }
    __device__ __forceinline__ const char* a_base() const { return (const char*)(ws + WS_XN); }
    __device__ __forceinline__ unsigned row_off(const MUnit& u, int R) const { int ml = u.mt * 256 + R; ml = ml < u.cnt ? ml : u.cnt - 1;
        return (unsigned)(((const int*)(ws + WS_LTOK))[(size_t)u.e * M + ml] >> 1) * 2048u; }
    __device__ __forceinline__ const char* b_base(const MUnit& u) const { return (const char*)(ws + WS_WGU) + ((size_t)((layer * 32 + u.e) * 2 + u.pn) * 256) * 2048; }
    __device__ __forceinline__ void a_ready(const MUnit&) const {}
    __device__ __forceinline__ void done(const MUnit& u) const {
        asm volatile("s_waitcnt vmcnt(0)" ::: "memory");
        if ((threadIdx.x & 63) == 0) __hip_atomic_fetch_add(counter(u.mtg), 1u, __ATOMIC_RELAXED, __HIP_MEMORY_SCOPE_AGENT);
    }
};
struct DnSched : MoeSchedBase {
    typedef MUnit UnitT;
    int x, nb1;
    int nE, nL, e0, ce;
    mutable int last_mtg;
    __device__ __forceinline__ void deal() {
        const int ME = (2 * xp4 <= nbx) ? xp4 : ((nbx >> 1) < xp4 ? (nbx >> 1) : xp4);
        nE = 4 * ME; nL = 4 * (xp4 - ME); last_mtg = -1; e0 = 0; ce = 0;
        if (lb >= x) { const int w = lb - x, q = nE / nb1, r = nE - q * nb1; e0 = w * q + (w < r ? w : r); ce = q + (w < r ? 1 : 0); }
    }
    __device__ __forceinline__ bool next(int i, MUnit& u) const {
        if (lb < x) return false;
        int ud;
        if (i < ce) ud = e0 + i;
        else { const int j = (nb1 - 1 - (lb - x)) + (i - ce) * nb1; if (j >= nL) return false; ud = nE + j; }
        decode(ud >> 2, u); u.pn = ud & 3; return true; }
    __device__ __forceinline__ const char* a_base() const { return (const char*)(ws + WS_P + P_HID); }
    __device__ __forceinline__ unsigned row_off(const MUnit& u, int R) const { return (unsigned)(u.slot0 + u.mt * 256 + R) * 512u; }
    __device__ __forceinline__ const char* b_base(const MUnit& u) const { return (const char*)(ws + WS_WD) + ((size_t)(layer * 32 + u.e) * 1024 + u.pn * 256) * 512; }
    __device__ __forceinline__ void a_ready(const MUnit& u) const {
        if (u.mtg == last_mtg) return;
        last_mtg = u.mtg;
        if (threadIdx.x < 64) {
            unsigned polls = 0; unsigned* c = counter(u.mtg);
            while ((unsigned)__builtin_amdgcn_readfirstlane(__hip_atomic_load(c, __ATOMIC_RELAXED, __HIP_MEMORY_SCOPE_AGENT)) < 16u) { if (++polls > (1u << 22)) break; __builtin_amdgcn_s_sleep(2); }
            __builtin_amdgcn_fence(__ATOMIC_ACQUIRE, "agent");
            asm volatile("s_waitcnt vmcnt(0)" ::: "memory");
        }
        asm volatile("" ::: "memory"); __builtin_amdgcn_s_barrier(); asm volatile("" ::: "memory");
    }
    __device__ __forceinline__ void done(const MUnit&) const {}
};
struct EpiGU {
    static constexpr bool PERM = true, AFTER_DRAIN = false;
    unsigned char* ws;
    __device__ __forceinline__ void operator()(const pg8::f32x4 (&acc)[2][2][4][2], const MUnit& u, int wr, int wc, int fr, int fq) const {
        bf16_t* HID = (bf16_t*)(ws + WS_P + P_HID); const float* lgate = (const float*)(ws + WS_LGATE) + (size_t)u.e * M;
#pragma unroll
        for (int ai = 0; ai < 2; ++ai)
#pragma unroll
            for (int m = 0; m < 4; ++m) { const int ml = u.mt * 256 + ai * 128 + wr * 64 + m * 16 + fr;
                if (ml < u.cnt) { const float gt = lgate[ml]; float h[8];
#pragma unroll
                    for (int n = 0; n < 2; ++n)
#pragma unroll
                        for (int e = 0; e < 4; ++e) h[n * 4 + e] = siluf_(acc[ai][0][m][n][e]) * acc[ai][1][m][n][e] * gt;
                    bf16_t* dp = HID + (size_t)(u.slot0 + ml) * 256 + u.pn * 128 + wc * 32 + 8 * fq;
                    u32x4 hv; hv.x = pack2(h[0], h[1]); hv.y = pack2(h[2], h[3]); hv.z = pack2(h[4], h[5]); hv.w = pack2(h[6], h[7]);
                    asm volatile("s_nop 1\n\tglobal_store_dwordx4 %0, %1, off sc1\n\ts_nop 0" :: "v"(dp), "v"(hv) : "memory"); } }
    }
};
struct EpiDn {
    static constexpr bool PERM = true, AFTER_DRAIN = false;
    unsigned char* ws;
    __device__ __forceinline__ void operator()(const pg8::f32x4 (&acc)[2][2][4][2], const MUnit& u, int wr, int wc, int fr, int fq) const {
        bf16_t* Y = (bf16_t*)(ws + WS_P + P_Y); const int* ltok = (const int*)(ws + WS_LTOK) + (size_t)u.e * M;
#pragma unroll
        for (int ai = 0; ai < 2; ++ai)
#pragma unroll
            for (int m = 0; m < 4; ++m) { const int ml = u.mt * 256 + ai * 128 + wr * 64 + m * 16 + fr;
                if (ml < u.cnt) { const int tk = ltok[ml]; bf16_t* rowp = Y + ((size_t)(tk & 1) * M + (tk >> 1)) * D + u.pn * 256 + wc * 32 + 8 * fq;
#pragma unroll
                    for (int bj = 0; bj < 2; ++bj) { const pg8::f32x4 v0 = acc[ai][bj][m][0], v1 = acc[ai][bj][m][1];
                        u32x4 w; w.x = pack2(v0[0], v0[1]); w.y = pack2(v0[2], v0[3]); w.z = pack2(v1[0], v1[1]); w.w = pack2(v1[2], v1[3]);
                        *(u32x4*)(rowp + bj * 128) = w; } } }
    }
};
__device__ __forceinline__ void phase_moe_merged(const Params& p, char* lds, int layer) {
    unsigned char* ws = p.ws;
    int* sh = (int*)(lds + 147456);
    const int* cntg = (const int*)(ws + WS_CTL) + CTL_CNT + layer * 32 * 64;
    if (threadIdx.x == 0) { int tp = 0, sp = 0;
        for (int e = 0; e < 32; ++e) { const int c = cntg[e * 64]; sh[e] = tp; sh[64 + e] = sp; sh[128 + e] = c; tp += (c + 255) >> 8; sp += c; }
        sh[32] = tp; }
    __syncthreads();
    if (threadIdx.x < 32) { const int e = threadIdx.x, c = sh[128 + e]; int rank = 0;
        for (int j = 0; j < 32; ++j) { const int cj = sh[128 + j]; rank += (cj > c || (cj == c && j < e)) ? 1 : 0; }
        const int rnd = rank >> 3, pos = rank & 7; sh[160 + ((rnd & 1) ? 7 - pos : pos) * 4 + rnd] = e; }
    __syncthreads();
    const int G = (int)gridDim.x, b = (int)blockIdx.x;
    GuSched SG; DnSched SD;
    {
        const int grp = b & 7, nbx = (G - grp + 7) >> 3, lb = b >> 3;
        const int e0 = sh[160 + grp * 4], e1 = sh[161 + grp * 4], e2 = sh[162 + grp * 4], e3 = sh[163 + grp * 4];
        const int m0 = sh[e0 + 1] - sh[e0], m1 = sh[e1 + 1] - sh[e1], m2 = sh[e2 + 1] - sh[e2], m3 = sh[e3 + 1] - sh[e3];
        SG.sh = sh; SG.nbx = nbx; SG.lb = lb; SG.layer = layer; SG.ws = ws; SG.xe0 = e0; SG.xe1 = e1; SG.xe2 = e2; SG.xe3 = e3; SG.setup(m0, m1, m2, m3);
        SD.sh = sh; SD.nbx = nbx; SD.lb = lb; SD.layer = layer; SD.ws = ws; SD.xe0 = e0; SD.xe1 = e1; SD.xe2 = e2; SD.xe3 = e3; SD.xp1 = SG.xp1; SD.xp2 = SG.xp2; SD.xp3 = SG.xp3; SD.xp4 = SG.xp4; SD.xq4 = SG.xq4; SD.tord = SG.tord;
        const int ngu = 2 * SG.xp4;
        SD.x = (ngu > nbx && ngu < 2 * nbx) ? ngu - nbx : 0; SD.nb1 = nbx - SD.x; SD.deal();
    }
    EpiGU EG{ws}; EpiDn ED{ws};
    pg8::gemm_phase_g<EpiGU, GuSched, 1024>((PG8_LAS unsigned char*)lds, SG, EG);
    pg8::gemm_phase_g<EpiDn, DnSched, 256>((PG8_LAS unsigned char*)lds, SD, ED);
    __syncthreads();
}

__device__ __forceinline__ void unpack8(const u32x4& v, float* f) { f[0] = lo16(v.x); f[1] = hi16(v.x); f[2] = lo16(v.y); f[3] = hi16(v.y); f[4] = lo16(v.z); f[5] = hi16(v.z); f[6] = lo16(v.w); f[7] = hi16(v.w); }
__device__ __forceinline__ void phase_post0(const Params& p) {
    const int tid = threadIdx.x, lane = tid & 63, wave = tid >> 6;
    unsigned char* ws = p.ws;
    bf16_t* O16 = (bf16_t*)(ws + WS_XN);
    const bf16_t* P = (const bf16_t*)(ws + WS_P);
    const bf16_t* AUX = (const bf16_t*)p.out;
    const int c0 = lane * 16;
    constexpr int NB = POST_NB;
    const int stride = (int)gridDim.x * 8;
    float cw[16], cb[16];
    if (lane < 32) {
#pragma unroll
        for (int j4 = 0; j4 < 4; ++j4) { const float4 lw = *(const float4*)(p.rw_ln_w + c0 + j4 * 4), lb = *(const float4*)(p.rw_ln_b + c0 + j4 * 4);
            cw[j4 * 4] = lw.x; cw[j4 * 4 + 1] = lw.y; cw[j4 * 4 + 2] = lw.z; cw[j4 * 4 + 3] = lw.w; cb[j4 * 4] = lb.x; cb[j4 * 4 + 1] = lb.y; cb[j4 * 4 + 2] = lb.z; cb[j4 * 4 + 3] = lb.w; }
    } else {
#pragma unroll
        for (int j = 0; j < 16; ++j) { cw[j] = p.hg_norm[(c0 - 512 + j) & 63]; cb[j] = 0.f; }
    }
    for (int tb = blockIdx.x * 8 + wave; tb < M; tb += NB * stride) {
        int tok[NB]; u32x4 r0[NB], r1[NB], ga[NB], gb[NB];
#pragma unroll
        for (int b = 0; b < NB; ++b) {
            const int ti_ = (tb + b * stride < M) ? tb + b * stride : tb;
            tok[b] = (gridDim.x == 256) ? (((ti_ >> 3) & 7) * 2048 + ((ti_ >> 6) & 31) * 64 + (ti_ >> 11) * 8 + (ti_ & 7)) : ti_;
            r0[b] = *(const u32x4*)(O16 + (size_t)tok[b] * D + c0); r1[b] = *(const u32x4*)(O16 + (size_t)tok[b] * D + c0 + 8);
            if (lane < 32) { ga[b] = *(const u32x4*)(AUX + (size_t)tok[b] * D + c0); gb[b] = *(const u32x4*)(AUX + (size_t)tok[b] * D + c0 + 8); }
            else { ga[b] = *(const u32x4*)(P + (size_t)tok[b] * EVEN_IN + 1792 + 1536 + (c0 - 512)); gb[b] = *(const u32x4*)(P + (size_t)tok[b] * EVEN_IN + 1792 + 1536 + (c0 - 512) + 8); }
        }
        u32x4 ha[NB], hb[NB];
#pragma unroll
        for (int b = 0; b < NB; ++b) { ha[b] = u32x4{0u, 0u, 0u, 0u}; hb[b] = ha[b];
            if (lane < 32) { ha[b] = *(const u32x4*)(AUX + (size_t)tok[b] * D + 512 + c0); hb[b] = *(const u32x4*)(AUX + (size_t)tok[b] * D + 512 + c0 + 8); } }
#pragma unroll
        for (int b = 0; b < NB; ++b) {
            if (tb + b * stride >= M) break;
            float y[16], x1[16], x2[16];
            unpack8(r0[b], y); unpack8(r1[b], y + 8); unpack8(ga[b], x1); unpack8(gb[b], x1 + 8); unpack8(ha[b], x2); unpack8(hb[b], x2 + 8);
            float o[16];
            if (lane < 32) {
                float s = 0.f;
#pragma unroll
                for (int j = 0; j < 16; ++j) s += y[j];
                s += dppf<0xB1>(s); s += dppf<0x4E>(s);
                const float mean = s * (1.0f / 64.0f);
                float q = 0.f;
#pragma unroll
                for (int j = 0; j < 16; ++j) { const float d = y[j] - mean; q += d * d; }
                q += dppf<0xB1>(q); q += dppf<0x4E>(q);
                const float rstd = rsqrtf(q * (1.0f / 64.0f) + 64e-5f);
#pragma unroll
                for (int j = 0; j < 16; ++j) o[j] = ((y[j] - mean) * rstd * cw[j] + cb[j] + x1[j]) * x2[j];
            } else {
                float q = 0.f;
#pragma unroll
                for (int j = 0; j < 16; ++j) q += y[j] * y[j];
                q += dppf<0xB1>(q); q += dppf<0x4E>(q);
                const float rstd = rsqrtf(q * (1.0f / 64.0f) + 1e-6f);
#pragma unroll
                for (int j = 0; j < 16; ++j) o[j] = y[j] * rstd * cw[j] * siluf_(x1[j]);
            }
            u32x4 w0, w1;
            w0.x = pack2(o[0], o[1]); w0.y = pack2(o[2], o[3]); w0.z = pack2(o[4], o[5]); w0.w = pack2(o[6], o[7]);
            w1.x = pack2(o[8], o[9]); w1.y = pack2(o[10], o[11]); w1.z = pack2(o[12], o[13]); w1.w = pack2(o[14], o[15]);
            *(u32x4*)(O16 + (size_t)tok[b] * D + c0) = w0; *(u32x4*)(O16 + (size_t)tok[b] * D + c0 + 8) = w1;
        }
    }
}


__device__ __forceinline__ bf16x8 frag_rm(const bf16_t* base, int ld, int lane) { return *(const bf16x8*)(base + (lane & 15) * ld + 8 * (lane >> 4)); }
__device__ __forceinline__ bf16x8 frag_tr(const bf16_t* base, int ld, int lane) {
    const int g = lane >> 4, i = lane & 15;
    const bf16_t* a0 = base + (8 * g + (i >> 2)) * ld + 4 * (i & 3);
    const s16x4 lo = __builtin_amdgcn_ds_read_tr16_b64_v4i16((LAS s16x4*)a0);
    const s16x4 hi = __builtin_amdgcn_ds_read_tr16_b64_v4i16((LAS s16x4*)(a0 + 4 * ld));
    bf16x8 r; r[0] = lo[0]; r[1] = lo[1]; r[2] = lo[2]; r[3] = lo[3]; r[4] = hi[0]; r[5] = hi[1]; r[6] = hi[2]; r[7] = hi[3];
    return r;
}
__device__ __forceinline__ float red8(float x) { x += dppf<0xB1>(x); x += dppf<0x4E>(x); x += dppf<0x141>(x); return x; }


__device__ __forceinline__ void tri_inverse_wave(const float* Nf, const bf16_t* Nb, bf16_t* Tb, bf16_t* Wb, int lane) {
    const int g = lane >> 4, li = lane & 15;
    {
        float Tc[16];
        const float* Nrow = Nf + (16 * g) * 68 + 16 * g;
#pragma unroll
        for (int i = 0; i < 16; ++i) {
            float acc = (i == li) ? 1.f : 0.f;
#pragma unroll
            for (int j = 0; j < i; ++j) acc -= Nrow[i * 68 + j] * Tc[j];
            Tc[i] = acc;
        }
#pragma unroll
        for (int i = 0; i < 16; ++i) Tb[(16 * g + i) * 72 + 16 * g + li] = f2bf(Tc[i]);
    }
    asm volatile("s_waitcnt lgkmcnt(0)" ::: "memory");
#pragma unroll
    for (int dl = 1; dl < 4; ++dl) {
#pragma unroll
        for (int j = 0; j + dl < 4; ++j) {
            const int i = j + dl;
            f32x4v w; w[0] = 0.f; w[1] = 0.f; w[2] = 0.f; w[3] = 0.f;
#pragma unroll
            for (int k0 = 0; k0 < 16 * dl; k0 += 32) {
                bf16x8 a = frag_rm(Nb + (16 * i) * 72 + 16 * j + k0, 72, lane);
                const bf16x8 b = frag_tr(Tb + (16 * j + k0) * 72 + 16 * j, 72, lane);
                if (k0 + 8 * g >= 16 * dl) { a[0] = 0; a[1] = 0; a[2] = 0; a[3] = 0; a[4] = 0; a[5] = 0; a[6] = 0; a[7] = 0; }
                w = MFMA16(a, b, w);
            }
#pragma unroll
            for (int r = 0; r < 4; ++r) Wb[(4 * g + r) * 24 + li] = f2bf(w[r]);
            asm volatile("s_waitcnt lgkmcnt(0)" ::: "memory");
            bf16x8 a = frag_rm(Tb + (16 * i) * 72 + 16 * i, 72, lane);
            if (g >= 2) { a[0] = 0; a[1] = 0; a[2] = 0; a[3] = 0; a[4] = 0; a[5] = 0; a[6] = 0; a[7] = 0; }
            const bf16x8 b = frag_tr(Wb, 24, lane);
            f32x4v t; t[0] = 0.f; t[1] = 0.f; t[2] = 0.f; t[3] = 0.f;
            t = MFMA16(a, b, t);
#pragma unroll
            for (int r = 0; r < 4; ++r) Tb[(16 * i + 4 * g + r) * 72 + 16 * j + li] = f2bf(-t[r]);
            asm volatile("s_waitcnt lgkmcnt(0)" ::: "memory");
        }
    }
}


__device__ __forceinline__ void hg_pre_load(const Params& p, int id, u32x4& q8, u32x4& f8) {
    const int tid = threadIdx.x, t = tid >> 3, d0 = (tid & 7) * 8;
    const int bb = id >> 8, hh = (id >> 5) & 7, c = id & 31;
    const bf16_t* P = (const bf16_t*)(p.ws + WS_P);
    const size_t tok = (size_t)bb * SEQ + c * 64 + t;
    q8 = *(const u32x4*)(P + tok * EVEN_IN + 1792 + hh * 64 + d0);
    f8 = *(const u32x4*)(P + tok * EVEN_IN + 1792 + 512 + hh * 64 + d0);
}
__device__ __forceinline__ void hg_pre_item(const Params& p, char* lds, int id, u32x4& pq8, u32x4& pf8, int next_id) {
    const int tid = threadIdx.x, lane = tid & 63, wave = tid >> 6, g = lane >> 4, li = lane & 15;
    const int bb = id >> 8, hh = (id >> 5) & 7, c = id & 31;
    unsigned char* ws = p.ws;
    const bf16_t* P = (const bf16_t*)(ws + WS_P);
    unsigned char* item = ws + WS_CHK_HG + (size_t)id * CHK_HG_ITEM;
    float* LG = (float*)lds;
    bf16_t* QV = (bf16_t*)(lds + 17408);
    bf16_t* KV = (bf16_t*)(lds + 26624);
    bf16_t* QT = (bf16_t*)(lds + 35840);
    bf16_t* KT = (bf16_t*)(lds + 45056);
    bf16_t* AyS = (bf16_t*)(lds + 81920);
    const int t = tid >> 3, part = tid & 7, d0 = part * 8;
    const size_t tok = (size_t)bb * SEQ + c * 64 + t;
    {
        const u32x4 q8 = pq8, f8 = pf8;
        if (next_id >= 0) hg_pre_load(p, next_id, pq8, pf8);
        float qv[8], fv[8];
        qv[0] = lo16(q8.x); qv[1] = hi16(q8.x); qv[2] = lo16(q8.y); qv[3] = hi16(q8.y); qv[4] = lo16(q8.z); qv[5] = hi16(q8.z); qv[6] = lo16(q8.w); qv[7] = hi16(q8.w);
        fv[0] = lo16(f8.x); fv[1] = hi16(f8.x); fv[2] = lo16(f8.y); fv[3] = hi16(f8.y); fv[4] = lo16(f8.z); fv[5] = hi16(f8.z); fv[6] = lo16(f8.w); fv[7] = hi16(f8.w);
        float kq[8];
#pragma unroll
        for (int e = 0; e < 8; ++e) {
            const float lbv = ((const float*)(lds + 131072))[320 + d0 + e];
            const float fg = lbv + (1.f - lbv) * sigmoidf_(fv[e]);
            LG[t * 68 + d0 + e] = __logf(fg);
            qv[e] = siluf_(qv[e]); kq[e] = 1.f - fg;
        }
        u32x4 o; o.x = pack2(qv[0], qv[1]); o.y = pack2(qv[2], qv[3]); o.z = pack2(qv[4], qv[5]); o.w = pack2(qv[6], qv[7]);
        *(u32x4*)(QV + t * 72 + d0) = o;
        o.x = pack2(kq[0], kq[1]); o.y = pack2(kq[2], kq[3]); o.z = pack2(kq[4], kq[5]); o.w = pack2(kq[6], kq[7]);
        *(u32x4*)(KV + t * 72 + d0) = o;
    }
    __syncthreads();
    if (tid < 64) { float run = 0.f;
#pragma unroll 8
        for (int s = 0; s < 64; ++s) { run += LG[s * 68 + tid]; LG[s * 68 + tid] = run; } }
    __syncthreads();
    {
        const int blk = t >> 4;
        const u32x4 q8 = *(const u32x4*)(QV + t * 72 + d0), k8 = *(const u32x4*)(KV + t * 72 + d0);
        float qv[8], kv[8];
        qv[0] = lo16(q8.x); qv[1] = hi16(q8.x); qv[2] = lo16(q8.y); qv[3] = hi16(q8.y); qv[4] = lo16(q8.z); qv[5] = hi16(q8.z); qv[6] = lo16(q8.w); qv[7] = hi16(q8.w);
        kv[0] = lo16(k8.x); kv[1] = hi16(k8.x); kv[2] = lo16(k8.y); kv[3] = hi16(k8.y); kv[4] = lo16(k8.z); kv[5] = hi16(k8.z); kv[6] = lo16(k8.w); kv[7] = hi16(k8.w);
        float lc[8], rp[8], kc[8], qt[8];
#pragma unroll
        for (int e = 0; e < 8; ++e) {
            lc[e] = LG[t * 68 + d0 + e];
            const float lcl = LG[63 * 68 + d0 + e];
            const float ref = blk ? LG[(16 * blk - 1) * 68 + d0 + e] : 0.f;
            rp[e] = qv[e] * __expf(lc[e]); kc[e] = kv[e] * __expf(lcl - lc[e]); qt[e] = qv[e] * __expf(lc[e] - ref);
            if (t == 0) ((float*)(item + 24576))[d0 + e] = __expf(lcl);
        }
        u32x4 o; o.x = pack2(rp[0], rp[1]); o.y = pack2(rp[2], rp[3]); o.z = pack2(rp[4], rp[5]); o.w = pack2(rp[6], rp[7]);
        __builtin_nontemporal_store(o, (u32x4*)(item + t * 128 + part * 16));
        o.x = pack2(kc[0], kc[1]); o.y = pack2(kc[2], kc[3]); o.z = pack2(kc[4], kc[5]); o.w = pack2(kc[6], kc[7]);
        __builtin_nontemporal_store(o, (u32x4*)(item + 16384 + t * 128 + part * 16));
        o.x = pack2(qt[0], qt[1]); o.y = pack2(qt[2], qt[3]); o.z = pack2(qt[4], qt[5]); o.w = pack2(qt[6], qt[7]);
        *(u32x4*)(QT + t * 72 + d0) = o;
#pragma unroll
        for (int ib = 0; ib < 4; ++ib) {
            if (ib >= blk) {
                float kt[8];
#pragma unroll
                for (int e = 0; e < 8; ++e) { const float ref = ib ? LG[(16 * ib - 1) * 68 + d0 + e] : 0.f; kt[e] = kv[e] * __expf(fminf(ref - lc[e], 80.f)); }
                o.x = pack2(kt[0], kt[1]); o.y = pack2(kt[2], kt[3]); o.z = pack2(kt[4], kt[5]); o.w = pack2(kt[6], kt[7]);
                *(u32x4*)(KT + (ib * 64 + t) * 72 + d0) = o;
            }
        }
    }
    __syncthreads();
    {
        const int ti = wave >> 1;
#pragma unroll
        for (int jj = 0; jj < 2; ++jj) {
            const int tj = (wave & 1) * 2 + jj, s = tj * 16 + li;
            f32x4v acc; acc[0] = 0.f; acc[1] = 0.f; acc[2] = 0.f; acc[3] = 0.f;
            if (tj <= ti) {
#pragma unroll
                for (int k0 = 0; k0 < 64; k0 += 32) acc = MFMA16(frag_rm(QT + ti * 16 * 72 + k0, 72, lane), frag_rm(KT + (ti * 64 + tj * 16) * 72 + k0, 72, lane), acc);
#pragma unroll
                for (int r = 0; r < 4; ++r) if (s > ti * 16 + 4 * g + r) acc[r] = 0.f;
            }
#pragma unroll
            for (int r = 0; r < 4; ++r) AyS[(ti * 16 + 4 * g + r) * 72 + s] = f2bf(acc[r]);
        }
    }
    __syncthreads();
    __builtin_nontemporal_store(*(const u32x4*)(AyS + t * 72 + d0), (u32x4*)(item + 8192 + t * 128 + part * 16));
    __syncthreads();
}


__device__ __forceinline__ void rw_pre_load(const Params& p, int id, u32x4 (&rw)[9]) {
    const int tid = threadIdx.x;
    if (tid < 448) {
        const int bb = id >> 8, hh = (id >> 5) & 7, c = id & 31;
        const int q = tid % 56, tg = tid / 56;
        int pcol;
        if (q < 24) pcol = (q >> 3) * 512 + hh * 64 + (q & 7) * 8; else if (q < 32) pcol = 1536 + (q - 24) * 8; else if (q < 40) pcol = 1600 + (q - 32) * 8; else pcol = 1664 + (q - 40) * 8;
        const bf16_t* src_ = (const bf16_t*)(p.ws + WS_P) + ((size_t)bb * SEQ + c * 64 + tg * 8) * EVEN_IN + pcol;
        rw[0].x = 0u; rw[0].y = 0u; rw[0].z = 0u; rw[0].w = 0u;
        if (c * 64 + tg * 8 > 0) rw[0] = *(const u32x4*)(src_ - EVEN_IN);
#pragma unroll
        for (int i = 0; i < 8; ++i) rw[i + 1] = *(const u32x4*)(src_ + (size_t)i * EVEN_IN);
    }
}

__device__ __forceinline__ float tanhf_(float x) { return 1.0f - 2.0f * __builtin_amdgcn_rcpf(1.0f + __expf(2.0f * x)); }
__device__ __forceinline__ u32x4 pack8(const float* f) { u32x4 o; o.x = pack2(f[0], f[1]); o.y = pack2(f[2], f[3]); o.z = pack2(f[4], f[5]); o.w = pack2(f[6], f[7]); return o; }

__device__ __forceinline__ void rw_pre_item(const Params& p, char* lds0, int id, u32x4 (&rw)[9], int next_id) {
    const int tid = threadIdx.x, lane = tid & 63, wave = tid >> 6, g = lane >> 4, li = lane & 15;
    const int bb = id >> 8, hh = (id >> 5) & 7, c = id & 31;
    int lz = 0; asm volatile("" : "+s"(lz));
    char* lds = lds0 + lz;
    unsigned char* ws = p.ws;
    const bf16_t* P = (const bf16_t*)(ws + WS_P);
    unsigned char* item = ws + WS_CHK_RW + (size_t)id * CHK_RW_ITEM;
    bf16_t* AUX = (bf16_t*)p.out;
    bf16_t* w2h = (bf16_t*)(lds + 0);
    bf16_t* a2h = (bf16_t*)(lds + 9216);
    bf16_t* g2h = (bf16_t*)(lds + 18432);
    bf16_t* TW = (bf16_t*)(lds + 36864);
    bf16_t* AL = (bf16_t*)(lds + 46080);
    bf16_t* SG = (bf16_t*)(lds + 55296);
    bf16_t* Rt = (bf16_t*)(lds + 0);
    bf16_t* At = (bf16_t*)(lds + 9216);
    bf16_t* Kh = (bf16_t*)(lds + 18432);
    bf16_t* Bh = (bf16_t*)(lds + 27648);
    bf16_t* Kt = (bf16_t*)(lds + 36864);
    bf16_t* Bt = (bf16_t*)(lds + 46080);
    bf16_t* Ap = (bf16_t*)(lds + 36864);
    bf16_t* Wv = (bf16_t*)(lds + 46080);
    bf16_t* Tb = (bf16_t*)(lds + 55296);
    bf16_t* Wb = (bf16_t*)(lds + 64512);
    float* GLs = (float*)(lds + 66048);
    float* TT = (float*)(lds + 132608);
    bf16_t* RS = (bf16_t*)(lds + 72704);
    bf16_t* KS = (bf16_t*)(lds + 81920);
    bf16_t* VS = (bf16_t*)(lds + 91136);
    float* LD = (float*)(lds + 100352);
    bf16_t* AG = (bf16_t*)(lds + 117760);
    bf16_t* Ark = (bf16_t*)(lds + 72704);
    bf16_t* Arb = (bf16_t*)(lds + 81920);
    bf16_t* Aak = (bf16_t*)(lds + 91136);
    bf16_t* Nb = (bf16_t*)(lds + 100352);
    float* Nf = (float*)(lds + 109568);
    bf16_t* OutA = Aak; bf16_t* OutB = Nb; bf16_t* OutC = Tb; bf16_t* OutD = (bf16_t*)Nf;
    const size_t tok0 = (size_t)bb * SEQ + c * 64;
    {
        const bf16_t* RWW = (const bf16_t*)(ws + WS_RWW) + (size_t)hh * 256 * 64;
#pragma unroll
        for (int i = 0; i < 4; ++i) { const int idx = tid + NT * i, r = idx >> 3, c8 = idx & 7; *(u32x4*)(w2h + r * 72 + c8 * 8) = *(const u32x4*)(RWW + r * 64 + c8 * 8); }
    }
    if (tid < 448) {
        const int q = tid % 56, tg = tid / 56;
        int pcol, role, lc;
        if (q < 24) { role = q >> 3; lc = (q & 7) * 8; pcol = role * 512 + hh * 64 + lc; }
        else if (q < 32) { role = 3; lc = (q - 24) * 8; pcol = 1536 + lc; }
        else if (q < 40) { role = 4; lc = (q - 32) * 8; pcol = 1600 + lc; }
        else { role = 5; lc = (q - 40) * 8; pcol = 1664 + lc; }
        const float4 m0 = *(const float4*)(p.ev_mu + pcol), m1 = *(const float4*)(p.ev_mu + pcol + 4);
        float y[8]; unpack8(rw[0], y);
        bf16_t* dst = (role == 0 ? RS : role == 1 ? KS : role == 2 ? VS : role == 3 ? TW : role == 4 ? AL : SG) + lc;
        const int dstride = role == 5 ? 136 : 72;
#pragma unroll
        for (int i = 0; i < 8; ++i) {
            float x[8], s[8]; unpack8(rw[i + 1], x);
            s[0] = x[0] + m0.x * (y[0] - x[0]); s[1] = x[1] + m0.y * (y[1] - x[1]); s[2] = x[2] + m0.z * (y[2] - x[2]); s[3] = x[3] + m0.w * (y[3] - x[3]);
            s[4] = x[4] + m1.x * (y[4] - x[4]); s[5] = x[5] + m1.y * (y[5] - x[5]); s[6] = x[6] + m1.z * (y[6] - x[6]); s[7] = x[7] + m1.w * (y[7] - x[7]);
#pragma unroll
            for (int e = 0; e < 8; ++e) y[e] = x[e];
            if (role == 3) {
#pragma unroll
                for (int e = 0; e < 8; ++e) s[e] = tanhf_(s[e]);
            } else if (role == 5) {
#pragma unroll
                for (int e = 0; e < 8; ++e) s[e] = sigmoidf_(s[e]);
            }
            *(u32x4*)(dst + (tg * 8 + i) * dstride) = pack8(s);
        }
    }
    if (next_id >= 0) rw_pre_load(p, next_id, rw);
    __syncthreads();
#pragma unroll 1
    for (int q = 0; q < 2; ++q) {
        const int T = wave * 2 + q, ti = T >> 2, cj = T & 3;
        f32x4v aw, aa, ag; aw[0] = 0.f; aw[1] = 0.f; aw[2] = 0.f; aw[3] = 0.f; aa = aw; ag = aw;
#pragma unroll
        for (int k0 = 0; k0 < 64; k0 += 32) {
            aw = MFMA16(frag_rm(TW + ti * 16 * 72 + k0, 72, lane), frag_tr(w2h + k0 * 72 + cj * 16, 72, lane), aw);
            aa = MFMA16(frag_rm(AL + ti * 16 * 72 + k0, 72, lane), frag_tr(a2h + k0 * 72 + cj * 16, 72, lane), aa);
        }
#pragma unroll
        for (int k0 = 0; k0 < 128; k0 += 32) ag = MFMA16(frag_tr(g2h + k0 * 72 + cj * 16, 72, lane), frag_rm(SG + ti * 16 * 136 + k0, 136, lane), ag);
        const int cc = cj * 16 + li;
        const float* PRM = (const float*)(lds0 + 131072);
        const float w0 = PRM[cc], a0 = PRM[64 + cc];
        float ldv[4];
#pragma unroll
        for (int r = 0; r < 4; ++r) {
            const int t = ti * 16 + 4 * g + r;
            ldv[r] = -0.6065306597126334f * sigmoidf_(aw[r] + w0);
            AG[t * 72 + cc] = f2bf(sigmoidf_(aa[r] + a0));
        }
        { u32x2 o_; o_.x = pack2(ag[0], ag[1]); o_.y = pack2(ag[2], ag[3]); __builtin_nontemporal_store(o_, (u32x2*)(AUX + (tok0 + ti * 16 + li) * D + 512 + hh * 64 + cj * 16 + 4 * g)); }
        ldv[1] += ldv[0]; ldv[2] += ldv[1]; ldv[3] += ldv[2];
        const float s16 = __shfl_up(ldv[3], 16), s32 = __shfl_up(ldv[3], 32), s48 = __shfl_up(ldv[3], 48);
        const float off = (g >= 1 ? s16 : 0.f) + (g >= 2 ? s32 : 0.f) + (g >= 3 ? s48 : 0.f);
#pragma unroll
        for (int r = 0; r < 4; ++r) LD[(ti * 16 + 4 * g + r) * 68 + cc] = ldv[r] + off;
        if (g == 3) TT[ti * 64 + cc] = ldv[3] + off;
    }
    __syncthreads();
    {
        const int t = tid >> 3, part = tid & 7, c0 = part * 8;
        float rs[8], ks[8], vs[8], ag[8];
        unpack8(*(const u32x4*)(RS + t * 72 + c0), rs); unpack8(*(const u32x4*)(KS + t * 72 + c0), ks); unpack8(*(const u32x4*)(VS + t * 72 + c0), vs); unpack8(*(const u32x4*)(AG + t * 72 + c0), ag);
        const float* PRM2 = (const float*)(lds0 + 131072);
        float kk[8], k2[8], bv[8], ss = 0.f, bon = 0.f;
#pragma unroll
        for (int e = 0; e < 8; ++e) {
            kk[e] = ks[e] * PRM2[128 + c0 + e]; ss += kk[e] * kk[e];
            k2[e] = ks[e] * (1.f + (ag[e] - 1.f) * PRM2[192 + c0 + e]);
            bon += rs[e] * k2[e] * PRM2[256 + c0 + e];
        }
        ss = red8(ss); bon = red8(bon);
        const float nrm = rsqrtf(ss + 1e-6f);
        float o1[8], o2[8], o3[8], o4[8], o5[8], o6[8];
#pragma unroll
        for (int e = 0; e < 8; ++e) {
            kk[e] *= nrm; bv[e] = kk[e] * ag[e];
            const int tiq = t >> 4; const float t0_ = TT[c0 + e], t1_ = TT[64 + c0 + e], t2_ = TT[128 + c0 + e];
            const float toff = (tiq >= 1 ? t0_ : 0.f) + (tiq >= 2 ? t1_ : 0.f) + (tiq >= 3 ? t2_ : 0.f);
            const float poff = ((t & 15) == 0 && t > 0) ? toff - (tiq == 1 ? t0_ : tiq == 2 ? t1_ : t2_) : toff;
            const float lc = LD[t * 68 + c0 + e] + toff, lcp = t ? LD[(t - 1) * 68 + c0 + e] + poff : 0.f, lcl = LD[63 * 68 + c0 + e] + t0_ + t1_ + t2_;
            const float eg = __expf(lc), egp = __expf(lcp), ei = __expf(-lc), eh = __expf(lcl - lc);
            o1[e] = rs[e] * eg; o2[e] = -kk[e] * egp; o3[e] = k2[e] * ei; o4[e] = bv[e] * ei; o5[e] = k2[e] * eh; o6[e] = bv[e] * eh;
            if (t == 0) GLs[c0 + e] = __expf(lcl);
            vs[e] *= bon;
        }
        __builtin_nontemporal_store(pack8(vs), (u32x4*)(AUX + (tok0 + t) * D + hh * 64 + c0));
        *(u32x4*)(Rt + t * 72 + c0) = pack8(o1); *(u32x4*)(At + t * 72 + c0) = pack8(o2); *(u32x4*)(Kt + t * 72 + c0) = pack8(o3);
        *(u32x4*)(Bt + t * 72 + c0) = pack8(o4); *(u32x4*)(Kh + t * 72 + c0) = pack8(o5); *(u32x4*)(Bh + t * 72 + c0) = pack8(o6);
        for (int i = tid; i < 64 * 72 / 2; i += NT) ((unsigned*)Tb)[i] = 0u;
        for (int i = tid; i < 32 * 24 / 2; i += NT) ((unsigned*)Wb)[i] = 0u;
    }
    __syncthreads();
    {
        const int ti = wave >> 1;
#pragma unroll 1
        for (int jj = 0; jj < 2; ++jj) {
            const int tj = (wave & 1) * 2 + jj, s = tj * 16 + li;
            f32x4v ab; ab[0] = 0.f; ab[1] = 0.f; ab[2] = 0.f; ab[3] = 0.f;
            if (tj <= ti) {
#pragma unroll
                for (int k0 = 0; k0 < 64; k0 += 32) ab = MFMA16(frag_rm(At + ti * 16 * 72 + k0, 72, lane), frag_rm(Bt + tj * 16 * 72 + k0, 72, lane), ab);
#pragma unroll
                for (int r = 0; r < 4; ++r) if (s >= ti * 16 + 4 * g + r) ab[r] = 0.f;
            }
#pragma unroll
            for (int r = 0; r < 4; ++r) { const int t = ti * 16 + 4 * g + r; Nb[t * 72 + s] = f2bf(-ab[r]); Nf[t * 68 + s] = -ab[r]; }
        }
    }
    __syncthreads();
    if (wave == 0) tri_inverse_wave(Nf, Nb, Tb, Wb, lane);
    else {
#pragma unroll 1
        for (int pos = wave - 1; pos < 16; pos += 7) {
            const int ti = pos >> 2, tj = pos & 3, s = tj * 16 + li;
            f32x4v rk, rb, ak; rk[0] = 0.f; rk[1] = 0.f; rk[2] = 0.f; rk[3] = 0.f; rb = rk; ak = rk;
            if (tj <= ti) {
#pragma unroll
                for (int k0 = 0; k0 < 64; k0 += 32) {
                    const bf16x8 fr = frag_rm(Rt + ti * 16 * 72 + k0, 72, lane), fa = frag_rm(At + ti * 16 * 72 + k0, 72, lane);
                    const bf16x8 fk = frag_rm(Kt + tj * 16 * 72 + k0, 72, lane), fb = frag_rm(Bt + tj * 16 * 72 + k0, 72, lane);
                    rk = MFMA16(fr, fk, rk); rb = MFMA16(fr, fb, rb); ak = MFMA16(fa, fk, ak);
                }
#pragma unroll
                for (int r = 0; r < 4; ++r) { const int t = ti * 16 + 4 * g + r;
                    if (s > t) { rk[r] = 0.f; rb[r] = 0.f; } if (s >= t) ak[r] = 0.f; }
            }
#pragma unroll
            for (int r = 0; r < 4; ++r) { const int t = ti * 16 + 4 * g + r; Ark[t * 72 + s] = f2bf(rk[r]); Arb[t * 72 + s] = f2bf(rb[r]); Aak[t * 72 + s] = f2bf(ak[r]); }
        }
    }
    __syncthreads();
#pragma unroll 1
    for (int q = 0; q < 2; ++q) {
        const int T = wave * 2 + q, ti = T >> 2, nj = T & 3;
        f32x4v x1, x2; x1[0] = 0.f; x1[1] = 0.f; x1[2] = 0.f; x1[3] = 0.f; x2 = x1;
#pragma unroll
        for (int k0 = 0; k0 < 64; k0 += 32) {
            const bf16x8 ft = frag_rm(Tb + ti * 16 * 72 + k0, 72, lane);
            x1 = MFMA16(ft, frag_tr(At + k0 * 72 + nj * 16, 72, lane), x1);
            x2 = MFMA16(ft, frag_tr(Aak + k0 * 72 + nj * 16, 72, lane), x2);
        }
#pragma unroll
        for (int r = 0; r < 4; ++r) { const int t = ti * 16 + 4 * g + r; Ap[t * 72 + nj * 16 + li] = f2bf(x1[r]); Wv[t * 72 + nj * 16 + li] = f2bf(x2[r]); }
    }
    __syncthreads();
#pragma unroll 1
    for (int q = 0; q < 2; ++q) {
        const int T = wave * 2 + q, ti = T >> 2, nj = T & 3;
        f32x4v x1, x2; x1[0] = 0.f; x1[1] = 0.f; x1[2] = 0.f; x1[3] = 0.f; x2 = x1;
#pragma unroll
        for (int k0 = 0; k0 < 64; k0 += 32) {
            const bf16x8 fb = frag_rm(Arb + ti * 16 * 72 + k0, 72, lane);
            x1 = MFMA16(fb, frag_tr(Ap + k0 * 72 + nj * 16, 72, lane), x1);
            x2 = MFMA16(fb, frag_tr(Wv + k0 * 72 + nj * 16, 72, lane), x2);
        }
#pragma unroll
        for (int r = 0; r < 4; ++r) { const int t = ti * 16 + 4 * g + r, n = nj * 16 + li;
            OutA[t * 72 + n] = f2bf(x1[r] + bf2f(Rt[t * 72 + n])); OutB[t * 72 + n] = f2bf(x2[r] + bf2f(Ark[t * 72 + n])); }
    }
#pragma unroll 1
    for (int q = 0; q < 2; ++q) {
        const int T = wave * 2 + q, mi = T >> 2, nj = T & 3;
        f32x4v x1, x2; x1[0] = 0.f; x1[1] = 0.f; x1[2] = 0.f; x1[3] = 0.f; x2 = x1;
#pragma unroll
        for (int k0 = 0; k0 < 64; k0 += 32) {
            const bf16x8 fb = frag_tr(Bh + k0 * 72 + nj * 16, 72, lane);
            x1 = MFMA16(frag_tr(Ap + k0 * 72 + mi * 16, 72, lane), fb, x1);
            x2 = MFMA16(frag_tr(Wv + k0 * 72 + mi * 16, 72, lane), fb, x2);
        }
#pragma unroll
        for (int r = 0; r < 4; ++r) { const int m = mi * 16 + 4 * g + r, n = nj * 16 + li;
            OutC[m * 72 + n] = f2bf(x1[r] + (m == n ? GLs[n] : 0.f)); OutD[m * 72 + n] = f2bf(x2[r] + bf2f(Kh[m * 72 + n])); }
    }
    __syncthreads();
    {
        const int t = tid >> 3, part = tid & 7;
        __builtin_nontemporal_store(*(const u32x4*)(OutA + t * 72 + part * 8), (u32x4*)(item + t * 128 + part * 16));
        __builtin_nontemporal_store(*(const u32x4*)(OutB + t * 72 + part * 8), (u32x4*)(item + 8192 + t * 128 + part * 16));
        __builtin_nontemporal_store(*(const u32x4*)(OutC + t * 72 + part * 8), (u32x4*)(item + 16384 + t * 128 + part * 16));
        __builtin_nontemporal_store(*(const u32x4*)(OutD + t * 72 + part * 8), (u32x4*)(item + 24576 + t * 128 + part * 16));
    }
    __syncthreads();
}

__device__ __forceinline__ void phase_pre0(const Params& p, char* lds) {
    u32x4 rw[9]; u32x4 hq8, hf8; bool hq_loaded = false;
    hq8 = u32x4{0u, 0u, 0u, 0u}; hf8 = hq8;
    if ((int)blockIdx.x < 2048) rw_pre_load(p, blockIdx.x, rw);
    int tab_hh = -1;
    for (int i = blockIdx.x; i < 4096; i += gridDim.x) {
        const int hh_i = (i >> 5) & 7;
        if (hh_i != tab_hh) {
            __syncthreads();
            float* PRM = (float*)(lds + 131072);
            if (threadIdx.x < 64) { const int ch = hh_i * 64 + threadIdx.x;
                PRM[threadIdx.x] = p.rw_w0[ch]; PRM[64 + threadIdx.x] = p.rw_a0[ch]; PRM[128 + threadIdx.x] = p.rw_k_k[ch]; PRM[192 + threadIdx.x] = p.rw_k_a[ch]; PRM[256 + threadIdx.x] = p.rw_r_k[ch];
                PRM[320 + threadIdx.x] = sigmoidf_(p.hg_lb[ch] - p.hg_lb[512 + ch]); }
            __syncthreads();
            tab_hh = hh_i;
        }
        if (i < 2048) rw_pre_item(p, lds, i, rw, (i + (int)gridDim.x < 2048) ? i + (int)gridDim.x : -1);
        else { if (!hq_loaded) { hg_pre_load(p, i - 2048, hq8, hf8); hq_loaded = true; }
            hg_pre_item(p, lds, i - 2048, hq8, hf8, (i + (int)gridDim.x < 4096) ? i + (int)gridDim.x - 2048 : -1); }
    }
}

template <bool RW>
__device__ __forceinline__ void seq64_unit(const Params& p, char* lds, int bb, int hh, int cg) {
    const int tid = threadIdx.x, lane = tid & 63, wave = tid >> 6, g = lane >> 4, li = lane & 15;
    unsigned char* ws = p.ws;
    const bf16_t* P = (const bf16_t*)(ws + WS_P);
    bf16_t* O16 = (bf16_t*)(ws + WS_XN);
    constexpr size_t ITEM = RW ? CHK_RW_ITEM : CHK_HG_ITEM;
    const unsigned char* chk = ws + (RW ? WS_CHK_RW : WS_CHK_HG) + (size_t)((bb * 8 + hh) * 32) * ITEM;
    constexpr int STG = 41984 + 512;
    bf16_t* St = (bf16_t*)(lds + 2 * STG);
    const int vcol = RW ? 1024 + hh * 64 + cg * 32 : 1792 + 1024 + hh * 64 + cg * 32;
    const int ocol = RW ? hh * 64 + cg * 32 : 512 + hh * 64 + cg * 32;
    const int mrow = tid >> 3, mc8 = tid & 7;
    const int vt = tid >> 2, vc = tid & 3;
    float mu[8];
#pragma unroll
    for (int e = 0; e < 8; ++e) mu[e] = RW ? p.ev_mu[vcol + vc * 8 + e] : 0.f;
    u32x4 rm0A, rm1A, rm2A, rm3A, rvA, rvpA, rm0B, rm1B, rm2B, rm3B, rvB, rvpB; float rglA = 0.f, rglB = 0.f;
    rm3A = u32x4{0u, 0u, 0u, 0u}; rvpA = rm3A; rvA = rm3A; rm3B = rm3A; rvpB = rm3A; rvB = rm3A;
#define SEQ_LOAD(c, X) do { const unsigned char* it = chk + (size_t)(c) * ITEM; \
        rm0##X = *(const u32x4*)(it + mrow * 128 + mc8 * 16); rm1##X = *(const u32x4*)(it + 8192 + mrow * 128 + mc8 * 16); rm2##X = *(const u32x4*)(it + 16384 + mrow * 128 + mc8 * 16); \
        if (RW) rm3##X = *(const u32x4*)(it + 24576 + mrow * 128 + mc8 * 16); else if (tid < 64) rgl##X = ((const float*)(it + 24576))[tid]; \
        if (tid < 256) { const size_t tk = (size_t)bb * SEQ + (c) * 64 + vt; rv##X = *(const u32x4*)(P + tk * EVEN_IN + vcol + vc * 8); \
            if (RW) { if ((c) * 64 + vt > 0) rvp##X = *(const u32x4*)(P + (tk - 1) * EVEN_IN + vcol + vc * 8); else rvp##X = u32x4{0u, 0u, 0u, 0u}; } } } while (0)
#define SEQ_STAGE(sb, X) do { char* sg_ = lds + (sb) * STG; \
        *(u32x4*)(sg_ + mrow * 144 + mc8 * 16) = rm0##X; *(u32x4*)(sg_ + 9216 + mrow * 144 + mc8 * 16) = rm1##X; \
        if (RW) { *(u32x4*)(sg_ + 18432 + mrow * 144 + mc8 * 16) = rm2##X; *(u32x4*)(sg_ + 27648 + mrow * 144 + mc8 * 16) = rm3##X; } \
        else { *(u32x4*)(sg_ + 27648 + mrow * 144 + mc8 * 16) = rm2##X; if (tid < 64) ((float*)(sg_ + 41984))[tid] = rgl##X; } \
        if (tid < 256) { u32x4 o_ = rv##X; \
            if (RW) { float a_[8], b_[8]; a_[0] = lo16(rv##X.x); a_[1] = hi16(rv##X.x); a_[2] = lo16(rv##X.y); a_[3] = hi16(rv##X.y); a_[4] = lo16(rv##X.z); a_[5] = hi16(rv##X.z); a_[6] = lo16(rv##X.w); a_[7] = hi16(rv##X.w); \
                b_[0] = lo16(rvp##X.x); b_[1] = hi16(rvp##X.x); b_[2] = lo16(rvp##X.y); b_[3] = hi16(rvp##X.y); b_[4] = lo16(rvp##X.z); b_[5] = hi16(rvp##X.z); b_[6] = lo16(rvp##X.w); b_[7] = hi16(rvp##X.w); \
                _Pragma("unroll") for (int e_ = 0; e_ < 8; ++e_) a_[e_] = a_[e_] + mu[e_] * (b_[e_] - a_[e_]); \
                o_.x = pack2(a_[0], a_[1]); o_.y = pack2(a_[2], a_[3]); o_.z = pack2(a_[4], a_[5]); o_.w = pack2(a_[6], a_[7]); } \
            *(u32x4*)(sg_ + 36864 + vt * 80 + vc * 16) = o_; } } while (0)
    SEQ_LOAD(0, A);
    SEQ_LOAD(1, B);
    for (int i = tid; i < 2 * 32 * 72 / 2; i += NT) ((unsigned*)St)[i] = 0u;
    SEQ_STAGE(0, A);
    SEQ_LOAD(2, A);
    f32x4v sacc; sacc[0] = 0.f; sacc[1] = 0.f; sacc[2] = 0.f; sacc[3] = 0.f;
    __syncthreads();
#define SEQ_COMPUTE(c) do { const int cur = (c) & 1; \
        const char* sg = lds + cur * STG; \
        const bf16_t* Rp = (const bf16_t*)sg; const bf16_t* Ay = (const bf16_t*)(sg + 9216); const bf16_t* Gc = (const bf16_t*)(sg + 18432); const bf16_t* Kc = (const bf16_t*)(sg + 27648); \
        const bf16_t* Vs = (const bf16_t*)(sg + 36864); const float* gL = (const float*)(sg + 41984); \
        const bf16_t* Sc = St + cur * 32 * 72; bf16_t* Sn = St + (cur ^ 1) * 32 * 72; \
        {   \
            const int ti = wave >> 1, vj = wave & 1; \
            f32x4v acc; acc[0] = 0.f; acc[1] = 0.f; acc[2] = 0.f; acc[3] = 0.f; \
_Pragma("unroll") \
            for (int k0 = 0; k0 < 64; k0 += 32) acc = MFMA16(frag_rm(Sc + vj * 16 * 72 + k0, 72, lane), frag_rm(Rp + ti * 16 * 72 + k0, 72, lane), acc); \
_Pragma("unroll") \
            for (int k0 = 0; k0 < 64; k0 += 32) acc = MFMA16(frag_tr(Vs + k0 * 40 + vj * 16, 40, lane), frag_rm(Ay + ti * 16 * 72 + k0, 72, lane), acc); \
            { u32x2 o_; o_.x = pack2(acc[0], acc[1]); o_.y = pack2(acc[2], acc[3]); *(u32x2*)(O16 + ((size_t)bb * SEQ + (c) * 64 + ti * 16 + li) * D + ocol + vj * 16 + 4 * g) = o_; } \
        } \
        {   \
            const int vi = wave >> 2, kj = wave & 3; \
            f32x4v t4; t4[0] = 0.f; t4[1] = 0.f; t4[2] = 0.f; t4[3] = 0.f; \
_Pragma("unroll") \
            for (int k0 = 0; k0 < 64; k0 += 32) t4 = MFMA16(frag_tr(Vs + k0 * 40 + vi * 16, 40, lane), frag_tr(Kc + k0 * 72 + kj * 16, 72, lane), t4); \
            if (RW) { \
_Pragma("unroll") \
                for (int k0 = 0; k0 < 64; k0 += 32) t4 = MFMA16(frag_rm(Sc + vi * 16 * 72 + k0, 72, lane), frag_tr(Gc + k0 * 72 + kj * 16, 72, lane), t4); \
                sacc = t4; \
            } else { const float gl = gL[kj * 16 + li]; \
_Pragma("unroll") \
                for (int r = 0; r < 4; ++r) sacc[r] = sacc[r] * gl + t4[r]; } \
_Pragma("unroll") \
            for (int r = 0; r < 4; ++r) Sn[(vi * 16 + 4 * g + r) * 72 + kj * 16 + li] = f2bf(sacc[r]); \
        } \
        __syncthreads(); } while (0)
#pragma unroll 1
    for (int c = 0; c < 32; c += 2) {
        SEQ_STAGE(1, B);
        if (c + 3 < 32) SEQ_LOAD(c + 3, B);
        SEQ_COMPUTE(c);
        if (c + 2 < 32) SEQ_STAGE(0, A);
        if (c + 4 < 32) SEQ_LOAD(c + 4, A);
        SEQ_COMPUTE(c + 1);
    }
#undef SEQ_COMPUTE
#undef SEQ_LOAD
#undef SEQ_STAGE
}

__device__ __forceinline__ void phase_mix0(const Params& p, char* lds) {
    for (int u = blockIdx.x; u < 256; u += gridDim.x) {
        const int v = u & 127, x = v & 7, j = v >> 3, pair = x * 8 + (j >> 1), bb = pair >> 3, hh = pair & 7, cg = j & 1;
        if (u < 128) seq64_unit<true>(p, lds, bb, hh, cg); else seq64_unit<false>(p, lds, bb, hh, cg);
        __syncthreads();
    }
}


constexpr size_t CHK_GD_ITEM = 90112;
constexpr size_t WS_CHK_GD = WS_ARENA;
static_assert(WS_CHK_GD + (size_t)1024 * CHK_GD_ITEM <= WS_END, "gdn chunk matrices fit the arena");

struct GdnRaw { u32x4 q[5], v[3]; float gb, gg; };
__device__ __forceinline__ void gdn_pre_load(const Params& p, int id, GdnRaw& R) {
    const int tid = threadIdx.x;
    const int bb = id >> 7, hh = (id >> 5) & 3, c = id & 31;
    const bf16_t* P = (const bf16_t*)(p.ws + WS_P);
    const size_t tok0 = (size_t)bb * SEQ + c * 64;
#pragma unroll
    for (int j = 0; j < 5; ++j) { const int i = tid + j * NT, row = i >> 5, ch = i & 31, t = row - 3;
        R.q[j] = u32x4{0u, 0u, 0u, 0u};
        if (i < 67 * 32 && c * 64 + t >= 0) R.q[j] = *(const u32x4*)(P + (tok0 + t) * P1_LD + (ch < 16 ? hh * 128 + ch * 8 : 512 + hh * 128 + (ch - 16) * 8)); }
#pragma unroll
    for (int j = 0; j < 3; ++j) { const int i = tid + j * NT, row = i >> 4, ch = i & 15, t = row - 3;
        R.v[j] = u32x4{0u, 0u, 0u, 0u};
        if (i < 67 * 16 && c * 64 + t >= 0) R.v[j] = *(const u32x4*)(P + (tok0 + t) * P1_LD + 1024 + hh * 128 + ch * 8); }
    R.gb = 0.f; R.gg = 0.f;
    if (tid < 64) { const float* GT = p.out; R.gb = GT[(tok0 + tid) * 16 + hh]; R.gg = GT[(tok0 + tid) * 16 + 4 + hh]; }
}
__device__ __forceinline__ void gdn_pre_item(const Params& p, char* lds0, int id, GdnRaw& R, int next_id) {
    const int tid = threadIdx.x, lane = tid & 63, wave = tid >> 6, g = lane >> 4, li = lane & 15;
    const int bb = id >> 7, hh = (id >> 5) & 3, c = id & 31;
    int lz = 0; asm volatile("" : "+s"(lz));
    char* lds = lds0 + lz;
    unsigned char* ws = p.ws;
    const bf16_t* P = (const bf16_t*)(ws + WS_P);
    const float* GT = p.out;
    unsigned char* item = ws + WS_CHK_GD + (size_t)id * CHK_GD_ITEM;
    constexpr int LQ = 136, LS = 72, LRQ = 264, LRV = 136;
    bf16_t* Qs = (bf16_t*)(lds + 0);
    bf16_t* Ks = (bf16_t*)(lds + 17408);
    bf16_t* RAWqk = (bf16_t*)(lds + 34816);
    bf16_t* Kt = (bf16_t*)(lds + 34816);
    bf16_t* Kte = (bf16_t*)(lds + 52224);
    bf16_t* RAWv = (bf16_t*)(lds + 70208);
    bf16_t* A1b = (bf16_t*)(lds + 70208);
    bf16_t* A2b = (bf16_t*)(lds + 79424);
    bf16_t* Tb = (bf16_t*)(lds + 88640);
    bf16_t* Tg = (bf16_t*)(lds + 97856);
    bf16_t* Wv = (bf16_t*)(lds + 107072);
    bf16_t* Wve = (bf16_t*)(lds + 116288);
    float* A2f = (float*)(lds + 125504);
    bf16_t* Wb = (bf16_t*)(lds + 142912);
    float* gam = (float*)(lds + 144448); float* be = gam + 64; float* egam = be + 64; float* edl = egam + 64; float* misc = edl + 64;
    const size_t tok0 = (size_t)bb * SEQ + c * 64;
#pragma unroll
    for (int j = 0; j < 5; ++j) { const int i = tid + j * NT, row = i >> 5, ch = i & 31; if (i < 67 * 32) *(u32x4*)(RAWqk + row * LRQ + ch * 8) = R.q[j]; }
#pragma unroll
    for (int j = 0; j < 3; ++j) { const int i = tid + j * NT, row = i >> 4, ch = i & 15; if (i < 67 * 16) *(u32x4*)(RAWv + row * LRV + ch * 8) = R.v[j]; }
    const float gb_ = R.gb, gg_ = R.gg;
    if (next_id >= 0) gdn_pre_load(p, next_id, R);
    if (wave == 0) {
        const float negA = -__expf(p.gd_a_log[hh]), dtb = p.gd_dt_bias[hh];
        const float bev = sigmoidf_(gb_);
        const float gg = negA * softplusf_(gg_ + dtb);
        float gc = gg;
#pragma unroll
        for (int off = 1; off < 64; off <<= 1) { const float y = __shfl_up(gc, off); if (lane >= off) gc += y; }
        const float gl = __shfl(gc, 63);
        gam[lane] = gc; be[lane] = bev; egam[lane] = __expf(gc); edl[lane] = __expf(gl - gc);
        if (lane == 0) misc[0] = __expf(gl);
    }
    __syncthreads();
    {
        const int lt = tid >> 4, lc = tid & 15;
        const float* CWT = (const float*)(lds0 + 145664);
#pragma unroll 1
        for (int grp = 0; grp < 3; ++grp) {
            float4 wA[4], wB[4];
#pragma unroll
            for (int r = 0; r < 4; ++r) { wA[r] = *(const float4*)(CWT + r * 384 + grp * 128 + lc * 8); wB[r] = *(const float4*)(CWT + r * 384 + grp * 128 + lc * 8 + 4); }
#pragma unroll 1
            for (int tt = 0; tt < 2; ++tt) {
                const int t = lt + 32 * tt;
                float y[8];
#pragma unroll
                for (int e = 0; e < 8; ++e) y[e] = 0.f;
#pragma unroll
                for (int r = 0; r < 4; ++r) {
                    const bf16_t* rp = grp < 2 ? RAWqk + (t + r) * LRQ + grp * 128 + lc * 8 : RAWv + (t + r) * LRV + lc * 8;
                    float x[8]; unpack8(*(const u32x4*)rp, x);
                    y[0] += wA[r].x * x[0]; y[1] += wA[r].y * x[1]; y[2] += wA[r].z * x[2]; y[3] += wA[r].w * x[3];
                    y[4] += wB[r].x * x[4]; y[5] += wB[r].y * x[5]; y[6] += wB[r].z * x[6]; y[7] += wB[r].w * x[7];
                }
                float ss = 0.f;
#pragma unroll
                for (int e = 0; e < 8; ++e) { y[e] = siluf_(y[e]); ss += y[e] * y[e]; }
                if (grp < 2) { ss = red16(ss); const float nrm = rsqrtf(ss + 1e-6f) * (grp == 0 ? 0.08838834764831845f : 1.f);
#pragma unroll
                    for (int e = 0; e < 8; ++e) y[e] *= nrm;
                    *(u32x4*)((grp == 0 ? Qs : Ks) + t * LQ + lc * 8) = pack8(y);
                } else *(u32x4*)(item + 73728 + t * 256 + lc * 16) = pack8(y);
            }
        }
    }
    __syncthreads();
    {
        for (int i = tid; i < 64 * LS / 2; i += NT) ((unsigned*)Tb)[i] = 0u;
        for (int i = tid; i < 32 * 24 / 2; i += NT) ((unsigned*)Wb)[i] = 0u;
        const int ti = wave >> 1;
#pragma unroll 1
        for (int jj = 0; jj < 2; ++jj) {
            const int tj = (wave & 1) * 2 + jj, s = tj * 16 + li;
            f32x4v aq, ak; aq[0] = 0.f; aq[1] = 0.f; aq[2] = 0.f; aq[3] = 0.f; ak = aq;
            if (tj <= ti) {
#pragma unroll
                for (int k0 = 0; k0 < 128; k0 += 32) {
                    const bf16x8 kb = frag_rm(Ks + tj * 16 * LQ + k0, LQ, lane);
                    aq = MFMA16(frag_rm(Qs + ti * 16 * LQ + k0, LQ, lane), kb, aq);
                    ak = MFMA16(frag_rm(Ks + ti * 16 * LQ + k0, LQ, lane), kb, ak);
                }
                const float gs = gam[s];
#pragma unroll
                for (int r = 0; r < 4; ++r) { const int t = ti * 16 + 4 * g + r; const float dcy = __expf(fminf(gam[t] - gs, 0.f));
                    aq[r] = (s <= t) ? aq[r] * dcy : 0.f; ak[r] = (s < t) ? ak[r] * be[t] * dcy : 0.f; }
            }
#pragma unroll
            for (int r = 0; r < 4; ++r) { const int t = ti * 16 + 4 * g + r; A1b[t * LS + s] = f2bf(aq[r]); A2b[t * LS + s] = f2bf(ak[r]); A2f[t * 68 + s] = ak[r]; }
        }
    }
    __syncthreads();
    if (wave == 0) tri_inverse_wave(A2f, A2b, Tb, Wb, lane);
    __syncthreads();
    {
        const int t = tid >> 3, s0 = (tid & 7) * 8;
        float tv[8], a[8], b[8], cc[8]; unpack8(*(const u32x4*)(Tb + t * LS + s0), tv);
        const float ed = edl[t];
#pragma unroll
        for (int e = 0; e < 8; ++e) { const float bs = be[s0 + e]; b[e] = tv[e] * bs; a[e] = b[e] * egam[s0 + e]; cc[e] = b[e] * ed; }
        *(u32x4*)(Tg + t * LS + s0) = pack8(a); *(u32x4*)(Wv + t * LS + s0) = pack8(b); *(u32x4*)(Wve + t * LS + s0) = pack8(cc);
    }
    __syncthreads();
#pragma unroll 1
    for (int q = 0; q < 4; ++q) {
        const int T = wave * 4 + q, ti = T >> 3, nj = T & 7;
        f32x4v x; x[0] = 0.f; x[1] = 0.f; x[2] = 0.f; x[3] = 0.f;
#pragma unroll
        for (int k0 = 0; k0 < 64; k0 += 32) x = MFMA16(frag_rm(Tg + ti * 16 * LS + k0, LS, lane), frag_tr(Ks + k0 * LQ + nj * 16, LQ, lane), x);
#pragma unroll
        for (int r = 0; r < 4; ++r) { const int t = ti * 16 + 4 * g + r; Kt[t * LQ + nj * 16 + li] = f2bf(x[r]); Kte[t * LQ + nj * 16 + li] = f2bf(x[r] * edl[t]); }
    }
    __syncthreads();
#pragma unroll 1
    for (int q = 0; q < 4; ++q) {
        const int T = wave * 4 + q, ti = T >> 3, nj = T & 7;
        f32x4v x; x[0] = 0.f; x[1] = 0.f; x[2] = 0.f; x[3] = 0.f;
#pragma unroll
        for (int k0 = 0; k0 < 64; k0 += 32) x = MFMA16(frag_rm(A1b + ti * 16 * LS + k0, LS, lane), frag_tr(Kt + k0 * LQ + nj * 16, LQ, lane), x);
#pragma unroll
        for (int r = 0; r < 4; ++r) { const int t = ti * 16 + 4 * g + r; bf16_t* qp = Qs + t * LQ + nj * 16 + li; *qp = f2bf(egam[t] * bf2f(*qp) - x[r]); }
    }
#pragma unroll 1
    for (int q = 0; q < 2; ++q) {
        const int T = wave * 2 + q, ti = T >> 2, nj = T & 3;
        f32x4v x; x[0] = 0.f; x[1] = 0.f; x[2] = 0.f; x[3] = 0.f;
#pragma unroll
        for (int k0 = 0; k0 < 64; k0 += 32) x = MFMA16(frag_tr(Wv + k0 * LS + nj * 16, LS, lane), frag_rm(A1b + ti * 16 * LS + k0, LS, lane), x);
        { u32x2 o_; o_.x = pack2(x[0], x[1]); o_.y = pack2(x[2], x[3]); *(u32x2*)((bf16_t*)(item + 16384) + (ti * 16 + li) * 64 + nj * 16 + 4 * g) = o_; }
    }
    __syncthreads();
    {
        const int t = tid >> 3, part = tid & 7;
        *(u32x4*)(item + t * 256 + part * 32) = *(const u32x4*)(Qs + t * LQ + part * 16);
        *(u32x4*)(item + t * 256 + part * 32 + 16) = *(const u32x4*)(Qs + t * LQ + part * 16 + 8);
    }
    {
        const float gl = misc[0];
#pragma unroll 1
        for (int q = 0; q < 8; ++q) {
            const int T = wave * 8 + q, mi = T >> 3, nj = T & 7;
            f32x4v x; x[0] = 0.f; x[1] = 0.f; x[2] = 0.f; x[3] = 0.f;
#pragma unroll
            for (int k0 = 0; k0 < 64; k0 += 32) x = MFMA16(frag_tr(Ks + k0 * LQ + nj * 16, LQ, lane), frag_tr(Kte + k0 * LQ + mi * 16, LQ, lane), x);
            { const int m = mi * 16 + li, n0 = nj * 16 + 4 * g; float y[4];
#pragma unroll
                for (int r = 0; r < 4; ++r) y[r] = (m == n0 + r ? gl : 0.f) - x[r];
                u32x2 o_; o_.x = pack2(y[0], y[1]); o_.y = pack2(y[2], y[3]); *(u32x2*)((bf16_t*)(item + 24576) + m * 128 + n0) = o_; }
        }
#pragma unroll 1
        for (int q = 0; q < 4; ++q) {
            const int T = wave * 4 + q, mi = T >> 3, nj = T & 7;
            f32x4v x; x[0] = 0.f; x[1] = 0.f; x[2] = 0.f; x[3] = 0.f;
#pragma unroll
            for (int k0 = 0; k0 < 64; k0 += 32) x = MFMA16(frag_tr(Ks + k0 * LQ + nj * 16, LQ, lane), frag_tr(Wve + k0 * LS + mi * 16, LS, lane), x);
            { u32x2 o_; o_.x = pack2(x[0], x[1]); o_.y = pack2(x[2], x[3]); *(u32x2*)((bf16_t*)(item + 57344) + (mi * 16 + li) * 128 + nj * 16 + 4 * g) = o_; }
        }
    }
    __syncthreads();
}

__device__ __forceinline__ void gdn_seq_unit(const Params& p, char* lds, int bb, int hh, int cg) {
    const int tid = threadIdx.x, lane = tid & 63, wave = tid >> 6, g = lane >> 4, li = lane & 15;
    unsigned char* ws = p.ws;
    bf16_t* O16 = (bf16_t*)(ws + WS_XN);
    const unsigned char* chk = ws + WS_CHK_GD + (size_t)((bb * 4 + hh) * 32) * CHK_GD_ITEM;
    constexpr int LQ = 136, LS = 72, LV = 40;
    bf16_t* Rp = (bf16_t*)(lds + 0);
    bf16_t* Ay = (bf16_t*)(lds + 17408);
    bf16_t* Gc = (bf16_t*)(lds + 26624);
    bf16_t* Kc = (bf16_t*)(lds + 61440);
    bf16_t* Vs = (bf16_t*)(lds + 78848);
    bf16_t* St = (bf16_t*)(lds + 83968);
    const int r8 = tid >> 3, c8 = tid & 7;
    const int r16 = tid >> 4, c16 = tid & 15, vt = tid >> 2, vc = tid & 3;
    u32x4 q0, q1, ao, g0, g1, g2, g3, k0r, k1r, rv;
    rv.x = 0u; rv.y = 0u; rv.z = 0u; rv.w = 0u;
#define GSEQ_LOAD(c) do { const unsigned char* it = chk + (size_t)(c) * CHK_GD_ITEM; \
        q0 = *(const u32x4*)(it + r16 * 256 + c16 * 16); q1 = *(const u32x4*)(it + (r16 + 32) * 256 + c16 * 16); \
        ao = *(const u32x4*)(it + 16384 + r8 * 128 + c8 * 16); \
        g0 = *(const u32x4*)(it + 24576 + r16 * 256 + c16 * 16); g1 = *(const u32x4*)(it + 24576 + (r16 + 32) * 256 + c16 * 16); \
        g2 = *(const u32x4*)(it + 24576 + (r16 + 64) * 256 + c16 * 16); g3 = *(const u32x4*)(it + 24576 + (r16 + 96) * 256 + c16 * 16); \
        k0r = *(const u32x4*)(it + 57344 + r16 * 256 + c16 * 16); k1r = *(const u32x4*)(it + 57344 + (r16 + 32) * 256 + c16 * 16); \
        if (tid < 256) rv = *(const u32x4*)(it + 73728 + vt * 256 + cg * 64 + vc * 16); } while (0)
#define GSEQ_STAGE() do { \
        *(u32x4*)(Rp + r16 * LQ + c16 * 8) = q0; *(u32x4*)(Rp + (r16 + 32) * LQ + c16 * 8) = q1; *(u32x4*)(Ay + r8 * LS + c8 * 8) = ao; \
        *(u32x4*)(Gc + r16 * LQ + c16 * 8) = g0; *(u32x4*)(Gc + (r16 + 32) * LQ + c16 * 8) = g1; *(u32x4*)(Gc + (r16 + 64) * LQ + c16 * 8) = g2; *(u32x4*)(Gc + (r16 + 96) * LQ + c16 * 8) = g3; \
        *(u32x4*)(Kc + r16 * LQ + c16 * 8) = k0r; *(u32x4*)(Kc + (r16 + 32) * LQ + c16 * 8) = k1r; \
        if (tid < 256) *(u32x4*)(Vs + vt * LV + vc * 8) = rv; } while (0)
    GSEQ_LOAD(0);
    for (int i = tid; i < 2 * 32 * LQ / 2; i += NT) ((unsigned*)St)[i] = 0u;
    for (int c = 0; c < 32; ++c) {
        const int cur = c & 1;
        GSEQ_STAGE();
        __syncthreads();
        if (c + 1 < 32) GSEQ_LOAD(c + 1);
        const bf16_t* Sc = St + cur * 32 * LQ; bf16_t* Sn = St + (cur ^ 1) * 32 * LQ;
        {
            const int ti = wave >> 1, vj = wave & 1;
            f32x4v acc; acc[0] = 0.f; acc[1] = 0.f; acc[2] = 0.f; acc[3] = 0.f;
#pragma unroll
            for (int k0 = 0; k0 < 128; k0 += 32) acc = MFMA16(frag_rm(Sc + vj * 16 * LQ + k0, LQ, lane), frag_rm(Rp + ti * 16 * LQ + k0, LQ, lane), acc);
#pragma unroll
            for (int k0 = 0; k0 < 64; k0 += 32) acc = MFMA16(frag_tr(Vs + k0 * LV + vj * 16, LV, lane), frag_rm(Ay + ti * 16 * LS + k0, LS, lane), acc);
            { u32x2 o_; o_.x = pack2(acc[0], acc[1]); o_.y = pack2(acc[2], acc[3]); *(u32x2*)(O16 + ((size_t)bb * SEQ + c * 64 + ti * 16 + li) * D + hh * 128 + cg * 32 + vj * 16 + 4 * g) = o_; }
        }
#pragma unroll
        for (int vi = 0; vi < 2; ++vi) {
            f32x4v t4; t4[0] = 0.f; t4[1] = 0.f; t4[2] = 0.f; t4[3] = 0.f;
#pragma unroll
            for (int k0 = 0; k0 < 64; k0 += 32) t4 = MFMA16(frag_tr(Vs + k0 * LV + vi * 16, LV, lane), frag_tr(Kc + k0 * LQ + wave * 16, LQ, lane), t4);
#pragma unroll
            for (int k0 = 0; k0 < 128; k0 += 32) t4 = MFMA16(frag_rm(Sc + vi * 16 * LQ + k0, LQ, lane), frag_tr(Gc + k0 * LQ + wave * 16, LQ, lane), t4);
#pragma unroll
            for (int r = 0; r < 4; ++r) Sn[(vi * 16 + 4 * g + r) * LQ + wave * 16 + li] = f2bf(t4[r]);
        }
        __syncthreads();
    }
#undef GSEQ_LOAD
#undef GSEQ_STAGE
}


constexpr size_t CHK_ML_ITEM = 9472;
constexpr size_t WS_CHK_ML = WS_CHK_GD + (size_t)1024 * CHK_GD_ITEM;
static_assert(WS_CHK_ML + (size_t)1024 * CHK_ML_ITEM <= WS_END, "mlstm chunk data fits the arena");

__device__ __forceinline__ void mlstm_pre_item(const Params& p, char* lds, int id) {
    const int tid = threadIdx.x, lane = tid & 63, wave = tid >> 6, g = lane >> 4, li = lane & 15;
    const int bb = id >> 7, hh = (id >> 5) & 3, c = id & 31;
    unsigned char* ws = p.ws;
    const bf16_t* P = (const bf16_t*)(ws + WS_P);
    const float* GT = p.out;
    unsigned char* item = ws + WS_CHK_ML + (size_t)id * CHK_ML_ITEM;
    constexpr int LQ = 136, LS = 72;
    bf16_t* Qs = (bf16_t*)lds;
    bf16_t* Ks = Qs + 64 * LQ;
    bf16_t* SC = Ks + 64 * LQ;
    float* fl = (float*)(SC + 64 * LS);
    float* zs = fl; float* Mt = fl + 64; float* rsum = fl + 128; float* summ = fl + 192;
    const float scale = 0.08838834764831845f;
    const float ib = p.ml_i_bias[hh], fb = p.ml_f_bias[hh];
    const size_t tokb = (size_t)bb * SEQ;
    {
        const int qt0 = tid >> 4, qc = tid & 15;
        const bf16_t* qsrc = P + (tokb + c * 64 + qt0) * P1_LD + 2048 + hh * 128 + qc * 8;
        *(u32x4*)(Qs + qt0 * LQ + qc * 8) = *(const u32x4*)qsrc; *(u32x4*)(Qs + (qt0 + 32) * LQ + qc * 8) = *(const u32x4*)(qsrc + (size_t)32 * P1_LD);
        *(u32x4*)(Ks + qt0 * LQ + qc * 8) = *(const u32x4*)(qsrc + 512); *(u32x4*)(Ks + (qt0 + 32) * LQ + qc * 8) = *(const u32x4*)(qsrc + 512 + (size_t)32 * P1_LD);
    }
    for (int cp = wave; cp < c; cp += 8) {
        const size_t tok = tokb + cp * 64 + lane;
        const float lf = -softplusf_(-(GT[tok * 16 + 12 + hh] + fb)), ig = GT[tok * 16 + 8 + hh] + ib;
        float bc = lf;
#pragma unroll
        for (int off = 1; off < 64; off <<= 1) { const float y = __shfl_up(bc, off); if (lane >= off) bc += y; }
        float z = ig - bc;
#pragma unroll
        for (int off = 32; off >= 1; off >>= 1) z = fmaxf(z, __shfl_xor(z, off));
        if (lane == 63) { summ[cp * 2] = bc; summ[cp * 2 + 1] = z; }
    }
    __syncthreads();
    if (wave == 0) {
        float m = 0.f;
        for (int cp = 0; cp < c; ++cp) m = summ[cp * 2] + fmaxf(m, summ[cp * 2 + 1]);
        const size_t tok = tokb + c * 64 + lane;
        const float lf = -softplusf_(-(GT[tok * 16 + 12 + hh] + fb)), ig = GT[tok * 16 + 8 + hh] + ib;
        float bc = lf;
#pragma unroll
        for (int off = 1; off < 64; off <<= 1) { const float y = __shfl_up(bc, off); if (lane >= off) bc += y; }
        const float z = ig - bc;
        float cz = z;
#pragma unroll
        for (int off = 1; off < 64; off <<= 1) { const float y = __shfl_up(cz, off); if (lane >= off) cz = fmaxf(cz, y); }
        const float Mtv = fmaxf(m, cz);
        const float Ml = __shfl(Mtv, 63);
        zs[lane] = z; Mt[lane] = Mtv; rsum[lane] = 0.f;
        float* sc_f = (float*)(item + 8192);
        sc_f[lane] = __expf(m - Mtv); sc_f[64 + lane] = __expf(-(bc + Mtv)); sc_f[128 + lane] = __expf(z - Ml) * scale;
        if (lane == 0) sc_f[256] = __expf(m - Ml);
    }
    __syncthreads();
    {
        const int ti = wave >> 1;
        float rs0 = 0.f, rs1 = 0.f, rs2 = 0.f, rs3 = 0.f;
#pragma unroll 1
        for (int jj = 0; jj < 2; ++jj) {
            const int tj = (wave & 1) * 2 + jj, s = tj * 16 + li;
            f32x4v acc; acc[0] = 0.f; acc[1] = 0.f; acc[2] = 0.f; acc[3] = 0.f;
            if (tj <= ti) {
#pragma unroll
                for (int k0 = 0; k0 < 128; k0 += 32) acc = MFMA16(frag_rm(Qs + ti * 16 * LQ + k0, LQ, lane), frag_rm(Ks + tj * 16 * LQ + k0, LQ, lane), acc);
                const float zv = zs[s];
#pragma unroll
                for (int r = 0; r < 4; ++r) { const int t = ti * 16 + 4 * g + r; acc[r] = (s <= t) ? acc[r] * scale * __expf(zv - Mt[t]) : 0.f; }
                rs0 += acc[0]; rs1 += acc[1]; rs2 += acc[2]; rs3 += acc[3];
            }
#pragma unroll
            for (int r = 0; r < 4; ++r) SC[(ti * 16 + 4 * g + r) * LS + s] = f2bf(acc[r]);
        }
        rs0 = red16(rs0); rs1 = red16(rs1); rs2 = red16(rs2); rs3 = red16(rs3);
        if (li == 0) { atomicAdd(&rsum[ti * 16 + 4 * g + 0], rs0); atomicAdd(&rsum[ti * 16 + 4 * g + 1], rs1); atomicAdd(&rsum[ti * 16 + 4 * g + 2], rs2); atomicAdd(&rsum[ti * 16 + 4 * g + 3], rs3); }
    }
    __syncthreads();
    { const int t = tid >> 3, part = tid & 7; *(u32x4*)(item + t * 128 + part * 16) = *(const u32x4*)(SC + t * LS + part * 8); }
    if (tid < 64) ((float*)(item + 8192))[192 + tid] = rsum[tid];
    __syncthreads();
}

__device__ __forceinline__ void mlstm_seq_unit(const Params& p, char* lds, int bb, int hh, int cg) {
    const int tid = threadIdx.x, lane = tid & 63, wave = tid >> 6, g = lane >> 4, li = lane & 15;
    unsigned char* ws = p.ws;
    const bf16_t* P = (const bf16_t*)(ws + WS_P);
    bf16_t* O16 = (bf16_t*)(ws + WS_XN);
    const unsigned char* chk = ws + WS_CHK_ML + (size_t)((bb * 4 + hh) * 32) * CHK_ML_ITEM;
    constexpr int LQ = 136, LV = 40, LS = 72;
    constexpr int STG = 55552;
    bf16_t* Ct = (bf16_t*)(lds + 2 * STG);
    float* nvec = (float*)(lds + 2 * STG + 2 * 32 * LQ * 2);
    for (int i = tid; i < 2 * 32 * LQ / 2; i += NT) ((unsigned*)Ct)[i] = 0u;
    if (tid < 256) nvec[tid] = 0.f;
    f32x4v cacc[2];
#pragma unroll
    for (int v = 0; v < 2; ++v) { cacc[v][0] = 0.f; cacc[v][1] = 0.f; cacc[v][2] = 0.f; cacc[v][3] = 0.f; }
    const int qt0 = tid >> 4, qc = tid & 15, vt = tid >> 2, vc = tid & 3, st = tid >> 3, sp = tid & 7;
    const bf16_t* qsrc = P + ((size_t)bb * SEQ + qt0) * P1_LD + 2048 + hh * 128 + qc * 8;
    const bf16_t* ksrc = qsrc + 512;
    const bf16_t* vsrc = P + ((size_t)bb * SEQ + vt) * P1_LD + 3072 + hh * 128 + cg * 32 + vc * 8;
    u32x4 rq0, rq1, rk0, rk1, rv, rs; float s_iw = 0.f, s_emt = 0.f, s_wsc = 0.f, s_rs = 0.f, s_dec = 0.f, v_wsc = 0.f;
    rv.x = 0u; rv.y = 0u; rv.z = 0u; rv.w = 0u;
#define MSEQ_LOAD(c) do { const size_t adv = (size_t)((c) * 64) * P1_LD; const unsigned char* it = chk + (size_t)(c) * CHK_ML_ITEM; const float* sf = (const float*)(it + 8192); \
        rq0 = *(const u32x4*)(qsrc + adv); rq1 = *(const u32x4*)(qsrc + adv + (size_t)32 * P1_LD); rk0 = *(const u32x4*)(ksrc + adv); rk1 = *(const u32x4*)(ksrc + adv + (size_t)32 * P1_LD); \
        rs = *(const u32x4*)(it + st * 128 + sp * 16); \
        if (tid < 256) { rv = *(const u32x4*)(vsrc + adv); v_wsc = sf[128 + vt]; } \
        if (tid < 64) { s_iw = sf[tid]; s_emt = sf[64 + tid]; s_wsc = sf[128 + tid]; s_rs = sf[192 + tid]; s_dec = sf[256]; } } while (0)
#define MSEQ_STAGE(sb) do { char* sg_ = lds + (sb) * STG; bf16_t* Qs_ = (bf16_t*)sg_; bf16_t* Ks_ = Qs_ + 64 * LQ; bf16_t* Vs_ = Ks_ + 64 * LQ; bf16_t* VWs_ = Vs_ + 64 * LV; bf16_t* SC_ = VWs_ + 64 * LV; float* fl_ = (float*)(SC_ + 64 * LS); \
        *(u32x4*)(Qs_ + qt0 * LQ + qc * 8) = rq0; *(u32x4*)(Qs_ + (qt0 + 32) * LQ + qc * 8) = rq1; \
        *(u32x4*)(Ks_ + qt0 * LQ + qc * 8) = rk0; *(u32x4*)(Ks_ + (qt0 + 32) * LQ + qc * 8) = rk1; \
        *(u32x4*)(SC_ + st * LS + sp * 8) = rs; \
        if (tid < 256) { *(u32x4*)(Vs_ + vt * LV + vc * 8) = rv; float x_[8]; unpack8(rv, x_); \
            _Pragma("unroll") for (int e_ = 0; e_ < 8; ++e_) x_[e_] *= v_wsc; \
            *(u32x4*)(VWs_ + vt * LV + vc * 8) = pack8(x_); } \
        if (tid < 64) { fl_[tid] = s_iw; fl_[64 + tid] = s_emt; fl_[128 + tid] = s_wsc; fl_[192 + tid] = s_rs; if (tid == 0) fl_[256] = s_dec; } } while (0)
    MSEQ_LOAD(0);
    MSEQ_STAGE(0);
    MSEQ_LOAD(1);
    __syncthreads();
    for (int c = 0; c < 32; ++c) {
        const int cur = c & 1, nxt = cur ^ 1;
        if (c + 1 < 32) MSEQ_STAGE(nxt);
        if (c + 2 < 32) MSEQ_LOAD(c + 2);
        const char* sg = lds + cur * STG;
        const bf16_t* Qs = (const bf16_t*)sg; const bf16_t* Ks = Qs + 64 * LQ; const bf16_t* Vs = Ks + 64 * LQ; const bf16_t* VWs = Vs + 64 * LV; const bf16_t* SC = VWs + 64 * LV;
        const float* iw = (const float*)(SC + 64 * LS); const float* emt = iw + 64; const float* wsc = emt + 64; const float* rsum = wsc + 64; const float* misc = rsum + 64;
        const float* ncur = nvec + cur * 128; float* nnxt = nvec + nxt * 128;
        {
            const int ti = wave >> 1, vj = wave & 1;
            f32x4v acc; acc[0] = 0.f; acc[1] = 0.f; acc[2] = 0.f; acc[3] = 0.f;
            const bf16_t* Cc = Ct + cur * 32 * LQ;
#pragma unroll
            for (int k0 = 0; k0 < 128; k0 += 32) acc = MFMA16(frag_rm(Cc + vj * 16 * LQ + k0, LQ, lane), frag_rm(Qs + ti * 16 * LQ + k0, LQ, lane), acc);
            const int t = ti * 16 + li; const float iwt = iw[t];
#pragma unroll
            for (int r = 0; r < 4; ++r) acc[r] *= iwt;
#pragma unroll
            for (int k0 = 0; k0 < 64; k0 += 32) acc = MFMA16(frag_tr(Vs + k0 * LV + vj * 16, LV, lane), frag_rm(SC + ti * 16 * LS + k0, LS, lane), acc);
            float qn = 0.f;
#pragma unroll
            for (int j8 = 0; j8 < 4; ++j8) { float x[8]; unpack8(*(const u32x4*)(Qs + (ti * 16 + li) * LQ + g * 32 + j8 * 8), x);
                const float4 n0 = *(const float4*)(ncur + g * 32 + j8 * 8), n1 = *(const float4*)(ncur + g * 32 + j8 * 8 + 4);
                qn += x[0] * n0.x + x[1] * n0.y + x[2] * n0.z + x[3] * n0.w + x[4] * n1.x + x[5] * n1.y + x[6] * n1.z + x[7] * n1.w; }
            qn += __shfl_xor(qn, 16); qn += __shfl_xor(qn, 32);
            {
                const float den = iwt * qn + rsum[t], inv = 1.0f / fmaxf(fabsf(den), emt[t]);
                u32x2 o_; o_.x = pack2(acc[0] * inv, acc[1] * inv); o_.y = pack2(acc[2] * inv, acc[3] * inv);
                *(u32x2*)(O16 + ((size_t)bb * SEQ + c * 64 + t) * D + 512 + hh * 128 + cg * 32 + vj * 16 + 4 * g) = o_;
            }
        }
        {
            const float dec = misc[0];
            bf16_t* Cn = Ct + nxt * 32 * LQ;
#pragma unroll
            for (int vi = 0; vi < 2; ++vi) {
                f32x4v t4; t4[0] = 0.f; t4[1] = 0.f; t4[2] = 0.f; t4[3] = 0.f;
#pragma unroll
                for (int k0 = 0; k0 < 64; k0 += 32) t4 = MFMA16(frag_tr(Ks + k0 * LQ + wave * 16, LQ, lane), frag_tr(VWs + k0 * LV + vi * 16, LV, lane), t4);
                cacc[vi][0] = dec * cacc[vi][0] + t4[0]; cacc[vi][1] = dec * cacc[vi][1] + t4[1]; cacc[vi][2] = dec * cacc[vi][2] + t4[2]; cacc[vi][3] = dec * cacc[vi][3] + t4[3];
                u32x2 o; o.x = pack2(cacc[vi][0], cacc[vi][1]); o.y = pack2(cacc[vi][2], cacc[vi][3]);
                *(u32x2*)(Cn + (vi * 16 + li) * LQ + wave * 16 + 4 * g) = o;
            }
            if (tid < 128) {
                float a = dec * ncur[tid];
#pragma unroll 8
                for (int s = 0; s < 64; ++s) a += wsc[s] * bf2f(Ks[s * LQ + tid]);
                nnxt[tid] = a;
            }
        }
        __syncthreads();
    }
#undef MSEQ_LOAD
#undef MSEQ_STAGE
}

__device__ __forceinline__ void phase_pre1(const Params& p, char* lds) {
    int tab_hh = -1;
    GdnRaw GR;
    if ((int)blockIdx.x < 1024) gdn_pre_load(p, blockIdx.x, GR);
    for (int i = blockIdx.x; i < 2048; i += gridDim.x) {
        if (i < 1024) {
            const int hh_i = (i >> 5) & 3;
            if (hh_i != tab_hh) {
                __syncthreads();
                float* CWT = (float*)(lds + 145664);
                for (int j = threadIdx.x; j < 4 * 384; j += NT) { const int r = j / 384, cc = j % 384; CWT[j] = p.gd_conv[r * 1536 + (cc >> 7) * 512 + hh_i * 128 + (cc & 127)]; }
                __syncthreads();
                tab_hh = hh_i;
            }
            gdn_pre_item(p, lds, i, GR, (i + (int)gridDim.x < 1024) ? i + (int)gridDim.x : -1);
        } else mlstm_pre_item(p, lds, i - 1024);
    }
}

__device__ __forceinline__ void phase_mix1(const Params& p, char* lds) {
    for (int u = blockIdx.x; u < 256; u += gridDim.x) {
        const int v = u & 127, x = v & 7, j = v >> 3, pair = x * 4 + (j >> 2), bb = pair >> 2, hh = pair & 3, cg = j & 3;
        if (u < 128) gdn_seq_unit(p, lds, bb, hh, cg);
        else mlstm_seq_unit(p, lds, bb, hh, cg);
        __syncthreads();
    }
}

__device__ __forceinline__ void phase_post1(const Params& p) {
    const int tid = threadIdx.x, lane = tid & 63, wave = tid >> 6;
    unsigned char* ws = p.ws;
    bf16_t* O16 = (bf16_t*)(ws + WS_XN);
    const bf16_t* P = (const bf16_t*)(ws + WS_P);
    const int c0 = lane * 16;
    constexpr int NB = POST_NB;
    const int stride = (int)gridDim.x * 8;
    const int gcol = lane < 32 ? 1536 + c0 : 3584 + (c0 - 512);
    float cw[16];
#pragma unroll
    for (int j = 0; j < 16; ++j) cw[j] = lane < 32 ? p.gd_norm[(c0 + j) & 127] : p.ml_norm[c0 - 512 + j];
    for (int tb = blockIdx.x * 8 + wave; tb < M; tb += NB * stride) {
        int tok[NB]; u32x4 r0[NB], r1[NB], g0[NB], g1[NB];
#pragma unroll
        for (int b = 0; b < NB; ++b) {
            const int ti_ = (tb + b * stride < M) ? tb + b * stride : tb;
            tok[b] = (gridDim.x == 256) ? (((ti_ >> 3) & 7) * 2048 + ((ti_ >> 6) & 31) * 64 + (ti_ >> 11) * 8 + (ti_ & 7)) : ti_;
            r0[b] = *(const u32x4*)(O16 + (size_t)tok[b] * D + c0); r1[b] = *(const u32x4*)(O16 + (size_t)tok[b] * D + c0 + 8);
            g0[b] = *(const u32x4*)(P + (size_t)tok[b] * P1_LD + gcol); g1[b] = *(const u32x4*)(P + (size_t)tok[b] * P1_LD + gcol + 8);
        }
#pragma unroll
        for (int b = 0; b < NB; ++b) {
            if (tb + b * stride >= M) break;
            float y[16], gt[16];
            unpack8(r0[b], y); unpack8(r1[b], y + 8); unpack8(g0[b], gt); unpack8(g1[b], gt + 8);
            float q = 0.f;
#pragma unroll
            for (int j = 0; j < 16; ++j) q += y[j] * y[j];
            q += dppf<0xB1>(q); q += dppf<0x4E>(q); q += dppf<0x141>(q);
            const float rstd = rsqrtf(q * (1.0f / 128.0f) + 1e-6f);
            float o[16];
            if (lane < 32) {
#pragma unroll
                for (int j = 0; j < 16; ++j) o[j] = y[j] * rstd * cw[j] * siluf_(gt[j]);
            } else {
#pragma unroll
                for (int j = 0; j < 16; ++j) o[j] = y[j] * rstd * cw[j] * sigmoidf_(gt[j]);
            }
            u32x4 w0, w1;
            w0.x = pack2(o[0], o[1]); w0.y = pack2(o[2], o[3]); w0.z = pack2(o[4], o[5]); w0.w = pack2(o[6], o[7]);
            w1.x = pack2(o[8], o[9]); w1.y = pack2(o[10], o[11]); w1.z = pack2(o[12], o[13]); w1.w = pack2(o[14], o[15]);
            *(u32x4*)(O16 + (size_t)tok[b] * D + c0) = w0; *(u32x4*)(O16 + (size_t)tok[b] * D + c0 + 8) = w1;
        }
    }
}


#define XB_TMO      128
#define XB_XCNT(j)  (256  + 64 * (j))
#define XB_XSUB(j)  (1280 + 64 * (j))
#define XB_XGEN(j)  (2304 + 64 * (j))
#define XB_TOP      3328
#define XB_TOPGEN   3392
#define XCD_BAR_WORDS 3456
#define XB_SPIN_CAP (1u << 22)
__device__ __forceinline__ unsigned xb_ld(unsigned* p)              { return __hip_atomic_load(p, __ATOMIC_RELAXED, __HIP_MEMORY_SCOPE_AGENT); }
__device__ __forceinline__ unsigned xb_add(unsigned* p, unsigned v) { return __hip_atomic_fetch_add(p, v, __ATOMIC_RELAXED, __HIP_MEMORY_SCOPE_AGENT); }
__device__ __forceinline__ unsigned xb_xcc_id() { return (unsigned)__builtin_amdgcn_s_getreg((3 << 11) | 20) & 0xFu; }
#define XB_SPIN(cond, bar) do { unsigned _sp = 0; while (cond) { __builtin_amdgcn_s_sleep(1); \
    if ((++_sp & 255u) == 0u) { if (xb_ld(&(bar)[XB_TMO])) break; if (_sp > XB_SPIN_CAP) { atomicAdd(&(bar)[XB_TMO], 1u); break; } } } } while (0)
struct XcdBarrier { unsigned* bar; unsigned x; volatile LAS unsigned* st; };
__device__ __forceinline__ XcdBarrier xcd_barrier_post(unsigned* bar, volatile LAS unsigned* st) {
    XcdBarrier b; b.bar = bar; b.x = xb_xcc_id(); b.st = st;
    if (threadIdx.x == 0) (void)xb_add(&bar[XB_XCNT(b.x)], 1u);
    return b;
}
__device__ __forceinline__ void xcd_barrier_complete(unsigned* bar, unsigned x, unsigned& nloc, unsigned& nx) {
    const unsigned G = gridDim.x * gridDim.y * gridDim.z;
    unsigned sum, cnt, mine, sp = 0u;
    for (;;) {
        sum = 0u; cnt = 0u; mine = 0u;
#pragma unroll
        for (unsigned j = 0; j < 16; ++j) { const unsigned c = xb_ld(&bar[XB_XCNT(j)]); sum += c; cnt += (c > 0u) ? 1u : 0u; mine = (j == x) ? c : mine; }
        if (sum == G) break;
        __builtin_amdgcn_s_sleep(1);
        if ((++sp & 255u) == 0u) { if (xb_ld(&bar[XB_TMO])) break; if (sp > XB_SPIN_CAP) { atomicAdd(&bar[XB_TMO], 1u); break; } }
    }
    nloc = mine > 0u ? mine : 1u; nx = cnt > 0u ? cnt : 1u;
}
__device__ __forceinline__ void xcd_barrier(const XcdBarrier& b) {
    asm volatile("s_waitcnt vmcnt(0)" ::: "memory");
    __syncthreads();
    if (threadIdx.x == 0) {
        unsigned* bar = b.bar;
        __builtin_amdgcn_s_waitcnt(0);
        unsigned nloc = b.st[0], nx = b.st[1];
        if (nloc == 0u) { xcd_barrier_complete(bar, b.x, nloc, nx); b.st[0] = nloc; b.st[1] = nx; }
        const unsigned old = xb_add(&bar[XB_XSUB(b.x)], 1u);
        const unsigned gen = old / nloc;
        if (old + 1u == (gen + 1u) * nloc) {
            __builtin_amdgcn_fence(__ATOMIC_RELEASE, "agent");
            asm volatile("s_waitcnt vmcnt(0)" ::: "memory");
            const unsigned og = xb_add(&bar[XB_TOP], 1u);
            const unsigned tg = og / nx;
            if (og + 1u == (tg + 1u) * nx) xb_add(&bar[XB_TOPGEN], 1u);
            else XB_SPIN(xb_ld(&bar[XB_TOPGEN]) == tg, bar);
            __builtin_amdgcn_fence(__ATOMIC_ACQUIRE, "agent");
            xb_add(&bar[XB_XGEN(b.x)], 1u);
            asm volatile("s_waitcnt vmcnt(0)" ::: "memory");
        } else {
            XB_SPIN(xb_ld(&bar[XB_XGEN(b.x)]) == gen, bar);
            __builtin_amdgcn_fence(__ATOMIC_ACQUIRE, "agent");
            asm volatile("s_waitcnt vmcnt(0)" ::: "memory");
        }
    }
    __syncthreads();
}

__device__ __forceinline__ void final_row(const Params& p, int tok, int lane, float* dst  , bool nt = false) {
    const bf16_t* H16 = (const bf16_t*)((const char*)p.out + H16_OFF);
    const bf16_t* Y0 = (const bf16_t*)(p.ws + WS_P + P_Y); const bf16_t* Y1 = Y0 + (size_t)M * D;
    float4 v[4];
#pragma unroll
    for (int i = 0; i < 4; ++i) {
        const u32x2 h = *(const u32x2*)(H16 + (size_t)tok * D + i * 256 + lane * 4), a = *(const u32x2*)(Y0 + (size_t)tok * D + i * 256 + lane * 4), b = *(const u32x2*)(Y1 + (size_t)tok * D + i * 256 + lane * 4);
        v[i].x = lo16(h.x) + lo16(a.x) + lo16(b.x); v[i].y = hi16(h.x) + hi16(a.x) + hi16(b.x); v[i].z = lo16(h.y) + lo16(a.y) + lo16(b.y); v[i].w = hi16(h.y) + hi16(a.y) + hi16(b.y);
    }
    float ss = 0.f;
#pragma unroll
    for (int i = 0; i < 4; ++i) ss += v[i].x * v[i].x + v[i].y * v[i].y + v[i].z * v[i].z + v[i].w * v[i].w;
    ss = red64(ss);
    const float rstd = rsqrtf(ss * (1.0f / D) + 1e-6f);
#pragma unroll
    for (int i = 0; i < 4; ++i) { const float4 g4 = *(const float4*)(p.norm_final + i * 256 + lane * 4);
        typedef float f32x4nt __attribute__((ext_vector_type(4)));
        f32x4nt o; o.x = v[i].x * rstd * g4.x; o.y = v[i].y * rstd * g4.y; o.z = v[i].z * rstd * g4.z; o.w = v[i].w * rstd * g4.w;
        if (nt) __builtin_nontemporal_store(o, (f32x4nt*)(dst + i * 256 + lane * 4)); else *(f32x4nt*)(dst + i * 256 + lane * 4) = o; }
}
__device__ __forceinline__ void final_row2(const Params& p, int tokA, int tokB, int lane, float* dstA, float* dstB, bool nt) {
    const bf16_t* H16 = (const bf16_t*)((const char*)p.out + H16_OFF);
    const bf16_t* Y0 = (const bf16_t*)(p.ws + WS_P + P_Y); const bf16_t* Y1 = Y0 + (size_t)M * D;
    u32x2 h[2][4], a[2][4], b[2][4];
#pragma unroll
    for (int t = 0; t < 2; ++t) { const int tok = t ? tokB : tokA;
#pragma unroll
        for (int i = 0; i < 4; ++i) { h[t][i] = *(const u32x2*)(H16 + (size_t)tok * D + i * 256 + lane * 4); a[t][i] = *(const u32x2*)(Y0 + (size_t)tok * D + i * 256 + lane * 4); b[t][i] = *(const u32x2*)(Y1 + (size_t)tok * D + i * 256 + lane * 4); } }
#pragma unroll
    for (int t = 0; t < 2; ++t) {
        float* dst = t ? dstB : dstA;
        float4 v[4];
#pragma unroll
        for (int i = 0; i < 4; ++i) {
            v[i].x = lo16(h[t][i].x) + lo16(a[t][i].x) + lo16(b[t][i].x); v[i].y = hi16(h[t][i].x) + hi16(a[t][i].x) + hi16(b[t][i].x);
            v[i].z = lo16(h[t][i].y) + lo16(a[t][i].y) + lo16(b[t][i].y); v[i].w = hi16(h[t][i].y) + hi16(a[t][i].y) + hi16(b[t][i].y); }
        float ss = 0.f;
#pragma unroll
        for (int i = 0; i < 4; ++i) ss += v[i].x * v[i].x + v[i].y * v[i].y + v[i].z * v[i].z + v[i].w * v[i].w;
        ss = red64(ss);
        const float rstd = rsqrtf(ss * (1.0f / D) + 1e-6f);
#pragma unroll
        for (int i = 0; i < 4; ++i) { const float4 g4 = *(const float4*)(p.norm_final + i * 256 + lane * 4);
            typedef float f32x4nt __attribute__((ext_vector_type(4)));
            f32x4nt o; o.x = v[i].x * rstd * g4.x; o.y = v[i].y * rstd * g4.y; o.z = v[i].z * rstd * g4.z; o.w = v[i].w * rstd * g4.w;
            if (nt) __builtin_nontemporal_store(o, (f32x4nt*)(dst + i * 256 + lane * 4)); else *(f32x4nt*)(dst + i * 256 + lane * 4) = o; }
    }
}
__device__ __forceinline__ void phase_final(const Params& p, char* lds, const XcdBarrier& bar) {
    const int tid = threadIdx.x, lane = tid & 63, wave = tid >> 6, G = (int)gridDim.x, b = (int)blockIdx.x;
    float* stage = (float*)lds;
    for (int base = b * 32; base < M / 2; base += G * 32)
#pragma unroll 1
        for (int q = 0; q < 4; q += 2) { const int tok = base + wave * 4 + q; final_row2(p, tok, tok + 1, lane, p.out + (size_t)tok * D, p.out + (size_t)(tok + 1) * D, true); }
    for (int r0 = 0; r0 < M / 2; r0 += G * 32) {
        const int base = M / 2 + r0 + b * 32;
        if (base < M) {
#pragma unroll 1
            for (int q = 0; q < 4; q += 2) { const int tl = wave * 4 + q; final_row2(p, base + tl, base + tl + 1, lane, stage + tl * 1024, stage + (tl + 1) * 1024, false); }
        }
        xcd_barrier(bar);
        if (base < M) {
            for (int i = tid; i < 32 * 256; i += NT) { const int tl = i >> 8, c4 = i & 255; typedef float f32x4nt __attribute__((ext_vector_type(4)));
                __builtin_nontemporal_store(*(const f32x4nt*)(stage + tl * 1024 + c4 * 4), (f32x4nt*)(p.out + (size_t)(base + tl) * D + c4 * 4)); }
        }
        __syncthreads();
    }
}

__global__ void __launch_bounds__(NT) fwd_kernel(Params p) {
    extern __shared__ __attribute__((aligned(16))) char lds[];
    const int lo = p.ph_lo, hi = p.ph_hi;
    volatile LAS unsigned* bst = (volatile LAS unsigned*)(lds + LDS_BYTES - 16);
    if (threadIdx.x < 4) bst[threadIdx.x] = 0u;
    __syncthreads();
    XcdBarrier bar; bar.bar = (unsigned*)(p.ws + WS_CTL) + CTL_BAR; bar.x = 0; bar.st = bst;
    if (hi - lo > 1) bar = xcd_barrier_post((unsigned*)(p.ws + WS_CTL) + CTL_BAR, bst);
    if (hi > 1000) cooperative_groups::this_grid().sync();
#define IN(k) (lo <= (k) && (k) < hi)
#define SEAM(k) do { if (IN(k) && IN((k) + 1)) xcd_barrier(bar); } while (0)
#define RUN(k, ...) do { if (IN(k)) { __VA_ARGS__; if (REP_PHASE == (k)) { xcd_barrier(bar); __VA_ARGS__; } } SEAM(k); } while (0)
    RUN(1, phase_prep_router(p); phase_convert<0>(p, lds); phase_rows<0>(p, lds, 0); phase_dense_gemm<0>(p, lds));
    RUN(2, phase_pre0(p, lds));
    RUN(3, phase_mix0(p, lds));
    RUN(4, phase_post0(p); phase_convert<1>(p, lds));
    RUN(5, phase_dense_gemm<1>(p, lds));
    RUN(6, phase_rows<1>(p, lds, 0));
    RUN(7, phase_moe_merged(p, lds, 0));
    RUN(8, phase_rows<2>(p, lds, 1));
    RUN(9, phase_dense_gemm<2>(p, lds));
    RUN(10, phase_pre1(p, lds));
    RUN(11, phase_mix1(p, lds));
    RUN(12, phase_post1(p); phase_convert<2>(p, lds));
    RUN(13, phase_dense_gemm<3>(p, lds));
    RUN(14, phase_rows<1>(p, lds, 1));
    RUN(15, phase_moe_merged(p, lds, 1));
    RUN(16, phase_final(p, lds, bar));
#undef RUN
#undef IN
#undef SEAM
}

extern "C" void kernel_launch(void* const* d_in, const int* in_sizes, int n_in, void* d_out, int out_size, void* d_ws, size_t ws_size, hipStream_t stream) {
    static int ok = 0, grid = 0;
    if (ok == 0) {
        ok = 1;
        if (n_in != 35 || out_size != M * D || ws_size < WS_END) { fprintf(stderr, "kernel_launch: unexpected sizes n_in=%d out=%d ws=%zu need=%zu\n", n_in, out_size, ws_size, (size_t)WS_END); ok = -1; }
        if (hipFuncSetAttribute((const void*)fwd_kernel, hipFuncAttributeMaxDynamicSharedMemorySize, LDS_BYTES) != hipSuccess) { fprintf(stderr, "kernel_launch: hipFuncSetAttribute failed\n"); ok = -1; }
        int dev = 0, cus = 0, per_cu = 0;
        hipGetDevice(&dev); hipDeviceGetAttribute(&cus, hipDeviceAttributeMultiprocessorCount, dev);
        if (hipOccupancyMaxActiveBlocksPerMultiprocessor(&per_cu, (const void*)fwd_kernel, NT, LDS_BYTES) != hipSuccess || per_cu < 1) { fprintf(stderr, "kernel_launch: occupancy query failed (%d)\n", per_cu); per_cu = 1; }
        (void)hipGetLastError();
        grid = cus * (per_cu > 1 ? 1 : per_cu);
        if (grid > 256) grid = 256;
        if (grid < 1) ok = -1;
    }
    if (ok < 0) return;
    Params p{};
    const float** f = (const float**)&p;
    for (int i = 0; i < 35; ++i) f[i] = (const float*)d_in[i];
    p.out = (float*)d_out; p.ws = (unsigned char*)d_ws;
    (void)hipMemsetAsync((char*)d_ws + WS_CTL, 0, 163840, stream);
#if SINGLE_LAUNCH
    p.ph_lo = 0; p.ph_hi = NPHASE;
    void* args[] = {&p};
    hipError_t e = hipLaunchCooperativeKernel((const void*)fwd_kernel, dim3(grid), dim3(NT), args, LDS_BYTES, stream);
    if (e != hipSuccess) fprintf(stderr, "kernel_launch: cooperative launch failed: %s (grid %d)\n", hipGetErrorString(e), grid);
#else
    for (int ph = 0; ph < NPHASE; ++ph) {
        p.ph_lo = ph; p.ph_hi = ph + 1;
        hipLaunchKernelGGL(fwd_kernel, dim3(grid), dim3(NT), LDS_BYTES, stream, p);
    }
#endif
}
```
